# Optimizing an MI355X kernel written in HIP

```python
import math
import jax, jax.numpy as jnp
from jax import lax
import numpy as np

D_MODEL = 4096
BATCH = 1
SEQ = 8192
DEPTH = 2

A_HEADS = 16
A_KV_GROUPS = 4
A_HEADS_PER_GROUP = A_HEADS // A_KV_GROUPS
HEAD_DIM = 128
A_WIDTH = A_HEADS * HEAD_DIM
A_KV_WIDTH = A_KV_GROUPS * HEAD_DIM
L_CMP = 32
STRIDE_CMP = 16
L_SEL = 64
N_SEL = 16
WINDOW = 512
Q_BLOCK = 128
BIG = 1e9
B_GROUPS = 16
CHUNK = 128
B_WIDTH = 2048
B_GROUP_DIM = B_WIDTH // B_GROUPS
NUM_BUCKETS = 32
MAX_DISTANCE = 128
NORM_EPS = 1e-6
NEG_INF = -1e30
SPLIT_SIZES = (A_WIDTH, 6 * A_KV_WIDTH, 3 * A_HEADS, A_WIDTH, B_WIDTH, B_WIDTH, B_WIDTH, D_MODEL, D_MODEL)
IN_WIDTH = A_WIDTH + 6 * A_KV_WIDTH + 3 * A_HEADS + A_WIDTH + 3 * B_WIDTH + 2 * D_MODEL

kernel_name = "hybrid_nsa_gmlp_gated_parallel"


def rms_norm(x, g):
    xf = x.astype(jnp.float32)
    y = xf * lax.rsqrt(jnp.mean(xf * xf, axis=-1, keepdims=True) + NORM_EPS)
    return (y * g.astype(jnp.float32)).astype(x.dtype)


def masked_softmax(logits, mask):
    lf = jnp.where(mask, logits.astype(jnp.float32), NEG_INF)
    return jax.nn.softmax(lf, axis=-1)


def t5_bucket(dist):
    n = jnp.maximum(dist, 0)
    max_exact = NUM_BUCKETS // 2
    nf = jnp.maximum(n, 1).astype(jnp.float32)
    large = max_exact + (jnp.log(nf / max_exact) / math.log(MAX_DISTANCE / max_exact)
                         * (NUM_BUCKETS - max_exact)).astype(jnp.int32)
    large = jnp.minimum(large, NUM_BUCKETS - 1)
    return jnp.where(n < max_exact, n, large)


def compress(kv, pe, w1, w2):
    b, t, g, dh = kv.shape
    nc = (t - L_CMP) // STRIDE_CMP + 1
    idx = jnp.arange(nc)[:, None] * STRIDE_CMP + jnp.arange(L_CMP)[None, :]
    blk = kv[:, idx] + pe[None, None, :, None, :]
    blk = jnp.transpose(blk, (0, 1, 3, 2, 4)).reshape(b, nc, g, L_CMP * dh)
    return jax.nn.silu(blk @ w1) @ w2


def nsa_compressed(q, kc, vc, rel_bias, t_pos):
    b, t, g, r, dh = q.shape
    nc = kc.shape[1]
    blk_end = jnp.arange(nc, dtype=jnp.int32) * STRIDE_CMP + (L_CMP - 1)
    dist = t_pos[:, None] - blk_end[None, :]
    valid = dist >= 0
    bias = rel_bias[t5_bucket(dist)].reshape(t, nc, g, r).transpose(2, 3, 0, 1)
    s = jnp.einsum('btgrd,bngd->bgrtn', q, kc) * (dh ** -0.5) + bias
    any_valid = jnp.any(valid, axis=-1)[:, None].astype(jnp.float32)
    p = masked_softmax(s, valid) * any_valid
    o = jnp.einsum('bgrtn,bngd->btgrd', p.astype(vc.dtype), vc)
    return o, p


def select_blocks(p_cmp, t_pos):
    pg = p_cmp.sum(axis=2)
    nc = pg.shape[-1]
    t = t_pos.shape[0]
    ns = t // L_SEL
    m_rng = L_SEL // STRIDE_CMP
    n_rng = L_CMP // STRIDE_CMP
    offs = (jnp.arange(m_rng)[:, None] - jnp.arange(n_rng)[None, :]).reshape(-1)
    idx = m_rng * jnp.arange(ns)[:, None] + offs[None, :]
    ok = (idx >= 0) & (idx < nc)
    gathered = jnp.take(pg, jnp.clip(idx, 0, nc - 1), axis=-1)
    imp = jnp.where(ok, gathered, 0.0).sum(-1)
    jt = t_pos // L_SEL
    j = jnp.arange(ns, dtype=jnp.int32)[None, :]
    forced = (j == 0) | (j == jt[:, None]) | (j == jt[:, None] - 1)
    future = j > jt[:, None]
    score = jnp.where(forced, BIG, jnp.where(future, -1.0, imp))
    _, sel = lax.top_k(score, min(N_SEL, ns))
    return sel


def nsa_selected(q, ks, vs, sel, rel_bias, t_pos):
    b, t, g, r, dh = q.shape
    ns = t // L_SEL
    nq = t // Q_BLOCK
    n = sel.shape[-1]
    kb = ks.reshape(b, ns, L_SEL, g, dh).transpose(0, 3, 1, 2, 4)
    vb = vs.reshape(b, ns, L_SEL, g, dh).transpose(0, 3, 1, 2, 4)
    tbl = rel_bias.reshape(NUM_BUCKETS, g, r).transpose(1, 0, 2)
    qc = q.reshape(b, nq, Q_BLOCK, g, r, dh).transpose(1, 0, 2, 3, 4, 5)
    selc = sel.reshape(b, g, nq, Q_BLOCK, n).transpose(2, 0, 1, 3, 4)
    tc = t_pos.reshape(nq, Q_BLOCK)
    bi = jnp.arange(b)[:, None, None, None]
    gi = jnp.arange(g)[None, :, None, None]
    key_off = jnp.arange(L_SEL, dtype=jnp.int32)

    def block(args):
        q_b, sel_b, t_b = args
        kg = kb[bi, gi, sel_b]
        vg = vb[bi, gi, sel_b]
        pos = sel_b[..., None] * L_SEL + key_off
        dist = t_b[None, None, :, None, None] - pos
        bias = tbl[gi[..., None], t5_bucket(dist)]
        bias = jnp.moveaxis(bias, -1, 2).reshape(b, g, r, Q_BLOCK, n * L_SEL)
        s = jnp.einsum('bqgrd,bgqnld->bgrqnl', q_b, kg).reshape(b, g, r, Q_BLOCK, n * L_SEL)
        s = s * (dh ** -0.5) + bias
        valid = (dist >= 0).reshape(b, g, 1, Q_BLOCK, n * L_SEL)
        p = masked_softmax(s, valid).astype(vg.dtype)
        return jnp.einsum('bgrqk,bgqkd->bqgrd', p, vg.reshape(b, g, Q_BLOCK, n * L_SEL, dh))

    o = lax.map(block, (qc, selc, tc))
    return o.transpose(1, 0, 2, 3, 4, 5).reshape(b, t, g, r, dh)


def nsa_window(q, kw, vw, rel_bias, t_pos):
    b, t, g, r, dh = q.shape
    nb = t // Q_BLOCK
    nw = WINDOW // Q_BLOCK
    kk = (nw + 1) * Q_BLOCK
    pad = ((0, 0), (WINDOW, 0), (0, 0), (0, 0))
    kp = jnp.pad(kw, pad).reshape(b, nb + nw, Q_BLOCK, g, dh)
    vp = jnp.pad(vw, pad).reshape(b, nb + nw, Q_BLOCK, g, dh)
    blk = jnp.arange(nb)[:, None] + jnp.arange(nw + 1)[None, :]
    kband = kp[:, blk].reshape(b, nb, kk, g, dh)
    vband = vp[:, blk].reshape(b, nb, kk, g, dh)
    pos_k = ((blk - nw)[..., None] * Q_BLOCK + jnp.arange(Q_BLOCK)).reshape(nb, kk).astype(jnp.int32)
    t_q = t_pos.reshape(nb, Q_BLOCK)
    dist = t_q[:, :, None] - pos_k[:, None, :]
    valid = (dist >= 0) & (dist < WINDOW) & (pos_k >= 0)[:, None, :]
    bias = rel_bias[t5_bucket(dist)].reshape(nb, Q_BLOCK, kk, g, r).transpose(3, 4, 0, 1, 2)
    qb = q.reshape(b, nb, Q_BLOCK, g, r, dh)
    s = jnp.einsum('bnqgrd,bnkgd->bgrnqk', qb, kband) * (dh ** -0.5) + bias
    p = masked_softmax(s, valid).astype(vband.dtype)
    o = jnp.einsum('bgrnqk,bnkgd->bnqgrd', p, vband)
    return o.reshape(b, t, g, r, dh)


def gmlp_chunked(u, v, norm_g, w_s, b_s):
    b, t, _ = u.shape
    nc = t // CHUNK
    u = jax.nn.gelu(u)
    v = rms_norm(jax.nn.gelu(v), norm_g)
    vc = v.reshape(b, nc, CHUNK, B_GROUPS, B_GROUP_DIM)
    causal = jnp.tril(jnp.ones((CHUNK, CHUNK), dtype=bool))
    w = jnp.where(causal[None], w_s, 0)
    f = jnp.einsum('gpq,bcqgd->bcpgd', w, vc) + b_s.T[None, None, :, :, None]
    return u * f.reshape(b, t, B_WIDTH)


def setup_inputs(seed: int = 0) -> dict:
    key = jax.random.key(seed)
    ks = jax.random.split(key, 17)

    def nrm(k, shape, scale):
        return jax.random.normal(k, shape, jnp.float32) * scale

    lc = L_CMP * HEAD_DIM
    return {
        "x": nrm(ks[0], (BATCH, SEQ, D_MODEL), 1.0),
        "rel_bias": nrm(ks[1], (NUM_BUCKETS, A_HEADS), 0.5),
        "pre_norm": 1.0 + nrm(ks[2], (DEPTH, D_MODEL), 0.01),
        "w_in": nrm(ks[3], (DEPTH, D_MODEL, IN_WIDTH), D_MODEL ** -0.5),
        "cmp_pe_k": nrm(ks[4], (DEPTH, L_CMP, HEAD_DIM), 0.1),
        "cmp_w1_k": nrm(ks[5], (DEPTH, lc, HEAD_DIM), lc ** -0.5),
        "cmp_w2_k": nrm(ks[6], (DEPTH, HEAD_DIM, HEAD_DIM), HEAD_DIM ** -0.5),
        "cmp_pe_v": nrm(ks[7], (DEPTH, L_CMP, HEAD_DIM), 0.1),
        "cmp_w1_v": nrm(ks[8], (DEPTH, lc, HEAD_DIM), lc ** -0.5),
        "cmp_w2_v": nrm(ks[9], (DEPTH, HEAD_DIM, HEAD_DIM), HEAD_DIM ** -0.5),
        "w_out_a": nrm(ks[10], (DEPTH, A_WIDTH, D_MODEL), A_WIDTH ** -0.5),
        "sgu_norm": 1.0 + nrm(ks[11], (DEPTH, B_WIDTH), 0.01),
        "sgu_w": nrm(ks[12], (DEPTH, B_GROUPS, CHUNK, CHUNK), CHUNK ** -0.5),
        "sgu_b": 1.0 + nrm(ks[13], (DEPTH, B_GROUPS, CHUNK), 0.1),
        "w_out_b": nrm(ks[14], (DEPTH, B_WIDTH, D_MODEL), B_WIDTH ** -0.5),
        "w_out": nrm(ks[15], (DEPTH, D_MODEL, D_MODEL), D_MODEL ** -0.5),
        "post_norm": 1.0 + nrm(ks[16], (DEPTH, D_MODEL), 0.01),
    }


def reference(x, rel_bias, pre_norm, w_in, cmp_pe_k, cmp_w1_k, cmp_w2_k, cmp_pe_v,
              cmp_w1_v, cmp_w2_v, w_out_a, sgu_norm, sgu_w, sgu_b, w_out_b, w_out, post_norm):
    b, t, _ = x.shape
    g, r, dh = A_KV_GROUPS, A_HEADS_PER_GROUP, HEAD_DIM
    t_pos = jnp.arange(t, dtype=jnp.int32)
    offsets = [int(o) for o in np.cumsum(SPLIT_SIZES)[:-1]]
    for layer in range(DEPTH):
        h = rms_norm(x, pre_norm[layer])
        proj = h @ w_in[layer]
        q, kv, gates_a, z_a, u_b, v_b, z_b, m_a, m_b = jnp.split(proj, offsets, axis=-1)
        q = q.reshape(b, t, g, r, dh)
        kv = kv.reshape(b, t, 6, g, dh)
        kc = compress(kv[:, :, 0], cmp_pe_k[layer], cmp_w1_k[layer], cmp_w2_k[layer])
        vc = compress(kv[:, :, 1], cmp_pe_v[layer], cmp_w1_v[layer], cmp_w2_v[layer])
        o_cmp, p_cmp = nsa_compressed(q, kc, vc, rel_bias, t_pos)
        sel = select_blocks(p_cmp, t_pos)
        o_sel = nsa_selected(q, kv[:, :, 2], kv[:, :, 3], sel, rel_bias, t_pos)
        o_win = nsa_window(q, kv[:, :, 4], kv[:, :, 5], rel_bias, t_pos)
        ga = jax.nn.sigmoid(gates_a).reshape(b, t, g, r, 3)
        o_a = (ga[..., 0:1] * o_cmp + ga[..., 1:2] * o_sel + ga[..., 2:3] * o_win).reshape(b, t, A_WIDTH)
        y_a = (o_a * jax.nn.silu(z_a)) @ w_out_a[layer]
        o_b = gmlp_chunked(u_b, v_b, sgu_norm[layer], sgu_w[layer], sgu_b[layer])
        y_b = (o_b * jax.nn.silu(z_b)) @ w_out_b[layer]
        merged = jax.nn.sigmoid(m_a) * y_a + jax.nn.sigmoid(m_b) * y_b
        x = x + rms_norm(merged @ w_out[layer], post_norm[layer])
    return x
```

```cpp
#include <hip/hip_runtime.h>
#include <cstdio>
#include <cstdint>
namespace pg8 {
#define PG8_LAS __attribute__((address_space(3)))
typedef unsigned short bf16_t;
typedef short bf16x8 __attribute__((ext_vector_type(8)));
typedef float f32x4 __attribute__((ext_vector_type(4)));
typedef unsigned u32x4 __attribute__((ext_vector_type(4)));
constexpr int BM = 256, BK = 64, HALF = 128, HTB = HALF * BK * 2  , STAGE_BYTES = 8 * HTB, NXCD = 8, WGM = 8;

__host__ __device__ __forceinline__ int lds_byte(int r, int c) { const int st = (r >> 4) * 2 + (c >> 5), rr = r & 15, cc = c & 31, ob = rr * 64 + cc * 2; return st * 1024 + (ob ^ (((ob >> 9) & 1) << 5)); }
__host__ __device__ __forceinline__ void stage_rc(int b, int& R, int& C) { const int st = b / 1024, sb = b % 1024, swz = sb ^ (((sb >> 9) & 1) << 5); R = (st >> 1) * 16 + swz / 64; C = (st & 1) * 32 + (swz % 64) / 2; }
__host__ __device__ __forceinline__ int perm32(int rho) { const int n = rho >> 4, i = rho & 15; return 8 * (i >> 2) + 4 * n + (i & 3); }

struct Unit { int pm, pn; };
struct Gemm { const bf16_t* A; const bf16_t* Bt; int M, N, K; };

struct StaticOrder {
    int nM, nN, nwg, G, c;
    __host__ __device__ void init(int M, int N, int G_, int c_) { nM = M / BM; nN = N / BM; nwg = nM * nN; G = G_; c = c_; }
    __host__ __device__ bool next(int i, Unit& u) const {
        const long L = (long)i * G + c; if (L >= nwg) return false;
        int wgid = (int)L; { const int q = nwg / NXCD, r = nwg % NXCD, xcd = wgid % NXCD, off = wgid / NXCD; wgid = (xcd < r ? xcd * (q + 1) : r * (q + 1) + (xcd - r) * q) + off; }
        const int nig = WGM * nN, gid = wgid / nig, fm = gid * WGM, gsz = (nM - fm) < WGM ? (nM - fm) : WGM;
        u.pm = fm + ((wgid % nig) % gsz); u.pn = (wgid % nig) / gsz; return true;
    }
    __device__ __forceinline__ void a_ready(const Unit&) const {}
    __device__ __forceinline__ void done(const Unit&) const {}
};
__device__ __forceinline__ unsigned cvt_pk_bf16(float lo, float hi) { unsigned r; asm volatile("v_cvt_pk_bf16_f32 %0, %1, %2" : "=v"(r) : "v"(lo), "v"(hi)); return r; }
typedef float f32x2 __attribute__((ext_vector_type(2)));
__device__ __forceinline__ float bf_lo(unsigned u) { return __uint_as_float(u << 16); }
__device__ __forceinline__ float bf_hi(unsigned u) { return __uint_as_float(u & 0xffff0000u); }
__device__ __forceinline__ float fast_sigmoid(float x) { return __builtin_amdgcn_rcpf(1.0f + __builtin_amdgcn_exp2f(-1.4426950408889634f * x)); }
struct EpiBf16Plain {
    static constexpr bool PERM = true, AFTER_DRAIN = false;
    bf16_t* O; int ldc;
    __device__ __forceinline__ void operator()(const f32x4 (&acc)[2][2][4][2], const Unit& u, int wr, int wc, int fr, int fq) const {
        const int row0 = u.pm * BM + wr * 64 + fr, col0 = u.pn * BM + wc * 32 + 8 * fq;
#pragma unroll
        for (int ai = 0; ai < 2; ++ai)
#pragma unroll
            for (int m = 0; m < 4; ++m) { bf16_t* rowp = O + (size_t)(row0 + ai * HALF + m * 16) * ldc + col0;
#pragma unroll
                for (int bj = 0; bj < 2; ++bj) { const f32x4 v0 = acc[ai][bj][m][0], v1 = acc[ai][bj][m][1];
                    u32x4 w; w.x = cvt_pk_bf16(v0[0], v0[1]); w.y = cvt_pk_bf16(v0[2], v0[3]); w.z = cvt_pk_bf16(v1[0], v1[1]); w.w = cvt_pk_bf16(v1[2], v1[3]);
                    *(u32x4*)(rowp + bj * HALF) = w; } }
    }
};
template <bool ADD> struct EpiGate {
    static constexpr bool PERM = true, AFTER_DRAIN = false;
    bf16_t* O; int ldc; const bf16_t* Mg; int ldm; const bf16_t* Prev;
    __device__ __forceinline__ void operator()(const f32x4 (&acc)[2][2][4][2], const Unit& u, int wr, int wc, int fr, int fq) const {
        const int row0 = u.pm * BM + wr * 64 + fr, col0 = u.pn * BM + wc * 32 + 8 * fq;
#pragma unroll
        for (int ai = 0; ai < 2; ++ai)
#pragma unroll
            for (int m = 0; m < 4; ++m) { const size_t row = (size_t)(row0 + ai * HALF + m * 16);
#pragma unroll
                for (int bj = 0; bj < 2; ++bj) { const f32x4 v0 = acc[ai][bj][m][0], v1 = acc[ai][bj][m][1];
                    const u32x4 mg = *(const u32x4*)(Mg + row * ldm + col0 + bj * HALF);
                    float r[8];
                    r[0] = v0[0] * fast_sigmoid(bf_lo(mg.x)); r[1] = v0[1] * fast_sigmoid(bf_hi(mg.x)); r[2] = v0[2] * fast_sigmoid(bf_lo(mg.y)); r[3] = v0[3] * fast_sigmoid(bf_hi(mg.y));
                    r[4] = v1[0] * fast_sigmoid(bf_lo(mg.z)); r[5] = v1[1] * fast_sigmoid(bf_hi(mg.z)); r[6] = v1[2] * fast_sigmoid(bf_lo(mg.w)); r[7] = v1[3] * fast_sigmoid(bf_hi(mg.w));
                    if (ADD) { const u32x4 pv = *(const u32x4*)(Prev + row * ldc + col0 + bj * HALF);
                        r[0] += bf_lo(pv.x); r[1] += bf_hi(pv.x); r[2] += bf_lo(pv.y); r[3] += bf_hi(pv.y); r[4] += bf_lo(pv.z); r[5] += bf_hi(pv.z); r[6] += bf_lo(pv.w); r[7] += bf_hi(pv.w); }
                    u32x4 w; w.x = cvt_pk_bf16(r[0], r[1]); w.y = cvt_pk_bf16(r[2], r[3]); w.z = cvt_pk_bf16(r[4], r[5]); w.w = cvt_pk_bf16(r[6], r[7]);
                    *(u32x4*)(O + row * ldc + col0 + bj * HALF) = w; } }
    }
};
struct EpiF32Plain {
    static constexpr bool PERM = false, AFTER_DRAIN = false;
    float* C; int ldc;
    __device__ __forceinline__ void operator()(const f32x4 (&acc)[2][2][4][2], const Unit& u, int wr, int wc, int fr, int fq) const {
        const int row0 = u.pm * BM + wr * 64 + fr, col0 = u.pn * BM + wc * 32 + 4 * fq;
#pragma unroll
        for (int ai = 0; ai < 2; ++ai)
#pragma unroll
            for (int m = 0; m < 4; ++m) { float* rowp = C + (size_t)(row0 + ai * HALF + m * 16) * ldc + col0;
#pragma unroll
                for (int bj = 0; bj < 2; ++bj)
#pragma unroll
                    for (int n = 0; n < 2; ++n) *(f32x4*)(rowp + bj * HALF + n * 16) = acc[ai][bj][m][n]; }
    }
};
template <class Epi, class Sched, bool STAMP = false>
__device__ __forceinline__ void gemm_phase(PG8_LAS unsigned char* lds, const Gemm g, const Sched& S, const Epi& E, unsigned long long* stamps) {
    int tid_o = threadIdx.x; asm volatile("" : "+v"(tid_o));
    const int tid = tid_o, wid = __builtin_amdgcn_readfirstlane(tid >> 6), lane = tid & 63, wr = wid >> 2, wc = wid & 3, fr = lane & 15, fq = lane >> 4;
    const int K = g.K, nt = K / BK;
    int ts_lo = 0, ts_hi = 0, nts = 0; const unsigned long long rt_entry = STAMP ? (unsigned long long)wall_clock64() : 0ull;
#define PG8_STAMP() do { if (STAMP && wid == 0 && nts < 64) { const unsigned long long _c = (unsigned long long)clock64(); \
        ts_lo = (lane == nts) ? (int)(unsigned)_c : ts_lo; ts_hi = (lane == nts) ? (int)(unsigned)(_c >> 32) : ts_hi; ++nts; } } while (0)
    PG8_STAMP();
    unsigned voffA[2], voffB[2];
#pragma unroll
    for (int i = 0; i < 2; ++i) { int R, C; stage_rc(tid * 16 + i * 8192, R, C); const int Rb = Epi::PERM ? ((R & ~31) + perm32(R & 31)) : R;
        voffA[i] = (unsigned)(R * K + C) * 2u; voffB[i] = (unsigned)(Rb * K + C) * 2u; }
    const size_t kstep = (size_t)(BK * 2);
    const size_t hstep = (size_t)HALF * K * 2;
    const size_t tstep = 2 * hstep;
    const unsigned ldsw = (unsigned)wid * 1024u;
    const int aoff = lds_byte(wr * 64 + fr, fq * 8), boff = lds_byte(wc * 32 + fr, fq * 8);
#define PG8_SA(b, h) (((b) * 2 + (h)) * HTB)
#define PG8_SB(b, h) ((4 + (b) * 2 + (h)) * HTB)
#define PG8_STAGE(bufoff, gbase, voff) do { _Pragma("unroll") for (int _i = 0; _i < 2; ++_i) \
        __builtin_amdgcn_global_load_lds((const unsigned*)((const char*)(gbase) + (voff)[_i]), (PG8_LAS unsigned*)(lds + (bufoff) + ldsw + _i * 8192), 16, 0, 0); } while (0)
#define PG8_LDA(dst, b, h) do { _Pragma("unroll") for (int m = 0; m < 4; ++m) _Pragma("unroll") for (int k = 0; k < 2; ++k) dst[m][k] = *(const PG8_LAS bf16x8*)(lds + PG8_SA(b, h) + aoff + m * 2048 + k * 1024); } while (0)
#define PG8_LDB(dst, b, h) do { _Pragma("unroll") for (int n = 0; n < 2; ++n) _Pragma("unroll") for (int k = 0; k < 2; ++k) dst[n][k] = *(const PG8_LAS bf16x8*)(lds + PG8_SB(b, h) + boff + n * 2048 + k * 1024); } while (0)
#define PG8_MMA(ai, bj, At, Bt) do { __builtin_amdgcn_s_setprio(1); _Pragma("unroll") for (int m = 0; m < 4; ++m) _Pragma("unroll") for (int n = 0; n < 2; ++n) _Pragma("unroll") for (int k = 0; k < 2; ++k) \
        acc[ai][bj][m][n] = __builtin_amdgcn_mfma_f32_16x16x32_bf16(Bt[n][k], At[m][k], acc[ai][bj][m][n], 0, 0, 0); __builtin_amdgcn_s_setprio(0); } while (0)
#define PG8_WAIT_V(n) asm volatile("s_waitcnt vmcnt(" #n ")" ::: "memory")
#define PG8_WAIT_L(n) asm volatile("s_waitcnt lgkmcnt(" #n ")" ::: "memory")
#define PG8_BAR __builtin_amdgcn_s_barrier()
#define PG8_SCHED __builtin_amdgcn_sched_barrier(0)
    Unit cur, nxt; int ui = 0;
    if (!S.next(0, cur)) return;
    f32x4 acc[2][2][4][2];
#pragma unroll
    for (int a = 0; a < 2; ++a)
#pragma unroll
        for (int b = 0; b < 2; ++b)
#pragma unroll
            for (int m = 0; m < 4; ++m)
#pragma unroll
                for (int n = 0; n < 2; ++n) acc[a][b][m][n] = (f32x4){0.f, 0.f, 0.f, 0.f};
    bf16x8 At[4][2], B0[2][2], B1[2][2];
    const char* cA = (const char*)g.A + (size_t)cur.pm * tstep; const char* cB = (const char*)g.Bt + (size_t)cur.pn * tstep;
    S.a_ready(cur);
    PG8_STAGE(PG8_SB(0, 0), cB, voffB); PG8_STAGE(PG8_SA(0, 0), cA, voffA); PG8_STAGE(PG8_SB(0, 1), cB + hstep, voffB); PG8_STAGE(PG8_SA(0, 1), cA + hstep, voffA);
    if (wr == 1) PG8_BAR;
    PG8_WAIT_V(4); PG8_BAR;
    PG8_STAGE(PG8_SB(1, 0), cB + kstep, voffB); PG8_STAGE(PG8_SA(1, 0), cA + kstep, voffA); PG8_STAGE(PG8_SB(1, 1), cB + hstep + kstep, voffB);
    PG8_WAIT_V(6); PG8_BAR;
    PG8_STAMP();
    for (;;) {
        const bool has_next = S.next(ui + 1, nxt);
        const char* nA = has_next ? (const char*)g.A + (size_t)nxt.pm * tstep : cA; const char* nB = has_next ? (const char*)g.Bt + (size_t)nxt.pn * tstep : cB;
        for (int t = 0; t < nt; t += 2) {
            const bool last = (t == nt - 2);
            const char* a1 = cA + (size_t)(t + 1) * kstep;
            const char* a2 = last ? nA : cA + (size_t)(t + 2) * kstep; const char* b2 = last ? nB : cB + (size_t)(t + 2) * kstep;
            const char* a3 = a2 + kstep; const char* b3 = b2 + kstep;
            if (last && has_next) S.a_ready(nxt);
            PG8_LDB(B0, 0, 0); PG8_SCHED; PG8_LDA(At, 0, 0); PG8_STAGE(PG8_SA(1, 1), a1 + hstep, voffA);
            PG8_WAIT_L(8); PG8_BAR; PG8_WAIT_L(0); PG8_MMA(0, 0, At, B0); PG8_BAR; PG8_SCHED;
            PG8_LDB(B1, 0, 1); PG8_STAGE(PG8_SB(0, 0), b2, voffB);
            PG8_BAR; PG8_WAIT_L(0); PG8_MMA(0, 1, At, B1); PG8_BAR;
            PG8_LDA(At, 0, 1); PG8_STAGE(PG8_SA(0, 0), a2, voffA);
            PG8_BAR; PG8_WAIT_L(0); PG8_MMA(1, 0, At, B0); PG8_BAR; PG8_SCHED;
            PG8_STAGE(PG8_SB(0, 1), b2 + hstep, voffB);
            PG8_WAIT_V(6); PG8_BAR; PG8_MMA(1, 1, At, B1); PG8_BAR;
            PG8_LDB(B0, 1, 0); PG8_SCHED; PG8_LDA(At, 1, 0); PG8_STAGE(PG8_SA(0, 1), a2 + hstep, voffA);
            PG8_WAIT_L(8); PG8_BAR; PG8_WAIT_L(0); PG8_MMA(0, 0, At, B0); PG8_BAR; PG8_SCHED;
            PG8_LDB(B1, 1, 1); PG8_STAGE(PG8_SB(1, 0), b3, voffB);
            PG8_BAR; PG8_WAIT_L(0); PG8_MMA(0, 1, At, B1); PG8_BAR;
            PG8_LDA(At, 1, 1); PG8_STAGE(PG8_SA(1, 0), a3, voffA);
            PG8_BAR; PG8_WAIT_L(0); PG8_MMA(1, 0, At, B0); PG8_BAR; PG8_SCHED;
            PG8_STAGE(PG8_SB(1, 1), b3 + hstep, voffB);
            PG8_WAIT_V(6); PG8_BAR; PG8_MMA(1, 1, At, B1); PG8_BAR;
        }
        PG8_STAMP();
        if constexpr (!Epi::AFTER_DRAIN) { E(acc, cur, wr, wc, fr, fq); S.done(cur); }
        PG8_STAMP();
        if (!has_next) break;
#pragma unroll
        for (int a = 0; a < 2; ++a)
#pragma unroll
            for (int b = 0; b < 2; ++b)
#pragma unroll
                for (int m = 0; m < 4; ++m)
#pragma unroll
                    for (int n = 0; n < 2; ++n) acc[a][b][m][n] = (f32x4){0.f, 0.f, 0.f, 0.f};
        cur = nxt; cA = nA; cB = nB; ++ui;
    }
    PG8_WAIT_V(0);
    if (wr == 0) PG8_BAR;
    PG8_BAR;
    if constexpr (Epi::AFTER_DRAIN) { E.fused(acc, cur, wr, wc, fr, fq, lds, wid, lane); S.done(cur); }
    PG8_STAMP();
    if (STAMP && wid == 0) { stamps[lane] = lane < nts ? (((unsigned long long)(unsigned)ts_hi << 32) | (unsigned)ts_lo) : 0ull;
        if (lane == 62) stamps[62] = rt_entry; if (lane == 63) stamps[63] = (unsigned long long)wall_clock64(); }
#undef PG8_STAMP
#undef PG8_SA
#undef PG8_SB
#undef PG8_STAGE
#undef PG8_LDA
#undef PG8_LDB
#undef PG8_MMA
#undef PG8_WAIT_V
#undef PG8_WAIT_L
#undef PG8_BAR
#undef PG8_SCHED
}
}

#define XB_TMO      128
#define XB_XCNT(j)  (256  + 64 * (j))
#define XB_XSUB(j)  (1280 + 64 * (j))
#define XB_XGEN(j)  (2304 + 64 * (j))
#define XB_TOP      3328
#define XB_TOPGEN   3392
#define XCD_BAR_WORDS 3456
#define XB_SPIN_CAP (1u << 18)
#define LAS __attribute__((address_space(3)))

__device__ __forceinline__ unsigned xb_ld(unsigned* p)              { return __hip_atomic_load(p, __ATOMIC_RELAXED, __HIP_MEMORY_SCOPE_AGENT); }
__device__ __forceinline__ unsigned xb_add(unsigned* p, unsigned v) { return __hip_atomic_fetch_add(p, v, __ATOMIC_RELAXED, __HIP_MEMORY_SCOPE_AGENT); }
__device__ __forceinline__ unsigned xb_xcc_id() { return (unsigned)__builtin_amdgcn_s_getreg((3 << 11) | 20) & 0xFu; }
#define XB_SPIN(cond, bar) do { unsigned _sp = 0; while (cond) { __builtin_amdgcn_s_sleep(1); \
    if ((++_sp & 255u) == 0u) { if (xb_ld(&(bar)[XB_TMO])) break; if (_sp > XB_SPIN_CAP) { atomicAdd(&(bar)[XB_TMO], 1u); break; } } } } while (0)

struct XcdBarrier {
    unsigned* bar; unsigned x;
    volatile LAS unsigned* st;
};

__device__ __forceinline__ XcdBarrier xcd_barrier_post(unsigned* bar, volatile LAS unsigned* st) {
    XcdBarrier b; b.bar = bar; b.x = xb_xcc_id(); b.st = st;
    if (threadIdx.x == 0) (void)xb_add(&bar[XB_XCNT(b.x)], 1u);
    return b;
}
__device__ __forceinline__ void xcd_barrier_complete(unsigned* bar, unsigned x, unsigned& nloc, unsigned& nx) {
    const unsigned G = gridDim.x * gridDim.y * gridDim.z;
    unsigned sum, cnt, mine, sp = 0u;
    for (;;) {
        sum = 0u; cnt = 0u; mine = 0u;
#pragma unroll
        for (unsigned j = 0; j < 16; ++j) { const unsigned c = xb_ld(&bar[XB_XCNT(j)]); sum += c; cnt += (c > 0u) ? 1u : 0u; mine = (j == x) ? c : mine; }
        if (sum == G) break;
        __builtin_amdgcn_s_sleep(1);
        if ((++sp & 255u) == 0u) { if (xb_ld(&bar[XB_TMO])) break; if (sp > XB_SPIN_CAP) { atomicAdd(&bar[XB_TMO], 1u); break; } }
    }
    nloc = mine > 0u ? mine : 1u; nx = cnt > 0u ? cnt : 1u;
}

__device__ __forceinline__ void xcd_barrier(const XcdBarrier& b) {
    asm volatile("s_waitcnt vmcnt(0)" ::: "memory");
    __syncthreads();
    if (threadIdx.x == 0) {
        unsigned* bar = b.bar;
        __builtin_amdgcn_s_waitcnt(0);
        unsigned nloc = b.st[0], nx = b.st[1];
        if (nloc == 0u) { xcd_barrier_complete(bar, b.x, nloc, nx); b.st[0] = nloc; b.st[1] = nx; }
        const unsigned old = xb_add(&bar[XB_XSUB(b.x)], 1u);
        const unsigned gen = old / nloc;
        if (old + 1u == (gen + 1u) * nloc) {
            __builtin_amdgcn_fence(__ATOMIC_RELEASE, "agent");
            asm volatile("s_waitcnt vmcnt(0)" ::: "memory");
            const unsigned og = xb_add(&bar[XB_TOP], 1u);
            const unsigned tg = og / nx;
            if (og + 1u == (tg + 1u) * nx) xb_add(&bar[XB_TOPGEN], 1u);
            else XB_SPIN(xb_ld(&bar[XB_TOPGEN]) == tg, bar);
            __builtin_amdgcn_fence(__ATOMIC_ACQUIRE, "agent");
            xb_add(&bar[XB_XGEN(b.x)], 1u);
            asm volatile("s_waitcnt vmcnt(0)" ::: "memory");
        } else {
            XB_SPIN(xb_ld(&bar[XB_XGEN(b.x)]) == gen, bar);
            __builtin_amdgcn_fence(__ATOMIC_ACQUIRE, "agent");
            asm volatile("s_waitcnt vmcnt(0)" ::: "memory");
        }
    }
    __syncthreads();
}
typedef pg8::bf16_t bf16_t;
typedef short bf16x8 __attribute__((ext_vector_type(8)));
typedef short s16x4 __attribute__((ext_vector_type(4)));
typedef float f32x4 __attribute__((ext_vector_type(4)));
typedef float f32x16 __attribute__((ext_vector_type(16)));
typedef unsigned u32x4 __attribute__((ext_vector_type(4)));
typedef unsigned u32x2 __attribute__((ext_vector_type(2)));
constexpr int T = 8192, DM = 4096, NIN = 21552, NP = 21760, DEPTH = 2, NWAVES = 8, NTHREADS = 512;
constexpr int C_Q = 0, C_KV = 2048, C_ZA = 5120, C_UB = 7168, C_VB = 9216, C_ZB = 11264, C_MA = 13312, C_MB = 17408, C_GA = 21504;
constexpr int AW = 2048, BW = 2048, HD = 128, NCMP = 511, NCP = 512;
constexpr float NORM_EPS = 1e-6f;
constexpr size_t al256(size_t x) { return (x + 255) & ~(size_t)255; }
constexpr size_t WS_CTL = 0, CTL_BYTES = 1u << 20;
constexpr size_t SZ_WIN = (size_t)NP * DM * 2, SZ_WAB = (size_t)DM * AW * 2, SZ_WO = (size_t)DM * DM * 2, SZ_W1 = (size_t)HD * 4096 * 2, SZ_W2 = (size_t)HD * HD * 2;
constexpr size_t WS_WIN = WS_CTL + CTL_BYTES;
constexpr size_t WS_WA = WS_WIN + DEPTH * SZ_WIN;
constexpr size_t WS_WB = WS_WA + DEPTH * SZ_WAB;
constexpr size_t WS_WO = WS_WB + DEPTH * SZ_WAB;
constexpr size_t WS_W1 = WS_WO + DEPTH * SZ_WO;
constexpr size_t WS_W2 = WS_W1 + DEPTH * 2 * SZ_W1;
constexpr size_t WS_H = al256(WS_W2 + DEPTH * 2 * SZ_W2);
constexpr size_t WS_PROJ = WS_H + (size_t)T * DM * 2;
constexpr size_t WS_KC = WS_PROJ + (size_t)T * NP * 2;
constexpr size_t WS_VC = WS_KC + (size_t)NCP * 512 * 2;
constexpr size_t WS_OA = WS_VC + (size_t)NCP * 512 * 2;
constexpr size_t WS_OB = WS_OA + (size_t)T * AW * 2;
constexpr size_t WS_T1 = WS_OB + (size_t)T * BW * 2;
constexpr size_t WS_MG = WS_T1 + (size_t)T * DM * 2;
constexpr size_t WS_Y = WS_MG + (size_t)T * DM * 2;
constexpr size_t WS_X1 = WS_Y + (size_t)T * DM * 4;
constexpr size_t WS_END = WS_X1 + (size_t)T * DM * 4;
constexpr int LDS_STAGE = 0;
constexpr int LDS_BIAS = 131072;
constexpr int LDS_MISC = LDS_BIAS + 16 * 256 * 4;
constexpr int LDS_BYTES = LDS_MISC + 64;
#define LAS3 __attribute__((address_space(3)))
#define LDS_WAIT() asm volatile("s_waitcnt lgkmcnt(0)" ::: "memory")
#define VM_WAIT() asm volatile("s_waitcnt vmcnt(0)" ::: "memory")

struct Params {
    const float *x, *rel_bias, *pre_norm, *w_in, *pe_k, *w1_k, *w2_k, *pe_v, *w1_v, *w2_v, *w_out_a, *sgu_norm, *sgu_w, *sgu_b, *w_out_b, *w_out, *post_norm;
    float* out; unsigned char* ws; int ph_lo, ph_hi;
};
__device__ __forceinline__ unsigned pk2(float lo, float hi) { return pg8::cvt_pk_bf16(lo, hi); }
__device__ __forceinline__ float wave_sum(float v) {
#pragma unroll
    for (int o = 1; o < 64; o <<= 1) v += __shfl_xor(v, o);
    return v;
}
__device__ const unsigned char BUCKET[128] = {0, 1, 2, 3, 4, 5, 6, 7, 8, 9, 10, 11, 12, 13, 14, 15, 16, 16, 16, 17, 17, 18, 18, 18, 19, 19, 19, 20, 20, 20, 20, 21, 21, 21, 21, 22, 22, 22, 22, 22, 23, 23, 23, 23, 23, 23, 24, 24, 24, 24, 24, 24, 25, 25, 25, 25, 25, 25, 25, 26, 26, 26, 26, 26, 26, 26, 26, 27, 27, 27, 27, 27, 27, 27, 27, 27, 27, 28, 28, 28, 28, 28, 28, 28, 28, 28, 28, 29, 29, 29, 29, 29, 29, 29, 29, 29, 29, 29, 29, 30, 30, 30, 30, 30, 30, 30, 30, 30, 30, 30, 30, 30, 30, 31, 31, 31, 31, 31, 31, 31, 31, 31, 31, 31, 31, 31, 31, 31};

__device__ __forceinline__ int srcmap_in(int n) { return n < 5120 ? n : (n < 21504 ? n + 48 : (n < 21552 ? n - 21504 + 5120 : -1)); }
template <bool REMAP>
__device__ __forceinline__ void transpose_item(const float* __restrict__ W, int K, int N, bf16_t* __restrict__ WT, LAS3 float* scr, int item, int nblk, int lane) {
    const int kb = item / nblk, nb = item - kb * nblk, k0 = 64 * kb, n0 = 32 * nb;
    const int nn = n0 + (lane & 31); const int s = REMAP ? srcmap_in(nn) : nn;
    const float* src = W + (size_t)(k0 + (lane >> 5)) * N + (s >= 0 ? s : 0);
#pragma unroll 8
    for (int i = 0; i < 32; ++i) { const float v = src[(size_t)(2 * i) * N]; scr[(2 * i + (lane >> 5)) * 33 + (lane & 31)] = (s >= 0) ? v : 0.f; }
    LDS_WAIT();
    const int c = lane & 7;
#pragma unroll
    for (int j = 0; j < 4; ++j) { const int n = (lane >> 3) + 8 * j; const LAS3 float* p = scr + (8 * c) * 33 + n;
        u32x4 o; o.x = pk2(p[0 * 33], p[1 * 33]); o.y = pk2(p[2 * 33], p[3 * 33]); o.z = pk2(p[4 * 33], p[5 * 33]); o.w = pk2(p[6 * 33], p[7 * 33]);
        *(u32x4*)(WT + (size_t)(n0 + n) * K + k0 + 8 * c) = o; }
    LDS_WAIT();
}
__device__ __forceinline__ void phase_weights(const Params& P, LAS3 unsigned char* lds, int gw, int NGW, int wave, int lane) {
    asm volatile("" : "+v"(lane));
    LAS3 float* scr = (LAS3 float*)(lds + LDS_STAGE + wave * 16384);
    constexpr int I_IN = 64 * (NP / 32), I_AB = 32 * 128, I_O = 64 * 128, I_W1 = 64 * 4, I_W2 = 2 * 4;
    constexpr int PER_LAYER = I_IN + 2 * I_AB + I_O + 2 * I_W1 + 2 * I_W2;
    for (int it = gw; it < DEPTH * PER_LAYER; it += NGW) {
        const int L = it / PER_LAYER; int r = it - L * PER_LAYER;
        unsigned char* ws = P.ws;
        if (r < I_IN) { transpose_item<true>(P.w_in + (size_t)L * DM * NIN, DM, NIN, (bf16_t*)(ws + WS_WIN + L * SZ_WIN), scr, r, NP / 32, lane); continue; } r -= I_IN;
        if (r < I_AB) { transpose_item<false>(P.w_out_a + (size_t)L * AW * DM, AW, DM, (bf16_t*)(ws + WS_WA + L * SZ_WAB), scr, r, 128, lane); continue; } r -= I_AB;
        if (r < I_AB) { transpose_item<false>(P.w_out_b + (size_t)L * BW * DM, BW, DM, (bf16_t*)(ws + WS_WB + L * SZ_WAB), scr, r, 128, lane); continue; } r -= I_AB;
        if (r < I_O) { transpose_item<false>(P.w_out + (size_t)L * DM * DM, DM, DM, (bf16_t*)(ws + WS_WO + L * SZ_WO), scr, r, 128, lane); continue; } r -= I_O;
        if (r < I_W1) { transpose_item<false>(P.w1_k + (size_t)L * 4096 * HD, 4096, HD, (bf16_t*)(ws + WS_W1 + (L * 2 + 0) * SZ_W1), scr, r, 4, lane); continue; } r -= I_W1;
        if (r < I_W1) { transpose_item<false>(P.w1_v + (size_t)L * 4096 * HD, 4096, HD, (bf16_t*)(ws + WS_W1 + (L * 2 + 1) * SZ_W1), scr, r, 4, lane); continue; } r -= I_W1;
        if (r < I_W2) { transpose_item<false>(P.w2_k + (size_t)L * HD * HD, HD, HD, (bf16_t*)(ws + WS_W2 + (L * 2 + 0) * SZ_W2), scr, r, 4, lane); continue; } r -= I_W2;
        transpose_item<false>(P.w2_v + (size_t)L * HD * HD, HD, HD, (bf16_t*)(ws + WS_W2 + (L * 2 + 1) * SZ_W2), scr, r, 4, lane);
    }
}
__device__ __forceinline__ void phase_prenorm(const float* __restrict__ x, const float* __restrict__ g, bf16_t* __restrict__ h, int gw, int NGW, int lane) {
    asm volatile("" : "+v"(lane));
    for (int m = gw; m < T; m += NGW) {
        const f32x4* xr = (const f32x4*)(x + (size_t)m * DM) + lane; f32x4 v[16]; float ss = 0.f;
#pragma unroll
        for (int j = 0; j < 16; ++j) { v[j] = xr[64 * j]; ss += (v[j][0] * v[j][0] + v[j][1] * v[j][1]) + (v[j][2] * v[j][2] + v[j][3] * v[j][3]); }
        const float rs = 1.0f / sqrtf(wave_sum(ss) * (1.0f / DM) + NORM_EPS);
        u32x2* o = (u32x2*)(h + (size_t)m * DM) + lane; const f32x4* gr = (const f32x4*)g + lane;
#pragma unroll
        for (int j = 0; j < 16; ++j) { const f32x4 gg = gr[64 * j]; u32x2 w; w.x = pk2(v[j][0] * rs * gg[0], v[j][1] * rs * gg[1]); w.y = pk2(v[j][2] * rs * gg[2], v[j][3] * rs * gg[3]); o[64 * j] = w; }
    }
}
__device__ __forceinline__ void phase_postnorm(const float* __restrict__ Y, const float* __restrict__ xold, const float* __restrict__ gpost, float* __restrict__ xnew,
                                               const float* __restrict__ gpre, bf16_t* __restrict__ h, bool next, int gw, int NGW, int lane) {
    asm volatile("" : "+v"(lane));
    for (int m = gw; m < T; m += NGW) {
        const f32x4* yr = (const f32x4*)(Y + (size_t)m * DM) + lane; f32x4 v[16]; float ss = 0.f;
#pragma unroll
        for (int j = 0; j < 16; ++j) { v[j] = yr[64 * j]; ss += (v[j][0] * v[j][0] + v[j][1] * v[j][1]) + (v[j][2] * v[j][2] + v[j][3] * v[j][3]); }
        const float rs = 1.0f / sqrtf(wave_sum(ss) * (1.0f / DM) + NORM_EPS);
        const f32x4* xr = (const f32x4*)(xold + (size_t)m * DM) + lane; const f32x4* gr = (const f32x4*)gpost + lane; f32x4* xo = (f32x4*)(xnew + (size_t)m * DM) + lane;
        float s2 = 0.f;
#pragma unroll
        for (int j = 0; j < 16; ++j) { const f32x4 gg = gr[64 * j], xx = xr[64 * j]; f32x4 r = xx + v[j] * rs * gg; v[j] = r; xo[64 * j] = r; s2 += (r[0] * r[0] + r[1] * r[1]) + (r[2] * r[2] + r[3] * r[3]); }
        if (next) {
            const float rs2 = 1.0f / sqrtf(wave_sum(s2) * (1.0f / DM) + NORM_EPS);
            u32x2* o = (u32x2*)(h + (size_t)m * DM) + lane; const f32x4* g2 = (const f32x4*)gpre + lane;
#pragma unroll
            for (int j = 0; j < 16; ++j) { const f32x4 gg = g2[64 * j]; u32x2 w; w.x = pk2(v[j][0] * rs2 * gg[0], v[j][1] * rs2 * gg[1]); w.y = pk2(v[j][2] * rs2 * gg[2], v[j][3] * rs2 * gg[3]); o[64 * j] = w; }
        }
    }
}
namespace att {
constexpr float SCALE = 0.08838834764831845f, LOG2E = 1.4426950408889634f, C2 = SCALE * LOG2E;
constexpr int SHM = 16384;
constexpr int L_V = 0, L_K = 2 * SHM, L_IMP = 4 * SHM, L_SEL = L_IMP + 32768, L_WS = L_SEL + 1024, L_SC = L_WS + 2048, L_END = L_SC + 4096;
static_assert(L_END <= 131072, "attention LDS");
#define KSWZ(row, colB) ((row) * 256 + ((colB) ^ (((row) & 7) << 4)))
#define SBAR() __builtin_amdgcn_sched_barrier(0)
__device__ __forceinline__ int v_st(int k, int c) { const int kk = (k & ~0xC) | ((k & 4) << 1) | ((k & 8) >> 1); return ((kk >> 3) * 4 + (c >> 5)) * 512 + ((kk & 7) * 32 + (c & 31)) * 2; }
__device__ __forceinline__ int v_rd_base(int lane) { return ((lane & 3) << 3) | (((lane >> 2) & 3) << 6) | (((lane >> 4) & 1) << 5) | (((lane >> 5) & 1) << 8); }
constexpr int v_rd_off(int d0, int ks, int half) { return d0 * 512 + ks * 4096 + half * 2048; }
__device__ __forceinline__ int crow(int r, int hi) { return (r & 3) + 8 * (r >> 2) + 4 * hi; }
__device__ __forceinline__ unsigned cvtpk(float lo, float hi) { unsigned r; asm volatile("v_cvt_pk_bf16_f32 %0, %1, %2" : "=v"(r) : "v"(lo), "v"(hi)); return r; }
enum { MODE_STAT = 0, MODE_IMP = 1, MODE_ONLINE = 2, MODE_ACC = 3 };

struct Ctx {
    bf16x8 qr[8]; f32x16 o[4];
    int tq, r32, hi, wid, lane, tid, t0;
    const LAS3 float* tb; float bfar;
    LAS3 char* lds;
};
__device__ __forceinline__ void qkt(f32x16& p0, f32x16& p1, const LAS3 char* Kt, int r32, int hi, const bf16x8* qr) {
    p0 = f32x16{}; p1 = f32x16{};
    const LAS3 char* kb[4];
#pragma unroll
    for (int dd = 0; dd < 4; ++dd) kb[dd] = Kt + KSWZ(r32, (dd * 16 + hi * 8) * 2);
#pragma unroll
    for (int d0 = 0; d0 < 8; ++d0) { const LAS3 char* a = kb[d0 & 3] + (d0 >> 2) * 128;
        const bf16x8 b0 = *reinterpret_cast<const LAS3 bf16x8*>(a);
        const bf16x8 b1 = *reinterpret_cast<const LAS3 bf16x8*>(a + 32 * 256);
        p0 = __builtin_amdgcn_mfma_f32_32x32x16_bf16(b0, qr[d0], p0, 0, 0, 0);
        p1 = __builtin_amdgcn_mfma_f32_32x32x16_bf16(b1, qr[d0], p1, 0, 0, 0);
        if ((d0 & 1) == 1) SBAR(); }
}
__device__ __forceinline__ void pv_tile(f32x16* o, int vb0, bf16x8 pa0, bf16x8 pa1, bf16x8 pa2, bf16x8 pa3) {
#define TRRD(dst, off) asm volatile("ds_read_b64_tr_b16 %0, %1 offset:%2" : "=&v"(dst) : "v"(vb0), "i"(off) : "memory")
#define PV_D0(d0) do { s16x4 l0, l1, l2, l3, h0, h1, h2, h3; constexpr int b_ = v_rd_off(d0, 0, 0); \
        TRRD(l0, b_); TRRD(h0, b_ + 2048); TRRD(l1, b_ + 4096); TRRD(h1, b_ + 6144); TRRD(l2, b_ + 8192); TRRD(h2, b_ + 10240); TRRD(l3, b_ + 12288); TRRD(h3, b_ + 14336); \
        asm volatile("s_waitcnt lgkmcnt(0)" ::: "memory"); SBAR(); \
        o[d0] = __builtin_amdgcn_mfma_f32_32x32x16_bf16(pa0, (bf16x8){l0[0], l0[1], l0[2], l0[3], h0[0], h0[1], h0[2], h0[3]}, o[d0], 0, 0, 0); \
        o[d0] = __builtin_amdgcn_mfma_f32_32x32x16_bf16(pa1, (bf16x8){l1[0], l1[1], l1[2], l1[3], h1[0], h1[1], h1[2], h1[3]}, o[d0], 0, 0, 0); \
        o[d0] = __builtin_amdgcn_mfma_f32_32x32x16_bf16(pa2, (bf16x8){l2[0], l2[1], l2[2], l2[3], h2[0], h2[1], h2[2], h2[3]}, o[d0], 0, 0, 0); \
        o[d0] = __builtin_amdgcn_mfma_f32_32x32x16_bf16(pa3, (bf16x8){l3[0], l3[1], l3[2], l3[3], h3[0], h3[1], h3[2], h3[3]}, o[d0], 0, 0, 0); } while (0)
    PV_D0(0); PV_D0(1); PV_D0(2); PV_D0(3);
#undef PV_D0
#undef TRRD
}
__device__ __forceinline__ void pack_p(const f32x16& p0, const f32x16& p1, bf16x8& pa0, bf16x8& pa1, bf16x8& pa2, bf16x8& pa3) {
#define PK4(P, B_, OUT) do { unsigned a0 = cvtpk(P[B_+0], P[B_+1]), a1 = cvtpk(P[B_+2], P[B_+3]); \
        unsigned b0 = cvtpk(P[B_+4], P[B_+5]), b1 = cvtpk(P[B_+6], P[B_+7]); \
        auto r0 = __builtin_amdgcn_permlane32_swap(a0, b0, false, false); auto r1 = __builtin_amdgcn_permlane32_swap(a1, b1, false, false); \
        u32x4 w = {r0[0], r1[0], r0[1], r1[1]}; OUT = *reinterpret_cast<bf16x8*>(&w); } while (0)
    PK4(p0, 0, pa0); PK4(p0, 8, pa1); PK4(p1, 0, pa2); PK4(p1, 8, pa3);
#undef PK4
}
__device__ __forceinline__ float half_max(float v) { auto rr = __builtin_amdgcn_permlane32_swap(__float_as_uint(v), __float_as_uint(v), false, false); return fmaxf(__uint_as_float(rr[0]), __uint_as_float(rr[1])); }
__device__ __forceinline__ float half_sum(float v) { auto rr = __builtin_amdgcn_permlane32_swap(__float_as_uint(v), __float_as_uint(v), false, false); return __uint_as_float(rr[0]) + __uint_as_float(rr[1]); }

template <int MODE, int STEP, int OFF, bool ROWSEL>
__device__ __forceinline__ void run_pass(Ctx& c, const bf16_t* __restrict__ Kg, const bf16_t* __restrict__ Vg, int ldk, int j_lo, int j_hi, unsigned W,
                                         float& m_reg, float& l_reg, float pscale, unsigned sm0, unsigned sm1, unsigned sm2, unsigned sm3) {
    constexpr bool HASV = (MODE == MODE_ONLINE || MODE == MODE_ACC);
    int tid = c.tid, r32 = c.r32, hi = c.hi, lane = c.lane;
    asm volatile("" : "+v"(tid), "+v"(r32), "+v"(hi), "+v"(lane));
    LAS3 char* V_lds = c.lds + L_V; LAS3 char* K_lds = c.lds + L_K;
    LAS3 float* wsf = (LAS3 float*)(c.lds + L_WS) + c.wid * 64; LAS3 float* al_l = wsf + 32;
    const int krow = tid >> 4;
    const unsigned ko0 = (unsigned)(krow * ldk + (((tid & 15) ^ (krow & 7)) * 8)) * 2u;
    const int vkk = ((tid >> 7) * 8) + ((tid & 31) >> 2), vkey = (vkk & ~0xC) | ((vkk & 4) << 1) | ((vkk & 8) >> 1), vcol = ((tid >> 5) & 3) * 32 + (tid & 3) * 8;
    const unsigned vo0 = (unsigned)(vkey * ldk + vcol) * 2u;
    const unsigned half_step = (unsigned)(32 * ldk) * 2u;
    const int vbase = (int)(uintptr_t)V_lds + v_rd_base(lane);
#define LOADT(j, bf) do { const char* kp_ = (const char*)(Kg + (size_t)((j) * 64) * ldk); LAS3 char* kd_ = K_lds + (bf) * SHM + c.wid * 1024; \
        __builtin_amdgcn_global_load_lds((const unsigned*)(kp_ + ko0), (LAS3 unsigned*)kd_, 16, 0, 0); \
        __builtin_amdgcn_global_load_lds((const unsigned*)(kp_ + ko0 + half_step), (LAS3 unsigned*)(kd_ + 8192), 16, 0, 0); \
        if (HASV) { const char* vp_ = (const char*)(Vg + (size_t)((j) * 64) * ldk); LAS3 char* vd_ = V_lds + (bf) * SHM + c.wid * 1024; \
            __builtin_amdgcn_global_load_lds((const unsigned*)(vp_ + vo0), (LAS3 unsigned*)vd_, 16, 0, 0); \
            __builtin_amdgcn_global_load_lds((const unsigned*)(vp_ + vo0 + half_step), (LAS3 unsigned*)(vd_ + 8192), 16, 0, 0); } } while (0)
    if (j_lo > j_hi) return;
    LOADT(j_lo, 0); VM_WAIT(); __syncthreads();
    const int tqw = c.t0 + 8 * c.wid;
    for (int j = j_lo; j <= j_hi; ++j) {
        const int cur = (j - j_lo) & 1;
        if (j < j_hi) LOADT(j + 1, cur ^ 1);
        const int kpos0 = STEP * (j * 64) + OFF;
        const int dmin = tqw - (kpos0 + STEP * 63), dmax = tqw + 7 - kpos0;
        bool rowsel = true;
        if (ROWSEL) { const unsigned wsel = (j < 32) ? sm0 : (j < 64) ? sm1 : (j < 96) ? sm2 : sm3; rowsel = (wsel >> (j & 31)) & 1u; }
        bool act = (dmax >= 0) && (dmin < (int)W);
        if (ROWSEL) act = act && __any(rowsel);
        if (act) {
            f32x16 p0, p1;
            SBAR(); qkt(p0, p1, K_lds + cur * SHM, r32, hi, c.qr); SBAR();
            const bool nearb = dmin < 113, needmask = (dmin < 0) || ((unsigned)dmax >= W);
            const int d0 = c.tq - kpos0 - STEP * 4 * hi;
#ifdef NO_NEAR
            if (false) {
#else
            if (nearb) {
#endif
                if (STEP == 1) {
                    const LAS3 float* tbase = c.tb + (d0 + 5);
#pragma unroll
                    for (int r = 0; r < 16; ++r) { const int cc = (r & 3) + 8 * (r >> 2);
                        p0[r] = fmaf(p0[r], C2, tbase[59 - cc]); p1[r] = fmaf(p1[r], C2, tbase[59 - cc - 32]);
                        if ((r & 3) == 3) SBAR(); }
                } else {
#pragma unroll
                    for (int r = 0; r < 16; ++r) { const int cc = (r & 3) + 8 * (r >> 2); const int da = d0 - STEP * cc, db = d0 - STEP * (cc + 32);
                        const float ba = c.tb[64 + min(max(da, 0), 127)], bb = c.tb[64 + min(max(db, 0), 127)];
                        p0[r] = fmaf(p0[r], C2, ba); p1[r] = fmaf(p1[r], C2, bb);
                        if ((r & 3) == 3) SBAR(); }
                }
            } else {
#pragma unroll
                for (int r = 0; r < 16; ++r) { p0[r] = fmaf(p0[r], C2, c.bfar); p1[r] = fmaf(p1[r], C2, c.bfar); }
            }
            SBAR();
            const float NEG = -__builtin_inff();
#ifdef NO_MASK
            if (false) {
#else
            if (needmask) {
#endif
#pragma unroll
                for (int r = 0; r < 16; ++r) { const int cc = (r & 3) + 8 * (r >> 2); const int da = d0 - STEP * cc, db = d0 - STEP * (cc + 32);
                    if ((unsigned)da >= W) p0[r] = NEG; if ((unsigned)db >= W) p1[r] = NEG; }
            }
            if (ROWSEL) {
#pragma unroll
                for (int r = 0; r < 16; ++r) { p0[r] = rowsel ? p0[r] : NEG; p1[r] = rowsel ? p1[r] : NEG; }
            }
            if (MODE == MODE_STAT || MODE == MODE_ONLINE) {
                float pmax = p0[0];
#pragma unroll
                for (int r = 1; r < 16; ++r) pmax = fmaxf(pmax, p0[r]);
#pragma unroll
                for (int r = 0; r < 16; ++r) pmax = fmaxf(pmax, p1[r]);
                pmax = half_max(pmax);
                const float mn = fmaxf(m_reg, pmax); const float alpha = __builtin_amdgcn_exp2f(m_reg - mn); m_reg = mn;
                float ps = 0.f;
#pragma unroll
                for (int r = 0; r < 16; ++r) { p0[r] = __builtin_amdgcn_exp2f(p0[r] - mn); p1[r] = __builtin_amdgcn_exp2f(p1[r] - mn); ps += p0[r] + p1[r]; }
                ps = half_sum(ps);
                l_reg = l_reg * alpha + ps;
                if (MODE == MODE_ONLINE) {
#ifdef NO_RESC
                    if (false) {
#else
                    if (__any(alpha < 1.f)) {
#endif
                        if (hi == 0) al_l[r32] = alpha; LDS_WAIT();
#pragma unroll
                        for (int d_ = 0; d_ < 4; ++d_)
#pragma unroll
                            for (int r = 0; r < 16; ++r) c.o[d_][r] *= al_l[crow(r, hi)];
                        SBAR(); }
                    SBAR(); bf16x8 pa0, pa1, pa2, pa3; pack_p(p0, p1, pa0, pa1, pa2, pa3); SBAR();
                    pv_tile(c.o, vbase + cur * SHM, pa0, pa1, pa2, pa3);
                }
            } else {
#pragma unroll
                for (int r = 0; r < 16; ++r) { p0[r] = __builtin_amdgcn_exp2f(p0[r] - m_reg) * pscale; p1[r] = __builtin_amdgcn_exp2f(p1[r] - m_reg) * pscale; }
                if (MODE == MODE_ACC) {
                    bf16x8 pa0, pa1, pa2, pa3; pack_p(p0, p1, pa0, pa1, pa2, pa3);
                    pv_tile(c.o, vbase + cur * SHM, pa0, pa1, pa2, pa3);
                } else {
                    LAS3 float* imp = (LAS3 float*)(c.lds + L_IMP) + (c.wid * 8 + (r32 >> 2)) * 128;
#pragma unroll
                    for (int hf = 0; hf < 2; ++hf)
#pragma unroll
                        for (int m = 0; m < 4; ++m) { const f32x16& P = hf ? p1 : p0;
                            float a = 2.f * (P[4 * m] + P[4 * m + 1] + P[4 * m + 2]) + P[4 * m + 3], b = P[4 * m + 3];
                            a += __shfl_xor(a, 1); b += __shfl_xor(b, 1); a += __shfl_xor(a, 2); b += __shfl_xor(b, 2);
                            const int jj = 16 * j + 8 * hf + 2 * m + hi;
                            if ((r32 & 3) == 0) { __hip_atomic_fetch_add(imp + jj, a, __ATOMIC_RELAXED, __HIP_MEMORY_SCOPE_WORKGROUP);
                                if (jj + 1 < 128) __hip_atomic_fetch_add(imp + jj + 1, b, __ATOMIC_RELAXED, __HIP_MEMORY_SCOPE_WORKGROUP); } }
                }
            }
        }
        VM_WAIT();
        __syncthreads();
    }
#undef LOADT
}
__device__ __forceinline__ void attn_unit(LAS3 char* lds, const bf16_t* __restrict__ proj, const bf16_t* __restrict__ kc, const bf16_t* __restrict__ vc, bf16_t* __restrict__ oa, int qt, int g) {
    int tid_ = threadIdx.x; asm volatile("" : "+v"(tid_));
    Ctx c; c.lds = lds; c.tid = tid_; c.lane = c.tid & 63; c.wid = __builtin_amdgcn_readfirstlane(c.tid >> 6); c.r32 = c.lane & 31; c.hi = c.lane >> 5;
    c.t0 = qt * 64; c.tq = c.t0 + 8 * c.wid + (c.r32 >> 2);
    const int head = g * 4 + (c.r32 & 3);
    c.tb = (const LAS3 float*)(lds + LDS_BIAS) + head * 256; c.bfar = c.tb[64 + 127];
    { const bf16_t* qp = proj + (size_t)c.tq * NP + C_Q + head * HD + c.hi * 8;
#pragma unroll
      for (int d0 = 0; d0 < 8; ++d0) c.qr[d0] = *(const bf16x8*)(qp + d0 * 16); }
    float ga[3];
    { const bf16_t* gp = proj + (size_t)c.tq * NP + C_GA + head * 3;
#pragma unroll
      for (int b = 0; b < 3; ++b) ga[b] = pg8::fast_sigmoid(__uint_as_float(((unsigned)gp[b]) << 16)); }
    { LAS3 f32x4* z = (LAS3 f32x4*)(lds + L_IMP);
#pragma unroll
      for (int i = 0; i < 4; ++i) z[c.tid + 512 * i] = (f32x4){0.f, 0.f, 0.f, 0.f}; }
    __syncthreads();
    const bf16_t* Kc = kc + g * HD; const bf16_t* Vc = vc + g * HD;
    const bf16_t* Ks = proj + C_KV + 2 * 512 + g * HD; const bf16_t* Vs = proj + C_KV + 3 * 512 + g * HD;
    const bf16_t* Kw = proj + C_KV + 4 * 512 + g * HD; const bf16_t* Vw = proj + C_KV + 5 * 512 + g * HD;
    const int ntc = (4 * qt + 2) / 64;
    constexpr unsigned WINF = 0x7fffffffu;
    float m_c = -1e30f, l_c = 0.f;
#ifndef ADBG
#define ADBG 0xff
#endif
    if (ADBG & 1) run_pass<MODE_STAT, 16, 31, false>(c, Kc, Vc, 512, 0, ntc, WINF, m_c, l_c, 0.f, 0u, 0u, 0u, 0u);
    const float rl_c = l_c > 0.f ? 1.0f / l_c : 0.f;
    if (ADBG & 2) run_pass<MODE_IMP, 16, 31, false>(c, Kc, Vc, 512, 0, ntc, WINF, m_c, l_c, rl_c, 0u, 0u, 0u, 0u);
#ifdef NO_TOPK
    if (false)
#endif
    {
        LAS3 float* scr = (LAS3 float*)(lds + L_SC) + c.wid * 128; LAS3 unsigned* selw = (LAS3 unsigned*)(lds + L_SEL);
#pragma unroll 1
        for (int tk = 0; tk < 8; ++tk) {
            const int tok = c.wid * 8 + tk; const LAS3 float* imp = (const LAS3 float*)(lds + L_IMP) + tok * 128;
            const int ja = c.lane, jb = c.lane + 64;
            float sa = imp[ja], sb = imp[jb];
            sa = (ja == 0 || ja == qt || ja == qt - 1) ? 1e9f : (ja > qt ? -1.f : sa);
            sb = (jb == qt || jb == qt - 1) ? 1e9f : (jb > qt ? -1.f : sb);
            scr[ja] = sa; scr[jb] = sb; LDS_WAIT();
            int ca = 0, cb = 0;
#pragma unroll 4
            for (int k = 0; k < 128; k += 4) { const f32x4 v = *(const LAS3 f32x4*)(scr + k);
#pragma unroll
                for (int e = 0; e < 4; ++e) { const float s = v[e]; const int kk = k + e;
                    ca += (s > sa || (s == sa && kk < ja)) ? 1 : 0; cb += (s > sb || (s == sb && kk < jb)) ? 1 : 0; } }
            const unsigned long long ba = __ballot(ca < 16), bb = __ballot(cb < 16);
            if (c.lane == 0) { selw[tok * 4 + 0] = (unsigned)ba; selw[tok * 4 + 1] = (unsigned)(ba >> 32); selw[tok * 4 + 2] = (unsigned)bb; selw[tok * 4 + 3] = (unsigned)(bb >> 32); }
            LDS_WAIT();
        }
    }
    unsigned sm0, sm1, sm2, sm3;
    { const LAS3 unsigned* selw = (const LAS3 unsigned*)(lds + L_SEL) + (c.wid * 8 + (c.r32 >> 2)) * 4; sm0 = selw[0]; sm1 = selw[1]; sm2 = selw[2]; sm3 = selw[3]; }
    LAS3 float* wsf = (LAS3 float*)(lds + L_WS) + c.wid * 64;
    {
        float m_s = -1e30f, l_s = 0.f;
#pragma unroll
        for (int d_ = 0; d_ < 4; ++d_) c.o[d_] = f32x16{};
        if (ADBG & 4) run_pass<MODE_ONLINE, 1, 0, true>(c, Ks, Vs, NP, 0, qt, WINF, m_s, l_s, 0.f, sm0, sm1, sm2, sm3);
        const float f = ga[1] / l_s;
        if (c.hi == 0) wsf[c.r32] = f; LDS_WAIT();
#pragma unroll
        for (int d_ = 0; d_ < 4; ++d_)
#pragma unroll
            for (int r = 0; r < 16; ++r) c.o[d_][r] *= wsf[crow(r, c.hi)];
    }
    if (ADBG & 8) run_pass<MODE_ACC, 16, 31, false>(c, Kc, Vc, 512, 0, ntc, WINF, m_c, l_c, ga[0] * rl_c, 0u, 0u, 0u, 0u);
    {
        float m_w = -1e30f, l_w = 0.f; const int jlo = qt >= 8 ? qt - 8 : 0;
        if (ADBG & 16) run_pass<MODE_STAT, 1, 0, false>(c, Kw, Vw, NP, jlo, qt, 512u, m_w, l_w, 0.f, 0u, 0u, 0u, 0u);
        if (ADBG & 32) run_pass<MODE_ACC, 1, 0, false>(c, Kw, Vw, NP, jlo, qt, 512u, m_w, l_w, ga[2] / l_w, 0u, 0u, 0u, 0u);
    }
#ifdef NO_EPI
    if (c.o[0][0] == 123.f && c.o[1][1] == 3.f && c.o[2][2] == 1.f && c.o[3][3] == 5.f) oa[0] = 1;
    if (false)
#endif
    {
        const int tw = c.t0 + 8 * c.wid;
        const char* zbase = (const char*)(proj + C_ZA + g * 4 * HD); char* obase = (char*)(oa + g * 4 * HD);
#pragma unroll
        for (int r = 0; r < 16; ++r) { const int row = crow(r, c.hi); const int tok = tw + (row >> 2), hd = row & 3;
            const unsigned zo = (unsigned)(tok * NP + hd * HD + c.r32) * 2u, oo = (unsigned)(tok * AW + hd * HD + c.r32) * 2u;
#pragma unroll
            for (int d0 = 0; d0 < 4; ++d0) { const float z = __uint_as_float(((unsigned)*(const bf16_t*)(zbase + zo + d0 * 64)) << 16);
                const float v = c.o[d0][r] * z * pg8::fast_sigmoid(z); const float vn = __shfl_xor(v, 1);
                if ((c.r32 & 1) == 0) *(unsigned*)(obase + oo + d0 * 64) = cvtpk(v, vn); }
            SBAR(); }
    }
    __syncthreads();
}
__device__ __forceinline__ void phase_attn(LAS3 char* lds, const bf16_t* proj, const bf16_t* kc, const bf16_t* vc, bf16_t* oa, int vcu, int G) {
#pragma unroll 1
    for (int item = vcu; item < 256; item += G) {
        const int g = item & 3, p = item >> 2;
#pragma unroll 1
        for (int s = 0; s < 2; ++s) attn_unit(lds, proj, kc, vc, oa, s ? p : 127 - p, g);
    }
}
}
__device__ __forceinline__ float gelu_tanh(float x) { const float y = 1.5957691216057308f * (x + 0.044715f * x * x * x); return x * pg8::fast_sigmoid(y); }
__device__ __forceinline__ float silu_f(float x) { return x * pg8::fast_sigmoid(x); }
__device__ __forceinline__ void compress_unit(LAS3 char* lds, const bf16_t* __restrict__ proj, const float* __restrict__ pe, const bf16_t* __restrict__ w1t, const bf16_t* __restrict__ w2t,
                                              bf16_t* __restrict__ outc, int u, int which) {
    int tid_o = threadIdx.x; asm volatile("" : "+v"(tid_o));
    const int tid = tid_o, lane = tid & 63, wid = __builtin_amdgcn_readfirstlane(tid >> 6), r32 = lane & 31, hi = lane >> 5;
    const int i = 8 * u + (r32 >> 2), g = r32 & 3;
    f32x16 acc[4];
#pragma unroll
    for (int nb = 0; nb < 4; ++nb) acc[nb] = f32x16{};
    const bf16_t* abase = proj + C_KV + which * 512 + g * HD + hi * 8;
    const bf16_t* bbase = w1t + (size_t)r32 * 4096 + wid * 512 + hi * 8;
#pragma unroll 2
    for (int lt = 0; lt < 4; ++lt) {
        const int l = wid * 4 + lt; int tokn = 16 * i + l; tokn = tokn < T ? tokn : T - 1;
        const bf16_t* ap = abase + (size_t)tokn * NP; const float* pp = pe + l * HD + hi * 8;
#pragma unroll
        for (int k8 = 0; k8 < 8; ++k8) {
            const u32x4 raw = *(const u32x4*)(ap + k8 * 16); const f32x4 e0 = *(const f32x4*)(pp + k8 * 16), e1 = *(const f32x4*)(pp + k8 * 16 + 4);
            u32x4 aw; aw.x = pk2(pg8::bf_lo(raw.x) + e0[0], pg8::bf_hi(raw.x) + e0[1]); aw.y = pk2(pg8::bf_lo(raw.y) + e0[2], pg8::bf_hi(raw.y) + e0[3]);
            aw.z = pk2(pg8::bf_lo(raw.z) + e1[0], pg8::bf_hi(raw.z) + e1[1]); aw.w = pk2(pg8::bf_lo(raw.w) + e1[2], pg8::bf_hi(raw.w) + e1[3]);
            const bf16x8 a = *reinterpret_cast<const bf16x8*>(&aw);
#pragma unroll
            for (int nb = 0; nb < 4; ++nb) { const bf16x8 b = *(const bf16x8*)(bbase + (size_t)(nb * 32) * 4096 + lt * 128 + k8 * 16);
                acc[nb] = __builtin_amdgcn_mfma_f32_32x32x16_bf16(a, b, acc[nb], 0, 0, 0); }
        }
    }
    LAS3 float* part = (LAS3 float*)lds + wid * 4096;
#pragma unroll
    for (int nb = 0; nb < 4; ++nb)
#pragma unroll
        for (int r = 0; r < 16; ++r) part[att::crow(r, hi) * 128 + nb * 32 + r32] = acc[nb][r];
    __syncthreads();
    f32x4 s0 = {0.f, 0.f, 0.f, 0.f}, s1 = {0.f, 0.f, 0.f, 0.f};
#pragma unroll
    for (int w = 0; w < 8; ++w) { const LAS3 f32x4* p = (const LAS3 f32x4*)((LAS3 float*)lds + w * 4096 + tid * 8); s0 += p[0]; s1 += p[1]; }
    __syncthreads();
    {
        u32x4 hw; hw.x = pk2(silu_f(s0[0]), silu_f(s0[1])); hw.y = pk2(silu_f(s0[2]), silu_f(s0[3])); hw.z = pk2(silu_f(s1[0]), silu_f(s1[1])); hw.w = pk2(silu_f(s1[2]), silu_f(s1[3]));
        const int row = tid >> 4, col = (tid & 15) * 8;
        *(LAS3 u32x4*)(lds + (row * 136 + col) * 2) = hw;
    }
    __syncthreads();
    if (wid < 4) {
        f32x16 o2 = f32x16{};
#pragma unroll
        for (int ks = 0; ks < 8; ++ks) { const bf16x8 a = *(const LAS3 bf16x8*)(lds + (r32 * 136 + ks * 16 + hi * 8) * 2);
            const bf16x8 b = *(const bf16x8*)(w2t + (size_t)(wid * 32 + r32) * HD + ks * 16 + hi * 8);
            o2 = __builtin_amdgcn_mfma_f32_32x32x16_bf16(a, b, o2, 0, 0, 0); }
#pragma unroll
        for (int r = 0; r < 16; ++r) { const int row = att::crow(r, hi); const int ii = 8 * u + (row >> 2), gg = row & 3;
            const float v = ii < NCMP ? o2[r] : 0.f; const float vn = __shfl_xor(v, 1);
            if ((r32 & 1) == 0) *(unsigned*)(outc + (size_t)(ii * 4 + gg) * HD + wid * 32 + r32) = pk2(v, vn); }
    }
    __syncthreads();
}
__device__ __forceinline__ void gmlp_unit(LAS3 char* lds, const bf16_t* __restrict__ proj, const float* __restrict__ gain, const float* __restrict__ sw, const float* __restrict__ sb,
                                          bf16_t* __restrict__ ob, int ch, int qd) {
    int tid_o = threadIdx.x; asm volatile("" : "+v"(tid_o));
    const int tid = tid_o, lane = tid & 63, wid = __builtin_amdgcn_readfirstlane(tid >> 6), r32 = lane & 31, hi = lane >> 5;
    const int tc0 = ch * 128;
    LAS3 float* rsl = (LAS3 float*)(lds + 2 * att::SHM);
    for (int tt = 0; tt < 16; ++tt) { const int tok = wid * 16 + tt; const bf16_t* vp = proj + (size_t)(tc0 + tok) * NP + C_VB + lane * 8; float ss = 0.f;
#pragma unroll
        for (int i = 0; i < 4; ++i) { const u32x4 raw = *(const u32x4*)(vp + i * 512); const unsigned w[4] = {raw.x, raw.y, raw.z, raw.w};
#pragma unroll
            for (int e = 0; e < 4; ++e) { const float a = gelu_tanh(pg8::bf_lo(w[e])), b = gelu_tanh(pg8::bf_hi(w[e])); ss += a * a + b * b; } }
        ss = wave_sum(ss);
        if (lane == 0) rsl[tok] = 1.0f / sqrtf(ss * (1.0f / BW) + NORM_EPS); }
    __syncthreads();
    const int wp = wid >> 1, wd = wid & 1;
    const int vbase = (int)(uintptr_t)(lds) + att::v_rd_base(lane);
    for (int gg = 0; gg < 4; ++gg) {
        const int G = qd * 4 + gg, cb = G * 128;
        { const int sr = tid >> 4, sc = (tid & 15) * 8; const f32x4 g0 = *(const f32x4*)(gain + cb + sc), g1 = *(const f32x4*)(gain + cb + sc + 4);
#pragma unroll
          for (int kq = 0; kq < 4; ++kq) { const int q = kq * 32 + sr; const u32x4 raw = *(const u32x4*)(proj + (size_t)(tc0 + q) * NP + C_VB + cb + sc); const float rs = rsl[q];
              u32x4 w; w.x = pk2(gelu_tanh(pg8::bf_lo(raw.x)) * rs * g0[0], gelu_tanh(pg8::bf_hi(raw.x)) * rs * g0[1]); w.y = pk2(gelu_tanh(pg8::bf_lo(raw.y)) * rs * g0[2], gelu_tanh(pg8::bf_hi(raw.y)) * rs * g0[3]);
              w.z = pk2(gelu_tanh(pg8::bf_lo(raw.z)) * rs * g1[0], gelu_tanh(pg8::bf_hi(raw.z)) * rs * g1[1]); w.w = pk2(gelu_tanh(pg8::bf_lo(raw.w)) * rs * g1[2], gelu_tanh(pg8::bf_hi(raw.w)) * rs * g1[3]);
              *(LAS3 u32x4*)(lds + (q >> 6) * att::SHM + att::v_st(q & 63, sc)) = w; } }
        bf16x8 af[8]; const int p = wp * 32 + r32;
        { const float* wrow = sw + ((size_t)G * 128 + p) * 128 + hi * 8;
#pragma unroll
          for (int ks = 0; ks < 8; ++ks) { if (ks < 2 * wp + 2) { const f32x4 a0 = *(const f32x4*)(wrow + ks * 16), a1 = *(const f32x4*)(wrow + ks * 16 + 4); const int q0 = ks * 16 + hi * 8;
                  u32x4 w; w.x = pk2(q0 + 0 <= p ? a0[0] : 0.f, q0 + 1 <= p ? a0[1] : 0.f); w.y = pk2(q0 + 2 <= p ? a0[2] : 0.f, q0 + 3 <= p ? a0[3] : 0.f);
                  w.z = pk2(q0 + 4 <= p ? a1[0] : 0.f, q0 + 5 <= p ? a1[1] : 0.f); w.w = pk2(q0 + 6 <= p ? a1[2] : 0.f, q0 + 7 <= p ? a1[3] : 0.f);
                  af[ks] = *reinterpret_cast<const bf16x8*>(&w); } else af[ks] = bf16x8{}; } }
        __syncthreads();
        f32x16 acc[2] = {f32x16{}, f32x16{}};
#define TRRD(dst, off) asm volatile("ds_read_b64_tr_b16 %0, %1 offset:%2" : "=&v"(dst) : "v"(vb1), "i"(off) : "memory")
#define GM_STEP(ks) do { if ((ks) < 2 * wp + 2) { s16x4 l0, h0, l1, h1; constexpr int o_ = ((ks) >> 2) * att::SHM + att::v_rd_off(0, (ks) & 3, 0); \
            TRRD(l0, o_); TRRD(h0, o_ + 2048); TRRD(l1, o_ + 512); TRRD(h1, o_ + 512 + 2048); \
            asm volatile("s_waitcnt lgkmcnt(0)" ::: "memory"); __builtin_amdgcn_sched_barrier(0); \
            acc[0] = __builtin_amdgcn_mfma_f32_32x32x16_bf16(af[ks], (bf16x8){l0[0], l0[1], l0[2], l0[3], h0[0], h0[1], h0[2], h0[3]}, acc[0], 0, 0, 0); \
            acc[1] = __builtin_amdgcn_mfma_f32_32x32x16_bf16(af[ks], (bf16x8){l1[0], l1[1], l1[2], l1[3], h1[0], h1[1], h1[2], h1[3]}, acc[1], 0, 0, 0); } } while (0)
        { const int vb1 = vbase + wd * 1024;
          GM_STEP(0); GM_STEP(1); GM_STEP(2); GM_STEP(3); GM_STEP(4); GM_STEP(5); GM_STEP(6); GM_STEP(7); }
#undef GM_STEP
#undef TRRD
#pragma unroll
        for (int r = 0; r < 16; ++r) { const int pr = wp * 32 + att::crow(r, hi); const float bs = sb[G * 128 + pr]; const size_t tok = (size_t)(tc0 + pr);
#pragma unroll
            for (int dd = 0; dd < 2; ++dd) { const int chn = cb + (wd * 2 + dd) * 32 + r32;
                const float uu = __uint_as_float(((unsigned)proj[tok * NP + C_UB + chn]) << 16), zz = __uint_as_float(((unsigned)proj[tok * NP + C_ZB + chn]) << 16);
                const float v = gelu_tanh(uu) * (acc[dd][r] + bs) * silu_f(zz); const float vn = __shfl_xor(v, 1);
                if ((r32 & 1) == 0) *(unsigned*)(ob + tok * BW + chn) = pk2(v, vn); } }
        __syncthreads();
    }
}
#ifndef N_LAUNCH_MODE
#define N_LAUNCH_MODE 1
#endif
constexpr int NPHASES = 1 + 6 * DEPTH;
#ifndef PHMASK
#define PHMASK 0x7f
#endif
__global__ void __launch_bounds__(NTHREADS, 2) fwd_kernel(Params P) {
    extern __shared__ __attribute__((aligned(16))) unsigned char lds_raw[];
    LAS3 unsigned char* lds = (LAS3 unsigned char*)lds_raw;
    const int tid = threadIdx.x, lane = tid & 63, wave = __builtin_amdgcn_readfirstlane(tid >> 6);
    const int G = gridDim.x; const int bx = blockIdx.x; const int vcu = (G % 8 == 0) ? (bx % 8) * (G / 8) + bx / 8 : bx;
    const int gw = vcu * NWAVES + wave, NGW = G * NWAVES;
    unsigned char* ws = P.ws;
    if (tid < 16) ((LAS3 unsigned*)(lds + LDS_MISC))[tid] = 0u;
    for (int i = tid; i < 16 * 256; i += NTHREADS) { const int hd = i >> 8; int d = (i & 255) - 64; d = d < 0 ? 0 : (d > 127 ? 127 : d); ((LAS3 float*)(lds + LDS_BIAS))[i] = P.rel_bias[BUCKET[d] * 16 + hd] * att::LOG2E; }
    __syncthreads();
    XcdBarrier bar; bar.bar = (unsigned*)(ws + WS_CTL); bar.x = 0; bar.st = nullptr;
    if (N_LAUNCH_MODE == 1) bar = xcd_barrier_post((unsigned*)(ws + WS_CTL), (volatile LAS unsigned*)(lds + LDS_MISC));
    const int lo = P.ph_lo, hi = P.ph_hi;
#define IN(k) (lo <= (k) && (k) < hi)
#define SEAM(k) do { if (IN(k) && IN((k) + 1)) xcd_barrier(bar); } while (0)
    bf16_t* hbuf = (bf16_t*)(ws + WS_H); bf16_t* proj = (bf16_t*)(ws + WS_PROJ); bf16_t* kc = (bf16_t*)(ws + WS_KC); bf16_t* vc = (bf16_t*)(ws + WS_VC);
    bf16_t* oa = (bf16_t*)(ws + WS_OA); bf16_t* ob = (bf16_t*)(ws + WS_OB); bf16_t* t1 = (bf16_t*)(ws + WS_T1); bf16_t* mg = (bf16_t*)(ws + WS_MG);
    float* Y = (float*)(ws + WS_Y); float* x1 = (float*)(ws + WS_X1);
    if (IN(0) && (PHMASK & 1)) {
        phase_weights(P, lds, gw, NGW, wave, lane);
        phase_prenorm(P.x, P.pre_norm, hbuf, gw, NGW, lane);
    }
    SEAM(0);
#pragma unroll 1
    for (int L = 0; L < DEPTH; ++L) {
        const int pb = 1 + 6 * L;
        if (IN(pb) && (PHMASK & 2)) {
            pg8::Gemm g{hbuf, (const bf16_t*)(ws + WS_WIN + L * SZ_WIN), T, NP, DM}; pg8::StaticOrder S; S.init(T, NP, G, bx);
            pg8::EpiBf16Plain E{proj, NP};
            pg8::gemm_phase<pg8::EpiBf16Plain, pg8::StaticOrder>(lds + LDS_STAGE, g, S, E, nullptr);
        }
        SEAM(pb);
        if (IN(pb + 1) && (PHMASK & 4)) {
#pragma unroll 1
            for (int item = vcu; item < 384; item += G) {
                if (item < 256) gmlp_unit((LAS3 char*)lds, proj, P.sgu_norm + L * BW, P.sgu_w + (size_t)L * 16 * 128 * 128, P.sgu_b + L * 16 * 128, ob, item >> 2, item & 3);
                else { const int ci = item - 256, which = ci & 1, u = ci >> 1;
                    compress_unit((LAS3 char*)lds, proj, (which ? P.pe_v : P.pe_k) + L * 32 * HD, (const bf16_t*)(ws + WS_W1 + (L * 2 + which) * SZ_W1), (const bf16_t*)(ws + WS_W2 + (L * 2 + which) * SZ_W2), which ? vc : kc, u, which); }
            }
        }
        SEAM(pb + 1);
        if (IN(pb + 2) && (PHMASK & 8)) att::phase_attn((LAS3 char*)lds, proj, kc, vc, oa, vcu, G);
        SEAM(pb + 2);
        if (IN(pb + 3) && (PHMASK & 16)) {
            pg8::StaticOrder S; S.init(T, DM, G, bx);
            { pg8::Gemm g{oa, (const bf16_t*)(ws + WS_WA + L * SZ_WAB), T, DM, AW}; pg8::EpiGate<false> E{t1, DM, proj + C_MA, NP, nullptr};
              pg8::gemm_phase<pg8::EpiGate<false>, pg8::StaticOrder>(lds + LDS_STAGE, g, S, E, nullptr); }
            { pg8::Gemm g{ob, (const bf16_t*)(ws + WS_WB + L * SZ_WAB), T, DM, BW}; pg8::EpiGate<true> E{mg, DM, proj + C_MB, NP, t1};
              pg8::gemm_phase<pg8::EpiGate<true>, pg8::StaticOrder>(lds + LDS_STAGE, g, S, E, nullptr); }
        }
        SEAM(pb + 3);
        if (IN(pb + 4) && (PHMASK & 32)) {
            pg8::Gemm g{mg, (const bf16_t*)(ws + WS_WO + L * SZ_WO), T, DM, DM}; pg8::StaticOrder S; S.init(T, DM, G, bx);
            pg8::EpiF32Plain E{Y, DM};
            pg8::gemm_phase<pg8::EpiF32Plain, pg8::StaticOrder>(lds + LDS_STAGE, g, S, E, nullptr);
        }
        SEAM(pb + 4);
        if (IN(pb + 5) && (PHMASK & 64)) {
            const bool last = (L == DEPTH - 1);
            phase_postnorm(Y, L == 0 ? P.x : x1, P.post_norm + L * DM, last ? P.out : x1, P.pre_norm + (last ? 0 : (L + 1)) * DM, hbuf, !last, gw, NGW, lane);
        }
        SEAM(pb + 5);
    }
#undef IN
#undef SEAM
}
extern "C" void kernel_launch(void* const* d_in, const int* in_sizes, int n_in, void* d_out, int out_size, void* d_ws, size_t ws_size, hipStream_t stream) {
    static int grid = 0;
    if (grid == 0) {
        if (n_in != 17 || in_sizes[0] != T * DM || out_size != T * DM || ws_size < WS_END) { fprintf(stderr, "kernel_launch: unexpected shapes (n_in %d, in0 %d, out %d, ws %zu < %zu)\n", n_in, n_in > 0 ? in_sizes[0] : -1, out_size, ws_size, (size_t)WS_END); grid = -1; return; }
        int dev = 0, cus = 0, per_cu = 0;
        if (hipGetDevice(&dev) != hipSuccess || hipDeviceGetAttribute(&cus, hipDeviceAttributeMultiprocessorCount, dev) != hipSuccess) { grid = -1; return; }
        if (hipFuncSetAttribute((const void*)fwd_kernel, hipFuncAttributeMaxDynamicSharedMemorySize, LDS_BYTES) != hipSuccess) { fprintf(stderr, "kernel_launch: hipFuncSetAttribute failed\n"); grid = -1; return; }
        if (hipOccupancyMaxActiveBlocksPerMultiprocessor(&per_cu, (const void*)fwd_kernel, NTHREADS, LDS_BYTES) != hipSuccess || per_cu < 1) { fprintf(stderr, "kernel_launch: occupancy query says %d blocks per CU\n", per_cu); (void)hipGetLastError(); grid = -1; return; }
        grid = cus;
    }
    if (grid < 0) return;
    (void)hipMemsetAsync((char*)d_ws + WS_CTL, 0, CTL_BYTES, stream);
    Params p{};
    p.x = (const float*)d_in[0]; p.rel_bias = (const float*)d_in[1]; p.pre_norm = (const float*)d_in[2]; p.w_in = (const float*)d_in[3];
    p.pe_k = (const float*)d_in[4]; p.w1_k = (const float*)d_in[5]; p.w2_k = (const float*)d_in[6]; p.pe_v = (const float*)d_in[7]; p.w1_v = (const float*)d_in[8]; p.w2_v = (const float*)d_in[9];
    p.w_out_a = (const float*)d_in[10]; p.sgu_norm = (const float*)d_in[11]; p.sgu_w = (const float*)d_in[12]; p.sgu_b = (const float*)d_in[13]; p.w_out_b = (const float*)d_in[14]; p.w_out = (const float*)d_in[15]; p.post_norm = (const float*)d_in[16];
    p.out = (float*)d_out; p.ws = (unsigned char*)d_ws;
#if N_LAUNCH_MODE == 1
    p.ph_lo = 0; p.ph_hi = NPHASES;
    hipLaunchKernelGGL(fwd_kernel, dim3(grid), dim3(NTHREADS), LDS_BYTES, stream, p);
#else
    for (int k = 0; k < NPHASES; ++k) { p.ph_lo = k; p.ph_hi = k + 1; hipLaunchKernelGGL(fwd_kernel, dim3(grid), dim3(NTHREADS), LDS_BYTES, stream, p); }
#endif
}
```

```cpp
#include <hip/hip_runtime.h>
#include <cstdio>
#include <cstdint>
namespace pg8 {
#define PG8_LAS __attribute__((address_space(3)))
typedef unsigned short bf16_t;
typedef short bf16x8 __attribute__((ext_vector_type(8)));
typedef float f32x4 __attribute__((ext_vector_type(4)));
typedef unsigned u32x4 __attribute__((ext_vector_type(4)));
constexpr int BM = 256, BK = 64, HALF = 128, HTB = HALF * BK * 2  , STAGE_BYTES = 8 * HTB, NXCD = 8, WGM = 8;

__host__ __device__ __forceinline__ int lds_byte(int r, int c) { const int st = (r >> 4) * 2 + (c >> 5), rr = r & 15, cc = c & 31, ob = rr * 64 + cc * 2; return st * 1024 + (ob ^ (((ob >> 9) & 1) << 5)); }
__host__ __device__ __forceinline__ void stage_rc(int b, int& R, int& C) { const int st = b / 1024, sb = b % 1024, swz = sb ^ (((sb >> 9) & 1) << 5); R = (st >> 1) * 16 + swz / 64; C = (st & 1) * 32 + (swz % 64) / 2; }
__host__ __device__ __forceinline__ int perm32(int rho) { const int n = rho >> 4, i = rho & 15; return 8 * (i >> 2) + 4 * n + (i & 3); }

struct Unit { int pm, pn; };
struct Gemm { const bf16_t* A; const bf16_t* Bt; int M, N, K; };

struct StaticOrder {
    int nM, nN, nwg, G, c;
    __host__ __device__ void init(int M, int N, int G_, int c_) { nM = M / BM; nN = N / BM; nwg = nM * nN; G = G_; c = c_; }
    __host__ __device__ bool next(int i, Unit& u) const {
        const long L = (long)i * G + c; if (L >= nwg) return false;
        int wgid = (int)L; { const int q = nwg / NXCD, r = nwg % NXCD, xcd = wgid % NXCD, off = wgid / NXCD; wgid = (xcd < r ? xcd * (q + 1) : r * (q + 1) + (xcd - r) * q) + off; }
        const int nig = WGM * nN, gid = wgid / nig, fm = gid * WGM, gsz = (nM - fm) < WGM ? (nM - fm) : WGM;
        u.pm = fm + ((wgid % nig) % gsz); u.pn = (wgid % nig) / gsz; return true;
    }
    __device__ __forceinline__ void a_ready(const Unit&) const {}
    __device__ __forceinline__ void done(const Unit&) const {}
};
typedef __bf16 bf16x2_t __attribute__((ext_vector_type(2)));
typedef float f32x2_t __attribute__((ext_vector_type(2)));
__device__ __forceinline__ unsigned cvt_pk_bf16(float lo, float hi) { const f32x2_t v = {lo, hi}; const bf16x2_t b = __builtin_convertvector(v, bf16x2_t); return __builtin_bit_cast(unsigned, b); }
typedef float f32x2 __attribute__((ext_vector_type(2)));
__device__ __forceinline__ float bf_lo(unsigned u) { return __uint_as_float(u << 16); }
__device__ __forceinline__ float bf_hi(unsigned u) { return __uint_as_float(u & 0xffff0000u); }
__device__ __forceinline__ float fast_sigmoid(float x) { return __builtin_amdgcn_rcpf(1.0f + __builtin_amdgcn_exp2f(-1.4426950408889634f * x)); }
struct EpiBf16Plain {
    static constexpr bool PERM = true, AFTER_DRAIN = false;
    bf16_t* O; int ldc;
    __device__ __forceinline__ void operator()(const f32x4 (&acc)[2][2][4][2], const Unit& u, int wr, int wc, int fr, int fq) const {
        const int row0 = u.pm * BM + wr * 64 + fr, col0 = u.pn * BM + wc * 32 + 8 * fq;
#pragma unroll
        for (int ai = 0; ai < 2; ++ai)
#pragma unroll
            for (int m = 0; m < 4; ++m) { bf16_t* rowp = O + (size_t)(row0 + ai * HALF + m * 16) * ldc + col0;
#pragma unroll
                for (int bj = 0; bj < 2; ++bj) { const f32x4 v0 = acc[ai][bj][m][0], v1 = acc[ai][bj][m][1];
                    u32x4 w; w.x = cvt_pk_bf16(v0[0], v0[1]); w.y = cvt_pk_bf16(v0[2], v0[3]); w.z = cvt_pk_bf16(v1[0], v1[1]); w.w = cvt_pk_bf16(v1[2], v1[3]);
                    *(u32x4*)(rowp + bj * HALF) = w; } }
    }
};
__device__ __forceinline__ float gelu_tanh_f(float x) { const float y = 1.5957691216057308f * (x + 0.044715f * x * x * x); return x * fast_sigmoid(y); }
struct EpiProj {
    static constexpr bool PERM = true, AFTER_DRAIN = false;
    static constexpr int PN_V0 = 36;
    bf16_t* O; int ldc; float* sspart;
    __device__ __forceinline__ void operator()(const f32x4 (&acc)[2][2][4][2], const Unit& u, int wr, int wc, int fr, int fq) const {
        const int row0 = u.pm * BM + wr * 64 + fr, col0 = u.pn * BM + wc * 32 + 8 * fq;
        const bool vtile = (u.pn >= PN_V0) && (u.pn < PN_V0 + 8);
        if (!vtile) {
#pragma unroll
            for (int ai = 0; ai < 2; ++ai)
#pragma unroll
                for (int m = 0; m < 4; ++m) { bf16_t* rowp = O + (size_t)(row0 + ai * HALF + m * 16) * ldc + col0;
#pragma unroll
                    for (int bj = 0; bj < 2; ++bj) { const f32x4 v0 = acc[ai][bj][m][0], v1 = acc[ai][bj][m][1];
                        u32x4 w; w.x = cvt_pk_bf16(v0[0], v0[1]); w.y = cvt_pk_bf16(v0[2], v0[3]); w.z = cvt_pk_bf16(v1[0], v1[1]); w.w = cvt_pk_bf16(v1[2], v1[3]);
                        *(u32x4*)(rowp + bj * HALF) = w; } }
        } else {
#pragma unroll
            for (int ai = 0; ai < 2; ++ai)
#pragma unroll
                for (int m = 0; m < 4; ++m) { const int row = row0 + ai * HALF + m * 16; bf16_t* rowp = O + (size_t)row * ldc + col0; float ss = 0.f;
#pragma unroll
                    for (int bj = 0; bj < 2; ++bj) { f32x4 v0 = acc[ai][bj][m][0], v1 = acc[ai][bj][m][1];
#pragma unroll
                        for (int e = 0; e < 4; ++e) { v0[e] = gelu_tanh_f(v0[e]); v1[e] = gelu_tanh_f(v1[e]); ss += v0[e] * v0[e] + v1[e] * v1[e]; }
                        u32x4 w; w.x = cvt_pk_bf16(v0[0], v0[1]); w.y = cvt_pk_bf16(v0[2], v0[3]); w.z = cvt_pk_bf16(v1[0], v1[1]); w.w = cvt_pk_bf16(v1[2], v1[3]);
                        *(u32x4*)(rowp + bj * HALF) = w; }
                    ss += __shfl_xor(ss, 16); ss += __shfl_xor(ss, 32);
                    if (fq == 0) sspart[(size_t)row * 32 + (u.pn - PN_V0) * 4 + wc] = ss; }
        }
    }
};
template <bool ADD> struct EpiGate {
    static constexpr bool PERM = true, AFTER_DRAIN = false;
    bf16_t* O; int ldc; const bf16_t* Mg; int ldm; const bf16_t* Prev;
    __device__ __forceinline__ void operator()(const f32x4 (&acc)[2][2][4][2], const Unit& u, int wr, int wc, int fr, int fq) const {
        const int row0 = u.pm * BM + wr * 64 + fr, col0 = u.pn * BM + wc * 32 + 8 * fq;
#pragma unroll
        for (int ai = 0; ai < 2; ++ai)
#pragma unroll
            for (int m = 0; m < 4; ++m) { const size_t row = (size_t)(row0 + ai * HALF + m * 16);
#pragma unroll
                for (int bj = 0; bj < 2; ++bj) { const f32x4 v0 = acc[ai][bj][m][0], v1 = acc[ai][bj][m][1];
                    const u32x4 mg = *(const u32x4*)(Mg + row * ldm + col0 + bj * HALF);
                    float r[8];
                    r[0] = v0[0] * fast_sigmoid(bf_lo(mg.x)); r[1] = v0[1] * fast_sigmoid(bf_hi(mg.x)); r[2] = v0[2] * fast_sigmoid(bf_lo(mg.y)); r[3] = v0[3] * fast_sigmoid(bf_hi(mg.y));
                    r[4] = v1[0] * fast_sigmoid(bf_lo(mg.z)); r[5] = v1[1] * fast_sigmoid(bf_hi(mg.z)); r[6] = v1[2] * fast_sigmoid(bf_lo(mg.w)); r[7] = v1[3] * fast_sigmoid(bf_hi(mg.w));
                    if (ADD) { const u32x4 pv = *(const u32x4*)(Prev + row * ldc + col0 + bj * HALF);
                        r[0] += bf_lo(pv.x); r[1] += bf_hi(pv.x); r[2] += bf_lo(pv.y); r[3] += bf_hi(pv.y); r[4] += bf_lo(pv.z); r[5] += bf_hi(pv.z); r[6] += bf_lo(pv.w); r[7] += bf_hi(pv.w); }
                    u32x4 w; w.x = cvt_pk_bf16(r[0], r[1]); w.y = cvt_pk_bf16(r[2], r[3]); w.z = cvt_pk_bf16(r[4], r[5]); w.w = cvt_pk_bf16(r[6], r[7]);
                    *(u32x4*)(O + row * ldc + col0 + bj * HALF) = w; } }
    }
};
struct EpiF32Plain {
    static constexpr bool PERM = false, AFTER_DRAIN = false;
    float* C; int ldc;
    __device__ __forceinline__ void operator()(const f32x4 (&acc)[2][2][4][2], const Unit& u, int wr, int wc, int fr, int fq) const {
        const int row0 = u.pm * BM + wr * 64 + fr, col0 = u.pn * BM + wc * 32 + 4 * fq;
#pragma unroll
        for (int ai = 0; ai < 2; ++ai)
#pragma unroll
            for (int m = 0; m < 4; ++m) { float* rowp = C + (size_t)(row0 + ai * HALF + m * 16) * ldc + col0;
#pragma unroll
                for (int bj = 0; bj < 2; ++bj)
#pragma unroll
                    for (int n = 0; n < 2; ++n) *(f32x4*)(rowp + bj * HALF + n * 16) = acc[ai][bj][m][n]; }
    }
};
template <class Epi, class Sched, bool STAMP = false>
__device__ __forceinline__ void gemm_phase(PG8_LAS unsigned char* lds, const Gemm g, const Sched& S, const Epi& E, unsigned long long* stamps) {
    int tid_o = threadIdx.x; asm volatile("" : "+v"(tid_o));
    const int tid = tid_o, wid = __builtin_amdgcn_readfirstlane(tid >> 6), lane = tid & 63, wr = wid >> 2, wc = wid & 3, fr = lane & 15, fq = lane >> 4;
    const int K = g.K, nt = K / BK;
    int ts_lo = 0, ts_hi = 0, nts = 0; const unsigned long long rt_entry = STAMP ? (unsigned long long)wall_clock64() : 0ull;
#define PG8_STAMP() do { if (STAMP && wid == 0 && nts < 64) { const unsigned long long _c = (unsigned long long)clock64(); \
        ts_lo = (lane == nts) ? (int)(unsigned)_c : ts_lo; ts_hi = (lane == nts) ? (int)(unsigned)(_c >> 32) : ts_hi; ++nts; } } while (0)
    PG8_STAMP();
    unsigned voffA[2], voffB[2];
#pragma unroll
    for (int i = 0; i < 2; ++i) { int R, C; stage_rc(tid * 16 + i * 8192, R, C); const int Rb = Epi::PERM ? ((R & ~31) + perm32(R & 31)) : R;
        voffA[i] = (unsigned)(R * K + C) * 2u; voffB[i] = (unsigned)(Rb * K + C) * 2u; }
    const size_t kstep = (size_t)(BK * 2);
    const size_t hstep = (size_t)HALF * K * 2;
    const size_t tstep = 2 * hstep;
    const unsigned ldsw = (unsigned)wid * 1024u;
    const int aoff = lds_byte(wr * 64 + fr, fq * 8), boff = lds_byte(wc * 32 + fr, fq * 8);
#define PG8_SA(b, h) (((b) * 2 + (h)) * HTB)
#define PG8_SB(b, h) ((4 + (b) * 2 + (h)) * HTB)
#define PG8_STAGE(bufoff, gbase, voff) do { _Pragma("unroll") for (int _i = 0; _i < 2; ++_i) \
        __builtin_amdgcn_global_load_lds((const unsigned*)((const char*)(gbase) + (voff)[_i]), (PG8_LAS unsigned*)(lds + (bufoff) + ldsw + _i * 8192), 16, 0, 0); } while (0)
#define PG8_LDA(dst, b, h) do { _Pragma("unroll") for (int m = 0; m < 4; ++m) _Pragma("unroll") for (int k = 0; k < 2; ++k) dst[m][k] = *(const PG8_LAS bf16x8*)(lds + PG8_SA(b, h) + aoff + m * 2048 + k * 1024); } while (0)
#define PG8_LDB(dst, b, h) do { _Pragma("unroll") for (int n = 0; n < 2; ++n) _Pragma("unroll") for (int k = 0; k < 2; ++k) dst[n][k] = *(const PG8_LAS bf16x8*)(lds + PG8_SB(b, h) + boff + n * 2048 + k * 1024); } while (0)
#define PG8_MMA(ai, bj, At, Bt) do { __builtin_amdgcn_s_setprio(1); _Pragma("unroll") for (int m = 0; m < 4; ++m) _Pragma("unroll") for (int n = 0; n < 2; ++n) _Pragma("unroll") for (int k = 0; k < 2; ++k) \
        acc[ai][bj][m][n] = __builtin_amdgcn_mfma_f32_16x16x32_bf16(Bt[n][k], At[m][k], acc[ai][bj][m][n], 0, 0, 0); __builtin_amdgcn_s_setprio(0); } while (0)
#define PG8_WAIT_V(n) asm volatile("s_waitcnt vmcnt(" #n ")" ::: "memory")
#define PG8_WAIT_L(n) asm volatile("s_waitcnt lgkmcnt(" #n ")" ::: "memory")
#define PG8_BAR __builtin_amdgcn_s_barrier()
#define PG8_SCHED __builtin_amdgcn_sched_barrier(0)
    Unit cur, nxt; int ui = 0;
    if (!S.next(0, cur)) return;
    f32x4 acc[2][2][4][2];
#pragma unroll
    for (int a = 0; a < 2; ++a)
#pragma unroll
        for (int b = 0; b < 2; ++b)
#pragma unroll
            for (int m = 0; m < 4; ++m)
#pragma unroll
                for (int n = 0; n < 2; ++n) acc[a][b][m][n] = (f32x4){0.f, 0.f, 0.f, 0.f};
    bf16x8 At[4][2], B0[2][2], B1[2][2];
    const char* cA = (const char*)g.A + (size_t)cur.pm * tstep; const char* cB = (const char*)g.Bt + (size_t)cur.pn * tstep;
    S.a_ready(cur);
    PG8_STAGE(PG8_SB(0, 0), cB, voffB); PG8_STAGE(PG8_SA(0, 0), cA, voffA); PG8_STAGE(PG8_SB(0, 1), cB + hstep, voffB); PG8_STAGE(PG8_SA(0, 1), cA + hstep, voffA);
    if (wr == 1) PG8_BAR;
    PG8_WAIT_V(4); PG8_BAR;
    PG8_STAGE(PG8_SB(1, 0), cB + kstep, voffB); PG8_STAGE(PG8_SA(1, 0), cA + kstep, voffA); PG8_STAGE(PG8_SB(1, 1), cB + hstep + kstep, voffB);
    PG8_WAIT_V(6); PG8_BAR;
    PG8_STAMP();
    for (;;) {
        const bool has_next = S.next(ui + 1, nxt);
        const char* nA = has_next ? (const char*)g.A + (size_t)nxt.pm * tstep : cA; const char* nB = has_next ? (const char*)g.Bt + (size_t)nxt.pn * tstep : cB;
        for (int t = 0; t < nt; t += 2) {
            const bool last = (t == nt - 2);
            const char* a1 = cA + (size_t)(t + 1) * kstep;
            const char* a2 = last ? nA : cA + (size_t)(t + 2) * kstep; const char* b2 = last ? nB : cB + (size_t)(t + 2) * kstep;
            const char* a3 = a2 + kstep; const char* b3 = b2 + kstep;
            if (last && has_next) S.a_ready(nxt);
            PG8_LDB(B0, 0, 0); PG8_SCHED; PG8_LDA(At, 0, 0); PG8_STAGE(PG8_SA(1, 1), a1 + hstep, voffA);
            PG8_WAIT_L(8); PG8_BAR; PG8_WAIT_L(0); PG8_MMA(0, 0, At, B0); PG8_BAR; PG8_SCHED;
            PG8_LDB(B1, 0, 1); PG8_STAGE(PG8_SB(0, 0), b2, voffB);
            PG8_BAR; PG8_WAIT_L(0); PG8_MMA(0, 1, At, B1); PG8_BAR;
            PG8_LDA(At, 0, 1); PG8_STAGE(PG8_SA(0, 0), a2, voffA);
            PG8_BAR; PG8_WAIT_L(0); PG8_MMA(1, 0, At, B0); PG8_BAR; PG8_SCHED;
            PG8_STAGE(PG8_SB(0, 1), b2 + hstep, voffB);
            PG8_WAIT_V(6); PG8_BAR; PG8_MMA(1, 1, At, B1); PG8_BAR;
            PG8_LDB(B0, 1, 0); PG8_SCHED; PG8_LDA(At, 1, 0); PG8_STAGE(PG8_SA(0, 1), a2 + hstep, voffA);
            PG8_WAIT_L(8); PG8_BAR; PG8_WAIT_L(0); PG8_MMA(0, 0, At, B0); PG8_BAR; PG8_SCHED;
            PG8_LDB(B1, 1, 1); PG8_STAGE(PG8_SB(1, 0), b3, voffB);
            PG8_BAR; PG8_WAIT_L(0); PG8_MMA(0, 1, At, B1); PG8_BAR;
            PG8_LDA(At, 1, 1); PG8_STAGE(PG8_SA(1, 0), a3, voffA);
            PG8_BAR; PG8_WAIT_L(0); PG8_MMA(1, 0, At, B0); PG8_BAR; PG8_SCHED;
            PG8_STAGE(PG8_SB(1, 1), b3 + hstep, voffB);
            PG8_WAIT_V(6); PG8_BAR; PG8_MMA(1, 1, At, B1); PG8_BAR;
        }
        PG8_STAMP();
        if constexpr (!Epi::AFTER_DRAIN) { E(acc, cur, wr, wc, fr, fq); S.done(cur); }
        PG8_STAMP();
        if (!has_next) break;
#pragma unroll
        for (int a = 0; a < 2; ++a)
#pragma unroll
            for (int b = 0; b < 2; ++b)
#pragma unroll
                for (int m = 0; m < 4; ++m)
#pragma unroll
                    for (int n = 0; n < 2; ++n) acc[a][b][m][n] = (f32x4){0.f, 0.f, 0.f, 0.f};
        cur = nxt; cA = nA; cB = nB; ++ui;
    }
    PG8_WAIT_V(0);
    if (wr == 0) PG8_BAR;
    PG8_BAR;
    if constexpr (Epi::AFTER_DRAIN) { E.fused(acc, cur, wr, wc, fr, fq, lds, wid, lane); S.done(cur); }
    PG8_STAMP();
    if (STAMP && wid == 0) { stamps[lane] = lane < nts ? (((unsigned long long)(unsigned)ts_hi << 32) | (unsigned)ts_lo) : 0ull;
        if (lane == 62) stamps[62] = rt_entry; if (lane == 63) stamps[63] = (unsigned long long)wall_clock64(); }
#undef PG8_STAMP
#undef PG8_SA
#undef PG8_SB
#undef PG8_STAGE
#undef PG8_LDA
#undef PG8_LDB
#undef PG8_MMA
#undef PG8_WAIT_V
#undef PG8_WAIT_L
#undef PG8_BAR
#undef PG8_SCHED
}
}

#define XB_TMO      128
#define XB_XCNT(j)  (256  + 64 * (j))
#define XB_XSUB(j)  (1280 + 64 * (j))
#define XB_XGEN(j)  (2304 + 64 * (j))
#define XB_TOP      3328
#define XB_TOPGEN   3392
#define XCD_BAR_WORDS 3456
#define XB_SPIN_CAP (1u << 18)
#define LAS __attribute__((address_space(3)))

__device__ __forceinline__ unsigned xb_ld(unsigned* p)              { return __hip_atomic_load(p, __ATOMIC_RELAXED, __HIP_MEMORY_SCOPE_AGENT); }
__device__ __forceinline__ unsigned xb_add(unsigned* p, unsigned v) { return __hip_atomic_fetch_add(p, v, __ATOMIC_RELAXED, __HIP_MEMORY_SCOPE_AGENT); }
__device__ __forceinline__ unsigned xb_xcc_id() { return (unsigned)__builtin_amdgcn_s_getreg((3 << 11) | 20) & 0xFu; }
#define XB_SPIN(cond, bar) do { unsigned _sp = 0; while (cond) { __builtin_amdgcn_s_sleep(1); \
    if ((++_sp & 255u) == 0u) { if (xb_ld(&(bar)[XB_TMO])) break; if (_sp > XB_SPIN_CAP) { atomicAdd(&(bar)[XB_TMO], 1u); break; } } } } while (0)

struct XcdBarrier {
    unsigned* bar; unsigned x;
    volatile LAS unsigned* st;
};

__device__ __forceinline__ XcdBarrier xcd_barrier_post(unsigned* bar, volatile LAS unsigned* st) {
    XcdBarrier b; b.bar = bar; b.x = xb_xcc_id(); b.st = st;
    if (threadIdx.x == 0) (void)xb_add(&bar[XB_XCNT(b.x)], 1u);
    return b;
}
__device__ __forceinline__ void xcd_barrier_complete(unsigned* bar, unsigned x, unsigned& nloc, unsigned& nx) {
    const unsigned G = gridDim.x * gridDim.y * gridDim.z;
    unsigned sum, cnt, mine, sp = 0u;
    for (;;) {
        sum = 0u; cnt = 0u; mine = 0u;
#pragma unroll
        for (unsigned j = 0; j < 16; ++j) { const unsigned c = xb_ld(&bar[XB_XCNT(j)]); sum += c; cnt += (c > 0u) ? 1u : 0u; mine = (j == x) ? c : mine; }
        if (sum == G) break;
        __builtin_amdgcn_s_sleep(1);
        if ((++sp & 255u) == 0u) { if (xb_ld(&bar[XB_TMO])) break; if (sp > XB_SPIN_CAP) { atomicAdd(&bar[XB_TMO], 1u); break; } }
    }
    nloc = mine > 0u ? mine : 1u; nx = cnt > 0u ? cnt : 1u;
}

__device__ __forceinline__ void xcd_barrier(const XcdBarrier& b) {
    asm volatile("s_waitcnt vmcnt(0)" ::: "memory");
    __syncthreads();
    if (threadIdx.x == 0) {
        unsigned* bar = b.bar;
        __builtin_amdgcn_s_waitcnt(0);
        unsigned nloc = b.st[0], nx = b.st[1];
        if (nloc == 0u) { xcd_barrier_complete(bar, b.x, nloc, nx); b.st[0] = nloc; b.st[1] = nx; }
        const unsigned old = xb_add(&bar[XB_XSUB(b.x)], 1u);
        const unsigned gen = old / nloc;
        if (old + 1u == (gen + 1u) * nloc) {
            __builtin_amdgcn_fence(__ATOMIC_RELEASE, "agent");
            asm volatile("s_waitcnt vmcnt(0)" ::: "memory");
            const unsigned og = xb_add(&bar[XB_TOP], 1u);
            const unsigned tg = og / nx;
            if (og + 1u == (tg + 1u) * nx) xb_add(&bar[XB_TOPGEN], 1u);
            else XB_SPIN(xb_ld(&bar[XB_TOPGEN]) == tg, bar);
            __builtin_amdgcn_fence(__ATOMIC_ACQUIRE, "agent");
            xb_add(&bar[XB_XGEN(b.x)], 1u);
            asm volatile("s_waitcnt vmcnt(0)" ::: "memory");
        } else {
            XB_SPIN(xb_ld(&bar[XB_XGEN(b.x)]) == gen, bar);
            __builtin_amdgcn_fence(__ATOMIC_ACQUIRE, "agent");
            asm volatile("s_waitcnt vmcnt(0)" ::: "memory");
        }
    }
    __syncthreads();
}
typedef pg8::bf16_t bf16_t;
typedef short bf16x8 __attribute__((ext_vector_type(8)));
typedef short s16x4 __attribute__((ext_vector_type(4)));
typedef float f32x4 __attribute__((ext_vector_type(4)));
typedef float f32x16 __attribute__((ext_vector_type(16)));
typedef unsigned u32x4 __attribute__((ext_vector_type(4)));
typedef unsigned u32x2 __attribute__((ext_vector_type(2)));
constexpr int T = 8192, DM = 4096, NIN = 21552, NP = 21760, DEPTH = 2, NWAVES = 8, NTHREADS = 512;
constexpr int C_Q = 0, C_KV = 2048, C_ZA = 5120, C_UB = 7168, C_VB = 9216, C_ZB = 11264, C_MA = 13312, C_MB = 17408, C_GA = 21504;
constexpr int AW = 2048, BW = 2048, HD = 128, NCMP = 511, NCP = 512;
constexpr float NORM_EPS = 1e-6f;
constexpr size_t al256(size_t x) { return (x + 255) & ~(size_t)255; }
constexpr size_t WS_CTL = 0, CTL_BYTES = 1u << 20;
constexpr size_t SZ_WIN = (size_t)NP * DM * 2, SZ_WAB = (size_t)DM * AW * 2, SZ_WO = (size_t)DM * DM * 2, SZ_W1 = (size_t)HD * 4096 * 2, SZ_W2 = (size_t)HD * HD * 2;
constexpr size_t WS_WIN = WS_CTL + CTL_BYTES;
constexpr size_t WS_WA = WS_WIN + DEPTH * SZ_WIN;
constexpr size_t WS_WB = WS_WA + DEPTH * SZ_WAB;
constexpr size_t WS_WO = WS_WB + DEPTH * SZ_WAB;
constexpr size_t WS_W1 = WS_WO + DEPTH * SZ_WO;
constexpr size_t WS_W2 = WS_W1 + DEPTH * 2 * SZ_W1;
constexpr size_t WS_H = al256(WS_W2 + DEPTH * 2 * SZ_W2);
constexpr size_t WS_PROJ = WS_H + (size_t)T * DM * 2;
constexpr size_t WS_KC = WS_PROJ + (size_t)T * NP * 2;
constexpr size_t WS_VC = WS_KC + (size_t)NCP * 512 * 2;
constexpr size_t WS_OA = WS_VC + (size_t)NCP * 512 * 2;
constexpr size_t WS_OB = WS_OA + (size_t)T * AW * 2;
constexpr size_t WS_T1 = WS_OB + (size_t)T * BW * 2;
constexpr size_t WS_MG = WS_T1 + (size_t)T * DM * 2;
constexpr size_t WS_Y = WS_MG + (size_t)T * DM * 2;
constexpr size_t WS_X1 = WS_Y + (size_t)T * DM * 4;
constexpr size_t WS_SS = WS_X1 + (size_t)T * DM * 4;
constexpr size_t WS_END = WS_SS + (size_t)T * 32 * 4;
constexpr int LDS_STAGE = 0;
constexpr int LDS_BIAS = 131072;
constexpr int LDS_MISC = LDS_BIAS + 16 * 256 * 4;
constexpr int LDS_RS = LDS_MISC + 64;
constexpr int LDS_BYTES = LDS_RS + 512;
#define LAS3 __attribute__((address_space(3)))
#define LDS_WAIT() asm volatile("s_waitcnt lgkmcnt(0)" ::: "memory")
#define VM_WAIT() asm volatile("s_waitcnt vmcnt(0)" ::: "memory")

struct Params {
    const float *x, *rel_bias, *pre_norm, *w_in, *pe_k, *w1_k, *w2_k, *pe_v, *w1_v, *w2_v, *w_out_a, *sgu_norm, *sgu_w, *sgu_b, *w_out_b, *w_out, *post_norm;
    float* out; unsigned char* ws; int ph_lo, ph_hi;
};
__device__ __forceinline__ unsigned pk2(float lo, float hi) { return pg8::cvt_pk_bf16(lo, hi); }
__device__ __forceinline__ float wave_sum(float v) {
#pragma unroll
    for (int o = 1; o < 64; o <<= 1) v += __shfl_xor(v, o);
    return v;
}
__device__ const unsigned char BUCKET[128] = {0, 1, 2, 3, 4, 5, 6, 7, 8, 9, 10, 11, 12, 13, 14, 15, 16, 16, 16, 17, 17, 18, 18, 18, 19, 19, 19, 20, 20, 20, 20, 21, 21, 21, 21, 22, 22, 22, 22, 22, 23, 23, 23, 23, 23, 23, 24, 24, 24, 24, 24, 24, 25, 25, 25, 25, 25, 25, 25, 26, 26, 26, 26, 26, 26, 26, 26, 27, 27, 27, 27, 27, 27, 27, 27, 27, 27, 28, 28, 28, 28, 28, 28, 28, 28, 28, 28, 29, 29, 29, 29, 29, 29, 29, 29, 29, 29, 29, 29, 30, 30, 30, 30, 30, 30, 30, 30, 30, 30, 30, 30, 30, 30, 31, 31, 31, 31, 31, 31, 31, 31, 31, 31, 31, 31, 31, 31, 31};

__device__ __forceinline__ int srcmap_in(int n) { return n < 5120 ? n : (n < 21504 ? n + 48 : (n < 21552 ? n - 21504 + 5120 : -1)); }
template <int MODE>
__device__ __forceinline__ void transpose_item(const float* __restrict__ W, int K, int N, bf16_t* __restrict__ WT, LAS3 float* scr, int item, int nblk, int lane) {
    const int kb = item / nblk, nb = item - kb * nblk, k0 = 64 * kb, n0 = 64 * nb;
    const int nn = n0 + 4 * (lane & 15); const int s = (MODE == 1) ? srcmap_in(nn) : nn;
    const float* src = W + (size_t)(k0 + (lane >> 4)) * N + (s >= 0 ? s : 0);
#pragma unroll 8
    for (int i = 0; i < 16; ++i) { f32x4 v = *(const f32x4*)(src + (size_t)(4 * i) * N); if (s < 0) v = (f32x4){0.f, 0.f, 0.f, 0.f};
        LAS3 float* d = scr + (4 * i + (lane >> 4)) * 65 + 4 * (lane & 15); d[0] = v[0]; d[1] = v[1]; d[2] = v[2]; d[3] = v[3]; }
    LDS_WAIT();
    const int c = lane & 7;
#pragma unroll
    for (int j = 0; j < 8; ++j) { const int n = (lane >> 3) + 8 * j; const LAS3 float* p = scr + (8 * c) * 65 + n;
        u32x4 o; o.x = pk2(p[0 * 65], p[1 * 65]); o.y = pk2(p[2 * 65], p[3 * 65]); o.z = pk2(p[4 * 65], p[5 * 65]); o.w = pk2(p[6 * 65], p[7 * 65]);
        if (MODE == 2) { const int k8 = (k0 >> 3) + c, na = n0 + n; *(u32x4*)(WT + (size_t)((((k8 >> 1) * (N >> 5) + (na >> 5)) * 64) + (k8 & 1) * 32 + (na & 31)) * 8) = o; }
        else *(u32x4*)(WT + (size_t)(n0 + n) * K + k0 + 8 * c) = o; }
    LDS_WAIT();
}
__device__ __forceinline__ void phase_weights(const Params& P, LAS3 unsigned char* lds, int gw, int NGW, int wave, int lane) {
    asm volatile("" : "+v"(lane));
    LAS3 float* scr = (LAS3 float*)(lds + LDS_STAGE + wave * 16640);
    constexpr int I_IN = 64 * (NP / 64), I_AB = 32 * 64, I_O = 64 * 64, I_W1 = 64 * 2, I_W2 = 2 * 2;
    constexpr int PER_LAYER = I_IN + 2 * I_AB + I_O + 2 * I_W1 + 2 * I_W2;
    for (int it = gw; it < DEPTH * PER_LAYER; it += NGW) {
        const int L = it / PER_LAYER; int r = it - L * PER_LAYER;
        unsigned char* ws = P.ws;
        if (r < I_IN) { transpose_item<1>(P.w_in + (size_t)L * DM * NIN, DM, NIN, (bf16_t*)(ws + WS_WIN + L * SZ_WIN), scr, r, NP / 64, lane); continue; } r -= I_IN;
        if (r < I_AB) { transpose_item<0>(P.w_out_a + (size_t)L * AW * DM, AW, DM, (bf16_t*)(ws + WS_WA + L * SZ_WAB), scr, r, 64, lane); continue; } r -= I_AB;
        if (r < I_AB) { transpose_item<0>(P.w_out_b + (size_t)L * BW * DM, BW, DM, (bf16_t*)(ws + WS_WB + L * SZ_WAB), scr, r, 64, lane); continue; } r -= I_AB;
        if (r < I_O) { transpose_item<0>(P.w_out + (size_t)L * DM * DM, DM, DM, (bf16_t*)(ws + WS_WO + L * SZ_WO), scr, r, 64, lane); continue; } r -= I_O;
        if (r < I_W1) { transpose_item<2>(P.w1_k + (size_t)L * 4096 * HD, 4096, HD, (bf16_t*)(ws + WS_W1 + (L * 2 + 0) * SZ_W1), scr, r, 2, lane); continue; } r -= I_W1;
        if (r < I_W1) { transpose_item<2>(P.w1_v + (size_t)L * 4096 * HD, 4096, HD, (bf16_t*)(ws + WS_W1 + (L * 2 + 1) * SZ_W1), scr, r, 2, lane); continue; } r -= I_W1;
        if (r < I_W2) { transpose_item<0>(P.w2_k + (size_t)L * HD * HD, HD, HD, (bf16_t*)(ws + WS_W2 + (L * 2 + 0) * SZ_W2), scr, r, 2, lane); continue; } r -= I_W2;
        transpose_item<0>(P.w2_v + (size_t)L * HD * HD, HD, HD, (bf16_t*)(ws + WS_W2 + (L * 2 + 1) * SZ_W2), scr, r, 2, lane);
    }
}
__device__ __forceinline__ void phase_prenorm(const float* __restrict__ x, const float* __restrict__ g, bf16_t* __restrict__ h, int gw, int NGW, int lane) {
    asm volatile("" : "+v"(lane));
    for (int m = gw; m < T; m += NGW) {
        const f32x4* xr = (const f32x4*)(x + (size_t)m * DM) + lane; f32x4 v[16]; float ss = 0.f;
#pragma unroll
        for (int j = 0; j < 16; ++j) { v[j] = xr[64 * j]; ss += (v[j][0] * v[j][0] + v[j][1] * v[j][1]) + (v[j][2] * v[j][2] + v[j][3] * v[j][3]); }
        const float rs = 1.0f / sqrtf(wave_sum(ss) * (1.0f / DM) + NORM_EPS);
        u32x2* o = (u32x2*)(h + (size_t)m * DM) + lane; const f32x4* gr = (const f32x4*)g + lane;
#pragma unroll
        for (int j = 0; j < 16; ++j) { const f32x4 gg = gr[64 * j]; u32x2 w; w.x = pk2(v[j][0] * rs * gg[0], v[j][1] * rs * gg[1]); w.y = pk2(v[j][2] * rs * gg[2], v[j][3] * rs * gg[3]); o[64 * j] = w; }
    }
}
__device__ __forceinline__ void phase_postnorm(const float* __restrict__ Y, const float* __restrict__ xold, const float* __restrict__ gpost, float* __restrict__ xnew,
                                               const float* __restrict__ gpre, bf16_t* __restrict__ h, bool next, int gw, int NGW, int lane) {
    asm volatile("" : "+v"(lane));
    for (int m = gw; m < T; m += NGW) {
        const f32x4* yr = (const f32x4*)(Y + (size_t)m * DM) + lane; f32x4 v[16]; float ss = 0.f;
#pragma unroll
        for (int j = 0; j < 16; ++j) { v[j] = yr[64 * j]; ss += (v[j][0] * v[j][0] + v[j][1] * v[j][1]) + (v[j][2] * v[j][2] + v[j][3] * v[j][3]); }
        const float rs = 1.0f / sqrtf(wave_sum(ss) * (1.0f / DM) + NORM_EPS);
        const f32x4* xr = (const f32x4*)(xold + (size_t)m * DM) + lane; const f32x4* gr = (const f32x4*)gpost + lane; f32x4* xo = (f32x4*)(xnew + (size_t)m * DM) + lane;
        float s2 = 0.f;
#pragma unroll
        for (int j = 0; j < 16; ++j) { const f32x4 gg = gr[64 * j], xx = xr[64 * j]; f32x4 r = xx + v[j] * rs * gg; v[j] = r; xo[64 * j] = r; s2 += (r[0] * r[0] + r[1] * r[1]) + (r[2] * r[2] + r[3] * r[3]); }
        if (next) {
            const float rs2 = 1.0f / sqrtf(wave_sum(s2) * (1.0f / DM) + NORM_EPS);
            u32x2* o = (u32x2*)(h + (size_t)m * DM) + lane; const f32x4* g2 = (const f32x4*)gpre + lane;
#pragma unroll
            for (int j = 0; j < 16; ++j) { const f32x4 gg = g2[64 * j]; u32x2 w; w.x = pk2(v[j][0] * rs2 * gg[0], v[j][1] * rs2 * gg[1]); w.y = pk2(v[j][2] * rs2 * gg[2], v[j][3] * rs2 * gg[3]); o[64 * j] = w; }
        }
    }
}
namespace att {
constexpr float SCALE = 0.08838834764831845f, LOG2E = 1.4426950408889634f, C2 = SCALE * LOG2E;
constexpr int SHM = 16384;
constexpr int L_V = 0, L_K = 2 * SHM, L_IMP = 4 * SHM, L_SEL = L_IMP + 32768, L_WS = L_SEL + 1024, L_SC = L_WS + 2048, L_END = L_SC + 4096;
static_assert(L_END <= 131072, "attention LDS");
#define KSWZ(row, colB) ((row) * 256 + ((colB) ^ (((row) & 7) << 4)))
#define SBAR() __builtin_amdgcn_sched_barrier(0)
__device__ __forceinline__ int v_st(int k, int c) { const int kk = (k & ~0xC) | ((k & 4) << 1) | ((k & 8) >> 1); return ((kk >> 3) * 4 + (c >> 5)) * 512 + ((kk & 7) * 32 + (c & 31)) * 2; }
__device__ __forceinline__ int v_rd_base(int lane) { return ((lane & 3) << 3) | (((lane >> 2) & 3) << 6) | (((lane >> 4) & 1) << 5) | (((lane >> 5) & 1) << 8); }
constexpr int v_rd_off(int d0, int ks, int half) { return d0 * 512 + ks * 4096 + half * 2048; }
__device__ __forceinline__ int crow(int r, int hi) { return (r & 3) + 8 * (r >> 2) + 4 * hi; }
__device__ __forceinline__ unsigned cvtpk(float lo, float hi) { return pg8::cvt_pk_bf16(lo, hi); }
enum { MODE_STAT = 0, MODE_IMP = 1, MODE_ONLINE = 2, MODE_ACC = 3 };

struct Ctx {
    bf16x8 qr[8]; f32x16 o[4];
    int tq, r32, hi, wid, lane, tid, t0;
    const LAS3 float* tb; float bfar;
    LAS3 char* lds;
};
__device__ __forceinline__ void qkt(f32x16& p0, f32x16& p1, const LAS3 char* Kt, int r32, int hi, const bf16x8* qr) {
    p0 = f32x16{}; p1 = f32x16{};
    const LAS3 char* kb[4];
#pragma unroll
    for (int dd = 0; dd < 4; ++dd) kb[dd] = Kt + KSWZ(r32, (dd * 16 + hi * 8) * 2);
#pragma unroll
    for (int d0 = 0; d0 < 8; ++d0) { const LAS3 char* a = kb[d0 & 3] + (d0 >> 2) * 128;
        const bf16x8 b0 = *reinterpret_cast<const LAS3 bf16x8*>(a);
        const bf16x8 b1 = *reinterpret_cast<const LAS3 bf16x8*>(a + 32 * 256);
        p0 = __builtin_amdgcn_mfma_f32_32x32x16_bf16(b0, qr[d0], p0, 0, 0, 0);
        p1 = __builtin_amdgcn_mfma_f32_32x32x16_bf16(b1, qr[d0], p1, 0, 0, 0);
        if ((d0 & 1) == 1) SBAR(); }
}
__device__ __forceinline__ void pv_tile(f32x16* o, int vb0, bf16x8 pa0, bf16x8 pa1, bf16x8 pa2, bf16x8 pa3) {
#define TRRD(dst, off) asm volatile("ds_read_b64_tr_b16 %0, %1 offset:%2" : "=&v"(dst) : "v"(vb0), "i"(off) : "memory")
#define PV_D0(d0) do { s16x4 l0, l1, l2, l3, h0, h1, h2, h3; constexpr int b_ = v_rd_off(d0, 0, 0); \
        TRRD(l0, b_); TRRD(h0, b_ + 2048); TRRD(l1, b_ + 4096); TRRD(h1, b_ + 6144); TRRD(l2, b_ + 8192); TRRD(h2, b_ + 10240); TRRD(l3, b_ + 12288); TRRD(h3, b_ + 14336); \
        asm volatile("s_waitcnt lgkmcnt(0)" ::: "memory"); SBAR(); \
        o[d0] = __builtin_amdgcn_mfma_f32_32x32x16_bf16(pa0, (bf16x8){l0[0], l0[1], l0[2], l0[3], h0[0], h0[1], h0[2], h0[3]}, o[d0], 0, 0, 0); \
        o[d0] = __builtin_amdgcn_mfma_f32_32x32x16_bf16(pa1, (bf16x8){l1[0], l1[1], l1[2], l1[3], h1[0], h1[1], h1[2], h1[3]}, o[d0], 0, 0, 0); \
        o[d0] = __builtin_amdgcn_mfma_f32_32x32x16_bf16(pa2, (bf16x8){l2[0], l2[1], l2[2], l2[3], h2[0], h2[1], h2[2], h2[3]}, o[d0], 0, 0, 0); \
        o[d0] = __builtin_amdgcn_mfma_f32_32x32x16_bf16(pa3, (bf16x8){l3[0], l3[1], l3[2], l3[3], h3[0], h3[1], h3[2], h3[3]}, o[d0], 0, 0, 0); } while (0)
    PV_D0(0); PV_D0(1); PV_D0(2); PV_D0(3);
#undef PV_D0
#undef TRRD
}
__device__ __forceinline__ void pack_p(const f32x16& p0, const f32x16& p1, bf16x8& pa0, bf16x8& pa1, bf16x8& pa2, bf16x8& pa3) {
#define PK4(P, B_, OUT) do { unsigned a0 = cvtpk(P[B_+0], P[B_+1]), a1 = cvtpk(P[B_+2], P[B_+3]); \
        unsigned b0 = cvtpk(P[B_+4], P[B_+5]), b1 = cvtpk(P[B_+6], P[B_+7]); \
        auto r0 = __builtin_amdgcn_permlane32_swap(a0, b0, false, false); auto r1 = __builtin_amdgcn_permlane32_swap(a1, b1, false, false); \
        u32x4 w = {r0[0], r1[0], r0[1], r1[1]}; OUT = *reinterpret_cast<bf16x8*>(&w); } while (0)
    PK4(p0, 0, pa0); PK4(p0, 8, pa1); PK4(p1, 0, pa2); PK4(p1, 8, pa3);
#undef PK4
}
__device__ __forceinline__ float half_max(float v) { auto rr = __builtin_amdgcn_permlane32_swap(__float_as_uint(v), __float_as_uint(v), false, false); return fmaxf(__uint_as_float(rr[0]), __uint_as_float(rr[1])); }
__device__ __forceinline__ float half_sum(float v) { auto rr = __builtin_amdgcn_permlane32_swap(__float_as_uint(v), __float_as_uint(v), false, false); return __uint_as_float(rr[0]) + __uint_as_float(rr[1]); }

template <int MODE, int STEP, int OFF, bool ROWSEL>
__device__ __forceinline__ void run_pass(Ctx& c, const bf16_t* __restrict__ Kg, const bf16_t* __restrict__ Vg, int ldk, int j_lo, int j_hi, unsigned W,
                                         float& m_reg, float& l_reg, float pscale, unsigned sm0, unsigned sm1, unsigned sm2, unsigned sm3) {
    constexpr bool HASV = (MODE == MODE_ONLINE || MODE == MODE_ACC);
    int tid = c.tid, r32 = c.r32, hi = c.hi, lane = c.lane;
    asm volatile("" : "+v"(tid), "+v"(r32), "+v"(hi), "+v"(lane));
    LAS3 char* V_lds = c.lds + L_V; LAS3 char* K_lds = c.lds + L_K;
    LAS3 float* wsf = (LAS3 float*)(c.lds + L_WS) + c.wid * 64; LAS3 float* al_l = wsf + 32;
    const int krow = tid >> 4;
    const unsigned ko0 = (unsigned)(krow * ldk + (((tid & 15) ^ (krow & 7)) * 8)) * 2u;
    const int vkk = ((tid >> 7) * 8) + ((tid & 31) >> 2), vkey = (vkk & ~0xC) | ((vkk & 4) << 1) | ((vkk & 8) >> 1), vcol = ((tid >> 5) & 3) * 32 + (tid & 3) * 8;
    const unsigned vo0 = (unsigned)(vkey * ldk + vcol) * 2u;
    const unsigned half_step = (unsigned)(32 * ldk) * 2u;
    const int vbase = (int)(uintptr_t)V_lds + v_rd_base(lane);
#define LOADT(j, bf) do { const char* kp_ = (const char*)(Kg + (size_t)((j) * 64) * ldk); LAS3 char* kd_ = K_lds + (bf) * SHM + c.wid * 1024; \
        __builtin_amdgcn_global_load_lds((const unsigned*)(kp_ + ko0), (LAS3 unsigned*)kd_, 16, 0, 0); \
        __builtin_amdgcn_global_load_lds((const unsigned*)(kp_ + ko0 + half_step), (LAS3 unsigned*)(kd_ + 8192), 16, 0, 0); \
        if (HASV) { const char* vp_ = (const char*)(Vg + (size_t)((j) * 64) * ldk); LAS3 char* vd_ = V_lds + (bf) * SHM + c.wid * 1024; \
            __builtin_amdgcn_global_load_lds((const unsigned*)(vp_ + vo0), (LAS3 unsigned*)vd_, 16, 0, 0); \
            __builtin_amdgcn_global_load_lds((const unsigned*)(vp_ + vo0 + half_step), (LAS3 unsigned*)(vd_ + 8192), 16, 0, 0); } } while (0)
    if (j_lo > j_hi) return;
    LOADT(j_lo, 0); VM_WAIT(); __syncthreads();
    const int tqw = c.t0 + 8 * c.wid;
    for (int j = j_lo; j <= j_hi; ++j) {
        const int cur = (j - j_lo) & 1;
        if (j < j_hi) LOADT(j + 1, cur ^ 1);
        const int kpos0 = STEP * (j * 64) + OFF;
        const int dmin = tqw - (kpos0 + STEP * 63), dmax = tqw + 7 - kpos0;
        bool rowsel = true;
        if (ROWSEL) { const unsigned wsel = (j < 32) ? sm0 : (j < 64) ? sm1 : (j < 96) ? sm2 : sm3; rowsel = (wsel >> (j & 31)) & 1u; }
        bool act = (dmax >= 0) && (dmin < (int)W);
        if (ROWSEL) act = act && __any(rowsel);
        if (act) {
            f32x16 p0, p1;
            SBAR(); qkt(p0, p1, K_lds + cur * SHM, r32, hi, c.qr); SBAR();
            const bool nearb = dmin < 113, needmask = (dmin < 0) || ((unsigned)dmax >= W);
            const int d0 = c.tq - kpos0 - STEP * 4 * hi;
#ifdef NO_NEAR
            if (false) {
#else
            if (nearb) {
#endif
                if (STEP == 1) {
                    const LAS3 float* tbase = c.tb + (d0 + 5);
#pragma unroll
                    for (int r = 0; r < 16; ++r) { const int cc = (r & 3) + 8 * (r >> 2);
                        p0[r] = fmaf(p0[r], C2, tbase[59 - cc]); p1[r] = fmaf(p1[r], C2, tbase[59 - cc - 32]);
                        if ((r & 3) == 3) SBAR(); }
                } else {
#pragma unroll
                    for (int r = 0; r < 16; ++r) { const int cc = (r & 3) + 8 * (r >> 2); const int da = d0 - STEP * cc, db = d0 - STEP * (cc + 32);
                        const float ba = c.tb[64 + min(max(da, 0), 127)], bb = c.tb[64 + min(max(db, 0), 127)];
                        p0[r] = fmaf(p0[r], C2, ba); p1[r] = fmaf(p1[r], C2, bb);
                        if ((r & 3) == 3) SBAR(); }
                }
            } else {
#pragma unroll
                for (int r = 0; r < 16; ++r) { p0[r] = fmaf(p0[r], C2, c.bfar); p1[r] = fmaf(p1[r], C2, c.bfar); }
            }
            SBAR();
            const float NEG = -__builtin_inff();
#ifdef NO_MASK
            if (false) {
#else
            if (needmask) {
#endif
#pragma unroll
                for (int r = 0; r < 16; ++r) { const int cc = (r & 3) + 8 * (r >> 2); const int da = d0 - STEP * cc, db = d0 - STEP * (cc + 32);
                    if ((unsigned)da >= W) p0[r] = NEG; if ((unsigned)db >= W) p1[r] = NEG; }
            }
            if (ROWSEL) {
#pragma unroll
                for (int r = 0; r < 16; ++r) { p0[r] = rowsel ? p0[r] : NEG; p1[r] = rowsel ? p1[r] : NEG; }
            }
            if (MODE == MODE_STAT || MODE == MODE_ONLINE) {
                float pmax = p0[0];
#pragma unroll
                for (int r = 1; r < 16; ++r) pmax = fmaxf(pmax, p0[r]);
#pragma unroll
                for (int r = 0; r < 16; ++r) pmax = fmaxf(pmax, p1[r]);
                pmax = half_max(pmax);
                const float mn = fmaxf(m_reg, pmax); const float alpha = __builtin_amdgcn_exp2f(m_reg - mn); m_reg = mn;
                float ps = 0.f;
#pragma unroll
                for (int r = 0; r < 16; ++r) { p0[r] = __builtin_amdgcn_exp2f(p0[r] - mn); p1[r] = __builtin_amdgcn_exp2f(p1[r] - mn); ps += p0[r] + p1[r]; }
                ps = half_sum(ps);
                l_reg = l_reg * alpha + ps;
                if (MODE == MODE_ONLINE) {
#ifdef NO_RESC
                    if (false) {
#else
                    if (__any(alpha < 1.f)) {
#endif
                        if (hi == 0) al_l[r32] = alpha; LDS_WAIT();
#pragma unroll
                        for (int d_ = 0; d_ < 4; ++d_)
#pragma unroll
                            for (int r = 0; r < 16; ++r) c.o[d_][r] *= al_l[crow(r, hi)];
                        SBAR(); }
                    SBAR(); bf16x8 pa0, pa1, pa2, pa3; pack_p(p0, p1, pa0, pa1, pa2, pa3); SBAR();
                    pv_tile(c.o, vbase + cur * SHM, pa0, pa1, pa2, pa3);
                }
            } else {
#pragma unroll
                for (int r = 0; r < 16; ++r) { p0[r] = __builtin_amdgcn_exp2f(p0[r] - m_reg) * pscale; p1[r] = __builtin_amdgcn_exp2f(p1[r] - m_reg) * pscale; }
                if (MODE == MODE_ACC) {
                    bf16x8 pa0, pa1, pa2, pa3; pack_p(p0, p1, pa0, pa1, pa2, pa3);
                    pv_tile(c.o, vbase + cur * SHM, pa0, pa1, pa2, pa3);
                } else {
                    LAS3 float* imp = (LAS3 float*)(c.lds + L_IMP) + (c.wid * 8 + (r32 >> 2)) * 128;
#pragma unroll
                    for (int hf = 0; hf < 2; ++hf)
#pragma unroll
                        for (int m = 0; m < 4; ++m) { const f32x16& P = hf ? p1 : p0;
                            float a = 2.f * (P[4 * m] + P[4 * m + 1] + P[4 * m + 2]) + P[4 * m + 3], b = P[4 * m + 3];
                            a += __shfl_xor(a, 1); b += __shfl_xor(b, 1); a += __shfl_xor(a, 2); b += __shfl_xor(b, 2);
                            const int jj = 16 * j + 8 * hf + 2 * m + hi;
                            if ((r32 & 3) == 0) { __hip_atomic_fetch_add(imp + jj, a, __ATOMIC_RELAXED, __HIP_MEMORY_SCOPE_WORKGROUP);
                                if (jj + 1 < 128) __hip_atomic_fetch_add(imp + jj + 1, b, __ATOMIC_RELAXED, __HIP_MEMORY_SCOPE_WORKGROUP); } }
                }
            }
        }
        VM_WAIT();
        __syncthreads();
    }
#undef LOADT
}
__device__ __forceinline__ void attn_unit(LAS3 char* lds, const bf16_t* __restrict__ proj, const bf16_t* __restrict__ kc, const bf16_t* __restrict__ vc, bf16_t* __restrict__ oa, int qt, int g) {
    int tid_ = threadIdx.x; asm volatile("" : "+v"(tid_));
    Ctx c; c.lds = lds; c.tid = tid_; c.lane = c.tid & 63; c.wid = __builtin_amdgcn_readfirstlane(c.tid >> 6); c.r32 = c.lane & 31; c.hi = c.lane >> 5;
    c.t0 = qt * 64; c.tq = c.t0 + 8 * c.wid + (c.r32 >> 2);
    const int head = g * 4 + (c.r32 & 3);
    c.tb = (const LAS3 float*)(lds + LDS_BIAS) + head * 256; c.bfar = c.tb[64 + 127];
    { const bf16_t* qp = proj + (size_t)c.tq * NP + C_Q + head * HD + c.hi * 8;
#pragma unroll
      for (int d0 = 0; d0 < 8; ++d0) c.qr[d0] = *(const bf16x8*)(qp + d0 * 16); }
    float ga[3];
    { const bf16_t* gp = proj + (size_t)c.tq * NP + C_GA + head * 3;
#pragma unroll
      for (int b = 0; b < 3; ++b) ga[b] = pg8::fast_sigmoid(__uint_as_float(((unsigned)gp[b]) << 16)); }
    { LAS3 f32x4* z = (LAS3 f32x4*)(lds + L_IMP);
#pragma unroll
      for (int i = 0; i < 4; ++i) z[c.tid + 512 * i] = (f32x4){0.f, 0.f, 0.f, 0.f}; }
    __syncthreads();
    const bf16_t* Kc = kc + g * HD; const bf16_t* Vc = vc + g * HD;
    const bf16_t* Ks = proj + C_KV + 2 * 512 + g * HD; const bf16_t* Vs = proj + C_KV + 3 * 512 + g * HD;
    const bf16_t* Kw = proj + C_KV + 4 * 512 + g * HD; const bf16_t* Vw = proj + C_KV + 5 * 512 + g * HD;
    const int ntc = (4 * qt + 2) / 64;
    constexpr unsigned WINF = 0x7fffffffu;
    float m_c = -1e30f, l_c = 0.f;
#ifndef ADBG
#define ADBG 0xff
#endif
    if (ADBG & 1) run_pass<MODE_STAT, 16, 31, false>(c, Kc, Vc, 512, 0, ntc, WINF, m_c, l_c, 0.f, 0u, 0u, 0u, 0u);
    const float rl_c = l_c > 0.f ? 1.0f / l_c : 0.f;
    if (ADBG & 2) run_pass<MODE_IMP, 16, 31, false>(c, Kc, Vc, 512, 0, ntc, WINF, m_c, l_c, rl_c, 0u, 0u, 0u, 0u);
#ifdef NO_TOPK
    if (false)
#endif
    {
        LAS3 float* scr = (LAS3 float*)(lds + L_SC) + c.wid * 128; LAS3 unsigned* selw = (LAS3 unsigned*)(lds + L_SEL);
#pragma unroll 1
        for (int tk = 0; tk < 8; ++tk) {
            const int tok = c.wid * 8 + tk; const LAS3 float* imp = (const LAS3 float*)(lds + L_IMP) + tok * 128;
            const int ja = c.lane, jb = c.lane + 64;
            float sa = imp[ja], sb = imp[jb];
            sa = (ja == 0 || ja == qt || ja == qt - 1) ? 1e9f : (ja > qt ? -1.f : sa);
            sb = (jb == qt || jb == qt - 1) ? 1e9f : (jb > qt ? -1.f : sb);
            scr[ja] = sa; scr[jb] = sb; LDS_WAIT();
            int ca = 0, cb = 0;
#pragma unroll 4
            for (int k = 0; k < 128; k += 4) { const f32x4 v = *(const LAS3 f32x4*)(scr + k);
#pragma unroll
                for (int e = 0; e < 4; ++e) { const float s = v[e]; const int kk = k + e;
                    ca += (s > sa || (s == sa && kk < ja)) ? 1 : 0; cb += (s > sb || (s == sb && kk < jb)) ? 1 : 0; } }
            const unsigned long long ba = __ballot(ca < 16), bb = __ballot(cb < 16);
            if (c.lane == 0) { selw[tok * 4 + 0] = (unsigned)ba; selw[tok * 4 + 1] = (unsigned)(ba >> 32); selw[tok * 4 + 2] = (unsigned)bb; selw[tok * 4 + 3] = (unsigned)(bb >> 32); }
            LDS_WAIT();
        }
    }
    unsigned sm0, sm1, sm2, sm3;
    { const LAS3 unsigned* selw = (const LAS3 unsigned*)(lds + L_SEL) + (c.wid * 8 + (c.r32 >> 2)) * 4; sm0 = selw[0]; sm1 = selw[1]; sm2 = selw[2]; sm3 = selw[3]; }
    LAS3 float* wsf = (LAS3 float*)(lds + L_WS) + c.wid * 64;
    {
        float m_s = -1e30f, l_s = 0.f;
#pragma unroll
        for (int d_ = 0; d_ < 4; ++d_) c.o[d_] = f32x16{};
        if (ADBG & 4) run_pass<MODE_ONLINE, 1, 0, true>(c, Ks, Vs, NP, 0, qt, WINF, m_s, l_s, 0.f, sm0, sm1, sm2, sm3);
        const float f = ga[1] / l_s;
        if (c.hi == 0) wsf[c.r32] = f; LDS_WAIT();
#pragma unroll
        for (int d_ = 0; d_ < 4; ++d_)
#pragma unroll
            for (int r = 0; r < 16; ++r) c.o[d_][r] *= wsf[crow(r, c.hi)];
    }
    if (ADBG & 8) run_pass<MODE_ACC, 16, 31, false>(c, Kc, Vc, 512, 0, ntc, WINF, m_c, l_c, ga[0] * rl_c, 0u, 0u, 0u, 0u);
    {
        float m_w = -1e30f, l_w = 0.f; const int jlo = qt >= 8 ? qt - 8 : 0;
        if (ADBG & 16) run_pass<MODE_STAT, 1, 0, false>(c, Kw, Vw, NP, jlo, qt, 512u, m_w, l_w, 0.f, 0u, 0u, 0u, 0u);
        if (ADBG & 32) run_pass<MODE_ACC, 1, 0, false>(c, Kw, Vw, NP, jlo, qt, 512u, m_w, l_w, ga[2] / l_w, 0u, 0u, 0u, 0u);
    }
#ifdef NO_EPI
    if (c.o[0][0] == 123.f && c.o[1][1] == 3.f && c.o[2][2] == 1.f && c.o[3][3] == 5.f) oa[0] = 1;
    if (false)
#endif
    {
        const int tw = c.t0 + 8 * c.wid;
        const char* zbase = (const char*)(proj + C_ZA + g * 4 * HD); char* obase = (char*)(oa + g * 4 * HD);
#pragma unroll
        for (int r = 0; r < 16; ++r) { const int row = crow(r, c.hi); const int tok = tw + (row >> 2), hd = row & 3;
            const unsigned zo = (unsigned)(tok * NP + hd * HD + c.r32) * 2u, oo = (unsigned)(tok * AW + hd * HD + c.r32) * 2u;
#pragma unroll
            for (int d0 = 0; d0 < 4; ++d0) { const float z = __uint_as_float(((unsigned)*(const bf16_t*)(zbase + zo + d0 * 64)) << 16);
                const float v = c.o[d0][r] * z * pg8::fast_sigmoid(z); const float vn = __shfl_xor(v, 1);
                if ((c.r32 & 1) == 0) *(unsigned*)(obase + oo + d0 * 64) = cvtpk(v, vn); }
            SBAR(); }
    }
    __syncthreads();
}
__device__ __forceinline__ void phase_attn(LAS3 char* lds, const bf16_t* proj, const bf16_t* kc, const bf16_t* vc, bf16_t* oa, int vcu, int G) {
#pragma unroll 1
    for (int item = vcu; item < 256; item += G) {
        const int g = item & 3, p = item >> 2;
#pragma unroll 1
        for (int s = 0; s < 2; ++s) attn_unit(lds, proj, kc, vc, oa, s ? p : 127 - p, g);
    }
}
}
__device__ __forceinline__ float gelu_tanh(float x) { const float y = 1.5957691216057308f * (x + 0.044715f * x * x * x); return x * pg8::fast_sigmoid(y); }
__device__ __forceinline__ float silu_f(float x) { return x * pg8::fast_sigmoid(x); }
__device__ __forceinline__ void compress_unit(LAS3 char* lds, const bf16_t* __restrict__ proj, const float* __restrict__ pe, const bf16_t* __restrict__ w1t, const bf16_t* __restrict__ w2t,
                                              bf16_t* __restrict__ outc, int u, int which) {
    int tid_o = threadIdx.x; asm volatile("" : "+v"(tid_o));
    const int tid = tid_o, lane = tid & 63, wid = __builtin_amdgcn_readfirstlane(tid >> 6), r32 = lane & 31, hi = lane >> 5;
    const int i = 8 * u + (r32 >> 2), g = r32 & 3;
    f32x16 acc[4];
#pragma unroll
    for (int nb = 0; nb < 4; ++nb) acc[nb] = f32x16{};
    const bf16_t* abase = proj + C_KV + which * 512 + g * HD + hi * 8;
    const bf16_t* bbase = w1t + (size_t)(wid * 32) * 2048 + lane * 8;
#pragma unroll 1
    for (int lt = 0; lt < 4; ++lt) {
        const int l = wid * 4 + lt; int tokn = 16 * i + l; tokn = tokn < T ? tokn : T - 1;
        const bf16_t* ap = abase + (size_t)tokn * NP; const float* pp = pe + l * HD + hi * 8;
#pragma unroll
        for (int hf = 0; hf < 2; ++hf) {
            u32x4 araw[4]; f32x4 e0[4], e1[4]; bf16x8 bfr[4][4];
#pragma unroll
            for (int k = 0; k < 4; ++k) { const int k8 = hf * 4 + k; araw[k] = *(const u32x4*)(ap + k8 * 16); e0[k] = *(const f32x4*)(pp + k8 * 16); e1[k] = *(const f32x4*)(pp + k8 * 16 + 4);
#pragma unroll
                for (int nb = 0; nb < 4; ++nb) bfr[k][nb] = *(const bf16x8*)(bbase + (size_t)((lt * 8 + k8) * 4 + nb) * 512); }
            __builtin_amdgcn_sched_barrier(0);
#pragma unroll
            for (int k = 0; k < 4; ++k) { const u32x4 raw = araw[k];
                u32x4 aw; aw.x = pk2(pg8::bf_lo(raw.x) + e0[k][0], pg8::bf_hi(raw.x) + e0[k][1]); aw.y = pk2(pg8::bf_lo(raw.y) + e0[k][2], pg8::bf_hi(raw.y) + e0[k][3]);
                aw.z = pk2(pg8::bf_lo(raw.z) + e1[k][0], pg8::bf_hi(raw.z) + e1[k][1]); aw.w = pk2(pg8::bf_lo(raw.w) + e1[k][2], pg8::bf_hi(raw.w) + e1[k][3]);
                const bf16x8 a = *reinterpret_cast<const bf16x8*>(&aw);
#pragma unroll
                for (int nb = 0; nb < 4; ++nb) acc[nb] = __builtin_amdgcn_mfma_f32_32x32x16_bf16(a, bfr[k][nb], acc[nb], 0, 0, 0); }
            __builtin_amdgcn_sched_barrier(0);
        }
    }
    LAS3 float* part = (LAS3 float*)lds + wid * 4096;
#pragma unroll
    for (int nb = 0; nb < 4; ++nb)
#pragma unroll
        for (int r = 0; r < 16; ++r) part[att::crow(r, hi) * 128 + nb * 32 + r32] = acc[nb][r];
    __syncthreads();
    f32x4 s0 = {0.f, 0.f, 0.f, 0.f}, s1 = {0.f, 0.f, 0.f, 0.f};
#pragma unroll
    for (int w = 0; w < 8; ++w) { const LAS3 f32x4* p = (const LAS3 f32x4*)((LAS3 float*)lds + w * 4096 + tid * 8); s0 += p[0]; s1 += p[1]; }
    __syncthreads();
    {
        u32x4 hw; hw.x = pk2(silu_f(s0[0]), silu_f(s0[1])); hw.y = pk2(silu_f(s0[2]), silu_f(s0[3])); hw.z = pk2(silu_f(s1[0]), silu_f(s1[1])); hw.w = pk2(silu_f(s1[2]), silu_f(s1[3]));
        const int row = tid >> 4, col = (tid & 15) * 8;
        *(LAS3 u32x4*)(lds + (row * 136 + col) * 2) = hw;
    }
    __syncthreads();
    if (wid < 4) {
        f32x16 o2 = f32x16{};
#pragma unroll
        for (int ks = 0; ks < 8; ++ks) { const bf16x8 a = *(const LAS3 bf16x8*)(lds + (r32 * 136 + ks * 16 + hi * 8) * 2);
            const bf16x8 b = *(const bf16x8*)(w2t + (size_t)(wid * 32 + r32) * HD + ks * 16 + hi * 8);
            o2 = __builtin_amdgcn_mfma_f32_32x32x16_bf16(a, b, o2, 0, 0, 0); }
#pragma unroll
        for (int r = 0; r < 16; ++r) { const int row = att::crow(r, hi); const int ii = 8 * u + (row >> 2), gg = row & 3;
            const float v = ii < NCMP ? o2[r] : 0.f; const float vn = __shfl_xor(v, 1);
            if ((r32 & 1) == 0) *(unsigned*)(outc + (size_t)(ii * 4 + gg) * HD + wid * 32 + r32) = pk2(v, vn); }
    }
    __syncthreads();
}
__device__ __forceinline__ void gmlp_unit(LAS3 char* lds, const bf16_t* __restrict__ proj, const float* __restrict__ sspart, const float* __restrict__ gain, const float* __restrict__ sw, const float* __restrict__ sb,
                                          bf16_t* __restrict__ ob, int ch, int qd) {
    int tid_o = threadIdx.x; asm volatile("" : "+v"(tid_o));
    const int tid = tid_o, lane = tid & 63, wid = __builtin_amdgcn_readfirstlane(tid >> 6), r32 = lane & 31, hi = lane >> 5;
    const int tc0 = ch * 128;
    LAS3 float* rsl = (LAS3 float*)(lds + LDS_RS);
    {   const int vkk = ((tid >> 7) * 8) + ((tid & 31) >> 2), vkey = (vkk & ~0xC) | ((vkk & 4) << 1) | ((vkk & 8) >> 1), vcol = ((tid >> 5) & 3) * 32 + (tid & 3) * 8;
        const unsigned vo0 = (unsigned)(vkey * NP + vcol) * 2u; const unsigned half_step = (unsigned)(32 * NP) * 2u;
#pragma unroll
        for (int gg = 0; gg < 4; ++gg)
#pragma unroll
            for (int kt = 0; kt < 2; ++kt) { const char* vp_ = (const char*)(proj + (size_t)(tc0 + kt * 64) * NP + C_VB + (qd * 4 + gg) * 128); LAS3 char* vd_ = lds + (gg * 2 + kt) * att::SHM + wid * 1024;
                __builtin_amdgcn_global_load_lds((const unsigned*)(vp_ + vo0), (LAS3 unsigned*)vd_, 16, 0, 0);
                __builtin_amdgcn_global_load_lds((const unsigned*)(vp_ + vo0 + half_step), (LAS3 unsigned*)(vd_ + 8192), 16, 0, 0); } }
    if (tid < 128) { const f32x4* sp = (const f32x4*)(sspart + (size_t)(tc0 + tid) * 32); f32x4 s = sp[0];
#pragma unroll
        for (int i = 1; i < 8; ++i) s += sp[i];
        rsl[tid] = 1.0f / sqrtf(((s[0] + s[1]) + (s[2] + s[3])) * (1.0f / BW) + NORM_EPS); }
    VM_WAIT();
    __syncthreads();
    const int gg = wid >> 1, wd = wid & 1, G = qd * 4 + gg, cb = G * 128;
    const int vb1 = (int)(uintptr_t)(lds) + gg * 2 * att::SHM + att::v_rd_base(lane) + wd * 1024;
    f32x4 gn[2][4];
#pragma unroll
    for (int dd = 0; dd < 2; ++dd)
#pragma unroll
        for (int m = 0; m < 4; ++m) gn[dd][m] = *(const f32x4*)(gain + cb + (wd * 2 + dd) * 32 + 8 * m + 4 * hi);
#pragma unroll 1
    for (int pb = 0; pb < 4; ++pb) {
        const int p = pb * 32 + r32; const size_t tok = (size_t)(tc0 + p); const int nks = 2 * pb + 2;
        f32x4 wr0[8], wr1[8]; u32x2 uu[2][4], zz[2][4];
        const float* wrow = sw + ((size_t)G * 128 + p) * 128 + hi * 8;
#pragma unroll
        for (int ks = 0; ks < 8; ++ks) if (ks < nks) { wr0[ks] = *(const f32x4*)(wrow + ks * 16); wr1[ks] = *(const f32x4*)(wrow + ks * 16 + 4); }
        const char* ubase = (const char*)(proj + tok * NP + C_UB + cb); const char* zbase = (const char*)(proj + tok * NP + C_ZB + cb); char* obase = (char*)(ob + tok * BW + cb);
#pragma unroll
        for (int dd = 0; dd < 2; ++dd)
#pragma unroll
            for (int m = 0; m < 4; ++m) { const int d0 = (wd * 2 + dd) * 32 + 8 * m + 4 * hi; uu[dd][m] = *(const u32x2*)(ubase + d0 * 2); zz[dd][m] = *(const u32x2*)(zbase + d0 * 2); }
        const float bs = sb[G * 128 + p];
        __builtin_amdgcn_sched_barrier(0);
        bf16x8 af[8];
#pragma unroll
        for (int ks = 0; ks < 8; ++ks) { if (ks < nks) { const f32x4 a0 = wr0[ks], a1 = wr1[ks]; const int q0 = ks * 16 + hi * 8;
                const f32x4 r0 = *(const LAS3 f32x4*)(rsl + q0), r1 = *(const LAS3 f32x4*)(rsl + q0 + 4);
                u32x4 w; w.x = pk2(q0 + 0 <= p ? a0[0] * r0[0] : 0.f, q0 + 1 <= p ? a0[1] * r0[1] : 0.f); w.y = pk2(q0 + 2 <= p ? a0[2] * r0[2] : 0.f, q0 + 3 <= p ? a0[3] * r0[3] : 0.f);
                w.z = pk2(q0 + 4 <= p ? a1[0] * r1[0] : 0.f, q0 + 5 <= p ? a1[1] * r1[1] : 0.f); w.w = pk2(q0 + 6 <= p ? a1[2] * r1[2] : 0.f, q0 + 7 <= p ? a1[3] * r1[3] : 0.f);
                af[ks] = *reinterpret_cast<const bf16x8*>(&w); } else af[ks] = bf16x8{}; }
        f32x16 acc[2] = {f32x16{}, f32x16{}};
#define TRRD(dst, off) asm volatile("ds_read_b64_tr_b16 %0, %1 offset:%2" : "=&v"(dst) : "v"(vb1), "i"(off) : "memory")
#define GM_STEP(ks) do { if ((ks) < nks) { s16x4 l0, h0, l1, h1; constexpr int o_ = ((ks) >> 2) * att::SHM + att::v_rd_off(0, (ks) & 3, 0); \
            TRRD(l0, o_); TRRD(h0, o_ + 2048); TRRD(l1, o_ + 512); TRRD(h1, o_ + 512 + 2048); \
            asm volatile("s_waitcnt lgkmcnt(0)" ::: "memory"); __builtin_amdgcn_sched_barrier(0); \
            acc[0] = __builtin_amdgcn_mfma_f32_32x32x16_bf16((bf16x8){l0[0], l0[1], l0[2], l0[3], h0[0], h0[1], h0[2], h0[3]}, af[ks], acc[0], 0, 0, 0); \
            acc[1] = __builtin_amdgcn_mfma_f32_32x32x16_bf16((bf16x8){l1[0], l1[1], l1[2], l1[3], h1[0], h1[1], h1[2], h1[3]}, af[ks], acc[1], 0, 0, 0); } } while (0)
        GM_STEP(0); GM_STEP(1); GM_STEP(2); GM_STEP(3); GM_STEP(4); GM_STEP(5); GM_STEP(6); GM_STEP(7);
#undef GM_STEP
#undef TRRD
#pragma unroll
        for (int dd = 0; dd < 2; ++dd)
#pragma unroll
            for (int m = 0; m < 4; ++m) { const int d0 = (wd * 2 + dd) * 32 + 8 * m + 4 * hi; const u32x2 u2 = uu[dd][m], z2 = zz[dd][m]; const f32x4 g4 = gn[dd][m];
                const float o0 = gelu_tanh(pg8::bf_lo(u2.x)) * (acc[dd][4 * m + 0] * g4[0] + bs) * silu_f(pg8::bf_lo(z2.x));
                const float o1 = gelu_tanh(pg8::bf_hi(u2.x)) * (acc[dd][4 * m + 1] * g4[1] + bs) * silu_f(pg8::bf_hi(z2.x));
                const float o2 = gelu_tanh(pg8::bf_lo(u2.y)) * (acc[dd][4 * m + 2] * g4[2] + bs) * silu_f(pg8::bf_lo(z2.y));
                const float o3 = gelu_tanh(pg8::bf_hi(u2.y)) * (acc[dd][4 * m + 3] * g4[3] + bs) * silu_f(pg8::bf_hi(z2.y));
                u32x2 w; w.x = pk2(o0, o1); w.y = pk2(o2, o3); *(u32x2*)(obase + d0 * 2) = w; }
    }
    __syncthreads();
}
#ifndef N_LAUNCH_MODE
#define N_LAUNCH_MODE 1
#endif
constexpr int NPHASES = 1 + 6 * DEPTH;
#ifndef PHMASK
#define PHMASK 0x7f
#endif
#ifndef REPMASK
#define REPMASK 0
#endif
#define REPS(bit) ((REPMASK & (bit)) ? 2 : 1)
__global__ void __launch_bounds__(NTHREADS, 2) fwd_kernel(Params P) {
    extern __shared__ __attribute__((aligned(16))) unsigned char lds_raw[];
    LAS3 unsigned char* lds = (LAS3 unsigned char*)lds_raw;
    const int tid = threadIdx.x, lane = tid & 63, wave = __builtin_amdgcn_readfirstlane(tid >> 6);
    const int G = gridDim.x; const int bx = blockIdx.x; const int vcu = (G % 8 == 0) ? (bx % 8) * (G / 8) + bx / 8 : bx;
    const int gw = vcu * NWAVES + wave, NGW = G * NWAVES;
    unsigned char* ws = P.ws;
    if (tid < 16) ((LAS3 unsigned*)(lds + LDS_MISC))[tid] = 0u;
    __syncthreads();
    XcdBarrier bar; bar.bar = (unsigned*)(ws + WS_CTL); bar.x = 0; bar.st = nullptr;
    if (N_LAUNCH_MODE == 1) bar = xcd_barrier_post((unsigned*)(ws + WS_CTL), (volatile LAS unsigned*)(lds + LDS_MISC));
    const int lo = P.ph_lo, hi = P.ph_hi;
#define IN(k) (lo <= (k) && (k) < hi)
#define SEAM(k) do { if (IN(k) && IN((k) + 1)) xcd_barrier(bar); } while (0)
    bf16_t* hbuf = (bf16_t*)(ws + WS_H); bf16_t* proj = (bf16_t*)(ws + WS_PROJ); bf16_t* kc = (bf16_t*)(ws + WS_KC); bf16_t* vc = (bf16_t*)(ws + WS_VC);
    bf16_t* oa = (bf16_t*)(ws + WS_OA); bf16_t* ob = (bf16_t*)(ws + WS_OB); bf16_t* t1 = (bf16_t*)(ws + WS_T1); bf16_t* mg = (bf16_t*)(ws + WS_MG);
    float* Y = (float*)(ws + WS_Y); float* x1 = (float*)(ws + WS_X1);
    if (IN(0) && (PHMASK & 1)) {
        for (int rep = 0; rep < REPS(1); ++rep) phase_weights(P, lds, gw, NGW, wave, lane);
        for (int rep = 0; rep < REPS(128); ++rep) phase_prenorm(P.x, P.pre_norm, hbuf, gw, NGW, lane);
    }
    __syncthreads();
    for (int i = tid; i < 16 * 256; i += NTHREADS) { const int hd = i >> 8; int d = (i & 255) - 64; d = d < 0 ? 0 : (d > 127 ? 127 : d); ((LAS3 float*)(lds + LDS_BIAS))[i] = P.rel_bias[BUCKET[d] * 16 + hd] * att::LOG2E; }
    __syncthreads();
    SEAM(0);
#pragma unroll 1
    for (int L = 0; L < DEPTH; ++L) {
        const int pb = 1 + 6 * L;
        if (IN(pb) && (PHMASK & 2)) for (int rep = 0; rep < REPS(2); ++rep) {
            pg8::Gemm g{hbuf, (const bf16_t*)(ws + WS_WIN + L * SZ_WIN), T, NP, DM}; pg8::StaticOrder S; S.init(T, NP, G, bx);
            pg8::EpiProj E{proj, NP, (float*)(ws + WS_SS)};
            pg8::gemm_phase<pg8::EpiProj, pg8::StaticOrder>(lds + LDS_STAGE, g, S, E, nullptr);
        }
        SEAM(pb);
        if (IN(pb + 1) && (PHMASK & 4)) for (int rep = 0; rep < REPS(4) + ((REPMASK & 768) ? 1 : 0); ++rep) {
#pragma unroll 1
            for (int item = vcu; item < 384; item += G) {
                if (item < 256) { if (rep > 0 && (REPMASK & 512)) continue;
                    gmlp_unit((LAS3 char*)lds, proj, (const float*)(ws + WS_SS), P.sgu_norm + L * BW, P.sgu_w + (size_t)L * 16 * 128 * 128, P.sgu_b + L * 16 * 128, ob, item >> 2, item & 3); }
                else { if (rep > 0 && (REPMASK & 256)) continue;
                    const int ci = item - 256, which = ci & 1, u = ci >> 1;
                    compress_unit((LAS3 char*)lds, proj, (which ? P.pe_v : P.pe_k) + L * 32 * HD, (const bf16_t*)(ws + WS_W1 + (L * 2 + which) * SZ_W1), (const bf16_t*)(ws + WS_W2 + (L * 2 + which) * SZ_W2), which ? vc : kc, u, which); }
            }
        }
        SEAM(pb + 1);
        if (IN(pb + 2) && (PHMASK & 8)) for (int rep = 0; rep < REPS(8); ++rep) att::phase_attn((LAS3 char*)lds, proj, kc, vc, oa, vcu, G);
        SEAM(pb + 2);
        if (IN(pb + 3) && (PHMASK & 16)) for (int rep = 0; rep < REPS(16); ++rep) {
            pg8::StaticOrder S; S.init(T, DM, G, bx);
            { pg8::Gemm g{oa, (const bf16_t*)(ws + WS_WA + L * SZ_WAB), T, DM, AW}; pg8::EpiGate<false> E{t1, DM, proj + C_MA, NP, nullptr};
              pg8::gemm_phase<pg8::EpiGate<false>, pg8::StaticOrder>(lds + LDS_STAGE, g, S, E, nullptr); }
            { pg8::Gemm g{ob, (const bf16_t*)(ws + WS_WB + L * SZ_WAB), T, DM, BW}; pg8::EpiGate<true> E{mg, DM, proj + C_MB, NP, t1};
              pg8::gemm_phase<pg8::EpiGate<true>, pg8::StaticOrder>(lds + LDS_STAGE, g, S, E, nullptr); }
        }
        SEAM(pb + 3);
        if (IN(pb + 4) && (PHMASK & 32)) for (int rep = 0; rep < REPS(32); ++rep) {
            pg8::Gemm g{mg, (const bf16_t*)(ws + WS_WO + L * SZ_WO), T, DM, DM}; pg8::StaticOrder S; S.init(T, DM, G, bx);
            pg8::EpiF32Plain E{Y, DM};
            pg8::gemm_phase<pg8::EpiF32Plain, pg8::StaticOrder>(lds + LDS_STAGE, g, S, E, nullptr);
        }
        SEAM(pb + 4);
        if (IN(pb + 5) && (PHMASK & 64)) for (int rep = 0; rep < REPS(64); ++rep) {
            const bool last = (L == DEPTH - 1);
            phase_postnorm(Y, L == 0 ? P.x : x1, P.post_norm + L * DM, last ? P.out : x1, P.pre_norm + (last ? 0 : (L + 1)) * DM, hbuf, !last, gw, NGW, lane);
        }
        SEAM(pb + 5);
    }
#undef IN
#undef SEAM
}
extern "C" void kernel_launch(void* const* d_in, const int* in_sizes, int n_in, void* d_out, int out_size, void* d_ws, size_t ws_size, hipStream_t stream) {
    static int grid = 0;
    if (grid == 0) {
        if (n_in != 17 || in_sizes[0] != T * DM || out_size != T * DM || ws_size < WS_END) { fprintf(stderr, "kernel_launch: unexpected shapes (n_in %d, in0 %d, out %d, ws %zu < %zu)\n", n_in, n_in > 0 ? in_sizes[0] : -1, out_size, ws_size, (size_t)WS_END); grid = -1; return; }
        int dev = 0, cus = 0, per_cu = 0;
        if (hipGetDevice(&dev) != hipSuccess || hipDeviceGetAttribute(&cus, hipDeviceAttributeMultiprocessorCount, dev) != hipSuccess) { grid = -1; return; }
        if (hipFuncSetAttribute((const void*)fwd_kernel, hipFuncAttributeMaxDynamicSharedMemorySize, LDS_BYTES) != hipSuccess) { fprintf(stderr, "kernel_launch: hipFuncSetAttribute failed\n"); grid = -1; return; }
        if (hipOccupancyMaxActiveBlocksPerMultiprocessor(&per_cu, (const void*)fwd_kernel, NTHREADS, LDS_BYTES) != hipSuccess || per_cu < 1) { fprintf(stderr, "kernel_launch: occupancy query says %d blocks per CU\n", per_cu); (void)hipGetLastError(); grid = -1; return; }
        grid = cus;
    }
    if (grid < 0) return;
    (void)hipMemsetAsync((char*)d_ws + WS_CTL, 0, CTL_BYTES, stream);
    Params p{};
    p.x = (const float*)d_in[0]; p.rel_bias = (const float*)d_in[1]; p.pre_norm = (const float*)d_in[2]; p.w_in = (const float*)d_in[3];
    p.pe_k = (const float*)d_in[4]; p.w1_k = (const float*)d_in[5]; p.w2_k = (const float*)d_in[6]; p.pe_v = (const float*)d_in[7]; p.w1_v = (const float*)d_in[8]; p.w2_v = (const float*)d_in[9];
    p.w_out_a = (const float*)d_in[10]; p.sgu_norm = (const float*)d_in[11]; p.sgu_w = (const float*)d_in[12]; p.sgu_b = (const float*)d_in[13]; p.w_out_b = (const float*)d_in[14]; p.w_out = (const float*)d_in[15]; p.post_norm = (const float*)d_in[16];
    p.out = (float*)d_out; p.ws = (unsigned char*)d_ws;
#if N_LAUNCH_MODE == 1
    p.ph_lo = 0; p.ph_hi = NPHASES;
    hipLaunchKernelGGL(fwd_kernel, dim3(grid), dim3(NTHREADS), LDS_BYTES, stream, p);
#else
    for (int k = 0; k < NPHASES; ++k) { p.ph_lo = k; p.ph_hi = k + 1; hipLaunchKernelGGL(fwd_kernel, dim3(grid), dim3(NTHREADS), LDS_BYTES, stream, p); }
#endif
}
```

```cpp
#include <hip/hip_runtime.h>
#include <cstdio>
#include <cstdint>
namespace pg8 {
#define PG8_LAS __attribute__((address_space(3)))
typedef unsigned short bf16_t;
typedef short bf16x8 __attribute__((ext_vector_type(8)));
typedef float f32x4 __attribute__((ext_vector_type(4)));
typedef unsigned u32x4 __attribute__((ext_vector_type(4)));
constexpr int BM = 256, BK = 64, HALF = 128, HTB = HALF * BK * 2  , STAGE_BYTES = 8 * HTB, NXCD = 8, WGM = 8;

__host__ __device__ __forceinline__ int lds_byte(int r, int c) { const int st = (r >> 4) * 2 + (c >> 5), rr = r & 15, cc = c & 31, ob = rr * 64 + cc * 2; return st * 1024 + (ob ^ (((ob >> 9) & 1) << 5)); }
__host__ __device__ __forceinline__ void stage_rc(int b, int& R, int& C) { const int st = b / 1024, sb = b % 1024, swz = sb ^ (((sb >> 9) & 1) << 5); R = (st >> 1) * 16 + swz / 64; C = (st & 1) * 32 + (swz % 64) / 2; }
__host__ __device__ __forceinline__ int perm32(int rho) { const int n = rho >> 4, i = rho & 15; return 8 * (i >> 2) + 4 * n + (i & 3); }

struct Unit { int pm, pn, sub; };
struct Gemm { const bf16_t* A; const bf16_t* Bt; int M, N, K; const bf16_t* A2; const bf16_t* Bt2; };

struct StaticOrder {
    int nM, nN, nwg, G, c;
    __host__ __device__ void init(int M, int N, int G_, int c_) { nM = M / BM; nN = N / BM; nwg = nM * nN; G = G_; c = c_; }
    __host__ __device__ bool next(int i, Unit& u) const {
        const long L = (long)i * G + c; if (L >= nwg) return false;
        int wgid = (int)L; { const int q = nwg / NXCD, r = nwg % NXCD, xcd = wgid % NXCD, off = wgid / NXCD; wgid = (xcd < r ? xcd * (q + 1) : r * (q + 1) + (xcd - r) * q) + off; }
        const int nig = WGM * nN, gid = wgid / nig, fm = gid * WGM, gsz = (nM - fm) < WGM ? (nM - fm) : WGM;
        u.pm = fm + ((wgid % nig) % gsz); u.pn = (wgid % nig) / gsz; u.sub = 0; return true;
    }
    __device__ __forceinline__ void a_ready(const Unit&) const {}
    __device__ __forceinline__ void done(const Unit&) const {}
    static constexpr bool DUAL = false;
    __device__ __forceinline__ const bf16_t* baseA(const Gemm& g, const Unit&) const { return g.A; }
    __device__ __forceinline__ const bf16_t* baseB(const Gemm& g, const Unit&) const { return g.Bt; }
};
struct DualOrder : StaticOrder {
    static constexpr bool DUAL = true;
    __host__ __device__ bool next(int i, Unit& u) const { const bool ok = StaticOrder::next(i >> 1, u); u.sub = i & 1; return ok; }
    __device__ __forceinline__ const bf16_t* baseA(const Gemm& g, const Unit& u) const { return u.sub ? g.A2 : g.A; }
    __device__ __forceinline__ const bf16_t* baseB(const Gemm& g, const Unit& u) const { return u.sub ? g.Bt2 : g.Bt; }
};
typedef __bf16 bf16x2_t __attribute__((ext_vector_type(2)));
typedef float f32x2_t __attribute__((ext_vector_type(2)));
__device__ __forceinline__ unsigned cvt_pk_bf16(float lo, float hi) { const f32x2_t v = {lo, hi}; const bf16x2_t b = __builtin_convertvector(v, bf16x2_t); return __builtin_bit_cast(unsigned, b); }
typedef float f32x2 __attribute__((ext_vector_type(2)));
__device__ __forceinline__ float bf_lo(unsigned u) { return __uint_as_float(u << 16); }
__device__ __forceinline__ float bf_hi(unsigned u) { return __uint_as_float(u & 0xffff0000u); }
__device__ __forceinline__ float fast_sigmoid(float x) { return __builtin_amdgcn_rcpf(1.0f + __builtin_amdgcn_exp2f(-1.4426950408889634f * x)); }
struct EpiBf16Plain {
    static constexpr bool PERM = true, AFTER_DRAIN = false;
    bf16_t* O; int ldc;
    __device__ __forceinline__ void operator()(const f32x4 (&acc)[2][2][4][2], const Unit& u, int wr, int wc, int fr, int fq) const {
        const int row0 = u.pm * BM + wr * 64 + fr, col0 = u.pn * BM + wc * 32 + 8 * fq;
#pragma unroll
        for (int ai = 0; ai < 2; ++ai)
#pragma unroll
            for (int m = 0; m < 4; ++m) { bf16_t* rowp = O + (size_t)(row0 + ai * HALF + m * 16) * ldc + col0;
#pragma unroll
                for (int bj = 0; bj < 2; ++bj) { const f32x4 v0 = acc[ai][bj][m][0], v1 = acc[ai][bj][m][1];
                    u32x4 w; w.x = cvt_pk_bf16(v0[0], v0[1]); w.y = cvt_pk_bf16(v0[2], v0[3]); w.z = cvt_pk_bf16(v1[0], v1[1]); w.w = cvt_pk_bf16(v1[2], v1[3]);
                    *(u32x4*)(rowp + bj * HALF) = w; } }
    }
};
__device__ __forceinline__ float gelu_tanh_f(float x) { const float y = 1.5957691216057308f * (x + 0.044715f * x * x * x); return x * fast_sigmoid(y); }
struct EpiProj {
    static constexpr bool PERM = true, AFTER_DRAIN = false;
    static constexpr int PN_V0 = 36;
    bf16_t* O; int ldc; float* sspart;
    __device__ __forceinline__ void operator()(const f32x4 (&acc)[2][2][4][2], const Unit& u, int wr, int wc, int fr, int fq) const {
        const int row0 = u.pm * BM + wr * 64 + fr, col0 = u.pn * BM + wc * 32 + 8 * fq;
        const bool vtile = (u.pn >= PN_V0) && (u.pn < PN_V0 + 8);
        if (!vtile) {
#pragma unroll
            for (int ai = 0; ai < 2; ++ai)
#pragma unroll
                for (int m = 0; m < 4; ++m) { bf16_t* rowp = O + (size_t)(row0 + ai * HALF + m * 16) * ldc + col0;
#pragma unroll
                    for (int bj = 0; bj < 2; ++bj) { const f32x4 v0 = acc[ai][bj][m][0], v1 = acc[ai][bj][m][1];
                        u32x4 w; w.x = cvt_pk_bf16(v0[0], v0[1]); w.y = cvt_pk_bf16(v0[2], v0[3]); w.z = cvt_pk_bf16(v1[0], v1[1]); w.w = cvt_pk_bf16(v1[2], v1[3]);
                        *(u32x4*)(rowp + bj * HALF) = w; } }
        } else {
#pragma unroll
            for (int ai = 0; ai < 2; ++ai)
#pragma unroll
                for (int m = 0; m < 4; ++m) { const int row = row0 + ai * HALF + m * 16; bf16_t* rowp = O + (size_t)row * ldc + col0; float ss = 0.f;
#pragma unroll
                    for (int bj = 0; bj < 2; ++bj) { f32x4 v0 = acc[ai][bj][m][0], v1 = acc[ai][bj][m][1];
#pragma unroll
                        for (int e = 0; e < 4; ++e) { v0[e] = gelu_tanh_f(v0[e]); v1[e] = gelu_tanh_f(v1[e]); ss += v0[e] * v0[e] + v1[e] * v1[e]; }
                        u32x4 w; w.x = cvt_pk_bf16(v0[0], v0[1]); w.y = cvt_pk_bf16(v0[2], v0[3]); w.z = cvt_pk_bf16(v1[0], v1[1]); w.w = cvt_pk_bf16(v1[2], v1[3]);
                        *(u32x4*)(rowp + bj * HALF) = w; }
                    ss += __shfl_xor(ss, 16); ss += __shfl_xor(ss, 32);
                    if (fq == 0) sspart[(size_t)row * 32 + (u.pn - PN_V0) * 4 + wc] = ss; }
        }
    }
};
template <bool ADD> struct EpiGate {
    static constexpr bool PERM = true, AFTER_DRAIN = false;
    bf16_t* O; int ldc; const bf16_t* Mg; int ldm; const bf16_t* Prev;
    __device__ __forceinline__ void operator()(const f32x4 (&acc)[2][2][4][2], const Unit& u, int wr, int wc, int fr, int fq) const {
        const int row0 = u.pm * BM + wr * 64 + fr, col0 = u.pn * BM + wc * 32 + 8 * fq;
#pragma unroll
        for (int ai = 0; ai < 2; ++ai)
#pragma unroll
            for (int m = 0; m < 4; ++m) { const size_t row = (size_t)(row0 + ai * HALF + m * 16);
#pragma unroll
                for (int bj = 0; bj < 2; ++bj) { const f32x4 v0 = acc[ai][bj][m][0], v1 = acc[ai][bj][m][1];
                    const u32x4 mg = *(const u32x4*)(Mg + row * ldm + col0 + bj * HALF);
                    float r[8];
                    r[0] = v0[0] * fast_sigmoid(bf_lo(mg.x)); r[1] = v0[1] * fast_sigmoid(bf_hi(mg.x)); r[2] = v0[2] * fast_sigmoid(bf_lo(mg.y)); r[3] = v0[3] * fast_sigmoid(bf_hi(mg.y));
                    r[4] = v1[0] * fast_sigmoid(bf_lo(mg.z)); r[5] = v1[1] * fast_sigmoid(bf_hi(mg.z)); r[6] = v1[2] * fast_sigmoid(bf_lo(mg.w)); r[7] = v1[3] * fast_sigmoid(bf_hi(mg.w));
                    if (ADD) { const u32x4 pv = *(const u32x4*)(Prev + row * ldc + col0 + bj * HALF);
                        r[0] += bf_lo(pv.x); r[1] += bf_hi(pv.x); r[2] += bf_lo(pv.y); r[3] += bf_hi(pv.y); r[4] += bf_lo(pv.z); r[5] += bf_hi(pv.z); r[6] += bf_lo(pv.w); r[7] += bf_hi(pv.w); }
                    u32x4 w; w.x = cvt_pk_bf16(r[0], r[1]); w.y = cvt_pk_bf16(r[2], r[3]); w.z = cvt_pk_bf16(r[4], r[5]); w.w = cvt_pk_bf16(r[6], r[7]);
                    *(u32x4*)(O + row * ldc + col0 + bj * HALF) = w; } }
    }
};
struct EpiMerge {
    static constexpr bool PERM = true, AFTER_DRAIN = false;
    bf16_t* O; int ldc; const bf16_t* Ma; const bf16_t* Mb; int ldm;
    __device__ __forceinline__ void mid(f32x4 (&acc)[2][2][4][2], const Unit& u, int wr, int wc, int fr, int fq) const {
        const int row0 = u.pm * BM + wr * 64 + fr, col0 = u.pn * BM + wc * 32 + 8 * fq;
#pragma unroll
        for (int ai = 0; ai < 2; ++ai)
#pragma unroll
            for (int m = 0; m < 4; ++m) { const size_t row = (size_t)(row0 + ai * HALF + m * 16);
#pragma unroll
                for (int bj = 0; bj < 2; ++bj) { const u32x4 a = *(const u32x4*)(Ma + row * ldm + col0 + bj * HALF), b = *(const u32x4*)(Mb + row * ldm + col0 + bj * HALF);
                    const unsigned aw[4] = {a.x, a.y, a.z, a.w}, bw[4] = {b.x, b.y, b.z, b.w};
#pragma unroll
                    for (int e = 0; e < 4; ++e) {
                        const float r0 = (1.0f + __builtin_amdgcn_exp2f(-1.4426950408889634f * bf_lo(bw[e]))) * __builtin_amdgcn_rcpf(1.0f + __builtin_amdgcn_exp2f(-1.4426950408889634f * bf_lo(aw[e])));
                        const float r1 = (1.0f + __builtin_amdgcn_exp2f(-1.4426950408889634f * bf_hi(bw[e]))) * __builtin_amdgcn_rcpf(1.0f + __builtin_amdgcn_exp2f(-1.4426950408889634f * bf_hi(aw[e])));
                        acc[ai][bj][m][e >> 1][(e & 1) * 2] *= r0; acc[ai][bj][m][e >> 1][(e & 1) * 2 + 1] *= r1; } } }
    }
    __device__ __forceinline__ void operator()(const f32x4 (&acc)[2][2][4][2], const Unit& u, int wr, int wc, int fr, int fq) const {
        const int row0 = u.pm * BM + wr * 64 + fr, col0 = u.pn * BM + wc * 32 + 8 * fq;
#pragma unroll
        for (int ai = 0; ai < 2; ++ai)
#pragma unroll
            for (int m = 0; m < 4; ++m) { const size_t row = (size_t)(row0 + ai * HALF + m * 16);
#pragma unroll
                for (int bj = 0; bj < 2; ++bj) { const f32x4 v0 = acc[ai][bj][m][0], v1 = acc[ai][bj][m][1];
                    const u32x4 mg = *(const u32x4*)(Mb + row * ldm + col0 + bj * HALF);
                    u32x4 w; w.x = cvt_pk_bf16(v0[0] * fast_sigmoid(bf_lo(mg.x)), v0[1] * fast_sigmoid(bf_hi(mg.x))); w.y = cvt_pk_bf16(v0[2] * fast_sigmoid(bf_lo(mg.y)), v0[3] * fast_sigmoid(bf_hi(mg.y)));
                    w.z = cvt_pk_bf16(v1[0] * fast_sigmoid(bf_lo(mg.z)), v1[1] * fast_sigmoid(bf_hi(mg.z))); w.w = cvt_pk_bf16(v1[2] * fast_sigmoid(bf_lo(mg.w)), v1[3] * fast_sigmoid(bf_hi(mg.w)));
                    *(u32x4*)(O + row * ldc + col0 + bj * HALF) = w; } }
    }
};
struct EpiF32Plain {
    static constexpr bool PERM = false, AFTER_DRAIN = false;
    float* C; int ldc;
    __device__ __forceinline__ void operator()(const f32x4 (&acc)[2][2][4][2], const Unit& u, int wr, int wc, int fr, int fq) const {
        const int row0 = u.pm * BM + wr * 64 + fr, col0 = u.pn * BM + wc * 32 + 4 * fq;
#pragma unroll
        for (int ai = 0; ai < 2; ++ai)
#pragma unroll
            for (int m = 0; m < 4; ++m) { float* rowp = C + (size_t)(row0 + ai * HALF + m * 16) * ldc + col0;
#pragma unroll
                for (int bj = 0; bj < 2; ++bj)
#pragma unroll
                    for (int n = 0; n < 2; ++n) *(f32x4*)(rowp + bj * HALF + n * 16) = acc[ai][bj][m][n]; }
    }
};
template <class Epi, class Sched, bool STAMP = false>
__device__ __forceinline__ void gemm_phase(PG8_LAS unsigned char* lds, const Gemm g, const Sched& S, const Epi& E, unsigned long long* stamps) {
    int tid_o = threadIdx.x; asm volatile("" : "+v"(tid_o));
    const int tid = tid_o, wid = __builtin_amdgcn_readfirstlane(tid >> 6), lane = tid & 63, wr = wid >> 2, wc = wid & 3, fr = lane & 15, fq = lane >> 4;
    const int K = g.K, nt = K / BK;
    int ts_lo = 0, ts_hi = 0, nts = 0; const unsigned long long rt_entry = STAMP ? (unsigned long long)wall_clock64() : 0ull;
#define PG8_STAMP() do { if (STAMP && wid == 0 && nts < 64) { const unsigned long long _c = (unsigned long long)clock64(); \
        ts_lo = (lane == nts) ? (int)(unsigned)_c : ts_lo; ts_hi = (lane == nts) ? (int)(unsigned)(_c >> 32) : ts_hi; ++nts; } } while (0)
    PG8_STAMP();
    unsigned voffA[2], voffB[2];
#pragma unroll
    for (int i = 0; i < 2; ++i) { int R, C; stage_rc(tid * 16 + i * 8192, R, C); const int Rb = Epi::PERM ? ((R & ~31) + perm32(R & 31)) : R;
        voffA[i] = (unsigned)(R * K + C) * 2u; voffB[i] = (unsigned)(Rb * K + C) * 2u; }
    const size_t kstep = (size_t)(BK * 2);
    const size_t hstep = (size_t)HALF * K * 2;
    const size_t tstep = 2 * hstep;
    const unsigned ldsw = (unsigned)wid * 1024u;
    const int aoff = lds_byte(wr * 64 + fr, fq * 8), boff = lds_byte(wc * 32 + fr, fq * 8);
#define PG8_SA(b, h) (((b) * 2 + (h)) * HTB)
#define PG8_SB(b, h) ((4 + (b) * 2 + (h)) * HTB)
#define PG8_STAGE(bufoff, gbase, voff) do { _Pragma("unroll") for (int _i = 0; _i < 2; ++_i) \
        __builtin_amdgcn_global_load_lds((const unsigned*)((const char*)(gbase) + (voff)[_i]), (PG8_LAS unsigned*)(lds + (bufoff) + ldsw + _i * 8192), 16, 0, 0); } while (0)
#define PG8_LDA(dst, b, h) do { _Pragma("unroll") for (int m = 0; m < 4; ++m) _Pragma("unroll") for (int k = 0; k < 2; ++k) dst[m][k] = *(const PG8_LAS bf16x8*)(lds + PG8_SA(b, h) + aoff + m * 2048 + k * 1024); } while (0)
#define PG8_LDB(dst, b, h) do { _Pragma("unroll") for (int n = 0; n < 2; ++n) _Pragma("unroll") for (int k = 0; k < 2; ++k) dst[n][k] = *(const PG8_LAS bf16x8*)(lds + PG8_SB(b, h) + boff + n * 2048 + k * 1024); } while (0)
#define PG8_MMA(ai, bj, At, Bt) do { __builtin_amdgcn_s_setprio(1); _Pragma("unroll") for (int m = 0; m < 4; ++m) _Pragma("unroll") for (int n = 0; n < 2; ++n) _Pragma("unroll") for (int k = 0; k < 2; ++k) \
        acc[ai][bj][m][n] = __builtin_amdgcn_mfma_f32_16x16x32_bf16(Bt[n][k], At[m][k], acc[ai][bj][m][n], 0, 0, 0); __builtin_amdgcn_s_setprio(0); } while (0)
#define PG8_WAIT_V(n) asm volatile("s_waitcnt vmcnt(" #n ")" ::: "memory")
#define PG8_WAIT_L(n) asm volatile("s_waitcnt lgkmcnt(" #n ")" ::: "memory")
#define PG8_BAR __builtin_amdgcn_s_barrier()
#define PG8_SCHED __builtin_amdgcn_sched_barrier(0)
    Unit cur, nxt; int ui = 0;
    if (!S.next(0, cur)) return;
    f32x4 acc[2][2][4][2];
#pragma unroll
    for (int a = 0; a < 2; ++a)
#pragma unroll
        for (int b = 0; b < 2; ++b)
#pragma unroll
            for (int m = 0; m < 4; ++m)
#pragma unroll
                for (int n = 0; n < 2; ++n) acc[a][b][m][n] = (f32x4){0.f, 0.f, 0.f, 0.f};
    bf16x8 At[4][2], B0[2][2], B1[2][2];
    const char* cA = (const char*)S.baseA(g, cur) + (size_t)cur.pm * tstep; const char* cB = (const char*)S.baseB(g, cur) + (size_t)cur.pn * tstep;
    S.a_ready(cur);
    PG8_STAGE(PG8_SB(0, 0), cB, voffB); PG8_STAGE(PG8_SA(0, 0), cA, voffA); PG8_STAGE(PG8_SB(0, 1), cB + hstep, voffB); PG8_STAGE(PG8_SA(0, 1), cA + hstep, voffA);
    if (wr == 1) PG8_BAR;
    PG8_WAIT_V(4); PG8_BAR;
    PG8_STAGE(PG8_SB(1, 0), cB + kstep, voffB); PG8_STAGE(PG8_SA(1, 0), cA + kstep, voffA); PG8_STAGE(PG8_SB(1, 1), cB + hstep + kstep, voffB);
    PG8_WAIT_V(6); PG8_BAR;
    PG8_STAMP();
    for (;;) {
        const bool has_next = S.next(ui + 1, nxt);
        const char* nA = has_next ? (const char*)S.baseA(g, nxt) + (size_t)nxt.pm * tstep : cA; const char* nB = has_next ? (const char*)S.baseB(g, nxt) + (size_t)nxt.pn * tstep : cB;
        for (int t = 0; t < nt; t += 2) {
            const bool last = (t == nt - 2);
            const char* a1 = cA + (size_t)(t + 1) * kstep;
            const char* a2 = last ? nA : cA + (size_t)(t + 2) * kstep; const char* b2 = last ? nB : cB + (size_t)(t + 2) * kstep;
            const char* a3 = a2 + kstep; const char* b3 = b2 + kstep;
            if (last && has_next) S.a_ready(nxt);
            PG8_LDB(B0, 0, 0); PG8_SCHED; PG8_LDA(At, 0, 0); PG8_STAGE(PG8_SA(1, 1), a1 + hstep, voffA);
            PG8_WAIT_L(8); PG8_BAR; PG8_WAIT_L(0); PG8_MMA(0, 0, At, B0); PG8_BAR; PG8_SCHED;
            PG8_LDB(B1, 0, 1); PG8_STAGE(PG8_SB(0, 0), b2, voffB);
            PG8_BAR; PG8_WAIT_L(0); PG8_MMA(0, 1, At, B1); PG8_BAR;
            PG8_LDA(At, 0, 1); PG8_STAGE(PG8_SA(0, 0), a2, voffA);
            PG8_BAR; PG8_WAIT_L(0); PG8_MMA(1, 0, At, B0); PG8_BAR; PG8_SCHED;
            PG8_STAGE(PG8_SB(0, 1), b2 + hstep, voffB);
            PG8_WAIT_V(6); PG8_BAR; PG8_MMA(1, 1, At, B1); PG8_BAR;
            PG8_LDB(B0, 1, 0); PG8_SCHED; PG8_LDA(At, 1, 0); PG8_STAGE(PG8_SA(0, 1), a2 + hstep, voffA);
            PG8_WAIT_L(8); PG8_BAR; PG8_WAIT_L(0); PG8_MMA(0, 0, At, B0); PG8_BAR; PG8_SCHED;
            PG8_LDB(B1, 1, 1); PG8_STAGE(PG8_SB(1, 0), b3, voffB);
            PG8_BAR; PG8_WAIT_L(0); PG8_MMA(0, 1, At, B1); PG8_BAR;
            PG8_LDA(At, 1, 1); PG8_STAGE(PG8_SA(1, 0), a3, voffA);
            PG8_BAR; PG8_WAIT_L(0); PG8_MMA(1, 0, At, B0); PG8_BAR; PG8_SCHED;
            PG8_STAGE(PG8_SB(1, 1), b3 + hstep, voffB);
            PG8_WAIT_V(6); PG8_BAR; PG8_MMA(1, 1, At, B1); PG8_BAR;
        }
        PG8_STAMP();
        bool keep_acc = false;
        if constexpr (Sched::DUAL) { if (cur.sub == 0) { E.mid(acc, cur, wr, wc, fr, fq); keep_acc = true; } else E(acc, cur, wr, wc, fr, fq); }
        else if constexpr (!Epi::AFTER_DRAIN) { E(acc, cur, wr, wc, fr, fq); S.done(cur); }
        PG8_STAMP();
        if (!has_next) break;
        if (!keep_acc)
#pragma unroll
        for (int a = 0; a < 2; ++a)
#pragma unroll
            for (int b = 0; b < 2; ++b)
#pragma unroll
                for (int m = 0; m < 4; ++m)
#pragma unroll
                    for (int n = 0; n < 2; ++n) acc[a][b][m][n] = (f32x4){0.f, 0.f, 0.f, 0.f};
        cur = nxt; cA = nA; cB = nB; ++ui;
    }
    PG8_WAIT_V(0);
    if (wr == 0) PG8_BAR;
    PG8_BAR;
    if constexpr (Epi::AFTER_DRAIN) { E.fused(acc, cur, wr, wc, fr, fq, lds, wid, lane); S.done(cur); }
    PG8_STAMP();
    if (STAMP && wid == 0) { stamps[lane] = lane < nts ? (((unsigned long long)(unsigned)ts_hi << 32) | (unsigned)ts_lo) : 0ull;
        if (lane == 62) stamps[62] = rt_entry; if (lane == 63) stamps[63] = (unsigned long long)wall_clock64(); }
#undef PG8_STAMP
#undef PG8_SA
#undef PG8_SB
#undef PG8_STAGE
#undef PG8_LDA
#undef PG8_LDB
#undef PG8_MMA
#undef PG8_WAIT_V
#undef PG8_WAIT_L
#undef PG8_BAR
#undef PG8_SCHED
}
}

#define XB_TMO      128
#define XB_XCNT(j)  (256  + 64 * (j))
#define XB_XSUB(j)  (1280 + 64 * (j))
#define XB_XGEN(j)  (2304 + 64 * (j))
#define XB_TOP      3328
#define XB_TOPGEN   3392
#define XCD_BAR_WORDS 3456
#define XB_SPIN_CAP (1u << 18)
#define LAS __attribute__((address_space(3)))

__device__ __forceinline__ unsigned xb_ld(unsigned* p)              { return __hip_atomic_load(p, __ATOMIC_RELAXED, __HIP_MEMORY_SCOPE_AGENT); }
__device__ __forceinline__ unsigned xb_add(unsigned* p, unsigned v) { return __hip_atomic_fetch_add(p, v, __ATOMIC_RELAXED, __HIP_MEMORY_SCOPE_AGENT); }
__device__ __forceinline__ unsigned xb_xcc_id() { return (unsigned)__builtin_amdgcn_s_getreg((3 << 11) | 20) & 0xFu; }
#define XB_SPIN(cond, bar) do { unsigned _sp = 0; while (cond) { __builtin_amdgcn_s_sleep(1); \
    if ((++_sp & 255u) == 0u) { if (xb_ld(&(bar)[XB_TMO])) break; if (_sp > XB_SPIN_CAP) { atomicAdd(&(bar)[XB_TMO], 1u); break; } } } } while (0)

struct XcdBarrier {
    unsigned* bar; unsigned x;
    volatile LAS unsigned* st;
};

__device__ __forceinline__ XcdBarrier xcd_barrier_post(unsigned* bar, volatile LAS unsigned* st) {
    XcdBarrier b; b.bar = bar; b.x = xb_xcc_id(); b.st = st;
    if (threadIdx.x == 0) (void)xb_add(&bar[XB_XCNT(b.x)], 1u);
    return b;
}
__device__ __forceinline__ void xcd_barrier_complete(unsigned* bar, unsigned x, unsigned& nloc, unsigned& nx) {
    const unsigned G = gridDim.x * gridDim.y * gridDim.z;
    unsigned sum, cnt, mine, sp = 0u;
    for (;;) {
        sum = 0u; cnt = 0u; mine = 0u;
#pragma unroll
        for (unsigned j = 0; j < 16; ++j) { const unsigned c = xb_ld(&bar[XB_XCNT(j)]); sum += c; cnt += (c > 0u) ? 1u : 0u; mine = (j == x) ? c : mine; }
        if (sum == G) break;
        __builtin_amdgcn_s_sleep(1);
        if ((++sp & 255u) == 0u) { if (xb_ld(&bar[XB_TMO])) break; if (sp > XB_SPIN_CAP) { atomicAdd(&bar[XB_TMO], 1u); break; } }
    }
    nloc = mine > 0u ? mine : 1u; nx = cnt > 0u ? cnt : 1u;
}

__device__ __forceinline__ void xcd_barrier(const XcdBarrier& b) {
    asm volatile("s_waitcnt vmcnt(0)" ::: "memory");
    __syncthreads();
    if (threadIdx.x == 0) {
        unsigned* bar = b.bar;
        __builtin_amdgcn_s_waitcnt(0);
        unsigned nloc = b.st[0], nx = b.st[1];
        if (nloc == 0u) { xcd_barrier_complete(bar, b.x, nloc, nx); b.st[0] = nloc; b.st[1] = nx; }
        const unsigned old = xb_add(&bar[XB_XSUB(b.x)], 1u);
        const unsigned gen = old / nloc;
        if (old + 1u == (gen + 1u) * nloc) {
            __builtin_amdgcn_fence(__ATOMIC_RELEASE, "agent");
            asm volatile("s_waitcnt vmcnt(0)" ::: "memory");
            const unsigned og = xb_add(&bar[XB_TOP], 1u);
            const unsigned tg = og / nx;
            if (og + 1u == (tg + 1u) * nx) xb_add(&bar[XB_TOPGEN], 1u);
            else XB_SPIN(xb_ld(&bar[XB_TOPGEN]) == tg, bar);
            __builtin_amdgcn_fence(__ATOMIC_ACQUIRE, "agent");
            xb_add(&bar[XB_XGEN(b.x)], 1u);
            asm volatile("s_waitcnt vmcnt(0)" ::: "memory");
        } else {
            XB_SPIN(xb_ld(&bar[XB_XGEN(b.x)]) == gen, bar);
            __builtin_amdgcn_fence(__ATOMIC_ACQUIRE, "agent");
            asm volatile("s_waitcnt vmcnt(0)" ::: "memory");
        }
    }
    __syncthreads();
}
typedef pg8::bf16_t bf16_t;
typedef short bf16x8 __attribute__((ext_vector_type(8)));
typedef short s16x4 __attribute__((ext_vector_type(4)));
typedef float f32x4 __attribute__((ext_vector_type(4)));
typedef float f32x16 __attribute__((ext_vector_type(16)));
typedef unsigned u32x4 __attribute__((ext_vector_type(4)));
typedef unsigned u32x2 __attribute__((ext_vector_type(2)));
constexpr int T = 8192, DM = 4096, NIN = 21552, NP = 21760, DEPTH = 2, NWAVES = 8, NTHREADS = 512;
constexpr int C_Q = 0, C_KV = 2048, C_ZA = 5120, C_UB = 7168, C_VB = 9216, C_ZB = 11264, C_MA = 13312, C_MB = 17408, C_GA = 21504;
constexpr int AW = 2048, BW = 2048, HD = 128, NCMP = 511, NCP = 512;
constexpr float NORM_EPS = 1e-6f;
constexpr size_t al256(size_t x) { return (x + 255) & ~(size_t)255; }
constexpr size_t WS_CTL = 0, CTL_BYTES = 1u << 20;
constexpr size_t SZ_WIN = (size_t)NP * DM * 2, SZ_WAB = (size_t)DM * AW * 2, SZ_WO = (size_t)DM * DM * 2, SZ_W1 = (size_t)HD * 4096 * 2, SZ_W2 = (size_t)HD * HD * 2;
constexpr size_t WS_WIN = WS_CTL + CTL_BYTES;
constexpr size_t WS_WA = WS_WIN + DEPTH * SZ_WIN;
constexpr size_t WS_WB = WS_WA + DEPTH * SZ_WAB;
constexpr size_t WS_WO = WS_WB + DEPTH * SZ_WAB;
constexpr size_t WS_W1 = WS_WO + DEPTH * SZ_WO;
constexpr size_t WS_W2 = WS_W1 + DEPTH * 2 * SZ_W1;
constexpr size_t WS_H = al256(WS_W2 + DEPTH * 2 * SZ_W2);
constexpr size_t WS_PROJ = WS_H + (size_t)T * DM * 2;
constexpr size_t WS_KC = WS_PROJ + (size_t)T * NP * 2;
constexpr size_t WS_VC = WS_KC + (size_t)NCP * 512 * 2;
constexpr size_t WS_OA = WS_VC + (size_t)NCP * 512 * 2;
constexpr size_t WS_OB = WS_OA + (size_t)T * AW * 2;
constexpr size_t WS_T1 = WS_OB + (size_t)T * BW * 2;
constexpr size_t WS_MG = WS_T1 + (size_t)T * DM * 2;
constexpr size_t WS_Y = WS_MG + (size_t)T * DM * 2;
constexpr size_t WS_X1 = WS_Y + (size_t)T * DM * 4;
constexpr size_t WS_SS = WS_X1 + (size_t)T * DM * 4;
constexpr size_t WS_END = WS_SS + (size_t)T * 32 * 4;
constexpr int LDS_STAGE = 0;
constexpr int LDS_BIAS = 131072;
constexpr int LDS_MISC = LDS_BIAS + 16 * 256 * 4;
constexpr int LDS_RS = LDS_MISC + 64;
constexpr int LDS_ATT = LDS_RS + 512;
constexpr int LDS_BYTES = LDS_ATT + 8192;
static_assert(LDS_BYTES <= 160 * 1024, "LDS");
#define LAS3 __attribute__((address_space(3)))
#define LDS_WAIT() asm volatile("s_waitcnt lgkmcnt(0)" ::: "memory")
#define VM_WAIT() asm volatile("s_waitcnt vmcnt(0)" ::: "memory")

struct Params {
    const float *x, *rel_bias, *pre_norm, *w_in, *pe_k, *w1_k, *w2_k, *pe_v, *w1_v, *w2_v, *w_out_a, *sgu_norm, *sgu_w, *sgu_b, *w_out_b, *w_out, *post_norm;
    float* out; unsigned char* ws; int ph_lo, ph_hi;
};
__device__ __forceinline__ unsigned pk2(float lo, float hi) { return pg8::cvt_pk_bf16(lo, hi); }
__device__ __forceinline__ float wave_sum(float v) {
#pragma unroll
    for (int o = 1; o < 64; o <<= 1) v += __shfl_xor(v, o);
    return v;
}
__device__ const unsigned char BUCKET[128] = {0, 1, 2, 3, 4, 5, 6, 7, 8, 9, 10, 11, 12, 13, 14, 15, 16, 16, 16, 17, 17, 18, 18, 18, 19, 19, 19, 20, 20, 20, 20, 21, 21, 21, 21, 22, 22, 22, 22, 22, 23, 23, 23, 23, 23, 23, 24, 24, 24, 24, 24, 24, 25, 25, 25, 25, 25, 25, 25, 26, 26, 26, 26, 26, 26, 26, 26, 27, 27, 27, 27, 27, 27, 27, 27, 27, 27, 28, 28, 28, 28, 28, 28, 28, 28, 28, 28, 29, 29, 29, 29, 29, 29, 29, 29, 29, 29, 29, 29, 30, 30, 30, 30, 30, 30, 30, 30, 30, 30, 30, 30, 30, 30, 31, 31, 31, 31, 31, 31, 31, 31, 31, 31, 31, 31, 31, 31, 31};

__device__ __forceinline__ int srcmap_in(int n) { return n < 5120 ? n : (n < 21504 ? n + 48 : (n < 21552 ? n - 21504 + 5120 : -1)); }
template <int MODE>
__device__ __forceinline__ void transpose_item(const float* __restrict__ W, int K, int N, bf16_t* __restrict__ WT, LAS3 float* scr, int item, int nblk, int lane) {
    const int kb = item / nblk, nb = item - kb * nblk, k0 = 64 * kb, n0 = 64 * nb;
    const int nn = n0 + 4 * (lane & 15); const int s = (MODE == 1) ? srcmap_in(nn) : nn;
    const float* src = W + (size_t)(k0 + (lane >> 4)) * N + (s >= 0 ? s : 0);
#pragma unroll 8
    for (int i = 0; i < 16; ++i) { f32x4 v = *(const f32x4*)(src + (size_t)(4 * i) * N); if (s < 0) v = (f32x4){0.f, 0.f, 0.f, 0.f};
        LAS3 float* d = scr + (4 * i + (lane >> 4)) * 65 + 4 * (lane & 15); d[0] = v[0]; d[1] = v[1]; d[2] = v[2]; d[3] = v[3]; }
    LDS_WAIT();
    const int c = lane & 7;
#pragma unroll
    for (int j = 0; j < 8; ++j) { const int n = (lane >> 3) + 8 * j; const LAS3 float* p = scr + (8 * c) * 65 + n;
        u32x4 o; o.x = pk2(p[0 * 65], p[1 * 65]); o.y = pk2(p[2 * 65], p[3 * 65]); o.z = pk2(p[4 * 65], p[5 * 65]); o.w = pk2(p[6 * 65], p[7 * 65]);
        if (MODE == 2) { const int k8 = (k0 >> 3) + c, na = n0 + n; *(u32x4*)(WT + (size_t)((((k8 >> 1) * (N >> 5) + (na >> 5)) * 64) + (k8 & 1) * 32 + (na & 31)) * 8) = o; }
        else *(u32x4*)(WT + (size_t)(n0 + n) * K + k0 + 8 * c) = o; }
    LDS_WAIT();
}
__device__ __forceinline__ void phase_weights(const Params& P, LAS3 unsigned char* lds, int gw, int NGW, int wave, int lane) {
    asm volatile("" : "+v"(lane));
    LAS3 float* scr = (LAS3 float*)(lds + LDS_STAGE + wave * 16640);
    constexpr int I_IN = 64 * (NP / 64), I_AB = 32 * 64, I_O = 64 * 64, I_W1 = 64 * 2, I_W2 = 2 * 2;
    constexpr int PER_LAYER = I_IN + 2 * I_AB + I_O + 2 * I_W1 + 2 * I_W2;
    for (int it = gw; it < DEPTH * PER_LAYER; it += NGW) {
        const int L = it / PER_LAYER; int r = it - L * PER_LAYER;
        unsigned char* ws = P.ws;
        if (r < I_IN) { transpose_item<1>(P.w_in + (size_t)L * DM * NIN, DM, NIN, (bf16_t*)(ws + WS_WIN + L * SZ_WIN), scr, r, NP / 64, lane); continue; } r -= I_IN;
        if (r < I_AB) { transpose_item<0>(P.w_out_a + (size_t)L * AW * DM, AW, DM, (bf16_t*)(ws + WS_WA + L * SZ_WAB), scr, r, 64, lane); continue; } r -= I_AB;
        if (r < I_AB) { transpose_item<0>(P.w_out_b + (size_t)L * BW * DM, BW, DM, (bf16_t*)(ws + WS_WB + L * SZ_WAB), scr, r, 64, lane); continue; } r -= I_AB;
        if (r < I_O) { transpose_item<0>(P.w_out + (size_t)L * DM * DM, DM, DM, (bf16_t*)(ws + WS_WO + L * SZ_WO), scr, r, 64, lane); continue; } r -= I_O;
        if (r < I_W1) { transpose_item<2>(P.w1_k + (size_t)L * 4096 * HD, 4096, HD, (bf16_t*)(ws + WS_W1 + (L * 2 + 0) * SZ_W1), scr, r, 2, lane); continue; } r -= I_W1;
        if (r < I_W1) { transpose_item<2>(P.w1_v + (size_t)L * 4096 * HD, 4096, HD, (bf16_t*)(ws + WS_W1 + (L * 2 + 1) * SZ_W1), scr, r, 2, lane); continue; } r -= I_W1;
        if (r < I_W2) { transpose_item<0>(P.w2_k + (size_t)L * HD * HD, HD, HD, (bf16_t*)(ws + WS_W2 + (L * 2 + 0) * SZ_W2), scr, r, 2, lane); continue; } r -= I_W2;
        transpose_item<0>(P.w2_v + (size_t)L * HD * HD, HD, HD, (bf16_t*)(ws + WS_W2 + (L * 2 + 1) * SZ_W2), scr, r, 2, lane);
    }
}
__device__ __forceinline__ void phase_prenorm(const float* __restrict__ x, const float* __restrict__ g, bf16_t* __restrict__ h, int gw, int NGW, int lane) {
    asm volatile("" : "+v"(lane));
    for (int m = gw; m < T; m += NGW) {
        const f32x4* xr = (const f32x4*)(x + (size_t)m * DM) + lane; f32x4 v[16]; float ss = 0.f;
#pragma unroll
        for (int j = 0; j < 16; ++j) { v[j] = xr[64 * j]; ss += (v[j][0] * v[j][0] + v[j][1] * v[j][1]) + (v[j][2] * v[j][2] + v[j][3] * v[j][3]); }
        const float rs = 1.0f / sqrtf(wave_sum(ss) * (1.0f / DM) + NORM_EPS);
        u32x2* o = (u32x2*)(h + (size_t)m * DM) + lane; const f32x4* gr = (const f32x4*)g + lane;
#pragma unroll
        for (int j = 0; j < 16; ++j) { const f32x4 gg = gr[64 * j]; u32x2 w; w.x = pk2(v[j][0] * rs * gg[0], v[j][1] * rs * gg[1]); w.y = pk2(v[j][2] * rs * gg[2], v[j][3] * rs * gg[3]); o[64 * j] = w; }
    }
}
__device__ __forceinline__ void phase_postnorm(const bf16_t* __restrict__ Y, const float* __restrict__ xold, const float* __restrict__ gpost, float* __restrict__ xnew,
                                               const float* __restrict__ gpre, bf16_t* __restrict__ h, bool next, int gw, int NGW, int lane) {
    asm volatile("" : "+v"(lane));
    for (int m = gw; m < T; m += NGW) {
        const u32x2* yr = (const u32x2*)(Y + (size_t)m * DM) + lane; f32x4 v[16]; float ss = 0.f;
#pragma unroll
        for (int j = 0; j < 16; ++j) { const u32x2 w = yr[64 * j]; v[j] = (f32x4){pg8::bf_lo(w.x), pg8::bf_hi(w.x), pg8::bf_lo(w.y), pg8::bf_hi(w.y)}; ss += (v[j][0] * v[j][0] + v[j][1] * v[j][1]) + (v[j][2] * v[j][2] + v[j][3] * v[j][3]); }
        const float rs = 1.0f / sqrtf(wave_sum(ss) * (1.0f / DM) + NORM_EPS);
        const f32x4* xr = (const f32x4*)(xold + (size_t)m * DM) + lane; const f32x4* gr = (const f32x4*)gpost + lane; f32x4* xo = (f32x4*)(xnew + (size_t)m * DM) + lane;
        float s2 = 0.f;
#pragma unroll
        for (int j = 0; j < 16; ++j) { const f32x4 gg = gr[64 * j], xx = xr[64 * j]; f32x4 r = xx + v[j] * rs * gg; v[j] = r; xo[64 * j] = r; s2 += (r[0] * r[0] + r[1] * r[1]) + (r[2] * r[2] + r[3] * r[3]); }
        if (next) {
            const float rs2 = 1.0f / sqrtf(wave_sum(s2) * (1.0f / DM) + NORM_EPS);
            u32x2* o = (u32x2*)(h + (size_t)m * DM) + lane; const f32x4* g2 = (const f32x4*)gpre + lane;
#pragma unroll
            for (int j = 0; j < 16; ++j) { const f32x4 gg = g2[64 * j]; u32x2 w; w.x = pk2(v[j][0] * rs2 * gg[0], v[j][1] * rs2 * gg[1]); w.y = pk2(v[j][2] * rs2 * gg[2], v[j][3] * rs2 * gg[3]); o[64 * j] = w; }
        }
    }
}
namespace att {
constexpr float SCALE = 0.08838834764831845f, LOG2E = 1.4426950408889634f, C2 = SCALE * LOG2E;
constexpr int SHM = 16384;
constexpr int NSLOT = 3;
constexpr int L_V = 0, L_K = NSLOT * SHM, L_IMP = 2 * NSLOT * SHM, L_SEL = LDS_ATT, L_WS = L_SEL + 1024, L_SC = L_WS + 2048, L_END = L_SC + 4096;
static_assert(L_IMP + 32768 <= 131072 && L_END <= LDS_ATT + 8192, "attention LDS");
#define KSWZ(row, colB) ((row) * 256 + ((colB) ^ (((row) & 7) << 4)))
#define SBAR() __builtin_amdgcn_sched_barrier(0)
__device__ __forceinline__ int v_st(int k, int c) { const int kk = (k & ~0xC) | ((k & 4) << 1) | ((k & 8) >> 1); return ((kk >> 3) * 4 + (c >> 5)) * 512 + ((kk & 7) * 32 + (c & 31)) * 2; }
__device__ __forceinline__ int v_rd_base(int lane) { return ((lane & 3) << 3) | (((lane >> 2) & 3) << 6) | (((lane >> 4) & 1) << 5) | (((lane >> 5) & 1) << 8); }
constexpr int v_rd_off(int d0, int ks, int half) { return d0 * 512 + ks * 4096 + half * 2048; }
__device__ __forceinline__ int crow(int r, int hi) { return (r & 3) + 8 * (r >> 2) + 4 * hi; }
__device__ __forceinline__ unsigned cvtpk(float lo, float hi) { return pg8::cvt_pk_bf16(lo, hi); }
enum { MODE_STAT = 0, MODE_IMP = 1, MODE_ONLINE = 2, MODE_ACC = 3 };

struct Ctx {
    bf16x8 qr[8]; f32x16 o[4];
    int tq, r32, hi, wid, lane, tid, t0;
    const LAS3 float* tb; float bfar;
    LAS3 char* lds;
};
__device__ __forceinline__ void qkt(f32x16& p0, f32x16& p1, const LAS3 char* Kt, int r32, int hi, const bf16x8* qr) {
    p0 = f32x16{}; p1 = f32x16{};
    const LAS3 char* kb[4];
#pragma unroll
    for (int dd = 0; dd < 4; ++dd) kb[dd] = Kt + KSWZ(r32, (dd * 16 + hi * 8) * 2);
#pragma unroll
    for (int d0 = 0; d0 < 8; ++d0) { const LAS3 char* a = kb[d0 & 3] + (d0 >> 2) * 128;
        const bf16x8 b0 = *reinterpret_cast<const LAS3 bf16x8*>(a);
        const bf16x8 b1 = *reinterpret_cast<const LAS3 bf16x8*>(a + 32 * 256);
        p0 = __builtin_amdgcn_mfma_f32_32x32x16_bf16(b0, qr[d0], p0, 0, 0, 0);
        p1 = __builtin_amdgcn_mfma_f32_32x32x16_bf16(b1, qr[d0], p1, 0, 0, 0);
        if ((d0 & 3) == 3) SBAR(); }
}
__device__ __forceinline__ void pv_tile(f32x16* o, int vb0, bf16x8 pa0, bf16x8 pa1, bf16x8 pa2, bf16x8 pa3) {
#define TRRD(dst, off) asm volatile("ds_read_b64_tr_b16 %0, %1 offset:%2" : "=&v"(dst) : "v"(vb0), "i"(off) : "memory")
#define PV_D0(d0) do { s16x4 l0, l1, l2, l3, h0, h1, h2, h3; constexpr int b_ = v_rd_off(d0, 0, 0); \
        TRRD(l0, b_); TRRD(h0, b_ + 2048); TRRD(l1, b_ + 4096); TRRD(h1, b_ + 6144); TRRD(l2, b_ + 8192); TRRD(h2, b_ + 10240); TRRD(l3, b_ + 12288); TRRD(h3, b_ + 14336); \
        asm volatile("s_waitcnt lgkmcnt(0)" ::: "memory"); SBAR(); \
        o[d0] = __builtin_amdgcn_mfma_f32_32x32x16_bf16(pa0, (bf16x8){l0[0], l0[1], l0[2], l0[3], h0[0], h0[1], h0[2], h0[3]}, o[d0], 0, 0, 0); \
        o[d0] = __builtin_amdgcn_mfma_f32_32x32x16_bf16(pa1, (bf16x8){l1[0], l1[1], l1[2], l1[3], h1[0], h1[1], h1[2], h1[3]}, o[d0], 0, 0, 0); \
        o[d0] = __builtin_amdgcn_mfma_f32_32x32x16_bf16(pa2, (bf16x8){l2[0], l2[1], l2[2], l2[3], h2[0], h2[1], h2[2], h2[3]}, o[d0], 0, 0, 0); \
        o[d0] = __builtin_amdgcn_mfma_f32_32x32x16_bf16(pa3, (bf16x8){l3[0], l3[1], l3[2], l3[3], h3[0], h3[1], h3[2], h3[3]}, o[d0], 0, 0, 0); } while (0)
    PV_D0(0); PV_D0(1); PV_D0(2); PV_D0(3);
#undef PV_D0
#undef TRRD
}
__device__ __forceinline__ void pack_p(const f32x16& p0, const f32x16& p1, bf16x8& pa0, bf16x8& pa1, bf16x8& pa2, bf16x8& pa3) {
#define PK4(P, B_, OUT) do { unsigned a0 = cvtpk(P[B_+0], P[B_+1]), a1 = cvtpk(P[B_+2], P[B_+3]); \
        unsigned b0 = cvtpk(P[B_+4], P[B_+5]), b1 = cvtpk(P[B_+6], P[B_+7]); \
        auto r0 = __builtin_amdgcn_permlane32_swap(a0, b0, false, false); auto r1 = __builtin_amdgcn_permlane32_swap(a1, b1, false, false); \
        u32x4 w = {r0[0], r1[0], r0[1], r1[1]}; OUT = *reinterpret_cast<bf16x8*>(&w); } while (0)
    PK4(p0, 0, pa0); SBAR(); PK4(p0, 8, pa1); SBAR(); PK4(p1, 0, pa2); SBAR(); PK4(p1, 8, pa3);
#undef PK4
}
__device__ __forceinline__ float half_max(float v) { auto rr = __builtin_amdgcn_permlane32_swap(__float_as_uint(v), __float_as_uint(v), false, false); return fmaxf(__uint_as_float(rr[0]), __uint_as_float(rr[1])); }
__device__ __forceinline__ float half_sum(float v) { auto rr = __builtin_amdgcn_permlane32_swap(__float_as_uint(v), __float_as_uint(v), false, false); return __uint_as_float(rr[0]) + __uint_as_float(rr[1]); }

template <int MODE, int STEP, int OFF, bool ROWSEL>
__device__ __forceinline__ void run_pass(Ctx& c, const bf16_t* __restrict__ Kg, const bf16_t* __restrict__ Vg, int ldk, int j_lo, int j_hi, unsigned W,
                                         float& m_reg, float& l_reg, float pscale, unsigned sm0, unsigned sm1, unsigned sm2, unsigned sm3) {
    constexpr bool HASV = (MODE == MODE_ONLINE || MODE == MODE_ACC);
    int tid = c.tid, r32 = c.r32, hi = c.hi, lane = c.lane;
    asm volatile("" : "+v"(tid), "+v"(r32), "+v"(hi), "+v"(lane));
    LAS3 char* V_lds = c.lds + L_V; LAS3 char* K_lds = c.lds + L_K;
    LAS3 float* wsf = (LAS3 float*)(c.lds + L_WS) + c.wid * 64; LAS3 float* al_l = wsf + 32;
    const int krow = tid >> 4;
    const unsigned ko0 = (unsigned)(krow * ldk + (((tid & 15) ^ (krow & 7)) * 8)) * 2u;
    const int vkk = ((tid >> 7) * 8) + ((tid & 31) >> 2), vkey = (vkk & ~0xC) | ((vkk & 4) << 1) | ((vkk & 8) >> 1), vcol = ((tid >> 5) & 3) * 32 + (tid & 3) * 8;
    const unsigned vo0 = (unsigned)(vkey * ldk + vcol) * 2u;
    const unsigned half_step = (unsigned)(32 * ldk) * 2u;
    const int vbase = (int)(uintptr_t)V_lds + v_rd_base(lane);
#define LOADT(j, bf) do { const char* kp_ = (const char*)(Kg + (size_t)((j) * 64) * ldk); LAS3 char* kd_ = K_lds + (bf) * SHM + c.wid * 1024; \
        __builtin_amdgcn_global_load_lds((const unsigned*)(kp_ + ko0), (LAS3 unsigned*)kd_, 16, 0, 0); \
        __builtin_amdgcn_global_load_lds((const unsigned*)((kp_ + half_step) + ko0), (LAS3 unsigned*)(kd_ + 8192), 16, 0, 0); \
        if (HASV) { const char* vp_ = (const char*)(Vg + (size_t)((j) * 64) * ldk); LAS3 char* vd_ = V_lds + (bf) * SHM + c.wid * 1024; \
            __builtin_amdgcn_global_load_lds((const unsigned*)(vp_ + vo0), (LAS3 unsigned*)vd_, 16, 0, 0); \
            __builtin_amdgcn_global_load_lds((const unsigned*)((vp_ + half_step) + vo0), (LAS3 unsigned*)(vd_ + 8192), 16, 0, 0); } } while (0)
    if (j_lo > j_hi) return;
    LOADT(j_lo, 0); if (j_lo < j_hi) LOADT(j_lo + 1, 1);
    if (j_lo < j_hi) { if (HASV) asm volatile("s_waitcnt vmcnt(4)" ::: "memory"); else asm volatile("s_waitcnt vmcnt(2)" ::: "memory"); } else VM_WAIT();
    __builtin_amdgcn_s_barrier(); asm volatile("" ::: "memory");
    const int tqw = c.t0 + 8 * c.wid;
    int cur = 0;
    for (int j = j_lo; j <= j_hi; ++j) {
        if (j + 2 <= j_hi) { const int nx = cur == 0 ? 2 : cur - 1; LOADT(j + 2, nx); }
        const int kpos0 = STEP * (j * 64) + OFF;
        const int dmin = tqw - (kpos0 + STEP * 63), dmax = tqw + 7 - kpos0;
        bool rowsel = true;
        if (ROWSEL) { const unsigned wsel = (j < 32) ? sm0 : (j < 64) ? sm1 : (j < 96) ? sm2 : sm3; rowsel = (wsel >> (j & 31)) & 1u; }
        bool act = (dmax >= 0) && (dmin < (int)W);
        if (ROWSEL) act = act && __any(rowsel);
        if (act) {
            f32x16 p0, p1;
            SBAR(); qkt(p0, p1, K_lds + cur * SHM, r32, hi, c.qr); SBAR();
            const bool nearb = dmin < 113, needmask = (dmin < 0) || ((unsigned)dmax >= W);
            const int d0 = c.tq - kpos0 - STEP * 4 * hi;
#ifdef NO_NEAR
            if (false) {
#else
            if (nearb) {
#endif
                if (STEP == 1) {
                    const LAS3 float* tbase = c.tb + (d0 + 5);
#pragma unroll
                    for (int r = 0; r < 16; ++r) { const int cc = (r & 3) + 8 * (r >> 2);
                        p0[r] = fmaf(p0[r], C2, tbase[59 - cc]); p1[r] = fmaf(p1[r], C2, tbase[59 - cc - 32]);
                        if ((r & 3) == 3) SBAR(); }
                } else {
#pragma unroll
                    for (int r = 0; r < 16; ++r) { const int cc = (r & 3) + 8 * (r >> 2); const int da = d0 - STEP * cc, db = d0 - STEP * (cc + 32);
                        const float ba = c.tb[64 + min(max(da, 0), 127)], bb = c.tb[64 + min(max(db, 0), 127)];
                        p0[r] = fmaf(p0[r], C2, ba); p1[r] = fmaf(p1[r], C2, bb);
                        if ((r & 3) == 3) SBAR(); }
                }
            } else {
#pragma unroll
                for (int r = 0; r < 16; ++r) { p0[r] = fmaf(p0[r], C2, c.bfar); p1[r] = fmaf(p1[r], C2, c.bfar); }
            }
            SBAR();
            const float NEG = -__builtin_inff();
#ifdef NO_MASK
            if (false) {
#else
            if (needmask) {
#endif
#pragma unroll
                for (int r = 0; r < 16; ++r) { const int cc = (r & 3) + 8 * (r >> 2); const int da = d0 - STEP * cc, db = d0 - STEP * (cc + 32);
                    if ((unsigned)da >= W) p0[r] = NEG; if ((unsigned)db >= W) p1[r] = NEG; }
            }
            if (ROWSEL) {
#pragma unroll
                for (int r = 0; r < 16; ++r) { p0[r] = rowsel ? p0[r] : NEG; p1[r] = rowsel ? p1[r] : NEG; }
            }
            if (MODE == MODE_STAT || MODE == MODE_ONLINE) {
                float pmax = p0[0];
#pragma unroll
                for (int r = 1; r < 16; ++r) pmax = fmaxf(pmax, p0[r]);
#pragma unroll
                for (int r = 0; r < 16; ++r) pmax = fmaxf(pmax, p1[r]);
                pmax = half_max(pmax);
                const float mn = fmaxf(m_reg, pmax); const float alpha = __builtin_amdgcn_exp2f(m_reg - mn); m_reg = mn;
                float ps = 0.f;
#pragma unroll
                for (int r = 0; r < 16; ++r) { p0[r] = __builtin_amdgcn_exp2f(p0[r] - mn); p1[r] = __builtin_amdgcn_exp2f(p1[r] - mn); ps += p0[r] + p1[r]; }
                ps = half_sum(ps);
                l_reg = l_reg * alpha + ps;
                if (MODE == MODE_ONLINE) {
#ifdef NO_RESC
                    if (false) {
#else
                    if (__any(alpha < 1.f)) {
#endif
                        if (hi == 0) al_l[r32] = alpha; LDS_WAIT();
#pragma unroll
                        for (int d_ = 0; d_ < 4; ++d_)
#pragma unroll
                            for (int r = 0; r < 16; ++r) c.o[d_][r] *= al_l[crow(r, hi)];
                        SBAR(); }
                    SBAR(); bf16x8 pa0, pa1, pa2, pa3; pack_p(p0, p1, pa0, pa1, pa2, pa3); SBAR();
                    pv_tile(c.o, vbase + cur * SHM, pa0, pa1, pa2, pa3);
                }
            } else {
#pragma unroll
                for (int r = 0; r < 16; ++r) { p0[r] = __builtin_amdgcn_exp2f(p0[r] - m_reg) * pscale; p1[r] = __builtin_amdgcn_exp2f(p1[r] - m_reg) * pscale; }
                if (MODE == MODE_ACC) {
                    bf16x8 pa0, pa1, pa2, pa3; pack_p(p0, p1, pa0, pa1, pa2, pa3);
                    pv_tile(c.o, vbase + cur * SHM, pa0, pa1, pa2, pa3);
                } else {
                    LAS3 float* imp = (LAS3 float*)(c.lds + L_IMP) + (c.wid * 8 + (r32 >> 2)) * 128;
#pragma unroll
                    for (int hf = 0; hf < 2; ++hf)
#pragma unroll
                        for (int m = 0; m < 4; ++m) { const f32x16& P = hf ? p1 : p0;
                            float a = 2.f * (P[4 * m] + P[4 * m + 1] + P[4 * m + 2]) + P[4 * m + 3], b = P[4 * m + 3];
                            a += __shfl_xor(a, 1); b += __shfl_xor(b, 1); a += __shfl_xor(a, 2); b += __shfl_xor(b, 2);
                            const int jj = 16 * j + 8 * hf + 2 * m + hi;
                            if ((r32 & 3) == 0) { __hip_atomic_fetch_add(imp + jj, a, __ATOMIC_RELAXED, __HIP_MEMORY_SCOPE_WORKGROUP);
                                if (jj + 1 < 128) __hip_atomic_fetch_add(imp + jj + 1, b, __ATOMIC_RELAXED, __HIP_MEMORY_SCOPE_WORKGROUP); } }
                }
            }
        }
        if (j + 2 <= j_hi) { if (HASV) asm volatile("s_waitcnt vmcnt(4)" ::: "memory"); else asm volatile("s_waitcnt vmcnt(2)" ::: "memory"); } else VM_WAIT();
        LDS_WAIT(); __builtin_amdgcn_s_barrier(); asm volatile("" ::: "memory");
        cur = cur == 2 ? 0 : cur + 1;
    }
#undef LOADT
}
template <int VAR>
__device__ __forceinline__ void sel_pass_pp(Ctx& c, const bf16_t* __restrict__ Kg, const bf16_t* __restrict__ Vg, const int ldk, const int n, float& m_reg, float& l_reg,
                                            unsigned sm0, unsigned sm1, unsigned sm2, unsigned sm3) {
    int tid = c.tid, r32 = c.r32, hi = c.hi, lane = c.lane;
    asm volatile("" : "+v"(tid), "+v"(r32), "+v"(hi), "+v"(lane));
    LAS3 char* V_lds = c.lds + L_V; LAS3 char* K_lds = c.lds + L_K;
    LAS3 float* al_l = (LAS3 float*)(c.lds + L_WS) + c.wid * 64 + 32;
    const int krow = tid >> 4;
    const unsigned ko0 = (unsigned)(krow * ldk + (((tid & 15) ^ (krow & 7)) * 8)) * 2u;
    const int vkk = ((tid >> 7) * 8) + ((tid & 31) >> 2), vkey = (vkk & ~0xC) | ((vkk & 4) << 1) | ((vkk & 8) >> 1), vcol = ((tid >> 5) & 3) * 32 + (tid & 3) * 8;
    const unsigned vo0 = (unsigned)(vkey * ldk + vcol) * 2u;
    const unsigned half_step = (unsigned)(32 * ldk) * 2u;
    const int vbase = (int)(uintptr_t)V_lds + v_rd_base(lane);
#define LOADT(j, bf) do { const char* kp_ = (const char*)(Kg + (size_t)((j) * 64) * ldk); LAS3 char* kd_ = K_lds + (bf) * SHM + c.wid * 1024; \
        __builtin_amdgcn_global_load_lds((const unsigned*)(kp_ + ko0), (LAS3 unsigned*)kd_, 16, 0, 0); \
        __builtin_amdgcn_global_load_lds((const unsigned*)((kp_ + half_step) + ko0), (LAS3 unsigned*)(kd_ + 8192), 16, 0, 0); \
        const char* vp_ = (const char*)(Vg + (size_t)((j) * 64) * ldk); LAS3 char* vd_ = V_lds + (bf) * SHM + c.wid * 1024; \
        __builtin_amdgcn_global_load_lds((const unsigned*)(vp_ + vo0), (LAS3 unsigned*)vd_, 16, 0, 0); \
        __builtin_amdgcn_global_load_lds((const unsigned*)((vp_ + half_step) + vo0), (LAS3 unsigned*)(vd_ + 8192), 16, 0, 0); } while (0)
    LOADT(0, 0); if (n > 1) LOADT(1, 1);
    if (n > 1) asm volatile("s_waitcnt vmcnt(4)" ::: "memory"); else VM_WAIT();
    __builtin_amdgcn_s_barrier(); asm volatile("" ::: "memory");
    const int role = c.wid >> 2, tqw = c.t0 + 8 * c.wid;
    const float NEG = -__builtin_inff();
#define STEP_END(oddstep, ldt) do { if (oddstep) { if (ldt) asm volatile("s_waitcnt vmcnt(4)" ::: "memory"); else VM_WAIT(); } LDS_WAIT(); __builtin_amdgcn_s_barrier(); asm volatile("" ::: "memory"); } while (0)
    if (role == 1) { __builtin_amdgcn_s_barrier(); asm volatile("" ::: "memory"); }
    int slot = 0;
#pragma unroll 1
    for (int j = 0; j < n; ++j) {
        const bool ldt = (j + 2 < n); const int lslot = slot == 0 ? 2 : slot - 1;
        if (role == 1 && ldt) LOADT(j + 2, lslot);
        bf16x8 pa0, pa1, pa2, pa3; bool resc = false;
        const unsigned wsel = (j < 32) ? sm0 : (j < 64) ? sm1 : (j < 96) ? sm2 : sm3; const bool rowsel = (wsel >> (j & 31)) & 1u;
        const bool actB = __any(rowsel);
        if (actB) {
            f32x16 p0, p1;
            if (VAR == 2 || VAR == 3) { p0 = c.o[0]; p1 = c.o[1]; } else { SBAR(); __builtin_amdgcn_s_setprio(2); qkt(p0, p1, K_lds + slot * SHM, r32, hi, c.qr); __builtin_amdgcn_s_setprio(0); SBAR(); }
            const int kpos0 = j * 64; const int dmin = tqw - (kpos0 + 63);
            if (VAR == 1 || VAR == 3) { resc = false; SBAR(); pack_p(p0, p1, pa0, pa1, pa2, pa3); SBAR(); } else {
            float mul = C2, add0 = c.bfar;
            if (dmin < 113) {
                const int d0 = c.tq - kpos0 - 4 * hi; const LAS3 float* tbase = c.tb + (d0 + 5);
#pragma unroll
                for (int r = 0; r < 16; ++r) { const int cc = (r & 3) + 8 * (r >> 2);
                    p0[r] = fmaf(p0[r], C2, tbase[59 - cc]); p1[r] = fmaf(p1[r], C2, tbase[59 - cc - 32]);
                    if ((r & 3) == 3) SBAR(); }
                if (dmin < 0) {
#pragma unroll
                    for (int r = 0; r < 16; ++r) { const int cc = (r & 3) + 8 * (r >> 2); if (d0 - cc < 0) p0[r] = NEG; if (d0 - cc - 32 < 0) p1[r] = NEG; }
                }
                mul = 1.f; add0 = 0.f;
            }
            SBAR();
            float pm = fmaxf(p0[0], p1[0]);
#pragma unroll
            for (int r = 1; r < 16; ++r) pm = fmaxf(fmaxf(pm, p0[r]), p1[r]);
            pm = half_max(pm);
            float xmax = fmaf(pm, mul, add0); xmax = rowsel ? xmax : NEG;
            const float mn = fmaxf(m_reg, xmax); const float alpha = __builtin_amdgcn_exp2f(m_reg - mn); m_reg = mn;
            const float off = rowsel ? (add0 - mn) : NEG;
#pragma unroll
            for (int r = 0; r < 16; ++r) { p0[r] = __builtin_amdgcn_exp2f(fmaf(p0[r], mul, off)); p1[r] = __builtin_amdgcn_exp2f(fmaf(p1[r], mul, off)); }
            float ps = 0.f;
#pragma unroll
            for (int r = 0; r < 16; ++r) ps += p0[r] + p1[r];
            ps = half_sum(ps);
            l_reg = l_reg * alpha + ps;
            resc = __any(alpha < 1.f);
            if (resc && hi == 0) al_l[r32] = alpha;
            SBAR(); pack_p(p0, p1, pa0, pa1, pa2, pa3); SBAR();
            }
        }
        STEP_END(role == 1, ldt);
        if (role == 0 && ldt) LOADT(j + 2, lslot);
        if (actB) {
#ifdef PP_NORESC
            if (false) {
#else
            if (resc) {
#endif
#pragma unroll
                for (int d_ = 0; d_ < 4; ++d_)
#pragma unroll
                    for (int r = 0; r < 16; ++r) c.o[d_][r] *= al_l[crow(r, hi)];
                SBAR(); }
            if (VAR == 2 || VAR == 3) { c.o[2][0] += __uint_as_float((unsigned)pa0[0]); } else pv_tile(c.o, vbase + slot * SHM, pa0, pa1, pa2, pa3);
        }
        STEP_END(role == 0, ldt);
        slot = slot == 2 ? 0 : slot + 1;
    }
    if (role == 0) { __builtin_amdgcn_s_barrier(); asm volatile("" ::: "memory"); }
#undef STEP_END
#undef LOADT
}
__device__ __forceinline__ void attn_unit(LAS3 char* lds, const bf16_t* __restrict__ proj, const bf16_t* __restrict__ kc, const bf16_t* __restrict__ vc, bf16_t* __restrict__ oa, int qt, int g) {
    int tid_ = threadIdx.x; asm volatile("" : "+v"(tid_));
    Ctx c; c.lds = lds; c.tid = tid_; c.lane = c.tid & 63; c.wid = __builtin_amdgcn_readfirstlane(c.tid >> 6); c.r32 = c.lane & 31; c.hi = c.lane >> 5;
    c.t0 = qt * 64; c.tq = c.t0 + 8 * c.wid + (c.r32 >> 2);
    const int head = g * 4 + (c.r32 & 3);
    c.tb = (const LAS3 float*)(lds + LDS_BIAS) + head * 256; c.bfar = c.tb[64 + 127];
    { const bf16_t* qp = proj + (size_t)c.tq * NP + C_Q + head * HD + c.hi * 8;
#pragma unroll
      for (int d0 = 0; d0 < 8; ++d0) c.qr[d0] = *(const bf16x8*)(qp + d0 * 16); }
    float ga[3];
    { const bf16_t* gp = proj + (size_t)c.tq * NP + C_GA + head * 3;
#pragma unroll
      for (int b = 0; b < 3; ++b) ga[b] = pg8::fast_sigmoid(__uint_as_float(((unsigned)gp[b]) << 16)); }
    { LAS3 f32x4* z = (LAS3 f32x4*)(lds + L_IMP);
#pragma unroll
      for (int i = 0; i < 4; ++i) z[c.tid + 512 * i] = (f32x4){0.f, 0.f, 0.f, 0.f}; }
    __syncthreads();
    const bf16_t* Kc = kc + g * HD; const bf16_t* Vc = vc + g * HD;
    const bf16_t* Ks = proj + C_KV + 2 * 512 + g * HD; const bf16_t* Vs = proj + C_KV + 3 * 512 + g * HD;
    const bf16_t* Kw = proj + C_KV + 4 * 512 + g * HD; const bf16_t* Vw = proj + C_KV + 5 * 512 + g * HD;
    const int ntc = (4 * qt + 2) / 64;
    constexpr unsigned WINF = 0x7fffffffu;
    float m_c = -1e30f, l_c = 0.f, rl_c = 0.f;
#ifndef ADBG
#define ADBG 0xff
#endif
#ifndef AREP
#define AREP 0
#endif
#pragma unroll 1
    for (int rep = 0; rep < ((AREP & 1) ? 2 : 1); ++rep) {
        if (rep) { LAS3 f32x4* z = (LAS3 f32x4*)(lds + L_IMP);
#pragma unroll
            for (int i = 0; i < 4; ++i) z[c.tid + 512 * i] = (f32x4){0.f, 0.f, 0.f, 0.f};
            __syncthreads(); m_c = -1e30f; l_c = 0.f; }
        run_pass<MODE_STAT, 16, 31, false>(c, Kc, Vc, 512, 0, ntc, WINF, m_c, l_c, 0.f, 0u, 0u, 0u, 0u);
        rl_c = l_c > 0.f ? 1.0f / l_c : 0.f;
        run_pass<MODE_IMP, 16, 31, false>(c, Kc, Vc, 512, 0, ntc, WINF, m_c, l_c, rl_c, 0u, 0u, 0u, 0u);
    }
#ifdef NO_TOPK
    if (false)
#endif
    {
        LAS3 unsigned* selw = (LAS3 unsigned*)(lds + L_SEL);
#pragma unroll 1
        for (int tk = 0; tk < 8; ++tk) {
            const int tok = c.wid * 8 + tk; const LAS3 float* imp = (const LAS3 float*)(lds + L_IMP) + tok * 128;
            const int ja = c.lane, jb = c.lane + 64;
            unsigned ka = __float_as_uint(imp[ja]) + 1u, kb = __float_as_uint(imp[jb]) + 1u;
            ka = (ja == 0 || ja == qt || ja == qt - 1) ? 0xffffffffu : (ja > qt ? 0u : ka);
            kb = (jb == qt || jb == qt - 1) ? 0xffffffffu : (jb > qt ? 0u : kb);
            unsigned T = 0u;
#pragma unroll 1
            for (int bit = 31; bit >= 0; --bit) { const unsigned cand = T | (1u << bit);
                const int cnt = __popcll(__ballot(ka >= cand)) + __popcll(__ballot(kb >= cand));
                T = cnt >= 16 ? cand : T; }
            const int cgt = __popcll(__ballot(ka > T)) + __popcll(__ballot(kb > T)); const int rr = 16 - cgt;
            const unsigned long long ea = __ballot(ka == T), eb = __ballot(kb == T);
            const int ra = __builtin_amdgcn_mbcnt_hi((unsigned)(ea >> 32), __builtin_amdgcn_mbcnt_lo((unsigned)ea, 0u));
            const int rb = __popcll(ea) + (int)__builtin_amdgcn_mbcnt_hi((unsigned)(eb >> 32), __builtin_amdgcn_mbcnt_lo((unsigned)eb, 0u));
            const unsigned long long ba = __ballot(ka > T || (ka == T && ra < rr)), bb = __ballot(kb > T || (kb == T && rb < rr));
            if (c.lane == 0) { selw[tok * 4 + 0] = (unsigned)ba; selw[tok * 4 + 1] = (unsigned)(ba >> 32); selw[tok * 4 + 2] = (unsigned)bb; selw[tok * 4 + 3] = (unsigned)(bb >> 32); }
        }
        LDS_WAIT();
    }
    unsigned sm0, sm1, sm2, sm3;
    { const LAS3 unsigned* selw = (const LAS3 unsigned*)(lds + L_SEL) + (c.wid * 8 + (c.r32 >> 2)) * 4; sm0 = selw[0]; sm1 = selw[1]; sm2 = selw[2]; sm3 = selw[3]; }
    LAS3 float* wsf = (LAS3 float*)(lds + L_WS) + c.wid * 64;
    {
        float m_s = -1e30f, l_s = 0.f;
#ifndef SELVAR
#define SELVAR 0
#endif
        if (AREP & 4) { m_s = -1e30f; l_s = 0.f;
#pragma unroll
            for (int d_ = 0; d_ < 4; ++d_) c.o[d_] = f32x16{};
            sel_pass_pp<SELVAR>(c, Ks, Vs, NP, qt + 1, m_s, l_s, sm0, sm1, sm2, sm3);
            asm volatile("" :: "v"(c.o[0]), "v"(c.o[1]), "v"(c.o[2]), "v"(c.o[3]), "v"(m_s), "v"(l_s)); }
        m_s = -1e30f; l_s = 0.f;
#pragma unroll
        for (int d_ = 0; d_ < 4; ++d_) c.o[d_] = f32x16{};
        sel_pass_pp<0>(c, Ks, Vs, NP, qt + 1, m_s, l_s, sm0, sm1, sm2, sm3);
        const float f = ga[1] / l_s;
        if (c.hi == 0) wsf[c.r32] = f; LDS_WAIT();
#pragma unroll
        for (int d_ = 0; d_ < 4; ++d_)
#pragma unroll
            for (int r = 0; r < 16; ++r) c.o[d_][r] *= wsf[crow(r, c.hi)];
    }
#pragma unroll 1
    for (int rep = ((AREP & 8) ? 0 : 1); rep < 2; ++rep) run_pass<MODE_ACC, 16, 31, false>(c, Kc, Vc, 512, 0, ntc, WINF, m_c, l_c, rep ? ga[0] * rl_c : 0.f, 0u, 0u, 0u, 0u);
    {
        float m_w = -1e30f, l_w = 0.f; const int jlo = qt >= 8 ? qt - 8 : 0;
#pragma unroll 1
        for (int rep = ((AREP & 16) ? 0 : 1); rep < 2; ++rep) {
            m_w = -1e30f; l_w = 0.f;
            run_pass<MODE_STAT, 1, 0, false>(c, Kw, Vw, NP, jlo, qt, 512u, m_w, l_w, 0.f, 0u, 0u, 0u, 0u);
            run_pass<MODE_ACC, 1, 0, false>(c, Kw, Vw, NP, jlo, qt, 512u, m_w, l_w, rep ? ga[2] / l_w : 0.f, 0u, 0u, 0u, 0u);
        }
    }
#ifdef NO_EPI
    if (c.o[0][0] == 123.f && c.o[1][1] == 3.f && c.o[2][2] == 1.f && c.o[3][3] == 5.f) oa[0] = 1;
    if (false)
#endif
    {
        const int tw = c.t0 + 8 * c.wid;
        const char* zbase = (const char*)(proj + C_ZA + g * 4 * HD); char* obase = (char*)(oa + g * 4 * HD);
#pragma unroll
        for (int r = 0; r < 16; ++r) { const int row = crow(r, c.hi); const int tok = tw + (row >> 2), hd = row & 3;
            const unsigned zo = (unsigned)(tok * NP + hd * HD + c.r32) * 2u, oo = (unsigned)(tok * AW + hd * HD + c.r32) * 2u;
#pragma unroll
            for (int d0 = 0; d0 < 4; ++d0) { const float z = __uint_as_float(((unsigned)*(const bf16_t*)(zbase + zo + d0 * 64)) << 16);
                const float v = c.o[d0][r] * z * pg8::fast_sigmoid(z); const float vn = __shfl_xor(v, 1);
                if ((c.r32 & 1) == 0) *(unsigned*)(obase + oo + d0 * 64) = cvtpk(v, vn); }
            SBAR(); }
    }
    __syncthreads();
}
__device__ __forceinline__ void phase_attn(LAS3 char* lds, const bf16_t* proj, const bf16_t* kc, const bf16_t* vc, bf16_t* oa, int vcu, int G) {
#pragma unroll 1
    for (int item = vcu; item < 256; item += G) {
        const int g = item >> 6, p = item & 63;
#pragma unroll 1
        for (int s = 0; s < 2; ++s) attn_unit(lds, proj, kc, vc, oa, s ? p : 127 - p, g);
    }
}
}
__device__ __forceinline__ float gelu_tanh(float x) { const float y = 1.5957691216057308f * (x + 0.044715f * x * x * x); return x * pg8::fast_sigmoid(y); }
__device__ __forceinline__ float silu_f(float x) { return x * pg8::fast_sigmoid(x); }
__device__ __forceinline__ void compress_unit(LAS3 char* lds, const bf16_t* __restrict__ proj, const float* __restrict__ pe, const bf16_t* __restrict__ w1t, const bf16_t* __restrict__ w2t,
                                              bf16_t* __restrict__ outc, int u, int which) {
    int tid_o = threadIdx.x; asm volatile("" : "+v"(tid_o));
    const int tid = tid_o, lane = tid & 63, wid = __builtin_amdgcn_readfirstlane(tid >> 6), r32 = lane & 31, hi = lane >> 5;
    const int i = 8 * u + (r32 >> 2), g = r32 & 3;
    f32x16 acc[4];
#pragma unroll
    for (int nb = 0; nb < 4; ++nb) acc[nb] = f32x16{};
    const bf16_t* abase = proj + C_KV + which * 512 + g * HD + hi * 8;
    const bf16_t* bbase = w1t + (size_t)(wid * 32) * 2048 + lane * 8;
#pragma unroll 1
    for (int lt = 0; lt < 4; ++lt) {
        const int l = wid * 4 + lt; int tokn = 16 * i + l; tokn = tokn < T ? tokn : T - 1;
        const bf16_t* ap = abase + (size_t)tokn * NP; const float* pp = pe + l * HD + hi * 8;
#pragma unroll
        for (int hf = 0; hf < 2; ++hf) {
            u32x4 araw[4]; f32x4 e0[4], e1[4]; bf16x8 bfr[4][4];
#pragma unroll
            for (int k = 0; k < 4; ++k) { const int k8 = hf * 4 + k; araw[k] = *(const u32x4*)(ap + k8 * 16); e0[k] = *(const f32x4*)(pp + k8 * 16); e1[k] = *(const f32x4*)(pp + k8 * 16 + 4);
#pragma unroll
                for (int nb = 0; nb < 4; ++nb) bfr[k][nb] = *(const bf16x8*)(bbase + (size_t)((lt * 8 + k8) * 4 + nb) * 512); }
            __builtin_amdgcn_sched_barrier(0);
#pragma unroll
            for (int k = 0; k < 4; ++k) { const u32x4 raw = araw[k];
                u32x4 aw; aw.x = pk2(pg8::bf_lo(raw.x) + e0[k][0], pg8::bf_hi(raw.x) + e0[k][1]); aw.y = pk2(pg8::bf_lo(raw.y) + e0[k][2], pg8::bf_hi(raw.y) + e0[k][3]);
                aw.z = pk2(pg8::bf_lo(raw.z) + e1[k][0], pg8::bf_hi(raw.z) + e1[k][1]); aw.w = pk2(pg8::bf_lo(raw.w) + e1[k][2], pg8::bf_hi(raw.w) + e1[k][3]);
                const bf16x8 a = *reinterpret_cast<const bf16x8*>(&aw);
#pragma unroll
                for (int nb = 0; nb < 4; ++nb) acc[nb] = __builtin_amdgcn_mfma_f32_32x32x16_bf16(a, bfr[k][nb], acc[nb], 0, 0, 0); }
            __builtin_amdgcn_sched_barrier(0);
        }
    }
    LAS3 float* part = (LAS3 float*)lds + wid * 4096;
#pragma unroll
    for (int nb = 0; nb < 4; ++nb)
#pragma unroll
        for (int r = 0; r < 16; ++r) part[att::crow(r, hi) * 128 + nb * 32 + r32] = acc[nb][r];
    __syncthreads();
    f32x4 s0 = {0.f, 0.f, 0.f, 0.f}, s1 = {0.f, 0.f, 0.f, 0.f};
#pragma unroll
    for (int w = 0; w < 8; ++w) { const LAS3 f32x4* p = (const LAS3 f32x4*)((LAS3 float*)lds + w * 4096 + tid * 8); s0 += p[0]; s1 += p[1]; }
    __syncthreads();
    {
        u32x4 hw; hw.x = pk2(silu_f(s0[0]), silu_f(s0[1])); hw.y = pk2(silu_f(s0[2]), silu_f(s0[3])); hw.z = pk2(silu_f(s1[0]), silu_f(s1[1])); hw.w = pk2(silu_f(s1[2]), silu_f(s1[3]));
        const int row = tid >> 4, col = (tid & 15) * 8;
        *(LAS3 u32x4*)(lds + (row * 136 + col) * 2) = hw;
    }
    __syncthreads();
    if (wid < 4) {
        f32x16 o2 = f32x16{};
#pragma unroll
        for (int ks = 0; ks < 8; ++ks) { const bf16x8 a = *(const LAS3 bf16x8*)(lds + (r32 * 136 + ks * 16 + hi * 8) * 2);
            const bf16x8 b = *(const bf16x8*)(w2t + (size_t)(wid * 32 + r32) * HD + ks * 16 + hi * 8);
            o2 = __builtin_amdgcn_mfma_f32_32x32x16_bf16(a, b, o2, 0, 0, 0); }
#pragma unroll
        for (int r = 0; r < 16; ++r) { const int row = att::crow(r, hi); const int ii = 8 * u + (row >> 2), gg = row & 3;
            const float v = ii < NCMP ? o2[r] : 0.f; const float vn = __shfl_xor(v, 1);
            if ((r32 & 1) == 0) *(unsigned*)(outc + (size_t)(ii * 4 + gg) * HD + wid * 32 + r32) = pk2(v, vn); }
    }
    __syncthreads();
}
__device__ __forceinline__ void gmlp_unit(LAS3 char* lds, const bf16_t* __restrict__ proj, const float* __restrict__ sspart, const float* __restrict__ gain, const float* __restrict__ sw, const float* __restrict__ sb,
                                          bf16_t* __restrict__ ob, int ch, int qd) {
    int tid_o = threadIdx.x; asm volatile("" : "+v"(tid_o));
    const int tid = tid_o, lane = tid & 63, wid = __builtin_amdgcn_readfirstlane(tid >> 6), r32 = lane & 31, hi = lane >> 5;
    const int tc0 = ch * 128;
    LAS3 float* rsl = (LAS3 float*)(lds + LDS_RS);
    {   const int vkk = ((tid >> 7) * 8) + ((tid & 31) >> 2), vkey = (vkk & ~0xC) | ((vkk & 4) << 1) | ((vkk & 8) >> 1), vcol = ((tid >> 5) & 3) * 32 + (tid & 3) * 8;
        const unsigned vo0 = (unsigned)(vkey * NP + vcol) * 2u; const unsigned half_step = (unsigned)(32 * NP) * 2u;
#pragma unroll
        for (int gg = 0; gg < 4; ++gg)
#pragma unroll
            for (int kt = 0; kt < 2; ++kt) { const char* vp_ = (const char*)(proj + (size_t)(tc0 + kt * 64) * NP + C_VB + (qd * 4 + gg) * 128); LAS3 char* vd_ = lds + (gg * 2 + kt) * att::SHM + wid * 1024;
                __builtin_amdgcn_global_load_lds((const unsigned*)(vp_ + vo0), (LAS3 unsigned*)vd_, 16, 0, 0);
                __builtin_amdgcn_global_load_lds((const unsigned*)((vp_ + half_step) + vo0), (LAS3 unsigned*)(vd_ + 8192), 16, 0, 0); } }
    if (tid < 128) { const f32x4* sp = (const f32x4*)(sspart + (size_t)(tc0 + tid) * 32); f32x4 s = sp[0];
#pragma unroll
        for (int i = 1; i < 8; ++i) s += sp[i];
        rsl[tid] = 1.0f / sqrtf(((s[0] + s[1]) + (s[2] + s[3])) * (1.0f / BW) + NORM_EPS); }
    VM_WAIT();
    __syncthreads();
    const int gg = wid >> 1, wd = wid & 1, G = qd * 4 + gg, cb = G * 128;
    const int vb1 = (int)(uintptr_t)(lds) + gg * 2 * att::SHM + att::v_rd_base(lane) + wd * 1024;
    f32x4 gn[2][4];
#pragma unroll
    for (int dd = 0; dd < 2; ++dd)
#pragma unroll
        for (int m = 0; m < 4; ++m) gn[dd][m] = *(const f32x4*)(gain + cb + (wd * 2 + dd) * 32 + 8 * m + 4 * hi);
#pragma unroll 1
    for (int pb = 0; pb < 4; ++pb) {
        const int p = pb * 32 + r32; const size_t tok = (size_t)(tc0 + p); const int nks = 2 * pb + 2;
        f32x4 wr0[8], wr1[8]; u32x2 uu[2][4], zz[2][4];
        const float* wrow = sw + ((size_t)G * 128 + p) * 128 + hi * 8;
#pragma unroll
        for (int ks = 0; ks < 8; ++ks) if (ks < nks) { wr0[ks] = *(const f32x4*)(wrow + ks * 16); wr1[ks] = *(const f32x4*)(wrow + ks * 16 + 4); }
        const char* ubase = (const char*)(proj + tok * NP + C_UB + cb); const char* zbase = (const char*)(proj + tok * NP + C_ZB + cb); char* obase = (char*)(ob + tok * BW + cb);
#pragma unroll
        for (int dd = 0; dd < 2; ++dd)
#pragma unroll
            for (int m = 0; m < 4; ++m) { const int d0 = (wd * 2 + dd) * 32 + 8 * m + 4 * hi; uu[dd][m] = *(const u32x2*)(ubase + d0 * 2); zz[dd][m] = *(const u32x2*)(zbase + d0 * 2); }
        const float bs = sb[G * 128 + p];
        __builtin_amdgcn_sched_barrier(0);
        bf16x8 af[8];
#pragma unroll
        for (int ks = 0; ks < 8; ++ks) { if (ks < nks) { const f32x4 a0 = wr0[ks], a1 = wr1[ks]; const int q0 = ks * 16 + hi * 8;
                const f32x4 r0 = *(const LAS3 f32x4*)(rsl + q0), r1 = *(const LAS3 f32x4*)(rsl + q0 + 4);
                u32x4 w; w.x = pk2(q0 + 0 <= p ? a0[0] * r0[0] : 0.f, q0 + 1 <= p ? a0[1] * r0[1] : 0.f); w.y = pk2(q0 + 2 <= p ? a0[2] * r0[2] : 0.f, q0 + 3 <= p ? a0[3] * r0[3] : 0.f);
                w.z = pk2(q0 + 4 <= p ? a1[0] * r1[0] : 0.f, q0 + 5 <= p ? a1[1] * r1[1] : 0.f); w.w = pk2(q0 + 6 <= p ? a1[2] * r1[2] : 0.f, q0 + 7 <= p ? a1[3] * r1[3] : 0.f);
                af[ks] = *reinterpret_cast<const bf16x8*>(&w); } else af[ks] = bf16x8{}; }
        f32x16 acc[2] = {f32x16{}, f32x16{}};
#define TRRD(dst, off) asm volatile("ds_read_b64_tr_b16 %0, %1 offset:%2" : "=&v"(dst) : "v"(vb1), "i"(off) : "memory")
#define GM_STEP(ks) do { if ((ks) < nks) { s16x4 l0, h0, l1, h1; constexpr int o_ = ((ks) >> 2) * att::SHM + att::v_rd_off(0, (ks) & 3, 0); \
            TRRD(l0, o_); TRRD(h0, o_ + 2048); TRRD(l1, o_ + 512); TRRD(h1, o_ + 512 + 2048); \
            asm volatile("s_waitcnt lgkmcnt(0)" ::: "memory"); __builtin_amdgcn_sched_barrier(0); \
            acc[0] = __builtin_amdgcn_mfma_f32_32x32x16_bf16((bf16x8){l0[0], l0[1], l0[2], l0[3], h0[0], h0[1], h0[2], h0[3]}, af[ks], acc[0], 0, 0, 0); \
            acc[1] = __builtin_amdgcn_mfma_f32_32x32x16_bf16((bf16x8){l1[0], l1[1], l1[2], l1[3], h1[0], h1[1], h1[2], h1[3]}, af[ks], acc[1], 0, 0, 0); } } while (0)
        GM_STEP(0); GM_STEP(1); GM_STEP(2); GM_STEP(3); GM_STEP(4); GM_STEP(5); GM_STEP(6); GM_STEP(7);
#undef GM_STEP
#undef TRRD
#pragma unroll
        for (int dd = 0; dd < 2; ++dd)
#pragma unroll
            for (int m = 0; m < 4; ++m) { const int d0 = (wd * 2 + dd) * 32 + 8 * m + 4 * hi; const u32x2 u2 = uu[dd][m], z2 = zz[dd][m]; const f32x4 g4 = gn[dd][m];
                const float o0 = gelu_tanh(pg8::bf_lo(u2.x)) * (acc[dd][4 * m + 0] * g4[0] + bs) * silu_f(pg8::bf_lo(z2.x));
                const float o1 = gelu_tanh(pg8::bf_hi(u2.x)) * (acc[dd][4 * m + 1] * g4[1] + bs) * silu_f(pg8::bf_hi(z2.x));
                const float o2 = gelu_tanh(pg8::bf_lo(u2.y)) * (acc[dd][4 * m + 2] * g4[2] + bs) * silu_f(pg8::bf_lo(z2.y));
                const float o3 = gelu_tanh(pg8::bf_hi(u2.y)) * (acc[dd][4 * m + 3] * g4[3] + bs) * silu_f(pg8::bf_hi(z2.y));
                u32x2 w; w.x = pk2(o0, o1); w.y = pk2(o2, o3); *(u32x2*)(obase + d0 * 2) = w; }
    }
    __syncthreads();
}
#ifndef N_LAUNCH_MODE
#define N_LAUNCH_MODE 1
#endif
constexpr int NPHASES = 1 + 6 * DEPTH;
#ifndef PHMASK
#define PHMASK 0x7f
#endif
#ifndef REPMASK
#define REPMASK 0
#endif
#define REPS(bit) ((REPMASK & (bit)) ? 2 : 1)
__global__ void __launch_bounds__(NTHREADS, 2) fwd_kernel(Params P) {
    extern __shared__ __attribute__((aligned(16))) unsigned char lds_raw[];
    LAS3 unsigned char* lds = (LAS3 unsigned char*)lds_raw;
    const int tid = threadIdx.x, lane = tid & 63, wave = __builtin_amdgcn_readfirstlane(tid >> 6);
    const int G = gridDim.x; const int bx = blockIdx.x; const int vcu = (G % 8 == 0) ? (bx % 8) * (G / 8) + bx / 8 : bx;
    const int gw = vcu * NWAVES + wave, NGW = G * NWAVES;
    unsigned char* ws = P.ws;
    if (tid < 16) ((LAS3 unsigned*)(lds + LDS_MISC))[tid] = 0u;
    __syncthreads();
    XcdBarrier bar; bar.bar = (unsigned*)(ws + WS_CTL); bar.x = 0; bar.st = nullptr;
    if (N_LAUNCH_MODE == 1) bar = xcd_barrier_post((unsigned*)(ws + WS_CTL), (volatile LAS unsigned*)(lds + LDS_MISC));
    const int lo = P.ph_lo, hi = P.ph_hi;
#define IN(k) (lo <= (k) && (k) < hi)
#define SEAM(k) do { if (IN(k) && IN((k) + 1)) xcd_barrier(bar); } while (0)
    bf16_t* hbuf = (bf16_t*)(ws + WS_H); bf16_t* proj = (bf16_t*)(ws + WS_PROJ); bf16_t* kc = (bf16_t*)(ws + WS_KC); bf16_t* vc = (bf16_t*)(ws + WS_VC);
    bf16_t* oa = (bf16_t*)(ws + WS_OA); bf16_t* ob = (bf16_t*)(ws + WS_OB); bf16_t* t1 = (bf16_t*)(ws + WS_T1); bf16_t* mg = (bf16_t*)(ws + WS_MG);
    bf16_t* Y = (bf16_t*)(ws + WS_Y); float* x1 = (float*)(ws + WS_X1);
    if (IN(0) && (PHMASK & 1)) {
        for (int rep = 0; rep < REPS(1); ++rep) phase_weights(P, lds, gw, NGW, wave, lane);
        for (int rep = 0; rep < REPS(128); ++rep) phase_prenorm(P.x, P.pre_norm, hbuf, gw, NGW, lane);
    }
    __syncthreads();
    for (int i = tid; i < 16 * 256; i += NTHREADS) { const int hd = i >> 8; int d = (i & 255) - 64; d = d < 0 ? 0 : (d > 127 ? 127 : d); ((LAS3 float*)(lds + LDS_BIAS))[i] = P.rel_bias[BUCKET[d] * 16 + hd] * att::LOG2E; }
    __syncthreads();
    SEAM(0);
#pragma unroll 1
    for (int L = 0; L < DEPTH; ++L) {
        const int pb = 1 + 6 * L;
        if (IN(pb) && (PHMASK & 2)) for (int rep = 0; rep < REPS(2); ++rep) {
            pg8::Gemm g{hbuf, (const bf16_t*)(ws + WS_WIN + L * SZ_WIN), T, NP, DM, nullptr, nullptr}; pg8::StaticOrder S; S.init(T, NP, G, bx);
            pg8::EpiProj E{proj, NP, (float*)(ws + WS_SS)};
            pg8::gemm_phase<pg8::EpiProj, pg8::StaticOrder>(lds + LDS_STAGE, g, S, E, nullptr);
        }
        SEAM(pb);
        if (IN(pb + 1) && (PHMASK & 4)) for (int rep = 0; rep < REPS(4) + ((REPMASK & 768) ? 1 : 0); ++rep) {
#pragma unroll 1
            for (int item = vcu; item < 384; item += G) {
                if (item < 256) { if (rep > 0 && (REPMASK & 512)) continue;
                    gmlp_unit((LAS3 char*)lds, proj, (const float*)(ws + WS_SS), P.sgu_norm + L * BW, P.sgu_w + (size_t)L * 16 * 128 * 128, P.sgu_b + L * 16 * 128, ob, item >> 2, item & 3); }
                else { if (rep > 0 && (REPMASK & 256)) continue;
                    const int ci = item - 256, which = ci & 1, u = ci >> 1;
                    compress_unit((LAS3 char*)lds, proj, (which ? P.pe_v : P.pe_k) + L * 32 * HD, (const bf16_t*)(ws + WS_W1 + (L * 2 + which) * SZ_W1), (const bf16_t*)(ws + WS_W2 + (L * 2 + which) * SZ_W2), which ? vc : kc, u, which); }
            }
        }
        SEAM(pb + 1);
        if (IN(pb + 2) && (PHMASK & 8)) for (int rep = 0; rep < REPS(8); ++rep) att::phase_attn((LAS3 char*)lds, proj, kc, vc, oa, vcu, G);
        SEAM(pb + 2);
        if (IN(pb + 3) && (PHMASK & 16)) for (int rep = 0; rep < REPS(16); ++rep) {
            pg8::DualOrder S; S.init(T, DM, G, bx);
            pg8::Gemm g{oa, (const bf16_t*)(ws + WS_WA + L * SZ_WAB), T, DM, AW, ob, (const bf16_t*)(ws + WS_WB + L * SZ_WAB)};
            pg8::EpiMerge E{mg, DM, proj + C_MA, proj + C_MB, NP};
            pg8::gemm_phase<pg8::EpiMerge, pg8::DualOrder>(lds + LDS_STAGE, g, S, E, nullptr);
        }
        SEAM(pb + 3);
        if (IN(pb + 4) && (PHMASK & 32)) for (int rep = 0; rep < REPS(32); ++rep) {
            pg8::Gemm g{mg, (const bf16_t*)(ws + WS_WO + L * SZ_WO), T, DM, DM, nullptr, nullptr}; pg8::StaticOrder S; S.init(T, DM, G, bx);
            pg8::EpiBf16Plain E{Y, DM};
            pg8::gemm_phase<pg8::EpiBf16Plain, pg8::StaticOrder>(lds + LDS_STAGE, g, S, E, nullptr);
        }
        SEAM(pb + 4);
        if (IN(pb + 5) && (PHMASK & 64)) for (int rep = 0; rep < REPS(64); ++rep) {
            const bool last = (L == DEPTH - 1);
            phase_postnorm(Y, L == 0 ? P.x : x1, P.post_norm + L * DM, last ? P.out : x1, P.pre_norm + (last ? 0 : (L + 1)) * DM, hbuf, !last, gw, NGW, lane);
        }
        SEAM(pb + 5);
    }
#undef IN
#undef SEAM
}
extern "C" void kernel_launch(void* const* d_in, const int* in_sizes, int n_in, void* d_out, int out_size, void* d_ws, size_t ws_size, hipStream_t stream) {
    static int grid = 0;
    if (grid == 0) {
        if (n_in != 17 || in_sizes[0] != T * DM || out_size != T * DM || ws_size < WS_END) { fprintf(stderr, "kernel_launch: unexpected shapes (n_in %d, in0 %d, out %d, ws %zu < %zu)\n", n_in, n_in > 0 ? in_sizes[0] : -1, out_size, ws_size, (size_t)WS_END); grid = -1; return; }
        int dev = 0, cus = 0, per_cu = 0;
        if (hipGetDevice(&dev) != hipSuccess || hipDeviceGetAttribute(&cus, hipDeviceAttributeMultiprocessorCount, dev) != hipSuccess) { grid = -1; return; }
        if (hipFuncSetAttribute((const void*)fwd_kernel, hipFuncAttributeMaxDynamicSharedMemorySize, LDS_BYTES) != hipSuccess) { fprintf(stderr, "kernel_launch: hipFuncSetAttribute failed\n"); grid = -1; return; }
        if (hipOccupancyMaxActiveBlocksPerMultiprocessor(&per_cu, (const void*)fwd_kernel, NTHREADS, LDS_BYTES) != hipSuccess || per_cu < 1) { fprintf(stderr, "kernel_launch: occupancy query says %d blocks per CU\n", per_cu); (void)hipGetLastError(); grid = -1; return; }
        grid = cus;
    }
    if (grid < 0) return;
    (void)hipMemsetAsync((char*)d_ws + WS_CTL, 0, CTL_BYTES, stream);
    Params p{};
    p.x = (const float*)d_in[0]; p.rel_bias = (const float*)d_in[1]; p.pre_norm = (const float*)d_in[2]; p.w_in = (const float*)d_in[3];
    p.pe_k = (const float*)d_in[4]; p.w1_k = (const float*)d_in[5]; p.w2_k = (const float*)d_in[6]; p.pe_v = (const float*)d_in[7]; p.w1_v = (const float*)d_in[8]; p.w2_v = (const float*)d_in[9];
    p.w_out_a = (const float*)d_in[10]; p.sgu_norm = (const float*)d_in[11]; p.sgu_w = (const float*)d_in[12]; p.sgu_b = (const float*)d_in[13]; p.w_out_b = (const float*)d_in[14]; p.w_out = (const float*)d_in[15]; p.post_norm = (const float*)d_in[16];
    p.out = (float*)d_out; p.ws = (unsigned char*)d_ws;
#if N_LAUNCH_MODE == 1
    p.ph_lo = 0; p.ph_hi = NPHASES;
    hipLaunchKernelGGL(fwd_kernel, dim3(grid), dim3(NTHREADS), LDS_BYTES, stream, p);
#else
    for (int k = 0; k < NPHASES; ++k) { p.ph_lo = k; p.ph_hi = k + 1; hipLaunchKernelGGL(fwd_kernel, dim3(grid), dim3(NTHREADS), LDS_BYTES, stream, p); }
#endif
}
```

```cpp
#include <hip/hip_runtime.h>
#include <cstdio>
#include <cstdint>
namespace pg8 {
#define PG8_LAS __attribute__((address_space(3)))
typedef unsigned short bf16_t;
typedef short bf16x8 __attribute__((ext_vector_type(8)));
typedef float f32x4 __attribute__((ext_vector_type(4)));
typedef unsigned u32x4 __attribute__((ext_vector_type(4)));
constexpr int BM = 256, BK = 64, HALF = 128, HTB = HALF * BK * 2  , STAGE_BYTES = 8 * HTB, NXCD = 8, WGM = 8;

__host__ __device__ __forceinline__ int lds_byte(int r, int c) { const int st = (r >> 4) * 2 + (c >> 5), rr = r & 15, cc = c & 31, ob = rr * 64 + cc * 2; return st * 1024 + (ob ^ (((ob >> 9) & 1) << 5)); }
__host__ __device__ __forceinline__ void stage_rc(int b, int& R, int& C) { const int st = b / 1024, sb = b % 1024, swz = sb ^ (((sb >> 9) & 1) << 5); R = (st >> 1) * 16 + swz / 64; C = (st & 1) * 32 + (swz % 64) / 2; }
__host__ __device__ __forceinline__ int perm32(int rho) { const int n = rho >> 4, i = rho & 15; return 8 * (i >> 2) + 4 * n + (i & 3); }

struct Unit { int pm, pn, sub; };
struct Gemm { const bf16_t* A; const bf16_t* Bt; int M, N, K; const bf16_t* A2; const bf16_t* Bt2; };

struct StaticOrder {
    int nM, nN, nwg, G, c;
    __host__ __device__ void init(int M, int N, int G_, int c_) { nM = M / BM; nN = N / BM; nwg = nM * nN; G = G_; c = c_; }
    __host__ __device__ bool next(int i, Unit& u) const {
        const long L = (long)i * G + c; if (L >= nwg) return false;
        int wgid = (int)L; { const int q = nwg / NXCD, r = nwg % NXCD, xcd = wgid % NXCD, off = wgid / NXCD; wgid = (xcd < r ? xcd * (q + 1) : r * (q + 1) + (xcd - r) * q) + off; }
        const int nig = WGM * nN, gid = wgid / nig, fm = gid * WGM, gsz = (nM - fm) < WGM ? (nM - fm) : WGM;
        u.pm = fm + ((wgid % nig) % gsz); u.pn = (wgid % nig) / gsz; u.sub = 0; return true;
    }
    __device__ __forceinline__ void a_ready(const Unit&) const {}
    __device__ __forceinline__ void done(const Unit&) const {}
    static constexpr bool DUAL = false;
    __device__ __forceinline__ const bf16_t* baseA(const Gemm& g, const Unit&) const { return g.A; }
    __device__ __forceinline__ const bf16_t* baseB(const Gemm& g, const Unit&) const { return g.Bt; }
};
struct DualOrder : StaticOrder {
    static constexpr bool DUAL = true;
    __host__ __device__ bool next(int i, Unit& u) const { const bool ok = StaticOrder::next(i >> 1, u); u.sub = i & 1; return ok; }
    __device__ __forceinline__ const bf16_t* baseA(const Gemm& g, const Unit& u) const { return u.sub ? g.A2 : g.A; }
    __device__ __forceinline__ const bf16_t* baseB(const Gemm& g, const Unit& u) const { return u.sub ? g.Bt2 : g.Bt; }
};
typedef __bf16 bf16x2_t __attribute__((ext_vector_type(2)));
typedef float f32x2_t __attribute__((ext_vector_type(2)));
__device__ __forceinline__ unsigned cvt_pk_bf16(float lo, float hi) { const f32x2_t v = {lo, hi}; const bf16x2_t b = __builtin_convertvector(v, bf16x2_t); return __builtin_bit_cast(unsigned, b); }
typedef float f32x2 __attribute__((ext_vector_type(2)));
__device__ __forceinline__ float bf_lo(unsigned u) { return __uint_as_float(u << 16); }
__device__ __forceinline__ float bf_hi(unsigned u) { return __uint_as_float(u & 0xffff0000u); }
__device__ __forceinline__ float fast_sigmoid(float x) { return __builtin_amdgcn_rcpf(1.0f + __builtin_amdgcn_exp2f(-1.4426950408889634f * x)); }
struct EpiBf16Plain {
    static constexpr bool PERM = true, AFTER_DRAIN = false;
    bf16_t* O; int ldc;
    __device__ __forceinline__ void operator()(const f32x4 (&acc)[2][2][4][2], const Unit& u, int wr, int wc, int fr, int fq) const {
        const int row0 = u.pm * BM + wr * 64 + fr, col0 = u.pn * BM + wc * 32 + 8 * fq;
#pragma unroll
        for (int ai = 0; ai < 2; ++ai)
#pragma unroll
            for (int m = 0; m < 4; ++m) { bf16_t* rowp = O + (size_t)(row0 + ai * HALF + m * 16) * ldc + col0;
#pragma unroll
                for (int bj = 0; bj < 2; ++bj) { const f32x4 v0 = acc[ai][bj][m][0], v1 = acc[ai][bj][m][1];
                    u32x4 w; w.x = cvt_pk_bf16(v0[0], v0[1]); w.y = cvt_pk_bf16(v0[2], v0[3]); w.z = cvt_pk_bf16(v1[0], v1[1]); w.w = cvt_pk_bf16(v1[2], v1[3]);
                    *(u32x4*)(rowp + bj * HALF) = w; } }
    }
};
__device__ __forceinline__ float gelu_tanh_f(float x) { const float y = 1.5957691216057308f * (x + 0.044715f * x * x * x); return x * fast_sigmoid(y); }
struct EpiProj {
    static constexpr bool PERM = true, AFTER_DRAIN = false;
    static constexpr int PN_V0 = 36;
    bf16_t* O; int ldc; float* sspart;
    __device__ __forceinline__ void operator()(const f32x4 (&acc)[2][2][4][2], const Unit& u, int wr, int wc, int fr, int fq) const {
        const int row0 = u.pm * BM + wr * 64 + fr, col0 = u.pn * BM + wc * 32 + 8 * fq;
        const bool vtile = (u.pn >= PN_V0) && (u.pn < PN_V0 + 8);
        if (!vtile) {
#pragma unroll
            for (int ai = 0; ai < 2; ++ai)
#pragma unroll
                for (int m = 0; m < 4; ++m) { bf16_t* rowp = O + (size_t)(row0 + ai * HALF + m * 16) * ldc + col0;
#pragma unroll
                    for (int bj = 0; bj < 2; ++bj) { const f32x4 v0 = acc[ai][bj][m][0], v1 = acc[ai][bj][m][1];
                        u32x4 w; w.x = cvt_pk_bf16(v0[0], v0[1]); w.y = cvt_pk_bf16(v0[2], v0[3]); w.z = cvt_pk_bf16(v1[0], v1[1]); w.w = cvt_pk_bf16(v1[2], v1[3]);
                        *(u32x4*)(rowp + bj * HALF) = w; } }
        } else {
#pragma unroll
            for (int ai = 0; ai < 2; ++ai)
#pragma unroll
                for (int m = 0; m < 4; ++m) { const int row = row0 + ai * HALF + m * 16; bf16_t* rowp = O + (size_t)row * ldc + col0; float ss = 0.f;
#pragma unroll
                    for (int bj = 0; bj < 2; ++bj) { f32x4 v0 = acc[ai][bj][m][0], v1 = acc[ai][bj][m][1];
#pragma unroll
                        for (int e = 0; e < 4; ++e) { v0[e] = gelu_tanh_f(v0[e]); v1[e] = gelu_tanh_f(v1[e]); ss += v0[e] * v0[e] + v1[e] * v1[e]; }
                        u32x4 w; w.x = cvt_pk_bf16(v0[0], v0[1]); w.y = cvt_pk_bf16(v0[2], v0[3]); w.z = cvt_pk_bf16(v1[0], v1[1]); w.w = cvt_pk_bf16(v1[2], v1[3]);
                        *(u32x4*)(rowp + bj * HALF) = w; }
                    ss += __shfl_xor(ss, 16); ss += __shfl_xor(ss, 32);
                    if (fq == 0) sspart[(size_t)row * 32 + (u.pn - PN_V0) * 4 + wc] = ss; }
        }
    }
};
template <bool ADD> struct EpiGate {
    static constexpr bool PERM = true, AFTER_DRAIN = false;
    bf16_t* O; int ldc; const bf16_t* Mg; int ldm; const bf16_t* Prev;
    __device__ __forceinline__ void operator()(const f32x4 (&acc)[2][2][4][2], const Unit& u, int wr, int wc, int fr, int fq) const {
        const int row0 = u.pm * BM + wr * 64 + fr, col0 = u.pn * BM + wc * 32 + 8 * fq;
#pragma unroll
        for (int ai = 0; ai < 2; ++ai)
#pragma unroll
            for (int m = 0; m < 4; ++m) { const size_t row = (size_t)(row0 + ai * HALF + m * 16);
#pragma unroll
                for (int bj = 0; bj < 2; ++bj) { const f32x4 v0 = acc[ai][bj][m][0], v1 = acc[ai][bj][m][1];
                    const u32x4 mg = *(const u32x4*)(Mg + row * ldm + col0 + bj * HALF);
                    float r[8];
                    r[0] = v0[0] * fast_sigmoid(bf_lo(mg.x)); r[1] = v0[1] * fast_sigmoid(bf_hi(mg.x)); r[2] = v0[2] * fast_sigmoid(bf_lo(mg.y)); r[3] = v0[3] * fast_sigmoid(bf_hi(mg.y));
                    r[4] = v1[0] * fast_sigmoid(bf_lo(mg.z)); r[5] = v1[1] * fast_sigmoid(bf_hi(mg.z)); r[6] = v1[2] * fast_sigmoid(bf_lo(mg.w)); r[7] = v1[3] * fast_sigmoid(bf_hi(mg.w));
                    if (ADD) { const u32x4 pv = *(const u32x4*)(Prev + row * ldc + col0 + bj * HALF);
                        r[0] += bf_lo(pv.x); r[1] += bf_hi(pv.x); r[2] += bf_lo(pv.y); r[3] += bf_hi(pv.y); r[4] += bf_lo(pv.z); r[5] += bf_hi(pv.z); r[6] += bf_lo(pv.w); r[7] += bf_hi(pv.w); }
                    u32x4 w; w.x = cvt_pk_bf16(r[0], r[1]); w.y = cvt_pk_bf16(r[2], r[3]); w.z = cvt_pk_bf16(r[4], r[5]); w.w = cvt_pk_bf16(r[6], r[7]);
                    *(u32x4*)(O + row * ldc + col0 + bj * HALF) = w; } }
    }
};
struct EpiMerge {
    static constexpr bool PERM = true, AFTER_DRAIN = false;
    bf16_t* O; int ldc; const bf16_t* Ma; const bf16_t* Mb; int ldm;
    __device__ __forceinline__ void mid(f32x4 (&acc)[2][2][4][2], const Unit& u, int wr, int wc, int fr, int fq) const {
        const int row0 = u.pm * BM + wr * 64 + fr, col0 = u.pn * BM + wc * 32 + 8 * fq;
#pragma unroll
        for (int ai = 0; ai < 2; ++ai)
#pragma unroll
            for (int m = 0; m < 4; ++m) { const size_t row = (size_t)(row0 + ai * HALF + m * 16);
#pragma unroll
                for (int bj = 0; bj < 2; ++bj) { const u32x4 a = *(const u32x4*)(Ma + row * ldm + col0 + bj * HALF), b = *(const u32x4*)(Mb + row * ldm + col0 + bj * HALF);
                    const unsigned aw[4] = {a.x, a.y, a.z, a.w}, bw[4] = {b.x, b.y, b.z, b.w};
#pragma unroll
                    for (int e = 0; e < 4; ++e) {
                        const float r0 = (1.0f + __builtin_amdgcn_exp2f(-1.4426950408889634f * bf_lo(bw[e]))) * __builtin_amdgcn_rcpf(1.0f + __builtin_amdgcn_exp2f(-1.4426950408889634f * bf_lo(aw[e])));
                        const float r1 = (1.0f + __builtin_amdgcn_exp2f(-1.4426950408889634f * bf_hi(bw[e]))) * __builtin_amdgcn_rcpf(1.0f + __builtin_amdgcn_exp2f(-1.4426950408889634f * bf_hi(aw[e])));
                        acc[ai][bj][m][e >> 1][(e & 1) * 2] *= r0; acc[ai][bj][m][e >> 1][(e & 1) * 2 + 1] *= r1; } } }
    }
    __device__ __forceinline__ void operator()(const f32x4 (&acc)[2][2][4][2], const Unit& u, int wr, int wc, int fr, int fq) const {
        const int row0 = u.pm * BM + wr * 64 + fr, col0 = u.pn * BM + wc * 32 + 8 * fq;
#pragma unroll
        for (int ai = 0; ai < 2; ++ai)
#pragma unroll
            for (int m = 0; m < 4; ++m) { const size_t row = (size_t)(row0 + ai * HALF + m * 16);
#pragma unroll
                for (int bj = 0; bj < 2; ++bj) { const f32x4 v0 = acc[ai][bj][m][0], v1 = acc[ai][bj][m][1];
                    const u32x4 mg = *(const u32x4*)(Mb + row * ldm + col0 + bj * HALF);
                    u32x4 w; w.x = cvt_pk_bf16(v0[0] * fast_sigmoid(bf_lo(mg.x)), v0[1] * fast_sigmoid(bf_hi(mg.x))); w.y = cvt_pk_bf16(v0[2] * fast_sigmoid(bf_lo(mg.y)), v0[3] * fast_sigmoid(bf_hi(mg.y)));
                    w.z = cvt_pk_bf16(v1[0] * fast_sigmoid(bf_lo(mg.z)), v1[1] * fast_sigmoid(bf_hi(mg.z))); w.w = cvt_pk_bf16(v1[2] * fast_sigmoid(bf_lo(mg.w)), v1[3] * fast_sigmoid(bf_hi(mg.w)));
                    *(u32x4*)(O + row * ldc + col0 + bj * HALF) = w; } }
    }
};
struct EpiF32Plain {
    static constexpr bool PERM = false, AFTER_DRAIN = false;
    float* C; int ldc;
    __device__ __forceinline__ void operator()(const f32x4 (&acc)[2][2][4][2], const Unit& u, int wr, int wc, int fr, int fq) const {
        const int row0 = u.pm * BM + wr * 64 + fr, col0 = u.pn * BM + wc * 32 + 4 * fq;
#pragma unroll
        for (int ai = 0; ai < 2; ++ai)
#pragma unroll
            for (int m = 0; m < 4; ++m) { float* rowp = C + (size_t)(row0 + ai * HALF + m * 16) * ldc + col0;
#pragma unroll
                for (int bj = 0; bj < 2; ++bj)
#pragma unroll
                    for (int n = 0; n < 2; ++n) *(f32x4*)(rowp + bj * HALF + n * 16) = acc[ai][bj][m][n]; }
    }
};
template <class Epi, class Sched, bool STAMP = false>
__device__ __forceinline__ void gemm_phase(PG8_LAS unsigned char* lds, const Gemm g, const Sched& S, const Epi& E, unsigned long long* stamps) {
    int tid_o = threadIdx.x; asm volatile("" : "+v"(tid_o));
    const int tid = tid_o, wid = __builtin_amdgcn_readfirstlane(tid >> 6), lane = tid & 63, wr = wid >> 2, wc = wid & 3, fr = lane & 15, fq = lane >> 4;
    const int K = g.K, nt = K / BK;
    int ts_lo = 0, ts_hi = 0, nts = 0; const unsigned long long rt_entry = STAMP ? (unsigned long long)wall_clock64() : 0ull;
#define PG8_STAMP() do { if (STAMP && wid == 0 && nts < 64) { const unsigned long long _c = (unsigned long long)clock64(); \
        ts_lo = (lane == nts) ? (int)(unsigned)_c : ts_lo; ts_hi = (lane == nts) ? (int)(unsigned)(_c >> 32) : ts_hi; ++nts; } } while (0)
    PG8_STAMP();
    unsigned voffA[2], voffB[2];
#pragma unroll
    for (int i = 0; i < 2; ++i) { int R, C; stage_rc(tid * 16 + i * 8192, R, C); const int Rb = Epi::PERM ? ((R & ~31) + perm32(R & 31)) : R;
        voffA[i] = (unsigned)(R * K + C) * 2u; voffB[i] = (unsigned)(Rb * K + C) * 2u; }
    const size_t kstep = (size_t)(BK * 2);
    const size_t hstep = (size_t)HALF * K * 2;
    const size_t tstep = 2 * hstep;
    const unsigned ldsw = (unsigned)wid * 1024u;
    const int aoff = lds_byte(wr * 64 + fr, fq * 8), boff = lds_byte(wc * 32 + fr, fq * 8);
#define PG8_SA(b, h) (((b) * 2 + (h)) * HTB)
#define PG8_SB(b, h) ((4 + (b) * 2 + (h)) * HTB)
#define PG8_STAGE(bufoff, gbase, voff) do { _Pragma("unroll") for (int _i = 0; _i < 2; ++_i) \
        __builtin_amdgcn_global_load_lds((const unsigned*)((const char*)(gbase) + (voff)[_i]), (PG8_LAS unsigned*)(lds + (bufoff) + ldsw + _i * 8192), 16, 0, 0); } while (0)
#define PG8_LDA(dst, b, h) do { _Pragma("unroll") for (int m = 0; m < 4; ++m) _Pragma("unroll") for (int k = 0; k < 2; ++k) dst[m][k] = *(const PG8_LAS bf16x8*)(lds + PG8_SA(b, h) + aoff + m * 2048 + k * 1024); } while (0)
#define PG8_LDB(dst, b, h) do { _Pragma("unroll") for (int n = 0; n < 2; ++n) _Pragma("unroll") for (int k = 0; k < 2; ++k) dst[n][k] = *(const PG8_LAS bf16x8*)(lds + PG8_SB(b, h) + boff + n * 2048 + k * 1024); } while (0)
#define PG8_MMA(ai, bj, At, Bt) do { __builtin_amdgcn_s_setprio(1); _Pragma("unroll") for (int m = 0; m < 4; ++m) _Pragma("unroll") for (int n = 0; n < 2; ++n) _Pragma("unroll") for (int k = 0; k < 2; ++k) \
        acc[ai][bj][m][n] = __builtin_amdgcn_mfma_f32_16x16x32_bf16(Bt[n][k], At[m][k], acc[ai][bj][m][n], 0, 0, 0); __builtin_amdgcn_s_setprio(0); } while (0)
#define PG8_WAIT_V(n) asm volatile("s_waitcnt vmcnt(" #n ")" ::: "memory")
#define PG8_WAIT_L(n) asm volatile("s_waitcnt lgkmcnt(" #n ")" ::: "memory")
#define PG8_BAR __builtin_amdgcn_s_barrier()
#define PG8_SCHED __builtin_amdgcn_sched_barrier(0)
    Unit cur, nxt; int ui = 0;
    if (!S.next(0, cur)) return;
    f32x4 acc[2][2][4][2];
#pragma unroll
    for (int a = 0; a < 2; ++a)
#pragma unroll
        for (int b = 0; b < 2; ++b)
#pragma unroll
            for (int m = 0; m < 4; ++m)
#pragma unroll
                for (int n = 0; n < 2; ++n) acc[a][b][m][n] = (f32x4){0.f, 0.f, 0.f, 0.f};
    bf16x8 At[4][2], B0[2][2], B1[2][2];
    const char* cA = (const char*)S.baseA(g, cur) + (size_t)cur.pm * tstep; const char* cB = (const char*)S.baseB(g, cur) + (size_t)cur.pn * tstep;
    S.a_ready(cur);
    PG8_STAGE(PG8_SB(0, 0), cB, voffB); PG8_STAGE(PG8_SA(0, 0), cA, voffA); PG8_STAGE(PG8_SB(0, 1), cB + hstep, voffB); PG8_STAGE(PG8_SA(0, 1), cA + hstep, voffA);
    if (wr == 1) PG8_BAR;
    PG8_WAIT_V(4); PG8_BAR;
    PG8_STAGE(PG8_SB(1, 0), cB + kstep, voffB); PG8_STAGE(PG8_SA(1, 0), cA + kstep, voffA); PG8_STAGE(PG8_SB(1, 1), cB + hstep + kstep, voffB);
    PG8_WAIT_V(6); PG8_BAR;
    PG8_STAMP();
    for (;;) {
        const bool has_next = S.next(ui + 1, nxt);
        const char* nA = has_next ? (const char*)S.baseA(g, nxt) + (size_t)nxt.pm * tstep : cA; const char* nB = has_next ? (const char*)S.baseB(g, nxt) + (size_t)nxt.pn * tstep : cB;
        for (int t = 0; t < nt; t += 2) {
            const bool last = (t == nt - 2);
            const char* a1 = cA + (size_t)(t + 1) * kstep;
            const char* a2 = last ? nA : cA + (size_t)(t + 2) * kstep; const char* b2 = last ? nB : cB + (size_t)(t + 2) * kstep;
            const char* a3 = a2 + kstep; const char* b3 = b2 + kstep;
            if (last && has_next) S.a_ready(nxt);
            PG8_LDB(B0, 0, 0); PG8_SCHED; PG8_LDA(At, 0, 0); PG8_STAGE(PG8_SA(1, 1), a1 + hstep, voffA);
            PG8_WAIT_L(8); PG8_BAR; PG8_WAIT_L(0); PG8_MMA(0, 0, At, B0); PG8_BAR; PG8_SCHED;
            PG8_LDB(B1, 0, 1); PG8_STAGE(PG8_SB(0, 0), b2, voffB);
            PG8_BAR; PG8_WAIT_L(0); PG8_MMA(0, 1, At, B1); PG8_BAR;
            PG8_LDA(At, 0, 1); PG8_STAGE(PG8_SA(0, 0), a2, voffA);
            PG8_BAR; PG8_WAIT_L(0); PG8_MMA(1, 0, At, B0); PG8_BAR; PG8_SCHED;
            PG8_STAGE(PG8_SB(0, 1), b2 + hstep, voffB);
            PG8_WAIT_V(6); PG8_BAR; PG8_MMA(1, 1, At, B1); PG8_BAR;
            PG8_LDB(B0, 1, 0); PG8_SCHED; PG8_LDA(At, 1, 0); PG8_STAGE(PG8_SA(0, 1), a2 + hstep, voffA);
            PG8_WAIT_L(8); PG8_BAR; PG8_WAIT_L(0); PG8_MMA(0, 0, At, B0); PG8_BAR; PG8_SCHED;
            PG8_LDB(B1, 1, 1); PG8_STAGE(PG8_SB(1, 0), b3, voffB);
            PG8_BAR; PG8_WAIT_L(0); PG8_MMA(0, 1, At, B1); PG8_BAR;
            PG8_LDA(At, 1, 1); PG8_STAGE(PG8_SA(1, 0), a3, voffA);
            PG8_BAR; PG8_WAIT_L(0); PG8_MMA(1, 0, At, B0); PG8_BAR; PG8_SCHED;
            PG8_STAGE(PG8_SB(1, 1), b3 + hstep, voffB);
            PG8_WAIT_V(6); PG8_BAR; PG8_MMA(1, 1, At, B1); PG8_BAR;
        }
        PG8_STAMP();
        bool keep_acc = false;
        if constexpr (Sched::DUAL) { if (cur.sub == 0) { E.mid(acc, cur, wr, wc, fr, fq); keep_acc = true; } else E(acc, cur, wr, wc, fr, fq); }
        else if constexpr (!Epi::AFTER_DRAIN) { E(acc, cur, wr, wc, fr, fq); S.done(cur); }
        PG8_STAMP();
        if (!has_next) break;
        if (!keep_acc)
#pragma unroll
        for (int a = 0; a < 2; ++a)
#pragma unroll
            for (int b = 0; b < 2; ++b)
#pragma unroll
                for (int m = 0; m < 4; ++m)
#pragma unroll
                    for (int n = 0; n < 2; ++n) acc[a][b][m][n] = (f32x4){0.f, 0.f, 0.f, 0.f};
        cur = nxt; cA = nA; cB = nB; ++ui;
    }
    PG8_WAIT_V(0);
    if (wr == 0) PG8_BAR;
    PG8_BAR;
    if constexpr (Epi::AFTER_DRAIN) { E.fused(acc, cur, wr, wc, fr, fq, lds, wid, lane); S.done(cur); }
    PG8_STAMP();
    if (STAMP && wid == 0) { stamps[lane] = lane < nts ? (((unsigned long long)(unsigned)ts_hi << 32) | (unsigned)ts_lo) : 0ull;
        if (lane == 62) stamps[62] = rt_entry; if (lane == 63) stamps[63] = (unsigned long long)wall_clock64(); }
#undef PG8_STAMP
#undef PG8_SA
#undef PG8_SB
#undef PG8_STAGE
#undef PG8_LDA
#undef PG8_LDB
#undef PG8_MMA
#undef PG8_WAIT_V
#undef PG8_WAIT_L
#undef PG8_BAR
#undef PG8_SCHED
}
}

#define XB_TMO      128
#define XB_XCNT(j)  (256  + 64 * (j))
#define XB_XSUB(j)  (1280 + 64 * (j))
#define XB_XGEN(j)  (2304 + 64 * (j))
#define XB_TOP      3328
#define XB_TOPGEN   3392
#define XCD_BAR_WORDS 3456
#define XB_SPIN_CAP (1u << 18)
#define LAS __attribute__((address_space(3)))

__device__ __forceinline__ unsigned xb_ld(unsigned* p)              { return __hip_atomic_load(p, __ATOMIC_RELAXED, __HIP_MEMORY_SCOPE_AGENT); }
__device__ __forceinline__ unsigned xb_add(unsigned* p, unsigned v) { return __hip_atomic_fetch_add(p, v, __ATOMIC_RELAXED, __HIP_MEMORY_SCOPE_AGENT); }
__device__ __forceinline__ unsigned xb_xcc_id() { return (unsigned)__builtin_amdgcn_s_getreg((3 << 11) | 20) & 0xFu; }
#define XB_SPIN(cond, bar) do { unsigned _sp = 0; while (cond) { __builtin_amdgcn_s_sleep(1); \
    if ((++_sp & 255u) == 0u) { if (xb_ld(&(bar)[XB_TMO])) break; if (_sp > XB_SPIN_CAP) { atomicAdd(&(bar)[XB_TMO], 1u); break; } } } } while (0)

struct XcdBarrier {
    unsigned* bar; unsigned x;
    volatile LAS unsigned* st;
};

__device__ __forceinline__ XcdBarrier xcd_barrier_post(unsigned* bar, volatile LAS unsigned* st) {
    XcdBarrier b; b.bar = bar; b.x = xb_xcc_id(); b.st = st;
    if (threadIdx.x == 0) (void)xb_add(&bar[XB_XCNT(b.x)], 1u);
    return b;
}
__device__ __forceinline__ void xcd_barrier_complete(unsigned* bar, unsigned x, unsigned& nloc, unsigned& nx) {
    const unsigned G = gridDim.x * gridDim.y * gridDim.z;
    unsigned sum, cnt, mine, sp = 0u;
    for (;;) {
        sum = 0u; cnt = 0u; mine = 0u;
#pragma unroll
        for (unsigned j = 0; j < 16; ++j) { const unsigned c = xb_ld(&bar[XB_XCNT(j)]); sum += c; cnt += (c > 0u) ? 1u : 0u; mine = (j == x) ? c : mine; }
        if (sum == G) break;
        __builtin_amdgcn_s_sleep(1);
        if ((++sp & 255u) == 0u) { if (xb_ld(&bar[XB_TMO])) break; if (sp > XB_SPIN_CAP) { atomicAdd(&bar[XB_TMO], 1u); break; } }
    }
    nloc = mine > 0u ? mine : 1u; nx = cnt > 0u ? cnt : 1u;
}

__device__ __forceinline__ void xcd_barrier(const XcdBarrier& b) {
    asm volatile("s_waitcnt vmcnt(0)" ::: "memory");
    __syncthreads();
    if (threadIdx.x == 0) {
        unsigned* bar = b.bar;
        __builtin_amdgcn_s_waitcnt(0);
        unsigned nloc = b.st[0], nx = b.st[1];
        if (nloc == 0u) { xcd_barrier_complete(bar, b.x, nloc, nx); b.st[0] = nloc; b.st[1] = nx; }
        const unsigned old = xb_add(&bar[XB_XSUB(b.x)], 1u);
        const unsigned gen = old / nloc;
        if (old + 1u == (gen + 1u) * nloc) {
            __builtin_amdgcn_fence(__ATOMIC_RELEASE, "agent");
            asm volatile("s_waitcnt vmcnt(0)" ::: "memory");
            const unsigned og = xb_add(&bar[XB_TOP], 1u);
            const unsigned tg = og / nx;
            if (og + 1u == (tg + 1u) * nx) xb_add(&bar[XB_TOPGEN], 1u);
            else XB_SPIN(xb_ld(&bar[XB_TOPGEN]) == tg, bar);
            __builtin_amdgcn_fence(__ATOMIC_ACQUIRE, "agent");
            xb_add(&bar[XB_XGEN(b.x)], 1u);
            asm volatile("s_waitcnt vmcnt(0)" ::: "memory");
        } else {
            XB_SPIN(xb_ld(&bar[XB_XGEN(b.x)]) == gen, bar);
            __builtin_amdgcn_fence(__ATOMIC_ACQUIRE, "agent");
            asm volatile("s_waitcnt vmcnt(0)" ::: "memory");
        }
    }
    __syncthreads();
}
typedef pg8::bf16_t bf16_t;
typedef short bf16x8 __attribute__((ext_vector_type(8)));
typedef short s16x4 __attribute__((ext_vector_type(4)));
typedef float f32x4 __attribute__((ext_vector_type(4)));
typedef float f32x16 __attribute__((ext_vector_type(16)));
typedef unsigned u32x4 __attribute__((ext_vector_type(4)));
typedef unsigned u32x2 __attribute__((ext_vector_type(2)));
constexpr int T = 8192, DM = 4096, NIN = 21552, NP = 21760, DEPTH = 2, NWAVES = 8, NTHREADS = 512;
constexpr int C_Q = 0, C_KV = 2048, C_ZA = 5120, C_UB = 7168, C_VB = 9216, C_ZB = 11264, C_MA = 13312, C_MB = 17408, C_GA = 21504;
constexpr int AW = 2048, BW = 2048, HD = 128, NCMP = 511, NCP = 512;
constexpr float NORM_EPS = 1e-6f;
constexpr size_t al256(size_t x) { return (x + 255) & ~(size_t)255; }
constexpr size_t WS_CTL = 0, CTL_BYTES = 1u << 20;
constexpr size_t SZ_WIN = (size_t)NP * DM * 2, SZ_WAB = (size_t)DM * AW * 2, SZ_WO = (size_t)DM * DM * 2, SZ_W1 = (size_t)HD * 4096 * 2, SZ_W2 = (size_t)HD * HD * 2;
constexpr size_t WS_WIN = WS_CTL + CTL_BYTES;
constexpr size_t WS_WA = WS_WIN + DEPTH * SZ_WIN;
constexpr size_t WS_WB = WS_WA + DEPTH * SZ_WAB;
constexpr size_t WS_WO = WS_WB + DEPTH * SZ_WAB;
constexpr size_t WS_W1 = WS_WO + DEPTH * SZ_WO;
constexpr size_t WS_W2 = WS_W1 + DEPTH * 2 * SZ_W1;
constexpr size_t WS_H = al256(WS_W2 + DEPTH * 2 * SZ_W2);
constexpr size_t WS_PROJ = WS_H + (size_t)T * DM * 2;
constexpr size_t WS_KC = WS_PROJ + (size_t)T * NP * 2;
constexpr size_t WS_VC = WS_KC + (size_t)NCP * 512 * 2;
constexpr size_t WS_OA = WS_VC + (size_t)NCP * 512 * 2;
constexpr size_t WS_OB = WS_OA + (size_t)T * AW * 2;
constexpr size_t WS_T1 = WS_OB + (size_t)T * BW * 2;
constexpr size_t WS_MG = WS_T1 + (size_t)T * DM * 2;
constexpr size_t WS_Y = WS_MG + (size_t)T * DM * 2;
constexpr size_t WS_X1 = WS_Y + (size_t)T * DM * 4;
constexpr size_t WS_SS = WS_X1 + (size_t)T * DM * 4;
constexpr size_t WS_PARK = WS_SS + (size_t)T * 32 * 4;
constexpr size_t WS_END = WS_PARK + (size_t)1024 * 32 * 512 * 16;
constexpr int LDS_STAGE = 0;
constexpr int LDS_BIAS = 131072;
constexpr int LDS_MISC = LDS_BIAS + 16 * 256 * 4;
constexpr int LDS_RS = LDS_MISC + 64;
constexpr int LDS_ATT = LDS_RS + 512;
constexpr int LDS_BYTES = LDS_ATT + 8192;
static_assert(LDS_BYTES <= 160 * 1024, "LDS");
#define LAS3 __attribute__((address_space(3)))
#define LDS_WAIT() asm volatile("s_waitcnt lgkmcnt(0)" ::: "memory")
#define VM_WAIT() asm volatile("s_waitcnt vmcnt(0)" ::: "memory")

struct Params {
    const float *x, *rel_bias, *pre_norm, *w_in, *pe_k, *w1_k, *w2_k, *pe_v, *w1_v, *w2_v, *w_out_a, *sgu_norm, *sgu_w, *sgu_b, *w_out_b, *w_out, *post_norm;
    float* out; unsigned char* ws; int ph_lo, ph_hi;
};
__device__ __forceinline__ unsigned pk2(float lo, float hi) { return pg8::cvt_pk_bf16(lo, hi); }
__device__ __forceinline__ float wave_sum(float v) {
#pragma unroll
    for (int o = 1; o < 64; o <<= 1) v += __shfl_xor(v, o);
    return v;
}
__device__ const unsigned char BUCKET[128] = {0, 1, 2, 3, 4, 5, 6, 7, 8, 9, 10, 11, 12, 13, 14, 15, 16, 16, 16, 17, 17, 18, 18, 18, 19, 19, 19, 20, 20, 20, 20, 21, 21, 21, 21, 22, 22, 22, 22, 22, 23, 23, 23, 23, 23, 23, 24, 24, 24, 24, 24, 24, 25, 25, 25, 25, 25, 25, 25, 26, 26, 26, 26, 26, 26, 26, 26, 27, 27, 27, 27, 27, 27, 27, 27, 27, 27, 28, 28, 28, 28, 28, 28, 28, 28, 28, 28, 29, 29, 29, 29, 29, 29, 29, 29, 29, 29, 29, 29, 30, 30, 30, 30, 30, 30, 30, 30, 30, 30, 30, 30, 30, 30, 31, 31, 31, 31, 31, 31, 31, 31, 31, 31, 31, 31, 31, 31, 31};

constexpr int W_ITEMS_PER_LAYER = 64 * (NP / 64) + 2 * 32 * 64 + 64 * 64 + 2 * 64 * 2 + 2 * 2 * 2;
constexpr int W_ITEMS = DEPTH * W_ITEMS_PER_LAYER;
constexpr int W_TAIL_ITEMS = 0;
__device__ __forceinline__ int srcmap_in(int n) { return n < 5120 ? n : (n < 21504 ? n + 48 : (n < 21552 ? n - 21504 + 5120 : -1)); }
template <int MODE>
__device__ __forceinline__ void transpose_item(const float* __restrict__ W, int K, int N, bf16_t* __restrict__ WT, LAS3 float* scr, int item, int nblk, int lane) {
    int kb, nb;
    if ((nblk & 3) == 0) { const int g8 = item >> 3, sub = item & 7, q = nblk >> 2; const int gk = g8 / q, gn = g8 - gk * q; nb = gn * 4 + (sub & 3); kb = gk * 2 + (sub >> 2); }
    else { kb = item / nblk; nb = item - kb * nblk; }
    const int k0 = 64 * kb, n0 = 64 * nb;
    const int nn = n0 + 4 * (lane & 15); const int s = (MODE == 1) ? srcmap_in(nn) : nn;
    const float* src = W + (size_t)(k0 + (lane >> 4)) * N + (s >= 0 ? s : 0);
    f32x4 v[16];
#pragma unroll
    for (int i = 0; i < 16; ++i) v[i] = *(const f32x4*)(src + (size_t)(4 * i) * N);
    __builtin_amdgcn_sched_barrier(0);
#pragma unroll
    for (int i = 0; i < 16; ++i) { f32x4 x = v[i]; if (s < 0) x = (f32x4){0.f, 0.f, 0.f, 0.f};
        LAS3 float* d = scr + (4 * i + (lane >> 4)) * 65 + 4 * (lane & 15); d[0] = x[0]; d[1] = x[1]; d[2] = x[2]; d[3] = x[3]; }
    LDS_WAIT();
    const int c = lane & 7;
#pragma unroll
    for (int j = 0; j < 8; ++j) { const int n = (lane >> 3) + 8 * j; const LAS3 float* p = scr + (8 * c) * 65 + n;
        u32x4 o; o.x = pk2(p[0 * 65], p[1 * 65]); o.y = pk2(p[2 * 65], p[3 * 65]); o.z = pk2(p[4 * 65], p[5 * 65]); o.w = pk2(p[6 * 65], p[7 * 65]);
        if (MODE == 2) { const int k8 = (k0 >> 3) + c, na = n0 + n; *(u32x4*)(WT + (size_t)((((k8 >> 1) * (N >> 5) + (na >> 5)) * 64) + (k8 & 1) * 32 + (na & 31)) * 8) = o; }
        else *(u32x4*)(WT + (size_t)(n0 + n) * K + k0 + 8 * c) = o; }
    LDS_WAIT();
}
__device__ __forceinline__ void phase_weights(const Params& P, LAS3 unsigned char* lds, int gw, int NGW, int wave, int lane, int it_lo, int it_hi) {
    asm volatile("" : "+v"(lane));
    LAS3 float* scr = (LAS3 float*)(lds + LDS_STAGE + wave * 16640);
    constexpr int I_IN = 64 * (NP / 64), I_AB = 32 * 64, I_O = 64 * 64, I_W1 = 64 * 2, I_W2 = 2 * 2;
    constexpr int PER_LAYER = I_IN + 2 * I_AB + I_O + 2 * I_W1 + 2 * I_W2;
    static_assert(PER_LAYER == W_ITEMS_PER_LAYER, "item count");
    for (int it = it_lo + gw; it < it_hi; it += NGW) {
        const int L = it / PER_LAYER; int r = it - L * PER_LAYER;
        unsigned char* ws = P.ws;
        if (r < I_IN) { transpose_item<1>(P.w_in + (size_t)L * DM * NIN, DM, NIN, (bf16_t*)(ws + WS_WIN + L * SZ_WIN), scr, r, NP / 64, lane); continue; } r -= I_IN;
        if (r < I_AB) { transpose_item<0>(P.w_out_a + (size_t)L * AW * DM, AW, DM, (bf16_t*)(ws + WS_WA + L * SZ_WAB), scr, r, 64, lane); continue; } r -= I_AB;
        if (r < I_AB) { transpose_item<0>(P.w_out_b + (size_t)L * BW * DM, BW, DM, (bf16_t*)(ws + WS_WB + L * SZ_WAB), scr, r, 64, lane); continue; } r -= I_AB;
        if (r < I_O) { transpose_item<0>(P.w_out + (size_t)L * DM * DM, DM, DM, (bf16_t*)(ws + WS_WO + L * SZ_WO), scr, r, 64, lane); continue; } r -= I_O;
        if (r < I_W1) { transpose_item<2>(P.w1_k + (size_t)L * 4096 * HD, 4096, HD, (bf16_t*)(ws + WS_W1 + (L * 2 + 0) * SZ_W1), scr, r, 2, lane); continue; } r -= I_W1;
        if (r < I_W1) { transpose_item<2>(P.w1_v + (size_t)L * 4096 * HD, 4096, HD, (bf16_t*)(ws + WS_W1 + (L * 2 + 1) * SZ_W1), scr, r, 2, lane); continue; } r -= I_W1;
        if (r < I_W2) { transpose_item<0>(P.w2_k + (size_t)L * HD * HD, HD, HD, (bf16_t*)(ws + WS_W2 + (L * 2 + 0) * SZ_W2), scr, r, 2, lane); continue; } r -= I_W2;
        transpose_item<0>(P.w2_v + (size_t)L * HD * HD, HD, HD, (bf16_t*)(ws + WS_W2 + (L * 2 + 1) * SZ_W2), scr, r, 2, lane);
    }
}
__device__ __forceinline__ void phase_prenorm(const float* __restrict__ x, const float* __restrict__ g, bf16_t* __restrict__ h, int gw, int NGW, int lane) {
    asm volatile("" : "+v"(lane));
    for (int m = gw; m < T; m += NGW) {
        const f32x4* xr = (const f32x4*)(x + (size_t)m * DM) + lane; f32x4 v[16]; float ss = 0.f;
#pragma unroll
        for (int j = 0; j < 16; ++j) { v[j] = xr[64 * j]; ss += (v[j][0] * v[j][0] + v[j][1] * v[j][1]) + (v[j][2] * v[j][2] + v[j][3] * v[j][3]); }
        const float rs = 1.0f / sqrtf(wave_sum(ss) * (1.0f / DM) + NORM_EPS);
        u32x2* o = (u32x2*)(h + (size_t)m * DM) + lane; const f32x4* gr = (const f32x4*)g + lane;
#pragma unroll
        for (int j = 0; j < 16; ++j) { const f32x4 gg = gr[64 * j]; u32x2 w; w.x = pk2(v[j][0] * rs * gg[0], v[j][1] * rs * gg[1]); w.y = pk2(v[j][2] * rs * gg[2], v[j][3] * rs * gg[3]); o[64 * j] = w; }
    }
}
template <bool XOLD_BF16, bool XNEW_BF16>
__device__ __forceinline__ void phase_postnorm(const bf16_t* __restrict__ Y, const void* __restrict__ xold, const float* __restrict__ gpost, void* __restrict__ xnew,
                                               const float* __restrict__ gpre, bf16_t* __restrict__ h, bool next, int gw, int NGW, int lane) {
    asm volatile("" : "+v"(lane));
    for (int m = gw; m < T; m += NGW) {
        const u32x2* yr = (const u32x2*)(Y + (size_t)m * DM) + lane; f32x4 v[16]; float ss = 0.f;
#pragma unroll
        for (int j = 0; j < 16; ++j) { const u32x2 w = yr[64 * j]; v[j] = (f32x4){pg8::bf_lo(w.x), pg8::bf_hi(w.x), pg8::bf_lo(w.y), pg8::bf_hi(w.y)}; ss += (v[j][0] * v[j][0] + v[j][1] * v[j][1]) + (v[j][2] * v[j][2] + v[j][3] * v[j][3]); }
        const float rs = 1.0f / sqrtf(wave_sum(ss) * (1.0f / DM) + NORM_EPS);
        const f32x4* gr = (const f32x4*)gpost + lane;
        float s2 = 0.f;
#pragma unroll
        for (int j = 0; j < 16; ++j) { const f32x4 gg = gr[64 * j]; f32x4 xx;
            if (XOLD_BF16) { const u32x2 w = ((const u32x2*)((const bf16_t*)xold + (size_t)m * DM) + lane)[64 * j]; xx = (f32x4){pg8::bf_lo(w.x), pg8::bf_hi(w.x), pg8::bf_lo(w.y), pg8::bf_hi(w.y)}; }
            else xx = ((const f32x4*)((const float*)xold + (size_t)m * DM) + lane)[64 * j];
            const f32x4 r = xx + v[j] * rs * gg; v[j] = r;
            if (XNEW_BF16) { u32x2 w; w.x = pk2(r[0], r[1]); w.y = pk2(r[2], r[3]); ((u32x2*)((bf16_t*)xnew + (size_t)m * DM) + lane)[64 * j] = w; }
            else ((f32x4*)((float*)xnew + (size_t)m * DM) + lane)[64 * j] = r;
            s2 += (r[0] * r[0] + r[1] * r[1]) + (r[2] * r[2] + r[3] * r[3]); }
        if (next) {
            const float rs2 = 1.0f / sqrtf(wave_sum(s2) * (1.0f / DM) + NORM_EPS);
            u32x2* o = (u32x2*)(h + (size_t)m * DM) + lane; const f32x4* g2 = (const f32x4*)gpre + lane;
#pragma unroll
            for (int j = 0; j < 16; ++j) { const f32x4 gg = g2[64 * j]; u32x2 w; w.x = pk2(v[j][0] * rs2 * gg[0], v[j][1] * rs2 * gg[1]); w.y = pk2(v[j][2] * rs2 * gg[2], v[j][3] * rs2 * gg[3]); o[64 * j] = w; }
        }
    }
}
namespace att {
constexpr float SCALE = 0.08838834764831845f, LOG2E = 1.4426950408889634f, C2 = SCALE * LOG2E;
constexpr int SHM = 16384;
constexpr int NSLOT = 3;
constexpr int L_V = 0, L_K = NSLOT * SHM, L_IMP = 2 * NSLOT * SHM, L_SEL = LDS_ATT, L_WS = L_SEL + 1024, L_SC = L_WS + 2048, L_END = L_SC + 4096;
static_assert(L_IMP + 32768 <= 131072 && L_END <= LDS_ATT + 8192, "attention LDS");
#define KSWZ(row, colB) ((row) * 256 + ((colB) ^ (((row) & 7) << 4)))
#define SBAR() __builtin_amdgcn_sched_barrier(0)
__device__ __forceinline__ int v_st(int k, int c) { const int kk = (k & ~0xC) | ((k & 4) << 1) | ((k & 8) >> 1); return ((kk >> 3) * 4 + (c >> 5)) * 512 + ((kk & 7) * 32 + (c & 31)) * 2; }
__device__ __forceinline__ int v_rd_base(int lane) { return ((lane & 3) << 3) | (((lane >> 2) & 3) << 6) | (((lane >> 4) & 1) << 5) | (((lane >> 5) & 1) << 8); }
constexpr int v_rd_off(int d0, int ks, int half) { return d0 * 512 + ks * 4096 + half * 2048; }
__device__ __forceinline__ int crow(int r, int hi) { return (r & 3) + 8 * (r >> 2) + 4 * hi; }
__device__ __forceinline__ unsigned cvtpk(float lo, float hi) { return pg8::cvt_pk_bf16(lo, hi); }
enum { MODE_STAT = 0, MODE_IMP = 1, MODE_ONLINE = 2, MODE_ACC = 3, MODE_IMPACC = 4 };
#ifndef PP_STAT
#define PP_STAT false
#endif
#ifndef PP_ACC
#define PP_ACC false
#endif

struct Ctx {
    bf16x8 qr[8]; f32x16 o[4];
    int tq, r32, hi, wid, lane, tid, t0;
    const LAS3 float* tb; float bfar;
    LAS3 char* lds;
};
__device__ __forceinline__ void qkt(f32x16& p0, f32x16& p1, const LAS3 char* Kt, int r32, int hi, const bf16x8* qr) {
    p0 = f32x16{}; p1 = f32x16{};
    const LAS3 char* kb[4];
#pragma unroll
    for (int dd = 0; dd < 4; ++dd) kb[dd] = Kt + KSWZ(r32, (dd * 16 + hi * 8) * 2);
#pragma unroll
    for (int d0 = 0; d0 < 8; ++d0) { const LAS3 char* a = kb[d0 & 3] + (d0 >> 2) * 128;
        const bf16x8 b0 = *reinterpret_cast<const LAS3 bf16x8*>(a);
        const bf16x8 b1 = *reinterpret_cast<const LAS3 bf16x8*>(a + 32 * 256);
        p0 = __builtin_amdgcn_mfma_f32_32x32x16_bf16(b0, qr[d0], p0, 0, 0, 0);
        p1 = __builtin_amdgcn_mfma_f32_32x32x16_bf16(b1, qr[d0], p1, 0, 0, 0);
        if ((d0 & 3) == 3) SBAR(); }
}
__device__ __forceinline__ void pv_tile(f32x16* o, int vb0, bf16x8 pa0, bf16x8 pa1, bf16x8 pa2, bf16x8 pa3) {
#define TRRD(dst, off) asm volatile("ds_read_b64_tr_b16 %0, %1 offset:%2" : "=&v"(dst) : "v"(vb0), "i"(off) : "memory")
#define PV_KS(ks, PA) do { s16x4 l0, l1, l2, l3, h0, h1, h2, h3; constexpr int b_ = v_rd_off(0, ks, 0); \
        TRRD(l0, b_); TRRD(h0, b_ + 2048); TRRD(l1, b_ + 512); TRRD(h1, b_ + 512 + 2048); TRRD(l2, b_ + 1024); TRRD(h2, b_ + 1024 + 2048); TRRD(l3, b_ + 1536); TRRD(h3, b_ + 1536 + 2048); \
        asm volatile("s_waitcnt lgkmcnt(0)" ::: "memory"); SBAR(); \
        o[0] = __builtin_amdgcn_mfma_f32_32x32x16_bf16(PA, (bf16x8){l0[0], l0[1], l0[2], l0[3], h0[0], h0[1], h0[2], h0[3]}, o[0], 0, 0, 0); \
        o[1] = __builtin_amdgcn_mfma_f32_32x32x16_bf16(PA, (bf16x8){l1[0], l1[1], l1[2], l1[3], h1[0], h1[1], h1[2], h1[3]}, o[1], 0, 0, 0); \
        o[2] = __builtin_amdgcn_mfma_f32_32x32x16_bf16(PA, (bf16x8){l2[0], l2[1], l2[2], l2[3], h2[0], h2[1], h2[2], h2[3]}, o[2], 0, 0, 0); \
        o[3] = __builtin_amdgcn_mfma_f32_32x32x16_bf16(PA, (bf16x8){l3[0], l3[1], l3[2], l3[3], h3[0], h3[1], h3[2], h3[3]}, o[3], 0, 0, 0); } while (0)
    PV_KS(0, pa0); PV_KS(1, pa1); PV_KS(2, pa2); PV_KS(3, pa3);
#undef PV_KS
#undef TRRD
}
__device__ __forceinline__ void pack_p(const f32x16& p0, const f32x16& p1, bf16x8& pa0, bf16x8& pa1, bf16x8& pa2, bf16x8& pa3) {
#define PK4(P, B_, OUT) do { unsigned a0 = cvtpk(P[B_+0], P[B_+1]), a1 = cvtpk(P[B_+2], P[B_+3]); \
        unsigned b0 = cvtpk(P[B_+4], P[B_+5]), b1 = cvtpk(P[B_+6], P[B_+7]); \
        auto r0 = __builtin_amdgcn_permlane32_swap(a0, b0, false, false); auto r1 = __builtin_amdgcn_permlane32_swap(a1, b1, false, false); \
        u32x4 w = {r0[0], r1[0], r0[1], r1[1]}; OUT = *reinterpret_cast<bf16x8*>(&w); } while (0)
    PK4(p0, 0, pa0); SBAR(); PK4(p0, 8, pa1); SBAR(); PK4(p1, 0, pa2); SBAR(); PK4(p1, 8, pa3);
#undef PK4
}
__device__ __forceinline__ float half_max(float v) { auto rr = __builtin_amdgcn_permlane32_swap(__float_as_uint(v), __float_as_uint(v), false, false); return fmaxf(__uint_as_float(rr[0]), __uint_as_float(rr[1])); }
__device__ __forceinline__ float half_sum(float v) { auto rr = __builtin_amdgcn_permlane32_swap(__float_as_uint(v), __float_as_uint(v), false, false); return __uint_as_float(rr[0]) + __uint_as_float(rr[1]); }

template <int MODE, int STEP, int OFF, bool ROWSEL, bool PP>
__device__ __forceinline__ void run_pass(Ctx& c, const bf16_t* __restrict__ Kg, const bf16_t* __restrict__ Vg, const int ldk, const int j_lo, const int j_hi, const unsigned W,
                                         float& m_reg, float& l_reg, const float pscale, unsigned sm0, unsigned sm1, unsigned sm2, unsigned sm3, const float gate = 1.f, const bool rev = false) {
    constexpr bool HASV = (MODE == MODE_ONLINE || MODE == MODE_ACC || MODE == MODE_IMPACC), RUNMAX = (MODE == MODE_ONLINE || MODE == MODE_STAT);
    int tid = c.tid, r32 = c.r32, hi = c.hi, lane = c.lane;
    asm volatile("" : "+v"(tid), "+v"(r32), "+v"(hi), "+v"(lane));
    const int n = j_hi - j_lo + 1;
    if (n <= 0) return;
    LAS3 char* V_lds = c.lds + L_V; LAS3 char* K_lds = c.lds + L_K;
    LAS3 float* al_l = (LAS3 float*)(c.lds + L_WS) + c.wid * 64 + 32;
    const int krow = tid >> 4;
    const unsigned ko0 = (unsigned)(krow * ldk + (((tid & 15) ^ (krow & 7)) * 8)) * 2u;
    const int vkk = ((tid >> 7) * 8) + ((tid & 31) >> 2), vkey = (vkk & ~0xC) | ((vkk & 4) << 1) | ((vkk & 8) >> 1), vcol = ((tid >> 5) & 3) * 32 + (tid & 3) * 8;
    const unsigned vo0 = (unsigned)(vkey * ldk + vcol) * 2u;
    const unsigned half_step = (unsigned)(32 * ldk) * 2u;
    const int vbase = (int)(uintptr_t)V_lds + v_rd_base(lane);
#define LOADT(j, bf) do { const char* kp_ = (const char*)(Kg + (size_t)((j) * 64) * ldk); LAS3 char* kd_ = K_lds + (bf) * SHM + c.wid * 1024; \
        __builtin_amdgcn_global_load_lds((const unsigned*)(kp_ + ko0), (LAS3 unsigned*)kd_, 16, 0, 0); \
        __builtin_amdgcn_global_load_lds((const unsigned*)((kp_ + half_step) + ko0), (LAS3 unsigned*)(kd_ + 8192), 16, 0, 0); \
        if (HASV) { const char* vp_ = (const char*)(Vg + (size_t)((j) * 64) * ldk); LAS3 char* vd_ = V_lds + (bf) * SHM + c.wid * 1024; \
            __builtin_amdgcn_global_load_lds((const unsigned*)(vp_ + vo0), (LAS3 unsigned*)vd_, 16, 0, 0); \
            __builtin_amdgcn_global_load_lds((const unsigned*)((vp_ + half_step) + vo0), (LAS3 unsigned*)(vd_ + 8192), 16, 0, 0); } } while (0)
#define WAIT_OLDER(younger) do { if (younger) { if (HASV) asm volatile("s_waitcnt vmcnt(4)" ::: "memory"); else asm volatile("s_waitcnt vmcnt(2)" ::: "memory"); } else VM_WAIT(); } while (0)
#define STEP_END(oddstep, ldt) do { if (oddstep) WAIT_OLDER(ldt); LDS_WAIT(); __builtin_amdgcn_s_barrier(); asm volatile("" ::: "memory"); } while (0)
#define TJ(t_) (rev ? j_hi - (t_) : j_lo + (t_))
    LOADT(TJ(0), 0); if (n > 1) LOADT(TJ(1), 1);
    WAIT_OLDER(n > 1);
    __builtin_amdgcn_s_barrier(); asm volatile("" ::: "memory");
    const int role = PP ? (c.wid >> 2) : 0, tqw = c.t0 + 8 * c.wid;
    const float NEG = -__builtin_inff();
    const float lp = RUNMAX ? 0.f : __builtin_amdgcn_logf(pscale);
    if (PP && role == 1) { __builtin_amdgcn_s_barrier(); asm volatile("" ::: "memory"); }
    int slot = 0;
#pragma unroll 1
    for (int t = 0; t < n; ++t) {
        const int j = TJ(t);
        const bool ldt = (t + 2 < n); const int lslot = slot == 0 ? 2 : slot - 1;
        if ((!PP || role == 1) && ldt) LOADT(TJ(t + 2), lslot);
        f32x16 p0, p1; float mul = C2, off = 0.f, alpha = 1.f; bool resc = false;
        const int kpos0 = STEP * (j * 64) + OFF;
        const int dmin = tqw - (kpos0 + STEP * 63), dmax = tqw + 7 - kpos0;
        bool rowsel = true;
        if (ROWSEL) { const unsigned wsel = (j < 32) ? sm0 : (j < 64) ? sm1 : (j < 96) ? sm2 : sm3; rowsel = (wsel >> (j & 31)) & 1u; }
        bool act = (dmax >= 0) && (dmin < (int)W);
        if (ROWSEL) act = act && __any(rowsel);
        if (act) {
            SBAR(); __builtin_amdgcn_s_setprio(2); qkt(p0, p1, K_lds + slot * SHM, r32, hi, c.qr); __builtin_amdgcn_s_setprio(0); SBAR();
            const bool needmask = (dmin < 0) || ((unsigned)dmax >= W);
            const int d0 = c.tq - kpos0 - STEP * 4 * hi;
            float add0 = c.bfar;
            if (dmin < 113) {
                if (STEP == 1) {
                    const LAS3 float* tbase = c.tb + (d0 + 5);
#pragma unroll
                    for (int r = 0; r < 16; ++r) { const int cc = (r & 3) + 8 * (r >> 2);
                        p0[r] = fmaf(p0[r], C2, tbase[59 - cc]); p1[r] = fmaf(p1[r], C2, tbase[59 - cc - 32]);
                        if ((r & 3) == 3) SBAR(); }
                } else {
#pragma unroll
                    for (int r = 0; r < 16; ++r) { const int cc = (r & 3) + 8 * (r >> 2); const int da = d0 - STEP * cc, db = d0 - STEP * (cc + 32);
                        const float ba = c.tb[64 + min(max(da, 0), 127)], bb = c.tb[64 + min(max(db, 0), 127)];
                        p0[r] = fmaf(p0[r], C2, ba); p1[r] = fmaf(p1[r], C2, bb);
                        if ((r & 3) == 3) SBAR(); }
                }
                mul = 1.f; add0 = 0.f;
            }
            if (needmask) {
#pragma unroll
                for (int r = 0; r < 16; ++r) { const int cc = (r & 3) + 8 * (r >> 2); const int da = d0 - STEP * cc, db = d0 - STEP * (cc + 32);
                    if ((unsigned)da >= W) p0[r] = NEG; if ((unsigned)db >= W) p1[r] = NEG; }
            }
            SBAR();
            if (RUNMAX) {
                float pm = fmaxf(p0[0], p1[0]);
#pragma unroll
                for (int r = 1; r < 16; ++r) pm = fmaxf(fmaxf(pm, p0[r]), p1[r]);
                pm = half_max(pm);
                float xmax = fmaf(pm, mul, add0); if (ROWSEL) xmax = rowsel ? xmax : NEG;
                float mn = m_reg;
                if (MODE != MODE_ONLINE || !__all(xmax - m_reg <= 8.0f)) { mn = fmaxf(m_reg, xmax); alpha = __builtin_amdgcn_exp2f(m_reg - mn); m_reg = mn; }
                off = add0 - mn; if (ROWSEL) off = rowsel ? off : NEG;
                if (MODE == MODE_ONLINE) { resc = __any(alpha < 1.f); if (resc && hi == 0) al_l[r32] = alpha; }
            } else off = (add0 - m_reg) + lp;
        }
        if (PP) STEP_END(role == 1, ldt);
        if (PP && role == 0 && ldt) LOADT(TJ(t + 2), lslot);
        if (act) {
#pragma unroll
            for (int r = 0; r < 16; ++r) { p0[r] = __builtin_amdgcn_exp2f(fmaf(p0[r], mul, off)); p1[r] = __builtin_amdgcn_exp2f(fmaf(p1[r], mul, off)); }
            if (RUNMAX) {
                float ps = 0.f;
#pragma unroll
                for (int r = 0; r < 16; ++r) ps += p0[r] + p1[r];
                ps = half_sum(ps);
                l_reg = l_reg * alpha + ps;
            }
            if (MODE == MODE_IMP || MODE == MODE_IMPACC) {
                LAS3 float* imp = (LAS3 float*)(c.lds + L_IMP) + (c.wid * 8 + (r32 >> 2)) * 128;
#pragma unroll
                for (int hf = 0; hf < 2; ++hf)
#pragma unroll
                    for (int m = 0; m < 4; ++m) { const f32x16& P = hf ? p1 : p0;
                        float a = 2.f * (P[4 * m] + P[4 * m + 1] + P[4 * m + 2]) + P[4 * m + 3], b = P[4 * m + 3];
                        a += __shfl_xor(a, 1); b += __shfl_xor(b, 1); a += __shfl_xor(a, 2); b += __shfl_xor(b, 2);
                        const int jj = 16 * j + 8 * hf + 2 * m + hi;
                        if ((r32 & 3) == 0) { __hip_atomic_fetch_add(imp + jj, a, __ATOMIC_RELAXED, __HIP_MEMORY_SCOPE_WORKGROUP);
                            if (jj + 1 < 128) __hip_atomic_fetch_add(imp + jj + 1, b, __ATOMIC_RELAXED, __HIP_MEMORY_SCOPE_WORKGROUP); } }
            }
            if (MODE == MODE_IMPACC) {
#pragma unroll
                for (int r = 0; r < 16; ++r) { p0[r] *= gate; p1[r] *= gate; }
            }
            if (HASV) {
                bf16x8 pa0, pa1, pa2, pa3;
                SBAR(); pack_p(p0, p1, pa0, pa1, pa2, pa3); SBAR();
                if (MODE == MODE_ONLINE && resc) {
#pragma unroll
                    for (int d_ = 0; d_ < 4; ++d_)
#pragma unroll
                        for (int r = 0; r < 16; ++r) c.o[d_][r] *= al_l[crow(r, hi)];
                    SBAR(); }
                pv_tile(c.o, vbase + slot * SHM, pa0, pa1, pa2, pa3);
            }
        }
        STEP_END(role == 0, ldt);
        slot = slot == 2 ? 0 : slot + 1;
    }
    if (PP && role == 0) { __builtin_amdgcn_s_barrier(); asm volatile("" ::: "memory"); }
#undef TJ
#undef STEP_END
#undef WAIT_OLDER
#undef LOADT
}
__device__ __forceinline__ void attn_unit(LAS3 char* lds, const bf16_t* __restrict__ proj, const bf16_t* __restrict__ kc, const bf16_t* __restrict__ vc, bf16_t* __restrict__ oa, float* park, int qt, int g, bool rev) {
    int tid_ = threadIdx.x; asm volatile("" : "+v"(tid_));
    Ctx c; c.lds = lds; c.tid = tid_; c.lane = c.tid & 63; c.wid = __builtin_amdgcn_readfirstlane(c.tid >> 6); c.r32 = c.lane & 31; c.hi = c.lane >> 5;
    c.t0 = qt * 64; c.tq = c.t0 + 8 * c.wid + (c.r32 >> 2);
    const int head = g * 4 + (c.r32 & 3);
    c.tb = (const LAS3 float*)(lds + LDS_BIAS) + head * 256; c.bfar = c.tb[64 + 127];
    { const bf16_t* qp = proj + (size_t)c.tq * NP + C_Q + head * HD + c.hi * 8;
#pragma unroll
      for (int d0 = 0; d0 < 8; ++d0) c.qr[d0] = *(const bf16x8*)(qp + d0 * 16); }
    float ga[3];
    { const bf16_t* gp = proj + (size_t)c.tq * NP + C_GA + head * 3;
#pragma unroll
      for (int b = 0; b < 3; ++b) ga[b] = pg8::fast_sigmoid(__uint_as_float(((unsigned)gp[b]) << 16)); }
    { LAS3 f32x4* z = (LAS3 f32x4*)(lds + L_IMP);
#pragma unroll
      for (int i = 0; i < 4; ++i) z[c.tid + 512 * i] = (f32x4){0.f, 0.f, 0.f, 0.f}; }
    __syncthreads();
    const bf16_t* Kc = kc + g * HD; const bf16_t* Vc = vc + g * HD;
    const bf16_t* Ks = proj + C_KV + 2 * 512 + g * HD; const bf16_t* Vs = proj + C_KV + 3 * 512 + g * HD;
    const bf16_t* Kw = proj + C_KV + 4 * 512 + g * HD; const bf16_t* Vw = proj + C_KV + 5 * 512 + g * HD;
    const int ntc = (4 * qt + 2) / 64;
    constexpr unsigned WINF = 0x7fffffffu;
    LAS3 float* wsf = (LAS3 float*)(lds + L_WS) + c.wid * 64;
#define PARK_PTR(sl_) int pt_ = c.tid; asm volatile("" : "+v"(pt_)); char* pp_ = (char*)park + ((size_t)blockIdx.x * 32 * 512 + (size_t)(sl_) * 16 * 512 + pt_) * 16
#define PARK_STORE(sl_) do { PARK_PTR(sl_); _Pragma("unroll") for (int d_ = 0; d_ < 4; ++d_) _Pragma("unroll") for (int q_ = 0; q_ < 4; ++q_) { \
        *(f32x4*)pp_ = (f32x4){c.o[d_][4 * q_], c.o[d_][4 * q_ + 1], c.o[d_][4 * q_ + 2], c.o[d_][4 * q_ + 3]}; pp_ += 8192; } } while (0)
#define PARK_ADD(sl_) do { PARK_PTR(sl_); _Pragma("unroll") for (int hh_ = 0; hh_ < 2; ++hh_) { f32x4 t_[8]; _Pragma("unroll") for (int e_ = 0; e_ < 8; ++e_) { t_[e_] = *(const f32x4*)pp_; pp_ += 8192; } SBAR(); \
        _Pragma("unroll") for (int e_ = 0; e_ < 8; ++e_) { const int d_ = hh_ * 2 + (e_ >> 2), q_ = e_ & 3; \
        c.o[d_][4 * q_] += t_[e_][0]; c.o[d_][4 * q_ + 1] += t_[e_][1]; c.o[d_][4 * q_ + 2] += t_[e_][2]; c.o[d_][4 * q_ + 3] += t_[e_][3]; } SBAR(); } } while (0)
#define ROW_SCALE(f_) do { if (c.hi == 0) wsf[c.r32] = (f_); LDS_WAIT(); _Pragma("unroll") for (int d_ = 0; d_ < 4; ++d_) _Pragma("unroll") for (int r = 0; r < 16; ++r) c.o[d_][r] *= wsf[crow(r, c.hi)]; } while (0)
#ifndef AREP
#define AREP 0
#endif
    {
        float m_c = -1e30f, l_c = 0.f;
        run_pass<MODE_STAT, 16, 31, false, false>(c, Kc, Vc, 512, 0, ntc, WINF, m_c, l_c, 0.f, 0u, 0u, 0u, 0u);
        const float rl_c = l_c > 0.f ? 1.0f / l_c : 0.f;
#pragma unroll
        for (int d_ = 0; d_ < 4; ++d_) c.o[d_] = f32x16{};
        run_pass<MODE_IMPACC, 16, 31, false, false>(c, Kc, Vc, 512, 0, ntc, WINF, m_c, l_c, rl_c, 0u, 0u, 0u, 0u, ga[0]);
        PARK_STORE(0);
    }
    {
        LAS3 unsigned* selw = (LAS3 unsigned*)(lds + L_SEL);
#pragma unroll 1
        for (int tk = 0; tk < 8; ++tk) {
            const int tok = c.wid * 8 + tk; const LAS3 float* imp = (const LAS3 float*)(lds + L_IMP) + tok * 128;
            const int ja = c.lane, jb = c.lane + 64;
            unsigned ka = __float_as_uint(imp[ja]) + 1u, kb = __float_as_uint(imp[jb]) + 1u;
            ka = (ja == 0 || ja == qt || ja == qt - 1) ? 0xffffffffu : (ja > qt ? 0u : ka);
            kb = (jb == qt || jb == qt - 1) ? 0xffffffffu : (jb > qt ? 0u : kb);
            unsigned T = 0u;
#pragma unroll 1
            for (int bit = 31; bit >= 0; --bit) { const unsigned cand = T | (1u << bit);
                const int cnt = __popcll(__ballot(ka >= cand)) + __popcll(__ballot(kb >= cand));
                T = cnt >= 16 ? cand : T; }
            const int cgt = __popcll(__ballot(ka > T)) + __popcll(__ballot(kb > T)); const int rr = 16 - cgt;
            const unsigned long long ea = __ballot(ka == T), eb = __ballot(kb == T);
            const int ra = __builtin_amdgcn_mbcnt_hi((unsigned)(ea >> 32), __builtin_amdgcn_mbcnt_lo((unsigned)ea, 0u));
            const int rb = __popcll(ea) + (int)__builtin_amdgcn_mbcnt_hi((unsigned)(eb >> 32), __builtin_amdgcn_mbcnt_lo((unsigned)eb, 0u));
            const unsigned long long ba = __ballot(ka > T || (ka == T && ra < rr)), bb = __ballot(kb > T || (kb == T && rb < rr));
            if (c.lane == 0) { selw[tok * 4 + 0] = (unsigned)ba; selw[tok * 4 + 1] = (unsigned)(ba >> 32); selw[tok * 4 + 2] = (unsigned)bb; selw[tok * 4 + 3] = (unsigned)(bb >> 32); }
        }
        LDS_WAIT();
    }
    {
        float m_w = -1e30f, l_w = 0.f; const int jlo = qt >= 8 ? qt - 8 : 0;
#pragma unroll
        for (int d_ = 0; d_ < 4; ++d_) c.o[d_] = f32x16{};
        run_pass<MODE_ONLINE, 1, 0, false, false>(c, Kw, Vw, NP, jlo, qt, 512u, m_w, l_w, 0.f, 0u, 0u, 0u, 0u);
        ROW_SCALE(ga[2] / l_w);
        PARK_STORE(1);
    }
    {
        unsigned sm0, sm1, sm2, sm3;
        { const LAS3 unsigned* selw = (const LAS3 unsigned*)(lds + L_SEL) + (c.wid * 8 + (c.r32 >> 2)) * 4; sm0 = selw[0]; sm1 = selw[1]; sm2 = selw[2]; sm3 = selw[3]; }
        float m_s = -1e30f, l_s = 0.f;
#pragma unroll
        for (int d_ = 0; d_ < 4; ++d_) c.o[d_] = f32x16{};
        run_pass<MODE_ONLINE, 1, 0, true, true>(c, Ks, Vs, NP, 0, qt, WINF, m_s, l_s, 0.f, sm0, sm1, sm2, sm3, 1.f, rev);
        ROW_SCALE(ga[1] / l_s);
        PARK_ADD(0);
        PARK_ADD(1);
    }
#undef PARK_STORE
#undef PARK_ADD
#undef ROW_SCALE
#ifdef NO_EPI
    if (c.o[0][0] == 123.f && c.o[1][1] == 3.f && c.o[2][2] == 1.f && c.o[3][3] == 5.f) oa[0] = 1;
    if (false)
#endif
    {
        const int tw = c.t0 + 8 * c.wid;
        const char* zbase = (const char*)(proj + C_ZA + g * 4 * HD); char* obase = (char*)(oa + g * 4 * HD);
#pragma unroll
        for (int r = 0; r < 16; ++r) { const int row = crow(r, c.hi); const int tok = tw + (row >> 2), hd = row & 3;
            const unsigned zo = (unsigned)(tok * NP + hd * HD + c.r32) * 2u, oo = (unsigned)(tok * AW + hd * HD + c.r32) * 2u;
#pragma unroll
            for (int d0 = 0; d0 < 4; ++d0) { const float z = __uint_as_float(((unsigned)*(const bf16_t*)(zbase + zo + d0 * 64)) << 16);
                const float v = c.o[d0][r] * z * pg8::fast_sigmoid(z); const float vn = __shfl_xor(v, 1);
                if ((c.r32 & 1) == 0) *(unsigned*)(obase + oo + d0 * 64) = cvtpk(v, vn); }
            SBAR(); }
    }
    __syncthreads();
}
__device__ __forceinline__ void phase_attn(LAS3 char* lds, const bf16_t* proj, const bf16_t* kc, const bf16_t* vc, bf16_t* oa, float* park, int vcu, int G) {
#pragma unroll 1
    for (int item = vcu; item < 256; item += G) {
        const int g = item >> 6, p = item & 63;
#pragma unroll 1
        for (int s = 0; s < 2; ++s) attn_unit(lds, proj, kc, vc, oa, park, s ? p : 127 - p, g, s != 0);
    }
}
}
__device__ __forceinline__ float gelu_tanh(float x) { const float y = 1.5957691216057308f * (x + 0.044715f * x * x * x); return x * pg8::fast_sigmoid(y); }
__device__ __forceinline__ float silu_f(float x) { return x * pg8::fast_sigmoid(x); }
__device__ __forceinline__ void compress_unit(LAS3 char* lds, const bf16_t* __restrict__ proj, const float* __restrict__ pe, const bf16_t* __restrict__ w1t, const bf16_t* __restrict__ w2t,
                                              bf16_t* __restrict__ outc, int u, int which) {
    int tid_o = threadIdx.x; asm volatile("" : "+v"(tid_o));
    const int tid = tid_o, lane = tid & 63, wid = __builtin_amdgcn_readfirstlane(tid >> 6), r32 = lane & 31, hi = lane >> 5;
    const int i = 8 * u + (r32 >> 2), g = r32 & 3;
    f32x16 acc[4];
#pragma unroll
    for (int nb = 0; nb < 4; ++nb) acc[nb] = f32x16{};
    const bf16_t* abase = proj + C_KV + which * 512 + g * HD + hi * 8;
    const bf16_t* bbase = w1t + (size_t)(wid * 32) * 2048 + lane * 8;
#pragma unroll 1
    for (int lt = 0; lt < 4; ++lt) {
        const int l = wid * 4 + lt; int tokn = 16 * i + l; tokn = tokn < T ? tokn : T - 1;
        const bf16_t* ap = abase + (size_t)tokn * NP; const float* pp = pe + l * HD + hi * 8;
#pragma unroll
        for (int hf = 0; hf < 2; ++hf) {
            u32x4 araw[4]; f32x4 e0[4], e1[4]; bf16x8 bfr[4][4];
#pragma unroll
            for (int k = 0; k < 4; ++k) { const int k8 = hf * 4 + k; araw[k] = *(const u32x4*)(ap + k8 * 16); e0[k] = *(const f32x4*)(pp + k8 * 16); e1[k] = *(const f32x4*)(pp + k8 * 16 + 4);
#pragma unroll
                for (int nb = 0; nb < 4; ++nb) bfr[k][nb] = *(const bf16x8*)(bbase + (size_t)((lt * 8 + k8) * 4 + nb) * 512); }
            __builtin_amdgcn_sched_barrier(0);
#pragma unroll
            for (int k = 0; k < 4; ++k) { const u32x4 raw = araw[k];
                u32x4 aw; aw.x = pk2(pg8::bf_lo(raw.x) + e0[k][0], pg8::bf_hi(raw.x) + e0[k][1]); aw.y = pk2(pg8::bf_lo(raw.y) + e0[k][2], pg8::bf_hi(raw.y) + e0[k][3]);
                aw.z = pk2(pg8::bf_lo(raw.z) + e1[k][0], pg8::bf_hi(raw.z) + e1[k][1]); aw.w = pk2(pg8::bf_lo(raw.w) + e1[k][2], pg8::bf_hi(raw.w) + e1[k][3]);
                const bf16x8 a = *reinterpret_cast<const bf16x8*>(&aw);
#pragma unroll
                for (int nb = 0; nb < 4; ++nb) acc[nb] = __builtin_amdgcn_mfma_f32_32x32x16_bf16(a, bfr[k][nb], acc[nb], 0, 0, 0); }
            __builtin_amdgcn_sched_barrier(0);
        }
    }
    LAS3 float* part = (LAS3 float*)lds + wid * 4096;
#pragma unroll
    for (int nb = 0; nb < 4; ++nb)
#pragma unroll
        for (int r = 0; r < 16; ++r) part[att::crow(r, hi) * 128 + nb * 32 + r32] = acc[nb][r];
    __syncthreads();
    f32x4 s0 = {0.f, 0.f, 0.f, 0.f}, s1 = {0.f, 0.f, 0.f, 0.f};
#pragma unroll
    for (int w = 0; w < 8; ++w) { const LAS3 f32x4* p = (const LAS3 f32x4*)((LAS3 float*)lds + w * 4096 + tid * 8); s0 += p[0]; s1 += p[1]; }
    __syncthreads();
    {
        u32x4 hw; hw.x = pk2(silu_f(s0[0]), silu_f(s0[1])); hw.y = pk2(silu_f(s0[2]), silu_f(s0[3])); hw.z = pk2(silu_f(s1[0]), silu_f(s1[1])); hw.w = pk2(silu_f(s1[2]), silu_f(s1[3]));
        const int row = tid >> 4, col = (tid & 15) * 8;
        *(LAS3 u32x4*)(lds + (row * 136 + col) * 2) = hw;
    }
    __syncthreads();
    if (wid < 4) {
        f32x16 o2 = f32x16{};
#pragma unroll
        for (int ks = 0; ks < 8; ++ks) { const bf16x8 a = *(const LAS3 bf16x8*)(lds + (r32 * 136 + ks * 16 + hi * 8) * 2);
            const bf16x8 b = *(const bf16x8*)(w2t + (size_t)(wid * 32 + r32) * HD + ks * 16 + hi * 8);
            o2 = __builtin_amdgcn_mfma_f32_32x32x16_bf16(a, b, o2, 0, 0, 0); }
#pragma unroll
        for (int r = 0; r < 16; ++r) { const int row = att::crow(r, hi); const int ii = 8 * u + (row >> 2), gg = row & 3;
            const float v = ii < NCMP ? o2[r] : 0.f; const float vn = __shfl_xor(v, 1);
            if ((r32 & 1) == 0) *(unsigned*)(outc + (size_t)(ii * 4 + gg) * HD + wid * 32 + r32) = pk2(v, vn); }
    }
    __syncthreads();
}
__device__ __forceinline__ void gmlp_unit(LAS3 char* lds, const bf16_t* __restrict__ proj, const float* __restrict__ sspart, const float* __restrict__ gain, const float* __restrict__ sw, const float* __restrict__ sb,
                                          bf16_t* __restrict__ ob, int ch, int qd) {
    int tid_o = threadIdx.x; asm volatile("" : "+v"(tid_o));
    const int tid = tid_o, lane = tid & 63, wid = __builtin_amdgcn_readfirstlane(tid >> 6), r32 = lane & 31, hi = lane >> 5;
    const int tc0 = ch * 128;
    LAS3 float* rsl = (LAS3 float*)(lds + LDS_RS);
    {   const int vkk = ((tid >> 7) * 8) + ((tid & 31) >> 2), vkey = (vkk & ~0xC) | ((vkk & 4) << 1) | ((vkk & 8) >> 1), vcol = ((tid >> 5) & 3) * 32 + (tid & 3) * 8;
        const unsigned vo0 = (unsigned)(vkey * NP + vcol) * 2u; const unsigned half_step = (unsigned)(32 * NP) * 2u;
#pragma unroll
        for (int gg = 0; gg < 4; ++gg)
#pragma unroll
            for (int kt = 0; kt < 2; ++kt) { const char* vp_ = (const char*)(proj + (size_t)(tc0 + kt * 64) * NP + C_VB + (qd * 4 + gg) * 128); LAS3 char* vd_ = lds + (gg * 2 + kt) * att::SHM + wid * 1024;
                __builtin_amdgcn_global_load_lds((const unsigned*)(vp_ + vo0), (LAS3 unsigned*)vd_, 16, 0, 0);
                __builtin_amdgcn_global_load_lds((const unsigned*)((vp_ + half_step) + vo0), (LAS3 unsigned*)(vd_ + 8192), 16, 0, 0); } }
    if (tid < 128) { const f32x4* sp = (const f32x4*)(sspart + (size_t)(tc0 + tid) * 32); f32x4 s = sp[0];
#pragma unroll
        for (int i = 1; i < 8; ++i) s += sp[i];
        rsl[tid] = 1.0f / sqrtf(((s[0] + s[1]) + (s[2] + s[3])) * (1.0f / BW) + NORM_EPS); }
    VM_WAIT();
    __syncthreads();
    const int gg = wid >> 1, wd = wid & 1, G = qd * 4 + gg, cb = G * 128;
    const int vb1 = (int)(uintptr_t)(lds) + gg * 2 * att::SHM + att::v_rd_base(lane) + wd * 1024;
    f32x4 gn[2][4];
#pragma unroll
    for (int dd = 0; dd < 2; ++dd)
#pragma unroll
        for (int m = 0; m < 4; ++m) gn[dd][m] = *(const f32x4*)(gain + cb + (wd * 2 + dd) * 32 + 8 * m + 4 * hi);
#pragma unroll 1
    for (int pb = 0; pb < 4; ++pb) {
        const int p = pb * 32 + r32; const size_t tok = (size_t)(tc0 + p); const int nks = 2 * pb + 2;
        f32x4 wr0[8], wr1[8]; u32x2 uu[2][4], zz[2][4];
        const float* wrow = sw + ((size_t)G * 128 + p) * 128 + hi * 8;
#pragma unroll
        for (int ks = 0; ks < 8; ++ks) if (ks < nks) { wr0[ks] = *(const f32x4*)(wrow + ks * 16); wr1[ks] = *(const f32x4*)(wrow + ks * 16 + 4); }
        const char* ubase = (const char*)(proj + tok * NP + C_UB + cb); const char* zbase = (const char*)(proj + tok * NP + C_ZB + cb); char* obase = (char*)(ob + tok * BW + cb);
#pragma unroll
        for (int dd = 0; dd < 2; ++dd)
#pragma unroll
            for (int m = 0; m < 4; ++m) { const int d0 = (wd * 2 + dd) * 32 + 8 * m + 4 * hi; uu[dd][m] = *(const u32x2*)(ubase + d0 * 2); zz[dd][m] = *(const u32x2*)(zbase + d0 * 2); }
        const float bs = sb[G * 128 + p];
        __builtin_amdgcn_sched_barrier(0);
        bf16x8 af[8];
#pragma unroll
        for (int ks = 0; ks < 8; ++ks) { if (ks < nks) { const f32x4 a0 = wr0[ks], a1 = wr1[ks]; const int q0 = ks * 16 + hi * 8;
                const f32x4 r0 = *(const LAS3 f32x4*)(rsl + q0), r1 = *(const LAS3 f32x4*)(rsl + q0 + 4);
                u32x4 w; w.x = pk2(q0 + 0 <= p ? a0[0] * r0[0] : 0.f, q0 + 1 <= p ? a0[1] * r0[1] : 0.f); w.y = pk2(q0 + 2 <= p ? a0[2] * r0[2] : 0.f, q0 + 3 <= p ? a0[3] * r0[3] : 0.f);
                w.z = pk2(q0 + 4 <= p ? a1[0] * r1[0] : 0.f, q0 + 5 <= p ? a1[1] * r1[1] : 0.f); w.w = pk2(q0 + 6 <= p ? a1[2] * r1[2] : 0.f, q0 + 7 <= p ? a1[3] * r1[3] : 0.f);
                af[ks] = *reinterpret_cast<const bf16x8*>(&w); } else af[ks] = bf16x8{}; }
        f32x16 acc[2] = {f32x16{}, f32x16{}};
#define TRRD(dst, off) asm volatile("ds_read_b64_tr_b16 %0, %1 offset:%2" : "=&v"(dst) : "v"(vb1), "i"(off) : "memory")
#define GM_STEP(ks) do { if ((ks) < nks) { s16x4 l0, h0, l1, h1; constexpr int o_ = ((ks) >> 2) * att::SHM + att::v_rd_off(0, (ks) & 3, 0); \
            TRRD(l0, o_); TRRD(h0, o_ + 2048); TRRD(l1, o_ + 512); TRRD(h1, o_ + 512 + 2048); \
            asm volatile("s_waitcnt lgkmcnt(0)" ::: "memory"); __builtin_amdgcn_sched_barrier(0); \
            acc[0] = __builtin_amdgcn_mfma_f32_32x32x16_bf16((bf16x8){l0[0], l0[1], l0[2], l0[3], h0[0], h0[1], h0[2], h0[3]}, af[ks], acc[0], 0, 0, 0); \
            acc[1] = __builtin_amdgcn_mfma_f32_32x32x16_bf16((bf16x8){l1[0], l1[1], l1[2], l1[3], h1[0], h1[1], h1[2], h1[3]}, af[ks], acc[1], 0, 0, 0); } } while (0)
        GM_STEP(0); GM_STEP(1); GM_STEP(2); GM_STEP(3); GM_STEP(4); GM_STEP(5); GM_STEP(6); GM_STEP(7);
#undef GM_STEP
#undef TRRD
#pragma unroll
        for (int dd = 0; dd < 2; ++dd)
#pragma unroll
            for (int m = 0; m < 4; ++m) { const int d0 = (wd * 2 + dd) * 32 + 8 * m + 4 * hi; const u32x2 u2 = uu[dd][m], z2 = zz[dd][m]; const f32x4 g4 = gn[dd][m];
                const float o0 = gelu_tanh(pg8::bf_lo(u2.x)) * (acc[dd][4 * m + 0] * g4[0] + bs) * silu_f(pg8::bf_lo(z2.x));
                const float o1 = gelu_tanh(pg8::bf_hi(u2.x)) * (acc[dd][4 * m + 1] * g4[1] + bs) * silu_f(pg8::bf_hi(z2.x));
                const float o2 = gelu_tanh(pg8::bf_lo(u2.y)) * (acc[dd][4 * m + 2] * g4[2] + bs) * silu_f(pg8::bf_lo(z2.y));
                const float o3 = gelu_tanh(pg8::bf_hi(u2.y)) * (acc[dd][4 * m + 3] * g4[3] + bs) * silu_f(pg8::bf_hi(z2.y));
                u32x2 w; w.x = pk2(o0, o1); w.y = pk2(o2, o3); *(u32x2*)(obase + d0 * 2) = w; }
    }
    __syncthreads();
}
#ifndef N_LAUNCH_MODE
#define N_LAUNCH_MODE 1
#endif
constexpr int NPHASES = 1 + 6 * DEPTH;
#ifndef PHMASK
#define PHMASK 0x7f
#endif
#ifndef REPMASK
#define REPMASK 0
#endif
#define REPS(bit) ((REPMASK & (bit)) ? 2 : 1)
__global__ void __launch_bounds__(NTHREADS, 2) fwd_kernel(Params P) {
    extern __shared__ __attribute__((aligned(16))) unsigned char lds_raw[];
    LAS3 unsigned char* lds = (LAS3 unsigned char*)lds_raw;
    const int tid = threadIdx.x, lane = tid & 63, wave = __builtin_amdgcn_readfirstlane(tid >> 6);
    const int G = gridDim.x; const int bx = blockIdx.x; const int vcu = (G % 8 == 0) ? (bx % 8) * (G / 8) + bx / 8 : bx;
    const int gw = vcu * NWAVES + wave, NGW = G * NWAVES;
    unsigned char* ws = P.ws;
    if (tid < 16) ((LAS3 unsigned*)(lds + LDS_MISC))[tid] = 0u;
    __syncthreads();
    XcdBarrier bar; bar.bar = (unsigned*)(ws + WS_CTL); bar.x = 0; bar.st = nullptr;
    if (N_LAUNCH_MODE == 1) bar = xcd_barrier_post((unsigned*)(ws + WS_CTL), (volatile LAS unsigned*)(lds + LDS_MISC));
    const int lo = P.ph_lo, hi = P.ph_hi;
#define IN(k) (lo <= (k) && (k) < hi)
#define SEAM(k) do { if (IN(k) && IN((k) + 1)) xcd_barrier(bar); } while (0)
    bf16_t* hbuf = (bf16_t*)(ws + WS_H); bf16_t* proj = (bf16_t*)(ws + WS_PROJ); bf16_t* kc = (bf16_t*)(ws + WS_KC); bf16_t* vc = (bf16_t*)(ws + WS_VC);
    bf16_t* oa = (bf16_t*)(ws + WS_OA); bf16_t* ob = (bf16_t*)(ws + WS_OB); bf16_t* t1 = (bf16_t*)(ws + WS_T1); bf16_t* mg = (bf16_t*)(ws + WS_MG);
    bf16_t* Y = (bf16_t*)(ws + WS_Y); bf16_t* x1 = (bf16_t*)(ws + WS_X1);
    constexpr int NU_PROJ = (T / 256) * (NP / 256);
#pragma unroll 1
    for (int w = 0; w < 2; ++w) {
        const int rem = NU_PROJ % G; const bool tailcu = (rem != 0) && (bx >= rem);
        const bool doit = (w == 0) ? (IN(0) && (PHMASK & 1)) : (IN(1) && tailcu);
        const bool alltail = (rem == 0);
        if (doit) {
            const int lo_ = (w == 0) ? 0 : W_ITEMS - W_TAIL_ITEMS, hi_ = (w == 0) ? (alltail ? W_ITEMS : W_ITEMS - W_TAIL_ITEMS) : W_ITEMS;
            const int gw_ = (w == 0) ? gw : (bx - rem) * NWAVES + wave, ngw_ = (w == 0) ? NGW : (G - rem) * NWAVES;
            for (int rep = 0; rep < REPS(1); ++rep) phase_weights(P, lds, gw_, ngw_, wave, lane, lo_, hi_);
        }
        if (w == 0 && IN(0) && (PHMASK & 1)) for (int rep = 0; rep < REPS(128); ++rep) phase_prenorm(P.x, P.pre_norm, hbuf, gw, NGW, lane);
        __syncthreads();
        for (int i = tid; i < 16 * 256; i += NTHREADS) { const int hd = i >> 8; int dd = (i & 255) - 64; dd = dd < 0 ? 0 : (dd > 127 ? 127 : dd); ((LAS3 float*)(lds + LDS_BIAS))[i] = P.rel_bias[BUCKET[dd] * 16 + hd] * att::LOG2E; }
        __syncthreads();
        if (w == 0) SEAM(0);
    }
#pragma unroll 1
    for (int L = 0; L < DEPTH; ++L) {
        const int pb = 1 + 6 * L;
        if (IN(pb) && (PHMASK & 2)) for (int rep = 0; rep < REPS(2); ++rep) {
            pg8::Gemm g{hbuf, (const bf16_t*)(ws + WS_WIN + L * SZ_WIN), T, NP, DM, nullptr, nullptr}; pg8::StaticOrder S; S.init(T, NP, G, bx);
            pg8::EpiProj E{proj, NP, (float*)(ws + WS_SS)};
            pg8::gemm_phase<pg8::EpiProj, pg8::StaticOrder>(lds + LDS_STAGE, g, S, E, nullptr);
        }
        SEAM(pb);
        if (IN(pb + 1) && (PHMASK & 4)) for (int rep = 0; rep < REPS(4) + ((REPMASK & 768) ? 1 : 0); ++rep) {
#pragma unroll 1
            for (int item = vcu; item < 384; item += G) {
                if (item < 256) { if (rep > 0 && (REPMASK & 512)) continue;
                    gmlp_unit((LAS3 char*)lds, proj, (const float*)(ws + WS_SS), P.sgu_norm + L * BW, P.sgu_w + (size_t)L * 16 * 128 * 128, P.sgu_b + L * 16 * 128, ob, item >> 2, item & 3); }
                else { if (rep > 0 && (REPMASK & 256)) continue;
                    const int ci = item - 256, which = ci & 1, u = ci >> 1;
                    compress_unit((LAS3 char*)lds, proj, (which ? P.pe_v : P.pe_k) + L * 32 * HD, (const bf16_t*)(ws + WS_W1 + (L * 2 + which) * SZ_W1), (const bf16_t*)(ws + WS_W2 + (L * 2 + which) * SZ_W2), which ? vc : kc, u, which); }
            }
        }
        SEAM(pb + 1);
        if (IN(pb + 2) && (PHMASK & 8)) for (int rep = 0; rep < REPS(8); ++rep) att::phase_attn((LAS3 char*)lds, proj, kc, vc, oa, (float*)(ws + WS_PARK), vcu, G);
        SEAM(pb + 2);
        if (IN(pb + 3) && (PHMASK & 16)) for (int rep = 0; rep < REPS(16); ++rep) {
            pg8::DualOrder S; S.init(T, DM, G, bx);
            pg8::Gemm g{oa, (const bf16_t*)(ws + WS_WA + L * SZ_WAB), T, DM, AW, ob, (const bf16_t*)(ws + WS_WB + L * SZ_WAB)};
            pg8::EpiMerge E{mg, DM, proj + C_MA, proj + C_MB, NP};
            pg8::gemm_phase<pg8::EpiMerge, pg8::DualOrder>(lds + LDS_STAGE, g, S, E, nullptr);
        }
        SEAM(pb + 3);
        if (IN(pb + 4) && (PHMASK & 32)) for (int rep = 0; rep < REPS(32); ++rep) {
            pg8::Gemm g{mg, (const bf16_t*)(ws + WS_WO + L * SZ_WO), T, DM, DM, nullptr, nullptr}; pg8::StaticOrder S; S.init(T, DM, G, bx);
            pg8::EpiBf16Plain E{Y, DM};
            pg8::gemm_phase<pg8::EpiBf16Plain, pg8::StaticOrder>(lds + LDS_STAGE, g, S, E, nullptr);
        }
        SEAM(pb + 4);
        if (IN(pb + 5) && (PHMASK & 64)) for (int rep = 0; rep < REPS(64); ++rep) {
            if (L == 0) phase_postnorm<false, true>(Y, P.x, P.post_norm, x1, P.pre_norm + DM, hbuf, true, gw, NGW, lane);
            else phase_postnorm<true, false>(Y, x1, P.post_norm + L * DM, P.out, P.pre_norm, hbuf, false, gw, NGW, lane);
        }
        SEAM(pb + 5);
    }
#undef IN
#undef SEAM
}
extern "C" void kernel_launch(void* const* d_in, const int* in_sizes, int n_in, void* d_out, int out_size, void* d_ws, size_t ws_size, hipStream_t stream) {
    static int grid = 0;
    if (grid == 0) {
        if (n_in != 17 || in_sizes[0] != T * DM || out_size != T * DM || ws_size < WS_END) { fprintf(stderr, "kernel_launch: unexpected shapes (n_in %d, in0 %d, out %d, ws %zu < %zu)\n", n_in, n_in > 0 ? in_sizes[0] : -1, out_size, ws_size, (size_t)WS_END); grid = -1; return; }
        int dev = 0, cus = 0, per_cu = 0;
        if (hipGetDevice(&dev) != hipSuccess || hipDeviceGetAttribute(&cus, hipDeviceAttributeMultiprocessorCount, dev) != hipSuccess) { grid = -1; return; }
        if (hipFuncSetAttribute((const void*)fwd_kernel, hipFuncAttributeMaxDynamicSharedMemorySize, LDS_BYTES) != hipSuccess) { fprintf(stderr, "kernel_launch: hipFuncSetAttribute failed\n"); grid = -1; return; }
        if (hipOccupancyMaxActiveBlocksPerMultiprocessor(&per_cu, (const void*)fwd_kernel, NTHREADS, LDS_BYTES) != hipSuccess || per_cu < 1) { fprintf(stderr, "kernel_launch: occupancy query says %d blocks per CU\n", per_cu); (void)hipGetLastError(); grid = -1; return; }
        grid = cus;
    }
    if (grid < 0) return;
    (void)hipMemsetAsync((char*)d_ws + WS_CTL, 0, CTL_BYTES, stream);
    Params p{};
    p.x = (const float*)d_in[0]; p.rel_bias = (const float*)d_in[1]; p.pre_norm = (const float*)d_in[2]; p.w_in = (const float*)d_in[3];
    p.pe_k = (const float*)d_in[4]; p.w1_k = (const float*)d_in[5]; p.w2_k = (const float*)d_in[6]; p.pe_v = (const float*)d_in[7]; p.w1_v = (const float*)d_in[8]; p.w2_v = (const float*)d_in[9];
    p.w_out_a = (const float*)d_in[10]; p.sgu_norm = (const float*)d_in[11]; p.sgu_w = (const float*)d_in[12]; p.sgu_b = (const float*)d_in[13]; p.w_out_b = (const float*)d_in[14]; p.w_out = (const float*)d_in[15]; p.post_norm = (const float*)d_in[16];
    p.out = (float*)d_out; p.ws = (unsigned char*)d_ws;
#if N_LAUNCH_MODE == 1
    p.ph_lo = 0; p.ph_hi = NPHASES;
    hipLaunchKernelGGL(fwd_kernel, dim3(grid), dim3(NTHREADS), LDS_BYTES, stream, p);
#else
    for (int k = 0; k < NPHASES; ++k) { p.ph_lo = k; p.ph_hi = k + 1; hipLaunchKernelGGL(fwd_kernel, dim3(grid), dim3(NTHREADS), LDS_BYTES, stream, p); }
#endif
}
```

```cpp
#include <hip/hip_runtime.h>
#include <cstdio>
#include <cstdint>
__device__ __forceinline__ int hw_lane_id() { int l; asm volatile("v_mbcnt_lo_u32_b32 %0, -1, 0\n\tv_mbcnt_hi_u32_b32 %0, -1, %0" : "=v"(l)); return l; }
namespace pg8 {
#define PG8_LAS __attribute__((address_space(3)))
typedef unsigned short bf16_t;
typedef short bf16x8 __attribute__((ext_vector_type(8)));
typedef float f32x4 __attribute__((ext_vector_type(4)));
typedef unsigned u32x4 __attribute__((ext_vector_type(4)));
constexpr int BM = 256, BK = 64, HALF = 128, HTB = HALF * BK * 2  , STAGE_BYTES = 8 * HTB, NXCD = 8, WGM = 8;

__host__ __device__ __forceinline__ int lds_byte(int r, int c) { const int st = (r >> 4) * 2 + (c >> 5), rr = r & 15, cc = c & 31, ob = rr * 64 + cc * 2; return st * 1024 + (ob ^ (((ob >> 9) & 1) << 5)); }
__host__ __device__ __forceinline__ void stage_rc(int b, int& R, int& C) { const int st = b / 1024, sb = b % 1024, swz = sb ^ (((sb >> 9) & 1) << 5); R = (st >> 1) * 16 + swz / 64; C = (st & 1) * 32 + (swz % 64) / 2; }
__host__ __device__ __forceinline__ int perm32(int rho) { const int n = rho >> 4, i = rho & 15; return 8 * (i >> 2) + 4 * n + (i & 3); }

struct Unit { int pm, pn, sub; };
struct Gemm { const bf16_t* A; const bf16_t* Bt; int M, N, K; const bf16_t* A2; const bf16_t* Bt2; };

struct StaticOrder {
    int nM, nN, nwg, G, c;
    __host__ __device__ void init(int M, int N, int G_, int c_) { nM = M / BM; nN = N / BM; nwg = nM * nN; G = G_; c = c_; }
    __host__ __device__ bool next(int i, Unit& u) const {
        const long L = (long)i * G + c; if (L >= nwg) return false;
        int wgid = (int)L; { const int q = nwg / NXCD, r = nwg % NXCD, xcd = wgid % NXCD, off = wgid / NXCD; wgid = (xcd < r ? xcd * (q + 1) : r * (q + 1) + (xcd - r) * q) + off; }
        const int nig = WGM * nN, gid = wgid / nig, fm = gid * WGM, gsz = (nM - fm) < WGM ? (nM - fm) : WGM;
        u.pm = fm + ((wgid % nig) % gsz); u.pn = (wgid % nig) / gsz; u.sub = 0; return true;
    }
    __device__ __forceinline__ void a_ready(const Unit&) const {}
    __device__ __forceinline__ void done(const Unit&) const {}
    static constexpr bool DUAL = false;
    __device__ __forceinline__ const bf16_t* baseA(const Gemm& g, const Unit&) const { return g.A; }
    __device__ __forceinline__ const bf16_t* baseB(const Gemm& g, const Unit&) const { return g.Bt; }
};
struct DualOrder : StaticOrder {
    static constexpr bool DUAL = true;
    __host__ __device__ bool next(int i, Unit& u) const { const bool ok = StaticOrder::next(i >> 1, u); u.sub = i & 1; return ok; }
    __device__ __forceinline__ const bf16_t* baseA(const Gemm& g, const Unit& u) const { return u.sub ? g.A2 : g.A; }
    __device__ __forceinline__ const bf16_t* baseB(const Gemm& g, const Unit& u) const { return u.sub ? g.Bt2 : g.Bt; }
};
typedef __bf16 bf16x2_t __attribute__((ext_vector_type(2)));
typedef float f32x2_t __attribute__((ext_vector_type(2)));
__device__ __forceinline__ unsigned cvt_pk_bf16(float lo, float hi) { const f32x2_t v = {lo, hi}; const bf16x2_t b = __builtin_convertvector(v, bf16x2_t); return __builtin_bit_cast(unsigned, b); }
typedef float f32x2 __attribute__((ext_vector_type(2)));
__device__ __forceinline__ float bf_lo(unsigned u) { return __uint_as_float(u << 16); }
__device__ __forceinline__ float bf_hi(unsigned u) { return __uint_as_float(u & 0xffff0000u); }
__device__ __forceinline__ float fast_sigmoid(float x) { return __builtin_amdgcn_rcpf(1.0f + __builtin_amdgcn_exp2f(-1.4426950408889634f * x)); }
struct EpiBf16Plain {
    static constexpr bool PERM = true, AFTER_DRAIN = false;
    bf16_t* O; int ldc;
    __device__ __forceinline__ void operator()(const f32x4 (&acc)[2][2][4][2], const Unit& u, int wr, int wc, int fr, int fq) const {
        const int row0 = u.pm * BM + wr * 64 + fr, col0 = u.pn * BM + wc * 32 + 8 * fq;
#pragma unroll
        for (int ai = 0; ai < 2; ++ai)
#pragma unroll
            for (int m = 0; m < 4; ++m) { bf16_t* rowp = O + (size_t)(row0 + ai * HALF + m * 16) * ldc + col0;
#pragma unroll
                for (int bj = 0; bj < 2; ++bj) { const f32x4 v0 = acc[ai][bj][m][0], v1 = acc[ai][bj][m][1];
                    u32x4 w; w.x = cvt_pk_bf16(v0[0], v0[1]); w.y = cvt_pk_bf16(v0[2], v0[3]); w.z = cvt_pk_bf16(v1[0], v1[1]); w.w = cvt_pk_bf16(v1[2], v1[3]);
                    *(u32x4*)(rowp + bj * HALF) = w; } }
    }
};
__device__ __forceinline__ float gelu_tanh_f(float x) { const float y = 1.5957691216057308f * (x + 0.044715f * x * x * x); return x * fast_sigmoid(y); }
struct EpiProj {
    static constexpr bool PERM = true, AFTER_DRAIN = false;
    static constexpr int PN_V0 = 36;
    bf16_t* O; int ldc; float* sspart;
    __device__ __forceinline__ void operator()(const f32x4 (&acc)[2][2][4][2], const Unit& u, int wr, int wc, int fr, int fq) const {
        const int row0 = u.pm * BM + wr * 64 + fr, col0 = u.pn * BM + wc * 32 + 8 * fq;
        const bool vtile = (u.pn >= PN_V0) && (u.pn < PN_V0 + 8);
        if (!vtile) {
#pragma unroll
            for (int ai = 0; ai < 2; ++ai)
#pragma unroll
                for (int m = 0; m < 4; ++m) { bf16_t* rowp = O + (size_t)(row0 + ai * HALF + m * 16) * ldc + col0;
#pragma unroll
                    for (int bj = 0; bj < 2; ++bj) { const f32x4 v0 = acc[ai][bj][m][0], v1 = acc[ai][bj][m][1];
                        u32x4 w; w.x = cvt_pk_bf16(v0[0], v0[1]); w.y = cvt_pk_bf16(v0[2], v0[3]); w.z = cvt_pk_bf16(v1[0], v1[1]); w.w = cvt_pk_bf16(v1[2], v1[3]);
                        *(u32x4*)(rowp + bj * HALF) = w; } }
        } else {
#pragma unroll
            for (int ai = 0; ai < 2; ++ai)
#pragma unroll
                for (int m = 0; m < 4; ++m) { const int row = row0 + ai * HALF + m * 16; bf16_t* rowp = O + (size_t)row * ldc + col0; float ss = 0.f;
#pragma unroll
                    for (int bj = 0; bj < 2; ++bj) { f32x4 v0 = acc[ai][bj][m][0], v1 = acc[ai][bj][m][1];
#pragma unroll
                        for (int e = 0; e < 4; ++e) { v0[e] = gelu_tanh_f(v0[e]); v1[e] = gelu_tanh_f(v1[e]); ss += v0[e] * v0[e] + v1[e] * v1[e]; }
                        u32x4 w; w.x = cvt_pk_bf16(v0[0], v0[1]); w.y = cvt_pk_bf16(v0[2], v0[3]); w.z = cvt_pk_bf16(v1[0], v1[1]); w.w = cvt_pk_bf16(v1[2], v1[3]);
                        *(u32x4*)(rowp + bj * HALF) = w; }
                    ss += __shfl_xor(ss, 16); ss += __shfl_xor(ss, 32);
                    if (fq == 0) sspart[(size_t)row * 32 + (u.pn - PN_V0) * 4 + wc] = ss; }
        }
    }
};
template <bool ADD> struct EpiGate {
    static constexpr bool PERM = true, AFTER_DRAIN = false;
    bf16_t* O; int ldc; const bf16_t* Mg; int ldm; const bf16_t* Prev;
    __device__ __forceinline__ void operator()(const f32x4 (&acc)[2][2][4][2], const Unit& u, int wr, int wc, int fr, int fq) const {
        const int row0 = u.pm * BM + wr * 64 + fr, col0 = u.pn * BM + wc * 32 + 8 * fq;
#pragma unroll
        for (int ai = 0; ai < 2; ++ai)
#pragma unroll
            for (int m = 0; m < 4; ++m) { const size_t row = (size_t)(row0 + ai * HALF + m * 16);
#pragma unroll
                for (int bj = 0; bj < 2; ++bj) { const f32x4 v0 = acc[ai][bj][m][0], v1 = acc[ai][bj][m][1];
                    const u32x4 mg = *(const u32x4*)(Mg + row * ldm + col0 + bj * HALF);
                    float r[8];
                    r[0] = v0[0] * fast_sigmoid(bf_lo(mg.x)); r[1] = v0[1] * fast_sigmoid(bf_hi(mg.x)); r[2] = v0[2] * fast_sigmoid(bf_lo(mg.y)); r[3] = v0[3] * fast_sigmoid(bf_hi(mg.y));
                    r[4] = v1[0] * fast_sigmoid(bf_lo(mg.z)); r[5] = v1[1] * fast_sigmoid(bf_hi(mg.z)); r[6] = v1[2] * fast_sigmoid(bf_lo(mg.w)); r[7] = v1[3] * fast_sigmoid(bf_hi(mg.w));
                    if (ADD) { const u32x4 pv = *(const u32x4*)(Prev + row * ldc + col0 + bj * HALF);
                        r[0] += bf_lo(pv.x); r[1] += bf_hi(pv.x); r[2] += bf_lo(pv.y); r[3] += bf_hi(pv.y); r[4] += bf_lo(pv.z); r[5] += bf_hi(pv.z); r[6] += bf_lo(pv.w); r[7] += bf_hi(pv.w); }
                    u32x4 w; w.x = cvt_pk_bf16(r[0], r[1]); w.y = cvt_pk_bf16(r[2], r[3]); w.z = cvt_pk_bf16(r[4], r[5]); w.w = cvt_pk_bf16(r[6], r[7]);
                    *(u32x4*)(O + row * ldc + col0 + bj * HALF) = w; } }
    }
};
struct EpiMerge {
    static constexpr bool PERM = true, AFTER_DRAIN = false;
    bf16_t* O; int ldc; const bf16_t* Ma; const bf16_t* Mb; int ldm;
    __device__ __forceinline__ void mid(f32x4 (&acc)[2][2][4][2], const Unit& u, int wr, int wc, int fr, int fq) const {
        const int row0 = u.pm * BM + wr * 64 + fr, col0 = u.pn * BM + wc * 32 + 8 * fq;
#pragma unroll
        for (int ai = 0; ai < 2; ++ai)
#pragma unroll
            for (int m = 0; m < 4; ++m) { const size_t row = (size_t)(row0 + ai * HALF + m * 16);
#pragma unroll
                for (int bj = 0; bj < 2; ++bj) { const u32x4 a = *(const u32x4*)(Ma + row * ldm + col0 + bj * HALF), b = *(const u32x4*)(Mb + row * ldm + col0 + bj * HALF);
                    const unsigned aw[4] = {a.x, a.y, a.z, a.w}, bw[4] = {b.x, b.y, b.z, b.w};
#pragma unroll
                    for (int e = 0; e < 4; ++e) {
                        const float r0 = (1.0f + __builtin_amdgcn_exp2f(-1.4426950408889634f * bf_lo(bw[e]))) * __builtin_amdgcn_rcpf(1.0f + __builtin_amdgcn_exp2f(-1.4426950408889634f * bf_lo(aw[e])));
                        const float r1 = (1.0f + __builtin_amdgcn_exp2f(-1.4426950408889634f * bf_hi(bw[e]))) * __builtin_amdgcn_rcpf(1.0f + __builtin_amdgcn_exp2f(-1.4426950408889634f * bf_hi(aw[e])));
                        acc[ai][bj][m][e >> 1][(e & 1) * 2] *= r0; acc[ai][bj][m][e >> 1][(e & 1) * 2 + 1] *= r1; } } }
    }
    __device__ __forceinline__ void operator()(const f32x4 (&acc)[2][2][4][2], const Unit& u, int wr, int wc, int fr, int fq) const {
        const int row0 = u.pm * BM + wr * 64 + fr, col0 = u.pn * BM + wc * 32 + 8 * fq;
#pragma unroll
        for (int ai = 0; ai < 2; ++ai)
#pragma unroll
            for (int m = 0; m < 4; ++m) { const size_t row = (size_t)(row0 + ai * HALF + m * 16);
#pragma unroll
                for (int bj = 0; bj < 2; ++bj) { const f32x4 v0 = acc[ai][bj][m][0], v1 = acc[ai][bj][m][1];
                    const u32x4 mg = *(const u32x4*)(Mb + row * ldm + col0 + bj * HALF);
                    u32x4 w; w.x = cvt_pk_bf16(v0[0] * fast_sigmoid(bf_lo(mg.x)), v0[1] * fast_sigmoid(bf_hi(mg.x))); w.y = cvt_pk_bf16(v0[2] * fast_sigmoid(bf_lo(mg.y)), v0[3] * fast_sigmoid(bf_hi(mg.y)));
                    w.z = cvt_pk_bf16(v1[0] * fast_sigmoid(bf_lo(mg.z)), v1[1] * fast_sigmoid(bf_hi(mg.z))); w.w = cvt_pk_bf16(v1[2] * fast_sigmoid(bf_lo(mg.w)), v1[3] * fast_sigmoid(bf_hi(mg.w)));
                    *(u32x4*)(O + row * ldc + col0 + bj * HALF) = w; } }
    }
};
struct EpiF32Plain {
    static constexpr bool PERM = false, AFTER_DRAIN = false;
    float* C; int ldc;
    __device__ __forceinline__ void operator()(const f32x4 (&acc)[2][2][4][2], const Unit& u, int wr, int wc, int fr, int fq) const {
        const int row0 = u.pm * BM + wr * 64 + fr, col0 = u.pn * BM + wc * 32 + 4 * fq;
#pragma unroll
        for (int ai = 0; ai < 2; ++ai)
#pragma unroll
            for (int m = 0; m < 4; ++m) { float* rowp = C + (size_t)(row0 + ai * HALF + m * 16) * ldc + col0;
#pragma unroll
                for (int bj = 0; bj < 2; ++bj)
#pragma unroll
                    for (int n = 0; n < 2; ++n) *(f32x4*)(rowp + bj * HALF + n * 16) = acc[ai][bj][m][n]; }
    }
};
struct ProjOrder : StaticOrder {
    int late, nearly, nlate;
    __host__ __device__ void init2(int M, int n_early, int n_late, int G_, int c_, int late_) { StaticOrder::init(M, n_early * BM, G_, c_); late = late_; nearly = n_early; nlate = n_late; }
    __host__ __device__ bool next(int i, Unit& u) const {
        if (!late) return StaticOrder::next(i, u);
        const long L = (long)i * G + c; if (L >= (long)nM * nlate) return false;
        u.pm = (int)(L % nM); u.pn = nearly + (int)(L / nM); u.sub = 0; return true;
    }
};
template <class Epi, class Sched, bool STAMP = false>
__device__ __forceinline__ void gemm_phase(PG8_LAS unsigned char* lds, const Gemm g, const Sched& S, const Epi& E, unsigned long long* stamps) {
    int tid_o = threadIdx.x; asm volatile("" : "+v"(tid_o));
    const int tid = tid_o, wid = __builtin_amdgcn_readfirstlane(tid >> 6), lane = tid & 63, wr = wid >> 2, wc = wid & 3, fr = lane & 15, fq = lane >> 4;
    const int K = g.K, nt = K / BK;
    int ts_lo = 0, ts_hi = 0, nts = 0; const unsigned long long rt_entry = STAMP ? (unsigned long long)wall_clock64() : 0ull;
#define PG8_STAMP() do { if (STAMP && wid == 0 && nts < 64) { const unsigned long long _c = (unsigned long long)clock64(); \
        ts_lo = (lane == nts) ? (int)(unsigned)_c : ts_lo; ts_hi = (lane == nts) ? (int)(unsigned)(_c >> 32) : ts_hi; ++nts; } } while (0)
    PG8_STAMP();
    unsigned voffA[2], voffB[2];
#pragma unroll
    for (int i = 0; i < 2; ++i) { int R, C; stage_rc(tid * 16 + i * 8192, R, C); const int Rb = Epi::PERM ? ((R & ~31) + perm32(R & 31)) : R;
        voffA[i] = (unsigned)(R * K + C) * 2u; voffB[i] = (unsigned)(Rb * K + C) * 2u; }
    const size_t kstep = (size_t)(BK * 2);
    const size_t hstep = (size_t)HALF * K * 2;
    const size_t tstep = 2 * hstep;
    const unsigned ldsw = (unsigned)wid * 1024u;
    const int aoff = lds_byte(wr * 64 + fr, fq * 8), boff = lds_byte(wc * 32 + fr, fq * 8);
#define PG8_SA(b, h) (((b) * 2 + (h)) * HTB)
#define PG8_SB(b, h) ((4 + (b) * 2 + (h)) * HTB)
#define PG8_STAGE(bufoff, gbase, voff) do { _Pragma("unroll") for (int _i = 0; _i < 2; ++_i) \
        __builtin_amdgcn_global_load_lds((const unsigned*)((const char*)(gbase) + (voff)[_i]), (PG8_LAS unsigned*)(lds + (bufoff) + ldsw + _i * 8192), 16, 0, 0); } while (0)
#define PG8_LDA(dst, b, h) do { _Pragma("unroll") for (int m = 0; m < 4; ++m) _Pragma("unroll") for (int k = 0; k < 2; ++k) dst[m][k] = *(const PG8_LAS bf16x8*)(lds + PG8_SA(b, h) + aoff + m * 2048 + k * 1024); } while (0)
#define PG8_LDB(dst, b, h) do { _Pragma("unroll") for (int n = 0; n < 2; ++n) _Pragma("unroll") for (int k = 0; k < 2; ++k) dst[n][k] = *(const PG8_LAS bf16x8*)(lds + PG8_SB(b, h) + boff + n * 2048 + k * 1024); } while (0)
#define PG8_MMA(ai, bj, At, Bt) do { __builtin_amdgcn_s_setprio(1); _Pragma("unroll") for (int m = 0; m < 4; ++m) _Pragma("unroll") for (int n = 0; n < 2; ++n) _Pragma("unroll") for (int k = 0; k < 2; ++k) \
        acc[ai][bj][m][n] = __builtin_amdgcn_mfma_f32_16x16x32_bf16(Bt[n][k], At[m][k], acc[ai][bj][m][n], 0, 0, 0); __builtin_amdgcn_s_setprio(0); } while (0)
#define PG8_WAIT_V(n) asm volatile("s_waitcnt vmcnt(" #n ")" ::: "memory")
#define PG8_WAIT_L(n) asm volatile("s_waitcnt lgkmcnt(" #n ")" ::: "memory")
#define PG8_BAR __builtin_amdgcn_s_barrier()
#define PG8_SCHED __builtin_amdgcn_sched_barrier(0)
    Unit cur, nxt; int ui = 0;
    if (!S.next(0, cur)) return;
    f32x4 acc[2][2][4][2];
#pragma unroll
    for (int a = 0; a < 2; ++a)
#pragma unroll
        for (int b = 0; b < 2; ++b)
#pragma unroll
            for (int m = 0; m < 4; ++m)
#pragma unroll
                for (int n = 0; n < 2; ++n) acc[a][b][m][n] = (f32x4){0.f, 0.f, 0.f, 0.f};
    bf16x8 At[4][2], B0[2][2], B1[2][2];
    const char* cA = (const char*)S.baseA(g, cur) + (size_t)cur.pm * tstep; const char* cB = (const char*)S.baseB(g, cur) + (size_t)cur.pn * tstep;
    S.a_ready(cur);
    PG8_STAGE(PG8_SB(0, 0), cB, voffB); PG8_STAGE(PG8_SA(0, 0), cA, voffA); PG8_STAGE(PG8_SB(0, 1), cB + hstep, voffB); PG8_STAGE(PG8_SA(0, 1), cA + hstep, voffA);
    if (wr == 1) PG8_BAR;
    PG8_WAIT_V(4); PG8_BAR;
    PG8_STAGE(PG8_SB(1, 0), cB + kstep, voffB); PG8_STAGE(PG8_SA(1, 0), cA + kstep, voffA); PG8_STAGE(PG8_SB(1, 1), cB + hstep + kstep, voffB);
    PG8_WAIT_V(6); PG8_BAR;
    PG8_STAMP();
    for (;;) {
        const bool has_next = S.next(ui + 1, nxt);
        const char* nA = has_next ? (const char*)S.baseA(g, nxt) + (size_t)nxt.pm * tstep : cA; const char* nB = has_next ? (const char*)S.baseB(g, nxt) + (size_t)nxt.pn * tstep : cB;
        for (int t = 0; t < nt; t += 2) {
            const bool last = (t == nt - 2);
            const char* a1 = cA + (size_t)(t + 1) * kstep;
            const char* a2 = last ? nA : cA + (size_t)(t + 2) * kstep; const char* b2 = last ? nB : cB + (size_t)(t + 2) * kstep;
            const char* a3 = a2 + kstep; const char* b3 = b2 + kstep;
            if (last && has_next) S.a_ready(nxt);
            PG8_LDB(B0, 0, 0); PG8_SCHED; PG8_LDA(At, 0, 0); PG8_STAGE(PG8_SA(1, 1), a1 + hstep, voffA);
            PG8_WAIT_L(8); PG8_BAR; PG8_WAIT_L(0); PG8_MMA(0, 0, At, B0); PG8_BAR; PG8_SCHED;
            PG8_LDB(B1, 0, 1); PG8_STAGE(PG8_SB(0, 0), b2, voffB);
            PG8_BAR; PG8_WAIT_L(0); PG8_MMA(0, 1, At, B1); PG8_BAR;
            PG8_LDA(At, 0, 1); PG8_STAGE(PG8_SA(0, 0), a2, voffA);
            PG8_BAR; PG8_WAIT_L(0); PG8_MMA(1, 0, At, B0); PG8_BAR; PG8_SCHED;
            PG8_STAGE(PG8_SB(0, 1), b2 + hstep, voffB);
            PG8_WAIT_V(6); PG8_BAR; PG8_MMA(1, 1, At, B1); PG8_BAR;
            PG8_LDB(B0, 1, 0); PG8_SCHED; PG8_LDA(At, 1, 0); PG8_STAGE(PG8_SA(0, 1), a2 + hstep, voffA);
            PG8_WAIT_L(8); PG8_BAR; PG8_WAIT_L(0); PG8_MMA(0, 0, At, B0); PG8_BAR; PG8_SCHED;
            PG8_LDB(B1, 1, 1); PG8_STAGE(PG8_SB(1, 0), b3, voffB);
            PG8_BAR; PG8_WAIT_L(0); PG8_MMA(0, 1, At, B1); PG8_BAR;
            PG8_LDA(At, 1, 1); PG8_STAGE(PG8_SA(1, 0), a3, voffA);
            PG8_BAR; PG8_WAIT_L(0); PG8_MMA(1, 0, At, B0); PG8_BAR; PG8_SCHED;
            PG8_STAGE(PG8_SB(1, 1), b3 + hstep, voffB);
            PG8_WAIT_V(6); PG8_BAR; PG8_MMA(1, 1, At, B1); PG8_BAR;
        }
        PG8_STAMP();
        bool keep_acc = false;
        if constexpr (Sched::DUAL) { if (cur.sub == 0) { E.mid(acc, cur, wr, wc, fr, fq); keep_acc = true; } else E(acc, cur, wr, wc, fr, fq); }
        else if constexpr (!Epi::AFTER_DRAIN) { E(acc, cur, wr, wc, fr, fq); S.done(cur); }
        PG8_STAMP();
        if (!has_next) break;
        if (!keep_acc)
#pragma unroll
        for (int a = 0; a < 2; ++a)
#pragma unroll
            for (int b = 0; b < 2; ++b)
#pragma unroll
                for (int m = 0; m < 4; ++m)
#pragma unroll
                    for (int n = 0; n < 2; ++n) acc[a][b][m][n] = (f32x4){0.f, 0.f, 0.f, 0.f};
        cur = nxt; cA = nA; cB = nB; ++ui;
    }
    PG8_WAIT_V(0);
    if (wr == 0) PG8_BAR;
    PG8_BAR;
    if constexpr (Epi::AFTER_DRAIN) { E.fused(acc, cur, wr, wc, fr, fq, lds, wid, lane); S.done(cur); }
    PG8_STAMP();
    if (STAMP && wid == 0) { stamps[lane] = lane < nts ? (((unsigned long long)(unsigned)ts_hi << 32) | (unsigned)ts_lo) : 0ull;
        if (lane == 62) stamps[62] = rt_entry; if (lane == 63) stamps[63] = (unsigned long long)wall_clock64(); }
#undef PG8_STAMP
#undef PG8_SA
#undef PG8_SB
#undef PG8_STAGE
#undef PG8_LDA
#undef PG8_LDB
#undef PG8_MMA
#undef PG8_WAIT_V
#undef PG8_WAIT_L
#undef PG8_BAR
#undef PG8_SCHED
}
}

#define XB_TMO      128
#define XB_XCNT(j)  (256  + 64 * (j))
#define XB_XSUB(j)  (1280 + 64 * (j))
#define XB_XGEN(j)  (2304 + 64 * (j))
#define XB_TOP      3328
#define XB_TOPGEN   3392
#define XCD_BAR_WORDS 3456
#define XB_SPIN_CAP (1u << 18)
#define LAS __attribute__((address_space(3)))

__device__ __forceinline__ unsigned xb_ld(unsigned* p)              { return __hip_atomic_load(p, __ATOMIC_RELAXED, __HIP_MEMORY_SCOPE_AGENT); }
__device__ __forceinline__ unsigned xb_add(unsigned* p, unsigned v) { return __hip_atomic_fetch_add(p, v, __ATOMIC_RELAXED, __HIP_MEMORY_SCOPE_AGENT); }
__device__ __forceinline__ unsigned xb_xcc_id() { return (unsigned)__builtin_amdgcn_s_getreg((3 << 11) | 20) & 0xFu; }
#define XB_SPIN(cond, bar) do { unsigned _sp = 0; while (cond) { __builtin_amdgcn_s_sleep(1); \
    if ((++_sp & 255u) == 0u) { if (xb_ld(&(bar)[XB_TMO])) break; if (_sp > XB_SPIN_CAP) { atomicAdd(&(bar)[XB_TMO], 1u); break; } } } } while (0)

struct XcdBarrier {
    unsigned* bar; unsigned x;
    volatile LAS unsigned* st;
};

__device__ __forceinline__ XcdBarrier xcd_barrier_post(unsigned* bar, volatile LAS unsigned* st) {
    XcdBarrier b; b.bar = bar; b.x = xb_xcc_id(); b.st = st;
    if (threadIdx.x == 0) (void)xb_add(&bar[XB_XCNT(b.x)], 1u);
    return b;
}
__device__ __forceinline__ void xcd_barrier_complete(unsigned* bar, unsigned x, unsigned& nloc, unsigned& nx) {
    const unsigned G = gridDim.x * gridDim.y * gridDim.z;
    unsigned sum, cnt, mine, sp = 0u;
    for (;;) {
        sum = 0u; cnt = 0u; mine = 0u;
#pragma unroll
        for (unsigned j = 0; j < 16; ++j) { const unsigned c = xb_ld(&bar[XB_XCNT(j)]); sum += c; cnt += (c > 0u) ? 1u : 0u; mine = (j == x) ? c : mine; }
        if (sum == G) break;
        __builtin_amdgcn_s_sleep(1);
        if ((++sp & 255u) == 0u) { if (xb_ld(&bar[XB_TMO])) break; if (sp > XB_SPIN_CAP) { atomicAdd(&bar[XB_TMO], 1u); break; } }
    }
    nloc = mine > 0u ? mine : 1u; nx = cnt > 0u ? cnt : 1u;
}

__device__ __forceinline__ void xcd_barrier(const XcdBarrier& b) {
    asm volatile("s_waitcnt vmcnt(0)" ::: "memory");
    __syncthreads();
    if (threadIdx.x == 0) {
        unsigned* bar = b.bar;
        __builtin_amdgcn_s_waitcnt(0);
        unsigned nloc = b.st[0], nx = b.st[1];
        if (nloc == 0u) { xcd_barrier_complete(bar, b.x, nloc, nx); b.st[0] = nloc; b.st[1] = nx; }
        const unsigned old = xb_add(&bar[XB_XSUB(b.x)], 1u);
        const unsigned gen = old / nloc;
        if (old + 1u == (gen + 1u) * nloc) {
            __builtin_amdgcn_fence(__ATOMIC_RELEASE, "agent");
            asm volatile("s_waitcnt vmcnt(0)" ::: "memory");
            const unsigned og = xb_add(&bar[XB_TOP], 1u);
            const unsigned tg = og / nx;
            if (og + 1u == (tg + 1u) * nx) xb_add(&bar[XB_TOPGEN], 1u);
            else XB_SPIN(xb_ld(&bar[XB_TOPGEN]) == tg, bar);
            __builtin_amdgcn_fence(__ATOMIC_ACQUIRE, "agent");
            xb_add(&bar[XB_XGEN(b.x)], 1u);
            asm volatile("s_waitcnt vmcnt(0)" ::: "memory");
        } else {
            XB_SPIN(xb_ld(&bar[XB_XGEN(b.x)]) == gen, bar);
            __builtin_amdgcn_fence(__ATOMIC_ACQUIRE, "agent");
            asm volatile("s_waitcnt vmcnt(0)" ::: "memory");
        }
    }
    __syncthreads();
}
typedef pg8::bf16_t bf16_t;
typedef short bf16x8 __attribute__((ext_vector_type(8)));
typedef short s16x4 __attribute__((ext_vector_type(4)));
typedef float f32x4 __attribute__((ext_vector_type(4)));
typedef float f32x16 __attribute__((ext_vector_type(16)));
typedef unsigned u32x4 __attribute__((ext_vector_type(4)));
typedef unsigned u32x2 __attribute__((ext_vector_type(2)));
constexpr int T = 8192, DM = 4096, NIN = 21552, NP = 21760, DEPTH = 2, NWAVES = 8, NTHREADS = 512;
constexpr int C_Q = 0, C_KV = 2048, C_ZA = 5120, C_UB = 7168, C_VB = 9216, C_ZB = 11264, C_MA = 13312, C_MB = 17408, C_GA = 21504;
constexpr int AW = 2048, BW = 2048, HD = 128, NCMP = 511, NCP = 512;
constexpr float NORM_EPS = 1e-6f;
constexpr size_t al256(size_t x) { return (x + 255) & ~(size_t)255; }
constexpr size_t WS_CTL = 0, CTL_BYTES = 1u << 20;
constexpr size_t SZ_WIN = (size_t)NP * DM * 2, SZ_WAB = (size_t)DM * AW * 2, SZ_WO = (size_t)DM * DM * 2, SZ_W1 = (size_t)HD * 4096 * 2, SZ_W2 = (size_t)HD * HD * 2;
constexpr size_t WS_WIN = WS_CTL + CTL_BYTES;
constexpr size_t WS_WA = WS_WIN + DEPTH * SZ_WIN;
constexpr size_t WS_WB = WS_WA + DEPTH * SZ_WAB;
constexpr size_t WS_WO = WS_WB + DEPTH * SZ_WAB;
constexpr size_t WS_W1 = WS_WO + DEPTH * SZ_WO;
constexpr size_t WS_W2 = WS_W1 + DEPTH * 2 * SZ_W1;
constexpr size_t WS_H = al256(WS_W2 + DEPTH * 2 * SZ_W2);
constexpr size_t WS_PROJ = WS_H + (size_t)T * DM * 2;
constexpr size_t WS_KC = WS_PROJ + (size_t)T * NP * 2;
constexpr size_t WS_VC = WS_KC + (size_t)NCP * 512 * 2;
constexpr size_t WS_OA = WS_VC + (size_t)NCP * 512 * 2;
constexpr size_t WS_OB = WS_OA + (size_t)T * AW * 2;
constexpr size_t WS_T1 = WS_OB + (size_t)T * BW * 2;
constexpr size_t WS_MG = WS_T1 + (size_t)T * DM * 2;
constexpr size_t WS_Y = WS_MG + (size_t)T * DM * 2;
constexpr size_t WS_X1 = WS_Y + (size_t)T * DM * 4;
constexpr size_t WS_SS = WS_X1 + (size_t)T * DM * 4;
constexpr size_t WS_PARK = WS_SS + (size_t)T * 32 * 4;
constexpr size_t WS_END = WS_PARK + (size_t)1024 * 32 * 512 * 16;
constexpr int LDS_STAGE = 0;
constexpr int LDS_BIAS = 131072;
constexpr int LDS_MISC = LDS_BIAS + 16 * 256 * 4;
constexpr int LDS_RS = LDS_MISC + 64;
constexpr int LDS_ATT = LDS_RS + 512;
constexpr int LDS_BYTES = LDS_ATT + 8192;
static_assert(LDS_BYTES <= 160 * 1024, "LDS");
#define LAS3 __attribute__((address_space(3)))
#define LDS_WAIT() asm volatile("s_waitcnt lgkmcnt(0)" ::: "memory")
#define VM_WAIT() asm volatile("s_waitcnt vmcnt(0)" ::: "memory")

struct Params {
    const float *x, *rel_bias, *pre_norm, *w_in, *pe_k, *w1_k, *w2_k, *pe_v, *w1_v, *w2_v, *w_out_a, *sgu_norm, *sgu_w, *sgu_b, *w_out_b, *w_out, *post_norm;
    float* out; unsigned char* ws; int ph_lo, ph_hi;
};
__device__ __forceinline__ unsigned pk2(float lo, float hi) { return pg8::cvt_pk_bf16(lo, hi); }
__device__ __forceinline__ float wave_sum(float v) {
#pragma unroll
    for (int o = 1; o < 64; o <<= 1) v += __shfl_xor(v, o);
    return v;
}
__device__ const unsigned char BUCKET[128] = {0, 1, 2, 3, 4, 5, 6, 7, 8, 9, 10, 11, 12, 13, 14, 15, 16, 16, 16, 17, 17, 18, 18, 18, 19, 19, 19, 20, 20, 20, 20, 21, 21, 21, 21, 22, 22, 22, 22, 22, 23, 23, 23, 23, 23, 23, 24, 24, 24, 24, 24, 24, 25, 25, 25, 25, 25, 25, 25, 26, 26, 26, 26, 26, 26, 26, 26, 27, 27, 27, 27, 27, 27, 27, 27, 27, 27, 28, 28, 28, 28, 28, 28, 28, 28, 28, 28, 29, 29, 29, 29, 29, 29, 29, 29, 29, 29, 29, 29, 30, 30, 30, 30, 30, 30, 30, 30, 30, 30, 30, 30, 30, 30, 31, 31, 31, 31, 31, 31, 31, 31, 31, 31, 31, 31, 31, 31, 31};

constexpr int W_ITEMS_PER_LAYER = 64 * (NP / 64) + 2 * 32 * 64 + 64 * 64 + 2 * 64 * 2 + 2 * 2 * 2;
constexpr int W_ITEMS = DEPTH * W_ITEMS_PER_LAYER;
constexpr int W_TAIL_ITEMS = 0;
__device__ __forceinline__ int srcmap_in(int n) { return n < 5120 ? n : (n < 21504 ? n + 48 : (n < 21552 ? n - 21504 + 5120 : -1)); }
template <int MODE>
__device__ __forceinline__ void transpose_item(const float* __restrict__ W, int K, int N, bf16_t* __restrict__ WT, LAS3 float* scr, int item, int nblk, int lane) {
    int kb, nb;
    if ((nblk & 3) == 0) { const int g8 = item >> 3, sub = item & 7, q = nblk >> 2; const int gk = g8 / q, gn = g8 - gk * q; nb = gn * 4 + (sub & 3); kb = gk * 2 + (sub >> 2); }
    else { kb = item / nblk; nb = item - kb * nblk; }
    const int k0 = 64 * kb, n0 = 64 * nb;
    const int nn = n0 + 4 * (lane & 15); const int s = (MODE == 1) ? srcmap_in(nn) : nn;
    const float* src = W + (size_t)(k0 + (lane >> 4)) * N + (s >= 0 ? s : 0);
    f32x4 v[16];
#pragma unroll
    for (int i = 0; i < 16; ++i) v[i] = *(const f32x4*)(src + (size_t)(4 * i) * N);
    __builtin_amdgcn_sched_barrier(0);
#pragma unroll
    for (int i = 0; i < 16; ++i) { f32x4 x = v[i]; if (s < 0) x = (f32x4){0.f, 0.f, 0.f, 0.f};
        LAS3 float* d = scr + (4 * i + (lane >> 4)) * 65 + 4 * (lane & 15); d[0] = x[0]; d[1] = x[1]; d[2] = x[2]; d[3] = x[3]; }
    LDS_WAIT();
    const int c = lane & 7;
#pragma unroll
    for (int j = 0; j < 8; ++j) { const int n = (lane >> 3) + 8 * j; const LAS3 float* p = scr + (8 * c) * 65 + n;
        u32x4 o; o.x = pk2(p[0 * 65], p[1 * 65]); o.y = pk2(p[2 * 65], p[3 * 65]); o.z = pk2(p[4 * 65], p[5 * 65]); o.w = pk2(p[6 * 65], p[7 * 65]);
        if (MODE == 2) { const int k8 = (k0 >> 3) + c, na = n0 + n; *(u32x4*)(WT + (size_t)((((k8 >> 1) * (N >> 5) + (na >> 5)) * 64) + (k8 & 1) * 32 + (na & 31)) * 8) = o; }
        else *(u32x4*)(WT + (size_t)(n0 + n) * K + k0 + 8 * c) = o; }
    LDS_WAIT();
}
__device__ __forceinline__ void phase_weights(const Params& P, LAS3 unsigned char* lds, int gw, int NGW, int wave, int lane, int it_lo, int it_hi) {
    asm volatile("" : "+v"(lane));
    LAS3 float* scr = (LAS3 float*)(lds + LDS_STAGE + wave * 16640);
    constexpr int I_IN = 64 * (NP / 64), I_AB = 32 * 64, I_O = 64 * 64, I_W1 = 64 * 2, I_W2 = 2 * 2;
    constexpr int PER_LAYER = I_IN + 2 * I_AB + I_O + 2 * I_W1 + 2 * I_W2;
    static_assert(PER_LAYER == W_ITEMS_PER_LAYER, "item count");
    for (int it = it_lo + gw; it < it_hi; it += NGW) {
        const int L = it / PER_LAYER; int r = it - L * PER_LAYER;
        unsigned char* ws = P.ws;
        if (r < I_IN) { transpose_item<1>(P.w_in + (size_t)L * DM * NIN, DM, NIN, (bf16_t*)(ws + WS_WIN + L * SZ_WIN), scr, r, NP / 64, lane); continue; } r -= I_IN;
        if (r < I_AB) { transpose_item<0>(P.w_out_a + (size_t)L * AW * DM, AW, DM, (bf16_t*)(ws + WS_WA + L * SZ_WAB), scr, r, 64, lane); continue; } r -= I_AB;
        if (r < I_AB) { transpose_item<0>(P.w_out_b + (size_t)L * BW * DM, BW, DM, (bf16_t*)(ws + WS_WB + L * SZ_WAB), scr, r, 64, lane); continue; } r -= I_AB;
        if (r < I_O) { transpose_item<0>(P.w_out + (size_t)L * DM * DM, DM, DM, (bf16_t*)(ws + WS_WO + L * SZ_WO), scr, r, 64, lane); continue; } r -= I_O;
        if (r < I_W1) { transpose_item<2>(P.w1_k + (size_t)L * 4096 * HD, 4096, HD, (bf16_t*)(ws + WS_W1 + (L * 2 + 0) * SZ_W1), scr, r, 2, lane); continue; } r -= I_W1;
        if (r < I_W1) { transpose_item<2>(P.w1_v + (size_t)L * 4096 * HD, 4096, HD, (bf16_t*)(ws + WS_W1 + (L * 2 + 1) * SZ_W1), scr, r, 2, lane); continue; } r -= I_W1;
        if (r < I_W2) { transpose_item<0>(P.w2_k + (size_t)L * HD * HD, HD, HD, (bf16_t*)(ws + WS_W2 + (L * 2 + 0) * SZ_W2), scr, r, 2, lane); continue; } r -= I_W2;
        transpose_item<0>(P.w2_v + (size_t)L * HD * HD, HD, HD, (bf16_t*)(ws + WS_W2 + (L * 2 + 1) * SZ_W2), scr, r, 2, lane);
    }
}
__device__ __forceinline__ void phase_prenorm(const float* __restrict__ x, const float* __restrict__ g, bf16_t* __restrict__ h, int gw, int NGW, int lane) {
    asm volatile("" : "+v"(lane));
#pragma unroll 2
    for (int m = gw; m < T; m += NGW) {
        const f32x4* xr = (const f32x4*)(x + (size_t)m * DM) + lane; f32x4 v[16]; float ss = 0.f;
#pragma unroll
        for (int j = 0; j < 16; ++j) { v[j] = xr[64 * j]; ss += (v[j][0] * v[j][0] + v[j][1] * v[j][1]) + (v[j][2] * v[j][2] + v[j][3] * v[j][3]); }
        const float rs = 1.0f / sqrtf(wave_sum(ss) * (1.0f / DM) + NORM_EPS);
        u32x2* o = (u32x2*)(h + (size_t)m * DM) + lane; const f32x4* gr = (const f32x4*)g + lane;
#pragma unroll
        for (int j = 0; j < 16; ++j) { const f32x4 gg = gr[64 * j]; u32x2 w; w.x = pk2(v[j][0] * rs * gg[0], v[j][1] * rs * gg[1]); w.y = pk2(v[j][2] * rs * gg[2], v[j][3] * rs * gg[3]); o[64 * j] = w; }
    }
}
template <bool XOLD_BF16, bool XNEW_BF16>
__device__ __forceinline__ void phase_postnorm(const bf16_t* __restrict__ Y, const void* __restrict__ xold, const float* __restrict__ gpost, void* __restrict__ xnew,
                                               const float* __restrict__ gpre, bf16_t* __restrict__ h, bool next, int gw, int NGW, int lane) {
    asm volatile("" : "+v"(lane));
#pragma unroll 2
    for (int m = gw; m < T; m += NGW) {
        const u32x2* yr = (const u32x2*)(Y + (size_t)m * DM) + lane; f32x4 v[16]; float ss = 0.f;
#pragma unroll
        for (int j = 0; j < 16; ++j) { const u32x2 w = yr[64 * j]; v[j] = (f32x4){pg8::bf_lo(w.x), pg8::bf_hi(w.x), pg8::bf_lo(w.y), pg8::bf_hi(w.y)}; ss += (v[j][0] * v[j][0] + v[j][1] * v[j][1]) + (v[j][2] * v[j][2] + v[j][3] * v[j][3]); }
        const float rs = 1.0f / sqrtf(wave_sum(ss) * (1.0f / DM) + NORM_EPS);
        const f32x4* gr = (const f32x4*)gpost + lane;
        float s2 = 0.f;
#pragma unroll
        for (int j = 0; j < 16; ++j) { const f32x4 gg = gr[64 * j]; f32x4 xx;
            if (XOLD_BF16) { const u32x2 w = ((const u32x2*)((const bf16_t*)xold + (size_t)m * DM) + lane)[64 * j]; xx = (f32x4){pg8::bf_lo(w.x), pg8::bf_hi(w.x), pg8::bf_lo(w.y), pg8::bf_hi(w.y)}; }
            else xx = ((const f32x4*)((const float*)xold + (size_t)m * DM) + lane)[64 * j];
            const f32x4 r = xx + v[j] * rs * gg; v[j] = r;
            if (XNEW_BF16) { u32x2 w; w.x = pk2(r[0], r[1]); w.y = pk2(r[2], r[3]); ((u32x2*)((bf16_t*)xnew + (size_t)m * DM) + lane)[64 * j] = w; }
            else ((f32x4*)((float*)xnew + (size_t)m * DM) + lane)[64 * j] = r;
            s2 += (r[0] * r[0] + r[1] * r[1]) + (r[2] * r[2] + r[3] * r[3]); }
        if (next) {
            const float rs2 = 1.0f / sqrtf(wave_sum(s2) * (1.0f / DM) + NORM_EPS);
            u32x2* o = (u32x2*)(h + (size_t)m * DM) + lane; const f32x4* g2 = (const f32x4*)gpre + lane;
#pragma unroll
            for (int j = 0; j < 16; ++j) { const f32x4 gg = g2[64 * j]; u32x2 w; w.x = pk2(v[j][0] * rs2 * gg[0], v[j][1] * rs2 * gg[1]); w.y = pk2(v[j][2] * rs2 * gg[2], v[j][3] * rs2 * gg[3]); o[64 * j] = w; }
        }
    }
}
namespace att {
constexpr float SCALE = 0.08838834764831845f, LOG2E = 1.4426950408889634f, C2 = SCALE * LOG2E;
constexpr int SHM = 16384;
constexpr int NSLOT = 3;
constexpr int L_V = 0, L_K = NSLOT * SHM, L_IMP = 2 * NSLOT * SHM, L_SEL = LDS_ATT, L_WS = L_SEL + 1024, L_SC = L_WS + 2048, L_END = L_SC + 4096;
static_assert(L_IMP + 32768 <= 131072 && L_END <= LDS_ATT + 8192, "attention LDS");
#define KSWZ(row, colB) ((row) * 256 + ((colB) ^ (((row) & 7) << 4)))
#define SBAR() __builtin_amdgcn_sched_barrier(0)
__device__ __forceinline__ int v_st(int k, int c) { const int kk = (k & ~0xC) | ((k & 4) << 1) | ((k & 8) >> 1); return ((kk >> 3) * 4 + (c >> 5)) * 512 + ((kk & 7) * 32 + (c & 31)) * 2; }
__device__ __forceinline__ int v_rd_base(int lane) { return ((lane & 3) << 3) | (((lane >> 2) & 3) << 6) | (((lane >> 4) & 1) << 5) | (((lane >> 5) & 1) << 8); }
constexpr int v_rd_off(int d0, int ks, int half) { return d0 * 512 + ks * 4096 + half * 2048; }
__device__ __forceinline__ int crow(int r, int hi) { return (r & 3) + 8 * (r >> 2) + 4 * hi; }
__device__ __forceinline__ unsigned cvtpk(float lo, float hi) { return pg8::cvt_pk_bf16(lo, hi); }
enum { MODE_STAT = 0, MODE_IMP = 1, MODE_ONLINE = 2, MODE_ACC = 3, MODE_IMPACC = 4 };
#ifndef PP_STAT
#define PP_STAT false
#endif
#ifndef PP_ACC
#define PP_ACC false
#endif

struct Ctx {
    bf16x8 qr[8]; f32x16 o[4];
    int tq, r32, hi, wid, lane, tid, t0;
    const LAS3 float* tb; float bfar;
    LAS3 char* lds;
};
__device__ __forceinline__ void qkt(f32x16& p0, f32x16& p1, const LAS3 char* Kt, int r32, int hi, const bf16x8* qr) {
    p0 = f32x16{}; p1 = f32x16{};
    const LAS3 char* kb[4];
#pragma unroll
    for (int dd = 0; dd < 4; ++dd) kb[dd] = Kt + KSWZ(r32, (dd * 16 + hi * 8) * 2);
#pragma unroll
    for (int d0 = 0; d0 < 8; ++d0) { const LAS3 char* a = kb[d0 & 3] + (d0 >> 2) * 128;
        const bf16x8 b0 = *reinterpret_cast<const LAS3 bf16x8*>(a);
        const bf16x8 b1 = *reinterpret_cast<const LAS3 bf16x8*>(a + 32 * 256);
        p0 = __builtin_amdgcn_mfma_f32_32x32x16_bf16(b0, qr[d0], p0, 0, 0, 0);
        p1 = __builtin_amdgcn_mfma_f32_32x32x16_bf16(b1, qr[d0], p1, 0, 0, 0);
        if ((d0 & 3) == 3) SBAR(); }
}
__device__ __forceinline__ void pv_tile(f32x16* o, int vb0, bf16x8 pa0, bf16x8 pa1, bf16x8 pa2, bf16x8 pa3) {
#define TRRD(dst, off) asm volatile("ds_read_b64_tr_b16 %0, %1 offset:%2" : "=&v"(dst) : "v"(vb0), "i"(off) : "memory")
#define PV_KS(ks, PA) do { s16x4 l0, l1, l2, l3, h0, h1, h2, h3; constexpr int b_ = v_rd_off(0, ks, 0); \
        TRRD(l0, b_); TRRD(h0, b_ + 2048); TRRD(l1, b_ + 512); TRRD(h1, b_ + 512 + 2048); TRRD(l2, b_ + 1024); TRRD(h2, b_ + 1024 + 2048); TRRD(l3, b_ + 1536); TRRD(h3, b_ + 1536 + 2048); \
        asm volatile("s_waitcnt lgkmcnt(0)" ::: "memory"); SBAR(); \
        o[0] = __builtin_amdgcn_mfma_f32_32x32x16_bf16(PA, (bf16x8){l0[0], l0[1], l0[2], l0[3], h0[0], h0[1], h0[2], h0[3]}, o[0], 0, 0, 0); \
        o[1] = __builtin_amdgcn_mfma_f32_32x32x16_bf16(PA, (bf16x8){l1[0], l1[1], l1[2], l1[3], h1[0], h1[1], h1[2], h1[3]}, o[1], 0, 0, 0); \
        o[2] = __builtin_amdgcn_mfma_f32_32x32x16_bf16(PA, (bf16x8){l2[0], l2[1], l2[2], l2[3], h2[0], h2[1], h2[2], h2[3]}, o[2], 0, 0, 0); \
        o[3] = __builtin_amdgcn_mfma_f32_32x32x16_bf16(PA, (bf16x8){l3[0], l3[1], l3[2], l3[3], h3[0], h3[1], h3[2], h3[3]}, o[3], 0, 0, 0); } while (0)
    PV_KS(0, pa0); PV_KS(1, pa1); PV_KS(2, pa2); PV_KS(3, pa3);
#undef PV_KS
#undef TRRD
}
__device__ __forceinline__ void pack_p(const f32x16& p0, const f32x16& p1, bf16x8& pa0, bf16x8& pa1, bf16x8& pa2, bf16x8& pa3) {
#define PK4(P, B_, OUT) do { u32x4 w = {cvtpk(P[B_+0], P[B_+1]), cvtpk(P[B_+2], P[B_+3]), cvtpk(P[B_+4], P[B_+5]), cvtpk(P[B_+6], P[B_+7])}; OUT = *reinterpret_cast<bf16x8*>(&w); } while (0)
    PK4(p0, 0, pa0); PK4(p0, 8, pa1); PK4(p1, 0, pa2); PK4(p1, 8, pa3);
#undef PK4
}
__device__ __forceinline__ float half_max(float v) { auto rr = __builtin_amdgcn_permlane32_swap(__float_as_uint(v), __float_as_uint(v), false, false); return fmaxf(__uint_as_float(rr[0]), __uint_as_float(rr[1])); }
__device__ __forceinline__ float half_sum(float v) { auto rr = __builtin_amdgcn_permlane32_swap(__float_as_uint(v), __float_as_uint(v), false, false); return __uint_as_float(rr[0]) + __uint_as_float(rr[1]); }

template <int MODE, int STEP, int OFF, bool ROWSEL, bool PP>
__device__ __forceinline__ void run_pass(Ctx& c, const bf16_t* __restrict__ Kg, const bf16_t* __restrict__ Vg, const int ldk, const int j_lo, const int j_hi, const unsigned W,
                                         float& m_reg, float& l_reg, const float pscale, unsigned sm0, unsigned sm1, unsigned sm2, unsigned sm3, const float gate = 1.f, const bool rev = false) {
    constexpr bool HASV = (MODE == MODE_ONLINE || MODE == MODE_ACC || MODE == MODE_IMPACC), RUNMAX = (MODE == MODE_ONLINE || MODE == MODE_STAT);
    int tid = c.tid, r32 = c.r32, hi = c.hi, lane = c.lane;
    asm volatile("" : "+v"(tid), "+v"(r32), "+v"(hi), "+v"(lane));
    const int n = j_hi - j_lo + 1;
    if (n <= 0) return;
    LAS3 char* V_lds = c.lds + L_V; LAS3 char* K_lds = c.lds + L_K;
    LAS3 float* al_l = (LAS3 float*)(c.lds + L_WS) + c.wid * 64 + 32;
    const int krow = tid >> 4;
    const unsigned ko0 = (unsigned)(krow * ldk + (((tid & 15) ^ (krow & 7)) * 8)) * 2u;
    const int vkk = ((tid >> 7) * 8) + ((tid & 31) >> 2), vkey = vkk, vcol = ((tid >> 5) & 3) * 32 + (tid & 3) * 8;
    const unsigned vo0 = (unsigned)(vkey * ldk + vcol) * 2u;
    const unsigned half_step = (unsigned)(32 * ldk) * 2u;
    const int vbase = (int)(uintptr_t)V_lds + v_rd_base(lane);
#define LOADT(j, bf) do { const char* kp_ = (const char*)(Kg + (size_t)((j) * 64) * ldk); LAS3 char* kd_ = K_lds + (bf) * SHM + c.wid * 1024; \
        __builtin_amdgcn_global_load_lds((const unsigned*)(kp_ + ko0), (LAS3 unsigned*)kd_, 16, 0, 0); \
        __builtin_amdgcn_global_load_lds((const unsigned*)((kp_ + half_step) + ko0), (LAS3 unsigned*)(kd_ + 8192), 16, 0, 0); \
        if (HASV) { const char* vp_ = (const char*)(Vg + (size_t)((j) * 64) * ldk); LAS3 char* vd_ = V_lds + (bf) * SHM + c.wid * 1024; \
            __builtin_amdgcn_global_load_lds((const unsigned*)(vp_ + vo0), (LAS3 unsigned*)vd_, 16, 0, 0); \
            __builtin_amdgcn_global_load_lds((const unsigned*)((vp_ + half_step) + vo0), (LAS3 unsigned*)(vd_ + 8192), 16, 0, 0); } } while (0)
#define WAIT_OLDER(younger) do { if (younger) { if (HASV) asm volatile("s_waitcnt vmcnt(4)" ::: "memory"); else asm volatile("s_waitcnt vmcnt(2)" ::: "memory"); } else VM_WAIT(); } while (0)
#define STEP_END(oddstep, ldt) do { if (oddstep) WAIT_OLDER(ldt); LDS_WAIT(); __builtin_amdgcn_s_barrier(); asm volatile("" ::: "memory"); } while (0)
#define TJ(t_) (rev ? j_hi - (t_) : j_lo + (t_))
    LOADT(TJ(0), 0); if (n > 1) LOADT(TJ(1), 1);
    WAIT_OLDER(n > 1);
    __builtin_amdgcn_s_barrier(); asm volatile("" ::: "memory");
    const int role = PP ? (c.wid >> 2) : 0, tqw = c.t0 + 8 * c.wid;
    const float NEG = -__builtin_inff();
    const float lp = RUNMAX ? 0.f : __builtin_amdgcn_logf(pscale);
    if (PP && role == 1) { __builtin_amdgcn_s_barrier(); asm volatile("" ::: "memory"); }
    int slot = 0;
#pragma unroll 1
    for (int t = 0; t < n; ++t) {
        const int j = TJ(t);
        const bool ldt = (t + 2 < n); const int lslot = slot == 0 ? 2 : slot - 1;
        if ((!PP || role == 1) && ldt) LOADT(TJ(t + 2), lslot);
        f32x16 p0, p1; float mul = C2, off = 0.f, alpha = 1.f; bool resc = false;
        const int kpos0 = STEP * (j * 64) + OFF;
        const int dmin = tqw - (kpos0 + STEP * 63), dmax = tqw + 7 - kpos0;
        bool rowsel = true;
        if (ROWSEL) { const unsigned wsel = (j < 32) ? sm0 : (j < 64) ? sm1 : (j < 96) ? sm2 : sm3; rowsel = (wsel >> (j & 31)) & 1u; }
        bool act = (dmax >= 0) && (dmin < (int)W);
        if (ROWSEL) act = act && __any(rowsel);
        if (act) {
            SBAR(); __builtin_amdgcn_s_setprio(2); qkt(p0, p1, K_lds + slot * SHM, r32, hi, c.qr); __builtin_amdgcn_s_setprio(0); SBAR();
            const bool needmask = (dmin < 0) || ((unsigned)dmax >= W);
            const int d0 = c.tq - kpos0 - STEP * 4 * hi;
            float add0 = c.bfar;
            if (dmin < 113) {
                if (STEP == 1) {
                    const LAS3 float* tbase = c.tb + (d0 + 5);
#pragma unroll
                    for (int r = 0; r < 16; ++r) { const int cc = (r & 3) + 8 * (r >> 2);
                        p0[r] = fmaf(p0[r], C2, tbase[59 - cc]); p1[r] = fmaf(p1[r], C2, tbase[59 - cc - 32]);
                        if ((r & 3) == 3) SBAR(); }
                } else {
#pragma unroll
                    for (int r = 0; r < 16; ++r) { const int cc = (r & 3) + 8 * (r >> 2); const int da = d0 - STEP * cc, db = d0 - STEP * (cc + 32);
                        const float ba = c.tb[64 + min(max(da, 0), 127)], bb = c.tb[64 + min(max(db, 0), 127)];
                        p0[r] = fmaf(p0[r], C2, ba); p1[r] = fmaf(p1[r], C2, bb);
                        if ((r & 3) == 3) SBAR(); }
                }
                mul = 1.f; add0 = 0.f;
            }
            if (needmask) {
#pragma unroll
                for (int r = 0; r < 16; ++r) { const int cc = (r & 3) + 8 * (r >> 2); const int da = d0 - STEP * cc, db = d0 - STEP * (cc + 32);
                    if ((unsigned)da >= W) p0[r] = NEG; if ((unsigned)db >= W) p1[r] = NEG; }
            }
            SBAR();
            if (RUNMAX) {
                float pm = fmaxf(p0[0], p1[0]);
#pragma unroll
                for (int r = 1; r < 16; ++r) pm = fmaxf(fmaxf(pm, p0[r]), p1[r]);
                pm = half_max(pm);
                float xmax = fmaf(pm, mul, add0); if (ROWSEL) xmax = rowsel ? xmax : NEG;
                float mn = m_reg;
                if (MODE != MODE_ONLINE || !__all(xmax - m_reg <= 8.0f)) { mn = fmaxf(m_reg, xmax); alpha = __builtin_amdgcn_exp2f(m_reg - mn); m_reg = mn; }
                off = add0 - mn; if (ROWSEL) off = rowsel ? off : NEG;
                if (MODE == MODE_ONLINE) { resc = __any(alpha < 1.f); if (resc && hi == 0) al_l[r32] = alpha; }
            } else off = (add0 - m_reg) + lp;
        }
        if (PP) STEP_END(role == 1, ldt);
        if (PP && role == 0 && ldt) LOADT(TJ(t + 2), lslot);
        if (act) {
#pragma unroll
            for (int r = 0; r < 16; ++r) { p0[r] = __builtin_amdgcn_exp2f(fmaf(p0[r], mul, off)); p1[r] = __builtin_amdgcn_exp2f(fmaf(p1[r], mul, off)); }
            if (RUNMAX) {
                float ps = 0.f;
#pragma unroll
                for (int r = 0; r < 16; ++r) ps += p0[r] + p1[r];
                ps = half_sum(ps);
                l_reg = l_reg * alpha + ps;
            }
            if (MODE == MODE_IMP || MODE == MODE_IMPACC) {
                LAS3 float* imp = (LAS3 float*)(c.lds + L_IMP) + (c.wid * 8 + (r32 >> 2)) * 128;
#pragma unroll
                for (int hf = 0; hf < 2; ++hf)
#pragma unroll
                    for (int m = 0; m < 4; ++m) { const f32x16& P = hf ? p1 : p0;
                        float a = 2.f * (P[4 * m] + P[4 * m + 1] + P[4 * m + 2]) + P[4 * m + 3], b = P[4 * m + 3];
                        a += __shfl_xor(a, 1); b += __shfl_xor(b, 1); a += __shfl_xor(a, 2); b += __shfl_xor(b, 2);
                        const int jj = 16 * j + 8 * hf + 2 * m + hi;
                        if ((r32 & 3) == 0) { __hip_atomic_fetch_add(imp + jj, a, __ATOMIC_RELAXED, __HIP_MEMORY_SCOPE_WORKGROUP);
                            if (jj + 1 < 128) __hip_atomic_fetch_add(imp + jj + 1, b, __ATOMIC_RELAXED, __HIP_MEMORY_SCOPE_WORKGROUP); } }
            }
            if (MODE == MODE_IMPACC) {
#pragma unroll
                for (int r = 0; r < 16; ++r) { p0[r] *= gate; p1[r] *= gate; }
            }
            if (HASV) {
                bf16x8 pa0, pa1, pa2, pa3;
                SBAR(); pack_p(p0, p1, pa0, pa1, pa2, pa3); SBAR();
                if (MODE == MODE_ONLINE && resc) {
#pragma unroll
                    for (int d_ = 0; d_ < 4; ++d_)
#pragma unroll
                        for (int r = 0; r < 16; ++r) c.o[d_][r] *= al_l[crow(r, hi)];
                    SBAR(); }
                pv_tile(c.o, vbase + slot * SHM, pa0, pa1, pa2, pa3);
            }
        }
        STEP_END(role == 0, ldt);
        slot = slot == 2 ? 0 : slot + 1;
    }
    if (PP && role == 0) { __builtin_amdgcn_s_barrier(); asm volatile("" ::: "memory"); }
#undef TJ
#undef STEP_END
#undef WAIT_OLDER
#undef LOADT
}
__device__ __forceinline__ void attn_unit(LAS3 char* lds, const bf16_t* __restrict__ proj, const bf16_t* __restrict__ kc, const bf16_t* __restrict__ vc, bf16_t* __restrict__ oa, float* park, int qt, int g, bool rev) {
    int tid_ = threadIdx.x; asm volatile("" : "+v"(tid_));
    Ctx c; c.lds = lds; c.tid = tid_; c.lane = c.tid & 63; c.wid = __builtin_amdgcn_readfirstlane(c.tid >> 6); c.r32 = c.lane & 31; c.hi = c.lane >> 5;
    c.t0 = qt * 64; c.tq = c.t0 + 8 * c.wid + (c.r32 >> 2);
    const int head = g * 4 + (c.r32 & 3);
    c.tb = (const LAS3 float*)(lds + LDS_BIAS) + head * 256; c.bfar = c.tb[64 + 127];
    { const bf16_t* qp = proj + (size_t)c.tq * NP + C_Q + head * HD + c.hi * 8;
#pragma unroll
      for (int d0 = 0; d0 < 8; ++d0) c.qr[d0] = *(const bf16x8*)(qp + d0 * 16); }
    float ga[3];
    { const bf16_t* gp = proj + (size_t)c.tq * NP + C_GA + head * 3;
#pragma unroll
      for (int b = 0; b < 3; ++b) ga[b] = pg8::fast_sigmoid(__uint_as_float(((unsigned)gp[b]) << 16)); }
    { LAS3 f32x4* z = (LAS3 f32x4*)(lds + L_IMP);
#pragma unroll
      for (int i = 0; i < 4; ++i) z[c.tid + 512 * i] = (f32x4){0.f, 0.f, 0.f, 0.f}; }
    __syncthreads();
    const bf16_t* Kc = kc + g * HD; const bf16_t* Vc = vc + g * HD;
    const bf16_t* Ks = proj + C_KV + 2 * 512 + g * HD; const bf16_t* Vs = proj + C_KV + 3 * 512 + g * HD;
    const bf16_t* Kw = proj + C_KV + 4 * 512 + g * HD; const bf16_t* Vw = proj + C_KV + 5 * 512 + g * HD;
    const int ntc = (4 * qt + 2) / 64;
    constexpr unsigned WINF = 0x7fffffffu;
    LAS3 float* wsf = (LAS3 float*)(lds + L_WS) + c.wid * 64;
#define PARK_PTR(sl_) int pt_ = c.tid; asm volatile("" : "+v"(pt_)); char* pp_ = (char*)park + ((size_t)blockIdx.x * 32 * 512 + (size_t)(sl_) * 16 * 512 + pt_) * 16
#define PARK_STORE(sl_) do { PARK_PTR(sl_); _Pragma("unroll") for (int d_ = 0; d_ < 4; ++d_) _Pragma("unroll") for (int q_ = 0; q_ < 4; ++q_) { \
        *(f32x4*)pp_ = (f32x4){c.o[d_][4 * q_], c.o[d_][4 * q_ + 1], c.o[d_][4 * q_ + 2], c.o[d_][4 * q_ + 3]}; pp_ += 8192; } } while (0)
#define PARK_ADD(sl_) do { PARK_PTR(sl_); _Pragma("unroll") for (int hh_ = 0; hh_ < 2; ++hh_) { f32x4 t_[8]; _Pragma("unroll") for (int e_ = 0; e_ < 8; ++e_) { t_[e_] = *(const f32x4*)pp_; pp_ += 8192; } SBAR(); \
        _Pragma("unroll") for (int e_ = 0; e_ < 8; ++e_) { const int d_ = hh_ * 2 + (e_ >> 2), q_ = e_ & 3; \
        c.o[d_][4 * q_] += t_[e_][0]; c.o[d_][4 * q_ + 1] += t_[e_][1]; c.o[d_][4 * q_ + 2] += t_[e_][2]; c.o[d_][4 * q_ + 3] += t_[e_][3]; } SBAR(); } } while (0)
#define ROW_SCALE(f_) do { if (c.hi == 0) wsf[c.r32] = (f_); LDS_WAIT(); _Pragma("unroll") for (int d_ = 0; d_ < 4; ++d_) _Pragma("unroll") for (int r = 0; r < 16; ++r) c.o[d_][r] *= wsf[crow(r, c.hi)]; } while (0)
#ifndef AREP
#define AREP 0
#endif
    {
        float m_c = -1e30f, l_c = 0.f;
        run_pass<MODE_STAT, 16, 31, false, false>(c, Kc, Vc, 512, 0, ntc, WINF, m_c, l_c, 0.f, 0u, 0u, 0u, 0u);
        const float rl_c = l_c > 0.f ? 1.0f / l_c : 0.f;
#pragma unroll
        for (int d_ = 0; d_ < 4; ++d_) c.o[d_] = f32x16{};
        run_pass<MODE_IMPACC, 16, 31, false, false>(c, Kc, Vc, 512, 0, ntc, WINF, m_c, l_c, rl_c, 0u, 0u, 0u, 0u, ga[0]);
        PARK_STORE(0);
    }
    {
        LAS3 unsigned* selw = (LAS3 unsigned*)(lds + L_SEL);
#pragma unroll 1
        for (int tk = 0; tk < 8; ++tk) {
            const int tok = c.wid * 8 + tk; const LAS3 float* imp = (const LAS3 float*)(lds + L_IMP) + tok * 128;
            const int ja = c.lane, jb = c.lane + 64;
            unsigned ka = __float_as_uint(imp[ja]) + 1u, kb = __float_as_uint(imp[jb]) + 1u;
            ka = (ja == 0 || ja == qt || ja == qt - 1) ? 0xffffffffu : (ja > qt ? 0u : ka);
            kb = (jb == qt || jb == qt - 1) ? 0xffffffffu : (jb > qt ? 0u : kb);
            unsigned T = 0u;
#pragma unroll 1
            for (int bit = 31; bit >= 0; --bit) { const unsigned cand = T | (1u << bit);
                const int cnt = __popcll(__ballot(ka >= cand)) + __popcll(__ballot(kb >= cand));
                T = cnt >= 16 ? cand : T; }
            const int cgt = __popcll(__ballot(ka > T)) + __popcll(__ballot(kb > T)); const int rr = 16 - cgt;
            const unsigned long long ea = __ballot(ka == T), eb = __ballot(kb == T);
            const int ra = __builtin_amdgcn_mbcnt_hi((unsigned)(ea >> 32), __builtin_amdgcn_mbcnt_lo((unsigned)ea, 0u));
            const int rb = __popcll(ea) + (int)__builtin_amdgcn_mbcnt_hi((unsigned)(eb >> 32), __builtin_amdgcn_mbcnt_lo((unsigned)eb, 0u));
            const unsigned long long ba = __ballot(ka > T || (ka == T && ra < rr)), bb = __ballot(kb > T || (kb == T && rb < rr));
            if (c.lane == 0) { selw[tok * 4 + 0] = (unsigned)ba; selw[tok * 4 + 1] = (unsigned)(ba >> 32); selw[tok * 4 + 2] = (unsigned)bb; selw[tok * 4 + 3] = (unsigned)(bb >> 32); }
        }
        LDS_WAIT();
    }
    {
        float m_w = -1e30f, l_w = 0.f; const int jlo = qt >= 8 ? qt - 8 : 0;
#pragma unroll
        for (int d_ = 0; d_ < 4; ++d_) c.o[d_] = f32x16{};
        run_pass<MODE_ONLINE, 1, 0, false, false>(c, Kw, Vw, NP, jlo, qt, 512u, m_w, l_w, 0.f, 0u, 0u, 0u, 0u);
        ROW_SCALE(ga[2] / l_w);
        PARK_STORE(1);
    }
    {
        unsigned sm0, sm1, sm2, sm3;
        { const LAS3 unsigned* selw = (const LAS3 unsigned*)(lds + L_SEL) + (c.wid * 8 + (c.r32 >> 2)) * 4; sm0 = selw[0]; sm1 = selw[1]; sm2 = selw[2]; sm3 = selw[3]; }
        float m_s = -1e30f, l_s = 0.f;
#pragma unroll
        for (int d_ = 0; d_ < 4; ++d_) c.o[d_] = f32x16{};
        run_pass<MODE_ONLINE, 1, 0, true, true>(c, Ks, Vs, NP, 0, qt, WINF, m_s, l_s, 0.f, sm0, sm1, sm2, sm3, 1.f, rev);
        ROW_SCALE(ga[1] / l_s);
        PARK_ADD(0);
        PARK_ADD(1);
    }
#undef PARK_STORE
#undef PARK_ADD
#undef ROW_SCALE
#ifdef NO_EPI
    if (c.o[0][0] == 123.f && c.o[1][1] == 3.f && c.o[2][2] == 1.f && c.o[3][3] == 5.f) oa[0] = 1;
    if (false)
#endif
    {
        const int tw = c.t0 + 8 * c.wid;
        const char* zbase = (const char*)(proj + C_ZA + g * 4 * HD); char* obase = (char*)(oa + g * 4 * HD);
#pragma unroll
        for (int r = 0; r < 16; ++r) { const int row = crow(r, c.hi); const int tok = tw + (row >> 2), hd = row & 3;
            const unsigned zo = (unsigned)(tok * NP + hd * HD + c.r32) * 2u, oo = (unsigned)(tok * AW + hd * HD + c.r32) * 2u;
#pragma unroll
            for (int d0 = 0; d0 < 4; ++d0) { const float z = __uint_as_float(((unsigned)*(const bf16_t*)(zbase + zo + d0 * 64)) << 16);
                const float v = c.o[d0][r] * z * pg8::fast_sigmoid(z); const float vn = __shfl_xor(v, 1);
                if ((c.r32 & 1) == 0) *(unsigned*)(obase + oo + d0 * 64) = cvtpk(v, vn); }
            SBAR(); }
    }
    __syncthreads();
}
__device__ __forceinline__ void phase_attn(LAS3 char* lds, const bf16_t* proj, const bf16_t* kc, const bf16_t* vc, bf16_t* oa, float* park, int vcu, int G) {
#pragma unroll 1
    for (int item = vcu; item < 256; item += G) {
        const int g = item >> 6, p = item & 63;
#pragma unroll 1
        for (int s = 0; s < 2; ++s) attn_unit(lds, proj, kc, vc, oa, park, s ? p : 127 - p, g, s != 0);
    }
}
}
__device__ __forceinline__ float gelu_tanh(float x) { const float y = 1.5957691216057308f * (x + 0.044715f * x * x * x); return x * pg8::fast_sigmoid(y); }
__device__ __forceinline__ float silu_f(float x) { return x * pg8::fast_sigmoid(x); }
__device__ __forceinline__ void compress_unit(LAS3 char* lds, const bf16_t* __restrict__ proj, const float* __restrict__ pe, const bf16_t* __restrict__ w1t, const bf16_t* __restrict__ w2t,
                                              bf16_t* __restrict__ outc, int u, int which) {
    int tid_o = threadIdx.x; asm volatile("" : "+v"(tid_o));
    const int tid = tid_o, lane = tid & 63, wid = __builtin_amdgcn_readfirstlane(tid >> 6), r32 = lane & 31, hi = lane >> 5;
    const int i = 8 * u + (r32 >> 2), g = r32 & 3;
    f32x16 acc[4];
#pragma unroll
    for (int nb = 0; nb < 4; ++nb) acc[nb] = f32x16{};
    const bf16_t* abase = proj + C_KV + which * 512 + g * HD + hi * 8;
    const bf16_t* bbase = w1t + (size_t)(wid * 32) * 2048 + lane * 8;
#pragma unroll 1
    for (int lt = 0; lt < 4; ++lt) {
        const int l = wid * 4 + lt; int tokn = 16 * i + l; tokn = tokn < T ? tokn : T - 1;
        const bf16_t* ap = abase + (size_t)tokn * NP; const float* pp = pe + l * HD + hi * 8;
#pragma unroll
        for (int hf = 0; hf < 2; ++hf) {
            u32x4 araw[4]; f32x4 e0[4], e1[4]; bf16x8 bfr[4][4];
#pragma unroll
            for (int k = 0; k < 4; ++k) { const int k8 = hf * 4 + k; araw[k] = *(const u32x4*)(ap + k8 * 16); e0[k] = *(const f32x4*)(pp + k8 * 16); e1[k] = *(const f32x4*)(pp + k8 * 16 + 4);
#pragma unroll
                for (int nb = 0; nb < 4; ++nb) bfr[k][nb] = *(const bf16x8*)(bbase + (size_t)((lt * 8 + k8) * 4 + nb) * 512); }
            __builtin_amdgcn_sched_barrier(0);
#pragma unroll
            for (int k = 0; k < 4; ++k) { const u32x4 raw = araw[k];
                u32x4 aw; aw.x = pk2(pg8::bf_lo(raw.x) + e0[k][0], pg8::bf_hi(raw.x) + e0[k][1]); aw.y = pk2(pg8::bf_lo(raw.y) + e0[k][2], pg8::bf_hi(raw.y) + e0[k][3]);
                aw.z = pk2(pg8::bf_lo(raw.z) + e1[k][0], pg8::bf_hi(raw.z) + e1[k][1]); aw.w = pk2(pg8::bf_lo(raw.w) + e1[k][2], pg8::bf_hi(raw.w) + e1[k][3]);
                const bf16x8 a = *reinterpret_cast<const bf16x8*>(&aw);
#pragma unroll
                for (int nb = 0; nb < 4; ++nb) acc[nb] = __builtin_amdgcn_mfma_f32_32x32x16_bf16(a, bfr[k][nb], acc[nb], 0, 0, 0); }
            __builtin_amdgcn_sched_barrier(0);
        }
    }
    LAS3 float* part = (LAS3 float*)lds + wid * 4096;
#pragma unroll
    for (int nb = 0; nb < 4; ++nb)
#pragma unroll
        for (int r = 0; r < 16; ++r) part[att::crow(r, hi) * 128 + nb * 32 + r32] = acc[nb][r];
    __syncthreads();
    f32x4 s0 = {0.f, 0.f, 0.f, 0.f}, s1 = {0.f, 0.f, 0.f, 0.f};
#pragma unroll
    for (int w = 0; w < 8; ++w) { const LAS3 f32x4* p = (const LAS3 f32x4*)((LAS3 float*)lds + w * 4096 + tid * 8); s0 += p[0]; s1 += p[1]; }
    __syncthreads();
    {
        u32x4 hw; hw.x = pk2(silu_f(s0[0]), silu_f(s0[1])); hw.y = pk2(silu_f(s0[2]), silu_f(s0[3])); hw.z = pk2(silu_f(s1[0]), silu_f(s1[1])); hw.w = pk2(silu_f(s1[2]), silu_f(s1[3]));
        const int row = tid >> 4, col = (tid & 15) * 8;
        *(LAS3 u32x4*)(lds + (row * 136 + col) * 2) = hw;
    }
    __syncthreads();
    if (wid < 4) {
        f32x16 o2 = f32x16{};
#pragma unroll
        for (int ks = 0; ks < 8; ++ks) { const bf16x8 a = *(const LAS3 bf16x8*)(lds + (r32 * 136 + ks * 16 + hi * 8) * 2);
            const bf16x8 b = *(const bf16x8*)(w2t + (size_t)(wid * 32 + r32) * HD + ks * 16 + hi * 8);
            o2 = __builtin_amdgcn_mfma_f32_32x32x16_bf16(a, b, o2, 0, 0, 0); }
#pragma unroll
        for (int r = 0; r < 16; ++r) { const int row = att::crow(r, hi); const int ii = 8 * u + (row >> 2), gg = row & 3;
            const float v = ii < NCMP ? o2[r] : 0.f; const float vn = __shfl_xor(v, 1);
            if ((r32 & 1) == 0) *(unsigned*)(outc + (size_t)(ii * 4 + gg) * HD + wid * 32 + r32) = pk2(v, vn); }
    }
    __syncthreads();
}
__device__ __forceinline__ void gmlp_unit(LAS3 char* lds, const bf16_t* __restrict__ proj, const float* __restrict__ sspart, const float* __restrict__ gain, const float* __restrict__ sw, const float* __restrict__ sb,
                                          bf16_t* __restrict__ ob, int ch, int qd) {
    int tid_o = threadIdx.x; asm volatile("" : "+v"(tid_o));
    const int tid = tid_o, lane = tid & 63, wid = __builtin_amdgcn_readfirstlane(tid >> 6), r32 = lane & 31, hi = lane >> 5;
    const int tc0 = ch * 128;
    LAS3 float* rsl = (LAS3 float*)(lds + LDS_RS);
    {   const int vkk = ((tid >> 7) * 8) + ((tid & 31) >> 2), vkey = (vkk & ~0xC) | ((vkk & 4) << 1) | ((vkk & 8) >> 1), vcol = ((tid >> 5) & 3) * 32 + (tid & 3) * 8;
        const unsigned vo0 = (unsigned)(vkey * NP + vcol) * 2u; const unsigned half_step = (unsigned)(32 * NP) * 2u;
#pragma unroll
        for (int gg = 0; gg < 4; ++gg)
#pragma unroll
            for (int kt = 0; kt < 2; ++kt) { const char* vp_ = (const char*)(proj + (size_t)(tc0 + kt * 64) * NP + C_VB + (qd * 4 + gg) * 128); LAS3 char* vd_ = lds + (gg * 2 + kt) * att::SHM + wid * 1024;
                __builtin_amdgcn_global_load_lds((const unsigned*)(vp_ + vo0), (LAS3 unsigned*)vd_, 16, 0, 0);
                __builtin_amdgcn_global_load_lds((const unsigned*)((vp_ + half_step) + vo0), (LAS3 unsigned*)(vd_ + 8192), 16, 0, 0); } }
    if (tid < 128) { const f32x4* sp = (const f32x4*)(sspart + (size_t)(tc0 + tid) * 32); f32x4 s = sp[0];
#pragma unroll
        for (int i = 1; i < 8; ++i) s += sp[i];
        rsl[tid] = 1.0f / sqrtf(((s[0] + s[1]) + (s[2] + s[3])) * (1.0f / BW) + NORM_EPS); }
    VM_WAIT();
    __syncthreads();
    const int gg = wid >> 1, wd = wid & 1, G = qd * 4 + gg, cb = G * 128;
    const int vb1 = (int)(uintptr_t)(lds) + gg * 2 * att::SHM + att::v_rd_base(lane) + wd * 1024;
    f32x4 gn[2][4];
#pragma unroll
    for (int dd = 0; dd < 2; ++dd)
#pragma unroll
        for (int m = 0; m < 4; ++m) gn[dd][m] = *(const f32x4*)(gain + cb + (wd * 2 + dd) * 32 + 8 * m + 4 * hi);
#pragma unroll 1
    for (int pb = 0; pb < 4; ++pb) {
        const int p = pb * 32 + r32; const size_t tok = (size_t)(tc0 + p); const int nks = 2 * pb + 2;
        f32x4 wr0[8], wr1[8]; u32x2 uu[2][4], zz[2][4];
        const float* wrow = sw + ((size_t)G * 128 + p) * 128 + hi * 8;
#pragma unroll
        for (int ks = 0; ks < 8; ++ks) if (ks < nks) { wr0[ks] = *(const f32x4*)(wrow + ks * 16); wr1[ks] = *(const f32x4*)(wrow + ks * 16 + 4); }
        const char* ubase = (const char*)(proj + tok * NP + C_UB + cb); const char* zbase = (const char*)(proj + tok * NP + C_ZB + cb); char* obase = (char*)(ob + tok * BW + cb);
#pragma unroll
        for (int dd = 0; dd < 2; ++dd)
#pragma unroll
            for (int m = 0; m < 4; ++m) { const int d0 = (wd * 2 + dd) * 32 + 8 * m + 4 * hi; uu[dd][m] = *(const u32x2*)(ubase + d0 * 2); zz[dd][m] = *(const u32x2*)(zbase + d0 * 2); }
        const float bs = sb[G * 128 + p];
        __builtin_amdgcn_sched_barrier(0);
        bf16x8 af[8];
#pragma unroll
        for (int ks = 0; ks < 8; ++ks) { if (ks < nks) { const f32x4 a0 = wr0[ks], a1 = wr1[ks]; const int q0 = ks * 16 + hi * 8;
                const f32x4 r0 = *(const LAS3 f32x4*)(rsl + q0), r1 = *(const LAS3 f32x4*)(rsl + q0 + 4);
                u32x4 w; w.x = pk2(q0 + 0 <= p ? a0[0] * r0[0] : 0.f, q0 + 1 <= p ? a0[1] * r0[1] : 0.f); w.y = pk2(q0 + 2 <= p ? a0[2] * r0[2] : 0.f, q0 + 3 <= p ? a0[3] * r0[3] : 0.f);
                w.z = pk2(q0 + 4 <= p ? a1[0] * r1[0] : 0.f, q0 + 5 <= p ? a1[1] * r1[1] : 0.f); w.w = pk2(q0 + 6 <= p ? a1[2] * r1[2] : 0.f, q0 + 7 <= p ? a1[3] * r1[3] : 0.f);
                af[ks] = *reinterpret_cast<const bf16x8*>(&w); } else af[ks] = bf16x8{}; }
        f32x16 acc[2] = {f32x16{}, f32x16{}};
#define TRRD(dst, off) asm volatile("ds_read_b64_tr_b16 %0, %1 offset:%2" : "=&v"(dst) : "v"(vb1), "i"(off) : "memory")
#define GM_STEP(ks) do { if ((ks) < nks) { s16x4 l0, h0, l1, h1; constexpr int o_ = ((ks) >> 2) * att::SHM + att::v_rd_off(0, (ks) & 3, 0); \
            TRRD(l0, o_); TRRD(h0, o_ + 2048); TRRD(l1, o_ + 512); TRRD(h1, o_ + 512 + 2048); \
            asm volatile("s_waitcnt lgkmcnt(0)" ::: "memory"); __builtin_amdgcn_sched_barrier(0); \
            acc[0] = __builtin_amdgcn_mfma_f32_32x32x16_bf16((bf16x8){l0[0], l0[1], l0[2], l0[3], h0[0], h0[1], h0[2], h0[3]}, af[ks], acc[0], 0, 0, 0); \
            acc[1] = __builtin_amdgcn_mfma_f32_32x32x16_bf16((bf16x8){l1[0], l1[1], l1[2], l1[3], h1[0], h1[1], h1[2], h1[3]}, af[ks], acc[1], 0, 0, 0); } } while (0)
        GM_STEP(0); GM_STEP(1); GM_STEP(2); GM_STEP(3); GM_STEP(4); GM_STEP(5); GM_STEP(6); GM_STEP(7);
#undef GM_STEP
#undef TRRD
#pragma unroll
        for (int dd = 0; dd < 2; ++dd)
#pragma unroll
            for (int m = 0; m < 4; ++m) { const int d0 = (wd * 2 + dd) * 32 + 8 * m + 4 * hi; const u32x2 u2 = uu[dd][m], z2 = zz[dd][m]; const f32x4 g4 = gn[dd][m];
                const float o0 = gelu_tanh(pg8::bf_lo(u2.x)) * (acc[dd][4 * m + 0] * g4[0] + bs) * silu_f(pg8::bf_lo(z2.x));
                const float o1 = gelu_tanh(pg8::bf_hi(u2.x)) * (acc[dd][4 * m + 1] * g4[1] + bs) * silu_f(pg8::bf_hi(z2.x));
                const float o2 = gelu_tanh(pg8::bf_lo(u2.y)) * (acc[dd][4 * m + 2] * g4[2] + bs) * silu_f(pg8::bf_lo(z2.y));
                const float o3 = gelu_tanh(pg8::bf_hi(u2.y)) * (acc[dd][4 * m + 3] * g4[3] + bs) * silu_f(pg8::bf_hi(z2.y));
                u32x2 w; w.x = pk2(o0, o1); w.y = pk2(o2, o3); *(u32x2*)(obase + d0 * 2) = w; }
    }
    __syncthreads();
}
#ifndef N_LAUNCH_MODE
#define N_LAUNCH_MODE 1
#endif
constexpr int NPHASES = 1 + 6 * DEPTH;
#ifndef PHMASK
#define PHMASK 0x7f
#endif
#ifndef REPMASK
#define REPMASK 0
#endif
#define REPS(bit) ((REPMASK & (bit)) ? 2 : 1)
__global__ void __launch_bounds__(NTHREADS, 2) fwd_kernel(Params P) {
    extern __shared__ __attribute__((aligned(16))) unsigned char lds_raw[];
    LAS3 unsigned char* lds = (LAS3 unsigned char*)lds_raw;
    const int tid = threadIdx.x, wave = __builtin_amdgcn_readfirstlane(tid >> 6);
#define lane hw_lane_id()
    const int G = gridDim.x; const int bx = blockIdx.x; const int vcu = (G % 8 == 0) ? (bx % 8) * (G / 8) + bx / 8 : bx;
    const int gw = vcu * NWAVES + wave, NGW = G * NWAVES;
    unsigned char* ws = P.ws;
    if (tid < 16) ((LAS3 unsigned*)(lds + LDS_MISC))[tid] = 0u;
    __syncthreads();
    XcdBarrier bar; bar.bar = (unsigned*)(ws + WS_CTL); bar.x = 0; bar.st = nullptr;
    if (N_LAUNCH_MODE == 1) bar = xcd_barrier_post((unsigned*)(ws + WS_CTL), (volatile LAS unsigned*)(lds + LDS_MISC));
    const int lo = P.ph_lo, hi = P.ph_hi;
#define IN(k) (lo <= (k) && (k) < hi)
#define SEAM(k) do { if (IN(k) && IN((k) + 1)) xcd_barrier(bar); } while (0)
    bf16_t* hbuf = (bf16_t*)(ws + WS_H); bf16_t* proj = (bf16_t*)(ws + WS_PROJ); bf16_t* kc = (bf16_t*)(ws + WS_KC); bf16_t* vc = (bf16_t*)(ws + WS_VC);
    bf16_t* oa = (bf16_t*)(ws + WS_OA); bf16_t* ob = (bf16_t*)(ws + WS_OB); bf16_t* t1 = (bf16_t*)(ws + WS_T1); bf16_t* mg = (bf16_t*)(ws + WS_MG);
    bf16_t* Y = (bf16_t*)(ws + WS_Y); bf16_t* x1 = (bf16_t*)(ws + WS_X1);
    constexpr int NU_PROJ = (T / 256) * (NP / 256);
#pragma unroll 1
    for (int w = 0; w < 2; ++w) {
        const int rem = NU_PROJ % G; const bool tailcu = (rem != 0) && (bx >= rem);
        const bool doit = (w == 0) ? (IN(0) && (PHMASK & 1)) : (IN(1) && tailcu);
        const bool alltail = (rem == 0);
        if (doit) {
            const int lo_ = (w == 0) ? 0 : W_ITEMS - W_TAIL_ITEMS, hi_ = (w == 0) ? (alltail ? W_ITEMS : W_ITEMS - W_TAIL_ITEMS) : W_ITEMS;
            const int gw_ = (w == 0) ? gw : (bx - rem) * NWAVES + wave, ngw_ = (w == 0) ? NGW : (G - rem) * NWAVES;
            for (int rep = 0; rep < REPS(1); ++rep) phase_weights(P, lds, gw_, ngw_, wave, lane, lo_, hi_);
        }
        if (w == 0 && IN(0) && (PHMASK & 1)) for (int rep = 0; rep < REPS(128); ++rep) phase_prenorm(P.x, P.pre_norm, hbuf, gw, NGW, lane);
        __syncthreads();
        for (int i = tid; i < 16 * 256; i += NTHREADS) { const int hd = i >> 8; int dd = (i & 255) - 64; dd = dd < 0 ? 0 : (dd > 127 ? 127 : dd); ((LAS3 float*)(lds + LDS_BIAS))[i] = P.rel_bias[BUCKET[dd] * 16 + hd] * att::LOG2E; }
        __syncthreads();
        if (w == 0) SEAM(0);
    }
#pragma unroll 1
    for (int L = 0; L < DEPTH; ++L) {
        const int pb = 1 + 6 * L;
        constexpr int PN_EARLY = 80, PN_LATE = NP / 256 - PN_EARLY, N_LATE_UNITS = (T / 256) * PN_LATE;
#pragma unroll 1
        for (int half = 0; half < 2; ++half) {
            if (IN(pb + half) && (PHMASK & 2)) for (int rep = 0; rep < REPS(2); ++rep) {
                pg8::Gemm g{hbuf, (const bf16_t*)(ws + WS_WIN + L * SZ_WIN), T, NP, DM, nullptr, nullptr}; pg8::ProjOrder S; S.init2(T, PN_EARLY, PN_LATE, G, bx, half);
                pg8::EpiProj E{proj, NP, (float*)(ws + WS_SS)};
                pg8::gemm_phase<pg8::EpiProj, pg8::ProjOrder>(lds + LDS_STAGE, g, S, E, nullptr);
            }
            if (half == 0) SEAM(pb);
        }
        if (IN(pb + 1) && (PHMASK & 4)) for (int rep = 0; rep < REPS(4); ++rep) {
            int it0 = 0, it1 = 0, it2 = 0, nit = 0;
            if (G == 256) {
                if (bx >= N_LATE_UNITS) { const int k = bx - N_LATE_UNITS;
                    if (k < 64) { it0 = 3 * k; it1 = 3 * k + 1; it2 = 3 * k + 2; nit = 3; } else { it0 = 192 + 2 * (k - 64); it1 = it0 + 1; nit = 2; } }
                else if (bx < 128) { it0 = 256 + bx; nit = 1; }
            }
#pragma unroll 1
            for (int q = 0; ; ++q) {
                int item;
                if (G == 256) { if (q >= nit) break; item = q == 0 ? it0 : (q == 1 ? it1 : it2); }
                else { item = bx + q * G; if (item >= 384) break; }
                if (item < 256) gmlp_unit((LAS3 char*)lds, proj, (const float*)(ws + WS_SS), P.sgu_norm + L * BW, P.sgu_w + (size_t)L * 16 * 128 * 128, P.sgu_b + L * 16 * 128, ob, item >> 2, item & 3);
                else { const int ci = item - 256, which = ci & 1, u = ci >> 1;
                    compress_unit((LAS3 char*)lds, proj, (which ? P.pe_v : P.pe_k) + L * 32 * HD, (const bf16_t*)(ws + WS_W1 + (L * 2 + which) * SZ_W1), (const bf16_t*)(ws + WS_W2 + (L * 2 + which) * SZ_W2), which ? vc : kc, u, which); }
            }
        }
        SEAM(pb + 1);
        if (IN(pb + 2) && (PHMASK & 8)) for (int rep = 0; rep < REPS(8); ++rep) att::phase_attn((LAS3 char*)lds, proj, kc, vc, oa, (float*)(ws + WS_PARK), vcu, G);
        SEAM(pb + 2);
        if (IN(pb + 3) && (PHMASK & 16)) for (int rep = 0; rep < REPS(16); ++rep) {
            pg8::DualOrder S; S.init(T, DM, G, bx);
            pg8::Gemm g{oa, (const bf16_t*)(ws + WS_WA + L * SZ_WAB), T, DM, AW, ob, (const bf16_t*)(ws + WS_WB + L * SZ_WAB)};
            pg8::EpiMerge E{mg, DM, proj + C_MA, proj + C_MB, NP};
            pg8::gemm_phase<pg8::EpiMerge, pg8::DualOrder>(lds + LDS_STAGE, g, S, E, nullptr);
        }
        SEAM(pb + 3);
        if (IN(pb + 4) && (PHMASK & 32)) for (int rep = 0; rep < REPS(32); ++rep) {
            pg8::Gemm g{mg, (const bf16_t*)(ws + WS_WO + L * SZ_WO), T, DM, DM, nullptr, nullptr}; pg8::StaticOrder S; S.init(T, DM, G, bx);
            pg8::EpiBf16Plain E{Y, DM};
            pg8::gemm_phase<pg8::EpiBf16Plain, pg8::StaticOrder>(lds + LDS_STAGE, g, S, E, nullptr);
        }
        SEAM(pb + 4);
        if (IN(pb + 5) && (PHMASK & 64)) for (int rep = 0; rep < REPS(64); ++rep) {
            if (L == 0) phase_postnorm<false, true>(Y, P.x, P.post_norm, x1, P.pre_norm + DM, hbuf, true, gw, NGW, lane);
            else phase_postnorm<true, false>(Y, x1, P.post_norm + L * DM, P.out, P.pre_norm, hbuf, false, gw, NGW, lane);
        }
        SEAM(pb + 5);
    }
#undef IN
#undef SEAM
#undef lane
}
extern "C" void kernel_launch(void* const* d_in, const int* in_sizes, int n_in, void* d_out, int out_size, void* d_ws, size_t ws_size, hipStream_t stream) {
    static int grid = 0;
    if (grid == 0) {
        if (n_in != 17 || in_sizes[0] != T * DM || out_size != T * DM || ws_size < WS_END) { fprintf(stderr, "kernel_launch: unexpected shapes (n_in %d, in0 %d, out %d, ws %zu < %zu)\n", n_in, n_in > 0 ? in_sizes[0] : -1, out_size, ws_size, (size_t)WS_END); grid = -1; return; }
        int dev = 0, cus = 0, per_cu = 0;
        if (hipGetDevice(&dev) != hipSuccess || hipDeviceGetAttribute(&cus, hipDeviceAttributeMultiprocessorCount, dev) != hipSuccess) { grid = -1; return; }
        if (hipFuncSetAttribute((const void*)fwd_kernel, hipFuncAttributeMaxDynamicSharedMemorySize, LDS_BYTES) != hipSuccess) { fprintf(stderr, "kernel_launch: hipFuncSetAttribute failed\n"); grid = -1; return; }
        if (hipOccupancyMaxActiveBlocksPerMultiprocessor(&per_cu, (const void*)fwd_kernel, NTHREADS, LDS_BYTES) != hipSuccess || per_cu < 1) { fprintf(stderr, "kernel_launch: occupancy query says %d blocks per CU\n", per_cu); (void)hipGetLastError(); grid = -1; return; }
        grid = cus;
    }
    if (grid < 0) return;
    (void)hipMemsetAsync((char*)d_ws + WS_CTL, 0, CTL_BYTES, stream);
    Params p{};
    p.x = (const float*)d_in[0]; p.rel_bias = (const float*)d_in[1]; p.pre_norm = (const float*)d_in[2]; p.w_in = (const float*)d_in[3];
    p.pe_k = (const float*)d_in[4]; p.w1_k = (const float*)d_in[5]; p.w2_k = (const float*)d_in[6]; p.pe_v = (const float*)d_in[7]; p.w1_v = (const float*)d_in[8]; p.w2_v = (const float*)d_in[9];
    p.w_out_a = (const float*)d_in[10]; p.sgu_norm = (const float*)d_in[11]; p.sgu_w = (const float*)d_in[12]; p.sgu_b = (const float*)d_in[13]; p.w_out_b = (const float*)d_in[14]; p.w_out = (const float*)d_in[15]; p.post_norm = (const float*)d_in[16];
    p.out = (float*)d_out; p.ws = (unsigned char*)d_ws;
#if N_LAUNCH_MODE == 1
    p.ph_lo = 0; p.ph_hi = NPHASES;
    hipLaunchKernelGGL(fwd_kernel, dim3(grid), dim3(NTHREADS), LDS_BYTES, stream, p);
#else
    for (int k = 0; k < NPHASES; ++k) { p.ph_lo = k; p.ph_hi = k + 1; hipLaunchKernelGGL(fwd_kernel, dim3(grid), dim3(NTHREADS), LDS_BYTES, stream, p); }
#endif
}
```

```cpp
#include <hip/hip_runtime.h>
#include <cstdio>
#include <cstdint>
__device__ __forceinline__ int hw_lane_id() { int l; asm volatile("v_mbcnt_lo_u32_b32 %0, -1, 0\n\tv_mbcnt_hi_u32_b32 %0, -1, %0" : "=v"(l)); return l; }
namespace pg8 {
#define PG8_LAS __attribute__((address_space(3)))
typedef unsigned short bf16_t;
typedef short bf16x8 __attribute__((ext_vector_type(8)));
typedef float f32x4 __attribute__((ext_vector_type(4)));
typedef unsigned u32x4 __attribute__((ext_vector_type(4)));
constexpr int BM = 256, BK = 64, HALF = 128, HTB = HALF * BK * 2  , STAGE_BYTES = 8 * HTB, NXCD = 8, WGM = 8;

__host__ __device__ __forceinline__ int lds_byte(int r, int c) { const int st = (r >> 4) * 2 + (c >> 5), rr = r & 15, cc = c & 31, ob = rr * 64 + cc * 2; return st * 1024 + (ob ^ (((ob >> 9) & 1) << 5)); }
__host__ __device__ __forceinline__ void stage_rc(int b, int& R, int& C) { const int st = b / 1024, sb = b % 1024, swz = sb ^ (((sb >> 9) & 1) << 5); R = (st >> 1) * 16 + swz / 64; C = (st & 1) * 32 + (swz % 64) / 2; }
__host__ __device__ __forceinline__ int perm32(int rho) { const int n = rho >> 4, i = rho & 15; return 8 * (i >> 2) + 4 * n + (i & 3); }

struct Unit { int pm, pn, sub; };
struct Gemm { const bf16_t* A; const bf16_t* Bt; int M, N, K; const bf16_t* A2; const bf16_t* Bt2; };

struct StaticOrder {
    int nM, nN, nwg, G, c;
    __host__ __device__ void init(int M, int N, int G_, int c_) { nM = M / BM; nN = N / BM; nwg = nM * nN; G = G_; c = c_; }
    __host__ __device__ bool next(int i, Unit& u) const {
        const long L = (long)i * G + c; if (L >= nwg) return false;
        int wgid = (int)L; { const int q = nwg / NXCD, r = nwg % NXCD, xcd = wgid % NXCD, off = wgid / NXCD; wgid = (xcd < r ? xcd * (q + 1) : r * (q + 1) + (xcd - r) * q) + off; }
        const int nig = WGM * nN, gid = wgid / nig, fm = gid * WGM, gsz = (nM - fm) < WGM ? (nM - fm) : WGM;
        u.pm = fm + ((wgid % nig) % gsz); u.pn = (wgid % nig) / gsz; u.sub = 0; return true;
    }
    __device__ __forceinline__ void a_ready(const Unit&) const {}
    __device__ __forceinline__ void done(const Unit&) const {}
    static constexpr bool DUAL = false;
    __device__ __forceinline__ const bf16_t* baseA(const Gemm& g, const Unit&) const { return g.A; }
    __device__ __forceinline__ const bf16_t* baseB(const Gemm& g, const Unit&) const { return g.Bt; }
};
struct DualOrder : StaticOrder {
    static constexpr bool DUAL = true;
    __host__ __device__ bool next(int i, Unit& u) const { const bool ok = StaticOrder::next(i >> 1, u); u.sub = i & 1; return ok; }
    __device__ __forceinline__ const bf16_t* baseA(const Gemm& g, const Unit& u) const { return u.sub ? g.A2 : g.A; }
    __device__ __forceinline__ const bf16_t* baseB(const Gemm& g, const Unit& u) const { return u.sub ? g.Bt2 : g.Bt; }
};
typedef __bf16 bf16x2_t __attribute__((ext_vector_type(2)));
typedef float f32x2_t __attribute__((ext_vector_type(2)));
__device__ __forceinline__ unsigned cvt_pk_bf16(float lo, float hi) { const f32x2_t v = {lo, hi}; const bf16x2_t b = __builtin_convertvector(v, bf16x2_t); return __builtin_bit_cast(unsigned, b); }
typedef float f32x2 __attribute__((ext_vector_type(2)));
__device__ __forceinline__ float bf_lo(unsigned u) { return __uint_as_float(u << 16); }
__device__ __forceinline__ float bf_hi(unsigned u) { return __uint_as_float(u & 0xffff0000u); }
__device__ __forceinline__ float fast_sigmoid(float x) { return __builtin_amdgcn_rcpf(1.0f + __builtin_amdgcn_exp2f(-1.4426950408889634f * x)); }
struct EpiBf16Plain {
    static constexpr bool PERM = true, AFTER_DRAIN = false;
    bf16_t* O; int ldc;
    __device__ __forceinline__ void operator()(const f32x4 (&acc)[2][2][4][2], const Unit& u, int wr, int wc, int fr, int fq) const {
        const int row0 = u.pm * BM + wr * 64 + fr, col0 = u.pn * BM + wc * 32 + 8 * fq;
#pragma unroll
        for (int ai = 0; ai < 2; ++ai)
#pragma unroll
            for (int m = 0; m < 4; ++m) { bf16_t* rowp = O + (size_t)(row0 + ai * HALF + m * 16) * ldc + col0;
#pragma unroll
                for (int bj = 0; bj < 2; ++bj) { const f32x4 v0 = acc[ai][bj][m][0], v1 = acc[ai][bj][m][1];
                    u32x4 w; w.x = cvt_pk_bf16(v0[0], v0[1]); w.y = cvt_pk_bf16(v0[2], v0[3]); w.z = cvt_pk_bf16(v1[0], v1[1]); w.w = cvt_pk_bf16(v1[2], v1[3]);
                    *(u32x4*)(rowp + bj * HALF) = w; } }
    }
};
__device__ __forceinline__ float gelu_tanh_f(float x) { const float y = 1.5957691216057308f * (x + 0.044715f * x * x * x); return x * fast_sigmoid(y); }
struct EpiProj {
    static constexpr bool PERM = true, AFTER_DRAIN = false;
    static constexpr int PN_V0 = 36;
    bf16_t* O; int ldc; float* sspart;
    __device__ __forceinline__ void operator()(const f32x4 (&acc)[2][2][4][2], const Unit& u, int wr, int wc, int fr, int fq) const {
        const int row0 = u.pm * BM + wr * 64 + fr, col0 = u.pn * BM + wc * 32 + 8 * fq;
        const bool vtile = (u.pn >= PN_V0) && (u.pn < PN_V0 + 8);
        if (!vtile) {
#pragma unroll
            for (int ai = 0; ai < 2; ++ai)
#pragma unroll
                for (int m = 0; m < 4; ++m) { bf16_t* rowp = O + (size_t)(row0 + ai * HALF + m * 16) * ldc + col0;
#pragma unroll
                    for (int bj = 0; bj < 2; ++bj) { const f32x4 v0 = acc[ai][bj][m][0], v1 = acc[ai][bj][m][1];
                        u32x4 w; w.x = cvt_pk_bf16(v0[0], v0[1]); w.y = cvt_pk_bf16(v0[2], v0[3]); w.z = cvt_pk_bf16(v1[0], v1[1]); w.w = cvt_pk_bf16(v1[2], v1[3]);
                        *(u32x4*)(rowp + bj * HALF) = w; } }
        } else {
#pragma unroll
            for (int ai = 0; ai < 2; ++ai)
#pragma unroll
                for (int m = 0; m < 4; ++m) { const int row = row0 + ai * HALF + m * 16; bf16_t* rowp = O + (size_t)row * ldc + col0; float ss = 0.f;
#pragma unroll
                    for (int bj = 0; bj < 2; ++bj) { f32x4 v0 = acc[ai][bj][m][0], v1 = acc[ai][bj][m][1];
#pragma unroll
                        for (int e = 0; e < 4; ++e) { v0[e] = gelu_tanh_f(v0[e]); v1[e] = gelu_tanh_f(v1[e]); ss += v0[e] * v0[e] + v1[e] * v1[e]; }
                        u32x4 w; w.x = cvt_pk_bf16(v0[0], v0[1]); w.y = cvt_pk_bf16(v0[2], v0[3]); w.z = cvt_pk_bf16(v1[0], v1[1]); w.w = cvt_pk_bf16(v1[2], v1[3]);
                        *(u32x4*)(rowp + bj * HALF) = w; }
                    ss += __shfl_xor(ss, 16); ss += __shfl_xor(ss, 32);
                    if (fq == 0) sspart[(size_t)row * 32 + (u.pn - PN_V0) * 4 + wc] = ss; }
        }
    }
};
template <bool ADD> struct EpiGate {
    static constexpr bool PERM = true, AFTER_DRAIN = false;
    bf16_t* O; int ldc; const bf16_t* Mg; int ldm; const bf16_t* Prev;
    __device__ __forceinline__ void operator()(const f32x4 (&acc)[2][2][4][2], const Unit& u, int wr, int wc, int fr, int fq) const {
        const int row0 = u.pm * BM + wr * 64 + fr, col0 = u.pn * BM + wc * 32 + 8 * fq;
#pragma unroll
        for (int ai = 0; ai < 2; ++ai)
#pragma unroll
            for (int m = 0; m < 4; ++m) { const size_t row = (size_t)(row0 + ai * HALF + m * 16);
#pragma unroll
                for (int bj = 0; bj < 2; ++bj) { const f32x4 v0 = acc[ai][bj][m][0], v1 = acc[ai][bj][m][1];
                    const u32x4 mg = *(const u32x4*)(Mg + row * ldm + col0 + bj * HALF);
                    float r[8];
                    r[0] = v0[0] * fast_sigmoid(bf_lo(mg.x)); r[1] = v0[1] * fast_sigmoid(bf_hi(mg.x)); r[2] = v0[2] * fast_sigmoid(bf_lo(mg.y)); r[3] = v0[3] * fast_sigmoid(bf_hi(mg.y));
                    r[4] = v1[0] * fast_sigmoid(bf_lo(mg.z)); r[5] = v1[1] * fast_sigmoid(bf_hi(mg.z)); r[6] = v1[2] * fast_sigmoid(bf_lo(mg.w)); r[7] = v1[3] * fast_sigmoid(bf_hi(mg.w));
                    if (ADD) { const u32x4 pv = *(const u32x4*)(Prev + row * ldc + col0 + bj * HALF);
                        r[0] += bf_lo(pv.x); r[1] += bf_hi(pv.x); r[2] += bf_lo(pv.y); r[3] += bf_hi(pv.y); r[4] += bf_lo(pv.z); r[5] += bf_hi(pv.z); r[6] += bf_lo(pv.w); r[7] += bf_hi(pv.w); }
                    u32x4 w; w.x = cvt_pk_bf16(r[0], r[1]); w.y = cvt_pk_bf16(r[2], r[3]); w.z = cvt_pk_bf16(r[4], r[5]); w.w = cvt_pk_bf16(r[6], r[7]);
                    *(u32x4*)(O + row * ldc + col0 + bj * HALF) = w; } }
    }
};
struct EpiMerge {
    static constexpr bool PERM = true, AFTER_DRAIN = false;
    bf16_t* O; int ldc; const bf16_t* Ma; const bf16_t* Mb; int ldm;
    __device__ __forceinline__ void mid(f32x4 (&acc)[2][2][4][2], const Unit& u, int wr, int wc, int fr, int fq) const {
        const int row0 = u.pm * BM + wr * 64 + fr, col0 = u.pn * BM + wc * 32 + 8 * fq;
#pragma unroll
        for (int ai = 0; ai < 2; ++ai)
#pragma unroll
            for (int m = 0; m < 4; ++m) { const size_t row = (size_t)(row0 + ai * HALF + m * 16);
#pragma unroll
                for (int bj = 0; bj < 2; ++bj) { const u32x4 a = *(const u32x4*)(Ma + row * ldm + col0 + bj * HALF), b = *(const u32x4*)(Mb + row * ldm + col0 + bj * HALF);
                    const unsigned aw[4] = {a.x, a.y, a.z, a.w}, bw[4] = {b.x, b.y, b.z, b.w};
#pragma unroll
                    for (int e = 0; e < 4; ++e) {
                        const float r0 = (1.0f + __builtin_amdgcn_exp2f(-1.4426950408889634f * bf_lo(bw[e]))) * __builtin_amdgcn_rcpf(1.0f + __builtin_amdgcn_exp2f(-1.4426950408889634f * bf_lo(aw[e])));
                        const float r1 = (1.0f + __builtin_amdgcn_exp2f(-1.4426950408889634f * bf_hi(bw[e]))) * __builtin_amdgcn_rcpf(1.0f + __builtin_amdgcn_exp2f(-1.4426950408889634f * bf_hi(aw[e])));
                        acc[ai][bj][m][e >> 1][(e & 1) * 2] *= r0; acc[ai][bj][m][e >> 1][(e & 1) * 2 + 1] *= r1; } } }
    }
    __device__ __forceinline__ void operator()(const f32x4 (&acc)[2][2][4][2], const Unit& u, int wr, int wc, int fr, int fq) const {
        const int row0 = u.pm * BM + wr * 64 + fr, col0 = u.pn * BM + wc * 32 + 8 * fq;
#pragma unroll
        for (int ai = 0; ai < 2; ++ai)
#pragma unroll
            for (int m = 0; m < 4; ++m) { const size_t row = (size_t)(row0 + ai * HALF + m * 16);
#pragma unroll
                for (int bj = 0; bj < 2; ++bj) { const f32x4 v0 = acc[ai][bj][m][0], v1 = acc[ai][bj][m][1];
                    const u32x4 mg = *(const u32x4*)(Mb + row * ldm + col0 + bj * HALF);
                    u32x4 w; w.x = cvt_pk_bf16(v0[0] * fast_sigmoid(bf_lo(mg.x)), v0[1] * fast_sigmoid(bf_hi(mg.x))); w.y = cvt_pk_bf16(v0[2] * fast_sigmoid(bf_lo(mg.y)), v0[3] * fast_sigmoid(bf_hi(mg.y)));
                    w.z = cvt_pk_bf16(v1[0] * fast_sigmoid(bf_lo(mg.z)), v1[1] * fast_sigmoid(bf_hi(mg.z))); w.w = cvt_pk_bf16(v1[2] * fast_sigmoid(bf_lo(mg.w)), v1[3] * fast_sigmoid(bf_hi(mg.w)));
                    *(u32x4*)(O + row * ldc + col0 + bj * HALF) = w; } }
    }
};
struct EpiF32Plain {
    static constexpr bool PERM = false, AFTER_DRAIN = false;
    float* C; int ldc;
    __device__ __forceinline__ void operator()(const f32x4 (&acc)[2][2][4][2], const Unit& u, int wr, int wc, int fr, int fq) const {
        const int row0 = u.pm * BM + wr * 64 + fr, col0 = u.pn * BM + wc * 32 + 4 * fq;
#pragma unroll
        for (int ai = 0; ai < 2; ++ai)
#pragma unroll
            for (int m = 0; m < 4; ++m) { float* rowp = C + (size_t)(row0 + ai * HALF + m * 16) * ldc + col0;
#pragma unroll
                for (int bj = 0; bj < 2; ++bj)
#pragma unroll
                    for (int n = 0; n < 2; ++n) *(f32x4*)(rowp + bj * HALF + n * 16) = acc[ai][bj][m][n]; }
    }
};
struct ProjOrder : StaticOrder {
    int late, nearly, nlate;
    __host__ __device__ void init2(int M, int n_early, int n_late, int G_, int c_, int late_) { StaticOrder::init(M, n_early * BM, G_, c_); late = late_; nearly = n_early; nlate = n_late; }
    __host__ __device__ bool next(int i, Unit& u) const {
        if (!late) return StaticOrder::next(i, u);
        const long L = (long)i * G + c; if (L >= (long)nM * nlate) return false;
        u.pm = (int)(L % nM); u.pn = nearly + (int)(L / nM); u.sub = 0; return true;
    }
};
#ifndef PG8_SP2
#define PG8_SP2 true
#endif
#ifndef PG8_ALIGN
#define PG8_ALIGN true
#endif
template <class Epi, class Sched, bool STAMP = false, bool ALIGN_EPI = PG8_ALIGN, bool SP2 = PG8_SP2>
__device__ __forceinline__ void gemm_phase(PG8_LAS unsigned char* lds, const Gemm g, const Sched& S, const Epi& E, unsigned long long* stamps) {
    int tid_o = threadIdx.x; asm volatile("" : "+v"(tid_o));
    const int tid = tid_o, wid = __builtin_amdgcn_readfirstlane(tid >> 6), lane = tid & 63, wr = wid >> 2, wc = wid & 3, fr = lane & 15, fq = lane >> 4;
    const int K = g.K, nt = K / BK;
    int ts_lo = 0, ts_hi = 0, nts = 0; const unsigned long long rt_entry = STAMP ? (unsigned long long)wall_clock64() : 0ull;
#define PG8_STAMP() do { if (STAMP && wid == 0 && nts < 64) { const unsigned long long _c = (unsigned long long)clock64(); \
        ts_lo = (lane == nts) ? (int)(unsigned)_c : ts_lo; ts_hi = (lane == nts) ? (int)(unsigned)(_c >> 32) : ts_hi; ++nts; } } while (0)
    PG8_STAMP();
    unsigned voffA[2], voffB[2];
#pragma unroll
    for (int i = 0; i < 2; ++i) { int R, C; stage_rc(tid * 16 + i * 8192, R, C); const int Rb = Epi::PERM ? ((R & ~31) + perm32(R & 31)) : R;
        voffA[i] = (unsigned)(R * K + C) * 2u; voffB[i] = (unsigned)(Rb * K + C) * 2u; }
    const size_t kstep = (size_t)(BK * 2);
    const size_t hstep = (size_t)HALF * K * 2;
    const size_t tstep = 2 * hstep;
    const unsigned ldsw = (unsigned)wid * 1024u;
    const int aoff = lds_byte(wr * 64 + fr, fq * 8), boff = lds_byte(wc * 32 + fr, fq * 8);
#define PG8_SA(b, h) (((b) * 2 + (h)) * HTB)
#define PG8_SB(b, h) ((4 + (b) * 2 + (h)) * HTB)
#define PG8_STAGE(bufoff, gbase, voff) do { _Pragma("unroll") for (int _i = 0; _i < 2; ++_i) \
        __builtin_amdgcn_global_load_lds((const unsigned*)((const char*)(gbase) + (voff)[_i]), (PG8_LAS unsigned*)(lds + (bufoff) + ldsw + _i * 8192), 16, 0, 0); } while (0)
#define PG8_LDA(dst, b, h) do { _Pragma("unroll") for (int m = 0; m < 4; ++m) _Pragma("unroll") for (int k = 0; k < 2; ++k) dst[m][k] = *(const PG8_LAS bf16x8*)(lds + PG8_SA(b, h) + aoff + m * 2048 + k * 1024); } while (0)
#define PG8_LDB(dst, b, h) do { _Pragma("unroll") for (int n = 0; n < 2; ++n) _Pragma("unroll") for (int k = 0; k < 2; ++k) dst[n][k] = *(const PG8_LAS bf16x8*)(lds + PG8_SB(b, h) + boff + n * 2048 + k * 1024); } while (0)
#define PG8_MMA(ai, bj, At, Bt) do { __builtin_amdgcn_s_setprio(1); _Pragma("unroll") for (int m = 0; m < 4; ++m) _Pragma("unroll") for (int n = 0; n < 2; ++n) _Pragma("unroll") for (int k = 0; k < 2; ++k) \
        acc[ai][bj][m][n] = __builtin_amdgcn_mfma_f32_16x16x32_bf16(Bt[n][k], At[m][k], acc[ai][bj][m][n], 0, 0, 0); __builtin_amdgcn_s_setprio(0); } while (0)
#define PG8_WAIT_V(n) asm volatile("s_waitcnt vmcnt(" #n ")" ::: "memory")
#define PG8_WAIT_L(n) asm volatile("s_waitcnt lgkmcnt(" #n ")" ::: "memory")
#define PG8_BAR __builtin_amdgcn_s_barrier()
#define PG8_SCHED __builtin_amdgcn_sched_barrier(0)
    Unit cur, nxt; int ui = 0;
    if (!S.next(0, cur)) return;
    f32x4 acc[2][2][4][2];
#pragma unroll
    for (int a = 0; a < 2; ++a)
#pragma unroll
        for (int b = 0; b < 2; ++b)
#pragma unroll
            for (int m = 0; m < 4; ++m)
#pragma unroll
                for (int n = 0; n < 2; ++n) acc[a][b][m][n] = (f32x4){0.f, 0.f, 0.f, 0.f};
    bf16x8 At[4][2], B0[2][2], B1[2][2];
    const char* cA = (const char*)S.baseA(g, cur) + (size_t)cur.pm * tstep; const char* cB = (const char*)S.baseB(g, cur) + (size_t)cur.pn * tstep;
    S.a_ready(cur);
    if constexpr (SP2) {
        PG8_STAGE(PG8_SB(0, 0), cB, voffB); PG8_STAGE(PG8_SB(0, 1), cB + hstep, voffB); PG8_STAGE(PG8_SA(0, 0), cA, voffA); PG8_STAGE(PG8_SA(0, 1), cA + hstep, voffA);
        if (wr == 1) PG8_BAR;
        PG8_WAIT_V(2); PG8_BAR;
        PG8_STAGE(PG8_SB(1, 0), cB + kstep, voffB); PG8_STAGE(PG8_SA(1, 0), cA + kstep, voffA); PG8_STAGE(PG8_SB(1, 1), cB + hstep + kstep, voffB);
        PG8_WAIT_V(6); PG8_BAR;
    } else {
    PG8_STAGE(PG8_SB(0, 0), cB, voffB); PG8_STAGE(PG8_SA(0, 0), cA, voffA); PG8_STAGE(PG8_SB(0, 1), cB + hstep, voffB); PG8_STAGE(PG8_SA(0, 1), cA + hstep, voffA);
    if (wr == 1) PG8_BAR;
    PG8_WAIT_V(4); PG8_BAR;
    PG8_STAGE(PG8_SB(1, 0), cB + kstep, voffB); PG8_STAGE(PG8_SA(1, 0), cA + kstep, voffA); PG8_STAGE(PG8_SB(1, 1), cB + hstep + kstep, voffB);
    PG8_WAIT_V(6); PG8_BAR;
    }
    PG8_STAMP();
    for (;;) {
        const bool has_next = S.next(ui + 1, nxt);
        const char* nA = has_next ? (const char*)S.baseA(g, nxt) + (size_t)nxt.pm * tstep : cA; const char* nB = has_next ? (const char*)S.baseB(g, nxt) + (size_t)nxt.pn * tstep : cB;
        for (int t = 0; t < nt; t += 2) {
            const bool last = (t == nt - 2);
            const char* a1 = cA + (size_t)(t + 1) * kstep;
            const char* a2 = last ? nA : cA + (size_t)(t + 2) * kstep; const char* b2 = last ? nB : cB + (size_t)(t + 2) * kstep;
            const char* a3 = a2 + kstep; const char* b3 = b2 + kstep;
            if (last && has_next) S.a_ready(nxt);
            if constexpr (SP2) {
            PG8_LDB(B0, 0, 0); PG8_LDB(B1, 0, 1); PG8_SCHED; PG8_LDA(At, 0, 0); PG8_STAGE(PG8_SA(1, 1), a1 + hstep, voffA);
            PG8_WAIT_V(8); PG8_WAIT_L(0); PG8_BAR; PG8_MMA(0, 0, At, B0); PG8_MMA(0, 1, At, B1); PG8_BAR; PG8_SCHED;
            PG8_LDA(At, 0, 1); PG8_STAGE(PG8_SB(0, 0), b2, voffB); PG8_STAGE(PG8_SB(0, 1), b2 + hstep, voffB); PG8_STAGE(PG8_SA(0, 0), a2, voffA);
            PG8_WAIT_V(8); PG8_WAIT_L(0); PG8_BAR; PG8_MMA(1, 0, At, B0); PG8_MMA(1, 1, At, B1); PG8_BAR; PG8_SCHED;
            PG8_LDB(B0, 1, 0); PG8_LDB(B1, 1, 1); PG8_SCHED; PG8_LDA(At, 1, 0); PG8_STAGE(PG8_SA(0, 1), a2 + hstep, voffA);
            PG8_WAIT_V(8); PG8_WAIT_L(0); PG8_BAR; PG8_MMA(0, 0, At, B0); PG8_MMA(0, 1, At, B1); PG8_BAR; PG8_SCHED;
            PG8_LDA(At, 1, 1); PG8_STAGE(PG8_SB(1, 0), b3, voffB); PG8_STAGE(PG8_SB(1, 1), b3 + hstep, voffB); PG8_STAGE(PG8_SA(1, 0), a3, voffA);
            PG8_WAIT_V(8); PG8_WAIT_L(0); PG8_BAR; PG8_MMA(1, 0, At, B0); PG8_MMA(1, 1, At, B1); PG8_BAR; PG8_SCHED;
            } else {
            PG8_LDB(B0, 0, 0); PG8_SCHED; PG8_LDA(At, 0, 0); PG8_STAGE(PG8_SA(1, 1), a1 + hstep, voffA);
            PG8_WAIT_L(8); PG8_BAR; PG8_WAIT_L(0); PG8_MMA(0, 0, At, B0); PG8_BAR; PG8_SCHED;
            PG8_LDB(B1, 0, 1); PG8_STAGE(PG8_SB(0, 0), b2, voffB);
            PG8_BAR; PG8_WAIT_L(0); PG8_MMA(0, 1, At, B1); PG8_BAR;
            PG8_LDA(At, 0, 1); PG8_STAGE(PG8_SA(0, 0), a2, voffA);
            PG8_BAR; PG8_WAIT_L(0); PG8_MMA(1, 0, At, B0); PG8_BAR; PG8_SCHED;
            PG8_STAGE(PG8_SB(0, 1), b2 + hstep, voffB);
            PG8_WAIT_V(6); PG8_BAR; PG8_MMA(1, 1, At, B1); PG8_BAR;
            PG8_LDB(B0, 1, 0); PG8_SCHED; PG8_LDA(At, 1, 0); PG8_STAGE(PG8_SA(0, 1), a2 + hstep, voffA);
            PG8_WAIT_L(8); PG8_BAR; PG8_WAIT_L(0); PG8_MMA(0, 0, At, B0); PG8_BAR; PG8_SCHED;
            PG8_LDB(B1, 1, 1); PG8_STAGE(PG8_SB(1, 0), b3, voffB);
            PG8_BAR; PG8_WAIT_L(0); PG8_MMA(0, 1, At, B1); PG8_BAR;
            PG8_LDA(At, 1, 1); PG8_STAGE(PG8_SA(1, 0), a3, voffA);
            PG8_BAR; PG8_WAIT_L(0); PG8_MMA(1, 0, At, B0); PG8_BAR; PG8_SCHED;
            PG8_STAGE(PG8_SB(1, 1), b3 + hstep, voffB);
            PG8_WAIT_V(6); PG8_BAR; PG8_MMA(1, 1, At, B1); PG8_BAR;
                    }
        }
        PG8_STAMP();
        if constexpr (ALIGN_EPI) { if (wr == 0) PG8_BAR; }
        bool keep_acc = false;
        if constexpr (Sched::DUAL) { if (cur.sub == 0) { E.mid(acc, cur, wr, wc, fr, fq); keep_acc = true; } else E(acc, cur, wr, wc, fr, fq); }
        else if constexpr (!Epi::AFTER_DRAIN) { E(acc, cur, wr, wc, fr, fq); S.done(cur); }
        PG8_STAMP();
        if (!has_next) break;
        if (!keep_acc)
#pragma unroll
        for (int a = 0; a < 2; ++a)
#pragma unroll
            for (int b = 0; b < 2; ++b)
#pragma unroll
                for (int m = 0; m < 4; ++m)
#pragma unroll
                    for (int n = 0; n < 2; ++n) acc[a][b][m][n] = (f32x4){0.f, 0.f, 0.f, 0.f};
        cur = nxt; cA = nA; cB = nB; ++ui;
        if constexpr (ALIGN_EPI) { if (wr == 1) PG8_BAR; }
    }
    PG8_WAIT_V(0);
    if constexpr (!ALIGN_EPI) { if (wr == 0) PG8_BAR; }
    PG8_BAR;
    if constexpr (Epi::AFTER_DRAIN) { E.fused(acc, cur, wr, wc, fr, fq, lds, wid, lane); S.done(cur); }
    PG8_STAMP();
    if (STAMP && wid == 0) { stamps[lane] = lane < nts ? (((unsigned long long)(unsigned)ts_hi << 32) | (unsigned)ts_lo) : 0ull;
        if (lane == 62) stamps[62] = rt_entry; if (lane == 63) stamps[63] = (unsigned long long)wall_clock64(); }
#undef PG8_STAMP
#undef PG8_SA
#undef PG8_SB
#undef PG8_STAGE
#undef PG8_LDA
#undef PG8_LDB
#undef PG8_MMA
#undef PG8_WAIT_V
#undef PG8_WAIT_L
#undef PG8_BAR
#undef PG8_SCHED
}
}

#define XB_TMO      128
#define XB_XCNT(j)  (256  + 64 * (j))
#define XB_XSUB(j)  (1280 + 64 * (j))
#define XB_XGEN(j)  (2304 + 64 * (j))
#define XB_TOP      3328
#define XB_TOPGEN   3392
#define XCD_BAR_WORDS 3456
#define XB_SPIN_CAP (1u << 18)
#define LAS __attribute__((address_space(3)))

__device__ __forceinline__ unsigned xb_ld(unsigned* p)              { return __hip_atomic_load(p, __ATOMIC_RELAXED, __HIP_MEMORY_SCOPE_AGENT); }
__device__ __forceinline__ unsigned xb_add(unsigned* p, unsigned v) { return __hip_atomic_fetch_add(p, v, __ATOMIC_RELAXED, __HIP_MEMORY_SCOPE_AGENT); }
__device__ __forceinline__ unsigned xb_xcc_id() { return (unsigned)__builtin_amdgcn_s_getreg((3 << 11) | 20) & 0xFu; }
#define XB_SPIN(cond, bar) do { unsigned _sp = 0; while (cond) { __builtin_amdgcn_s_sleep(1); \
    if ((++_sp & 255u) == 0u) { if (xb_ld(&(bar)[XB_TMO])) break; if (_sp > XB_SPIN_CAP) { atomicAdd(&(bar)[XB_TMO], 1u); break; } } } } while (0)

struct XcdBarrier {
    unsigned* bar; unsigned x;
    volatile LAS unsigned* st;
};

__device__ __forceinline__ XcdBarrier xcd_barrier_post(unsigned* bar, volatile LAS unsigned* st) {
    XcdBarrier b; b.bar = bar; b.x = xb_xcc_id(); b.st = st;
    if (threadIdx.x == 0) (void)xb_add(&bar[XB_XCNT(b.x)], 1u);
    return b;
}
__device__ __forceinline__ void xcd_barrier_complete(unsigned* bar, unsigned x, unsigned& nloc, unsigned& nx) {
    const unsigned G = gridDim.x * gridDim.y * gridDim.z;
    unsigned sum, cnt, mine, sp = 0u;
    for (;;) {
        sum = 0u; cnt = 0u; mine = 0u;
#pragma unroll
        for (unsigned j = 0; j < 16; ++j) { const unsigned c = xb_ld(&bar[XB_XCNT(j)]); sum += c; cnt += (c > 0u) ? 1u : 0u; mine = (j == x) ? c : mine; }
        if (sum == G) break;
        __builtin_amdgcn_s_sleep(1);
        if ((++sp & 255u) == 0u) { if (xb_ld(&bar[XB_TMO])) break; if (sp > XB_SPIN_CAP) { atomicAdd(&bar[XB_TMO], 1u); break; } }
    }
    nloc = mine > 0u ? mine : 1u; nx = cnt > 0u ? cnt : 1u;
}

__device__ __forceinline__ void xcd_barrier(const XcdBarrier& b) {
    asm volatile("s_waitcnt vmcnt(0)" ::: "memory");
    __syncthreads();
    if (threadIdx.x == 0) {
        unsigned* bar = b.bar;
        __builtin_amdgcn_s_waitcnt(0);
        unsigned nloc = b.st[0], nx = b.st[1];
        if (nloc == 0u) { xcd_barrier_complete(bar, b.x, nloc, nx); b.st[0] = nloc; b.st[1] = nx; }
        const unsigned old = xb_add(&bar[XB_XSUB(b.x)], 1u);
        const unsigned gen = old / nloc;
        if (old + 1u == (gen + 1u) * nloc) {
            __builtin_amdgcn_fence(__ATOMIC_RELEASE, "agent");
            asm volatile("s_waitcnt vmcnt(0)" ::: "memory");
            const unsigned og = xb_add(&bar[XB_TOP], 1u);
            const unsigned tg = og / nx;
            if (og + 1u == (tg + 1u) * nx) xb_add(&bar[XB_TOPGEN], 1u);
            else XB_SPIN(xb_ld(&bar[XB_TOPGEN]) == tg, bar);
            __builtin_amdgcn_fence(__ATOMIC_ACQUIRE, "agent");
            xb_add(&bar[XB_XGEN(b.x)], 1u);
            asm volatile("s_waitcnt vmcnt(0)" ::: "memory");
        } else {
            XB_SPIN(xb_ld(&bar[XB_XGEN(b.x)]) == gen, bar);
            __builtin_amdgcn_fence(__ATOMIC_ACQUIRE, "agent");
            asm volatile("s_waitcnt vmcnt(0)" ::: "memory");
        }
    }
    __syncthreads();
}
typedef pg8::bf16_t bf16_t;
typedef short bf16x8 __attribute__((ext_vector_type(8)));
typedef short s16x4 __attribute__((ext_vector_type(4)));
typedef float f32x4 __attribute__((ext_vector_type(4)));
typedef float f32x16 __attribute__((ext_vector_type(16)));
typedef unsigned u32x4 __attribute__((ext_vector_type(4)));
typedef unsigned u32x2 __attribute__((ext_vector_type(2)));
constexpr int T = 8192, DM = 4096, NIN = 21552, NP = 21760, DEPTH = 2, NWAVES = 8, NTHREADS = 512;
constexpr int C_Q = 0, C_KV = 2048, C_ZA = 5120, C_UB = 7168, C_VB = 9216, C_ZB = 11264, C_MA = 13312, C_MB = 17408, C_GA = 21504;
constexpr int AW = 2048, BW = 2048, HD = 128, NCMP = 511, NCP = 512;
constexpr float NORM_EPS = 1e-6f;
constexpr size_t al256(size_t x) { return (x + 255) & ~(size_t)255; }
constexpr size_t WS_CTL = 0, CTL_BYTES = 1u << 20;
constexpr size_t SZ_WIN = (size_t)NP * DM * 2, SZ_WAB = (size_t)DM * AW * 2, SZ_WO = (size_t)DM * DM * 2, SZ_W1 = (size_t)HD * 4096 * 2, SZ_W2 = (size_t)HD * HD * 2;
constexpr size_t WS_WIN = WS_CTL + CTL_BYTES;
constexpr size_t WS_WA = WS_WIN + DEPTH * SZ_WIN;
constexpr size_t WS_WB = WS_WA + DEPTH * SZ_WAB;
constexpr size_t WS_WO = WS_WB + DEPTH * SZ_WAB;
constexpr size_t WS_W1 = WS_WO + DEPTH * SZ_WO;
constexpr size_t WS_W2 = WS_W1 + DEPTH * 2 * SZ_W1;
constexpr size_t WS_H = al256(WS_W2 + DEPTH * 2 * SZ_W2);
constexpr size_t WS_PROJ = WS_H + (size_t)T * DM * 2;
constexpr size_t WS_KC = WS_PROJ + (size_t)T * NP * 2;
constexpr size_t WS_VC = WS_KC + (size_t)NCP * 512 * 2;
constexpr size_t WS_OA = WS_VC + (size_t)NCP * 512 * 2;
constexpr size_t WS_OB = WS_OA + (size_t)T * AW * 2;
constexpr size_t WS_T1 = WS_OB + (size_t)T * BW * 2;
constexpr size_t WS_MG = WS_T1 + (size_t)T * DM * 2;
constexpr size_t WS_Y = WS_MG + (size_t)T * DM * 2;
constexpr size_t WS_X1 = WS_Y + (size_t)T * DM * 4;
constexpr size_t WS_SS = WS_X1 + (size_t)T * DM * 4;
constexpr size_t WS_PARK = WS_SS + (size_t)T * 32 * 4;
constexpr size_t WS_END = WS_PARK + (size_t)1024 * 32 * 512 * 16;
constexpr int LDS_STAGE = 0;
constexpr int LDS_BIAS = 131072;
constexpr int LDS_MISC = LDS_BIAS + 16 * 256 * 4;
constexpr int LDS_RS = LDS_MISC + 64;
constexpr int LDS_ATT = LDS_RS + 512;
constexpr int LDS_BYTES = LDS_ATT + 8192;
static_assert(LDS_BYTES <= 160 * 1024, "LDS");
#define LAS3 __attribute__((address_space(3)))
#define LDS_WAIT() asm volatile("s_waitcnt lgkmcnt(0)" ::: "memory")
#define VM_WAIT() asm volatile("s_waitcnt vmcnt(0)" ::: "memory")

struct Params {
    const float *x, *rel_bias, *pre_norm, *w_in, *pe_k, *w1_k, *w2_k, *pe_v, *w1_v, *w2_v, *w_out_a, *sgu_norm, *sgu_w, *sgu_b, *w_out_b, *w_out, *post_norm;
    float* out; unsigned char* ws; int ph_lo, ph_hi;
};
__device__ __forceinline__ unsigned pk2(float lo, float hi) { return pg8::cvt_pk_bf16(lo, hi); }
__device__ __forceinline__ float wave_sum(float v) {
#pragma unroll
    for (int o = 1; o < 64; o <<= 1) v += __shfl_xor(v, o);
    return v;
}
__device__ const unsigned char BUCKET[128] = {0, 1, 2, 3, 4, 5, 6, 7, 8, 9, 10, 11, 12, 13, 14, 15, 16, 16, 16, 17, 17, 18, 18, 18, 19, 19, 19, 20, 20, 20, 20, 21, 21, 21, 21, 22, 22, 22, 22, 22, 23, 23, 23, 23, 23, 23, 24, 24, 24, 24, 24, 24, 25, 25, 25, 25, 25, 25, 25, 26, 26, 26, 26, 26, 26, 26, 26, 27, 27, 27, 27, 27, 27, 27, 27, 27, 27, 28, 28, 28, 28, 28, 28, 28, 28, 28, 28, 29, 29, 29, 29, 29, 29, 29, 29, 29, 29, 29, 29, 30, 30, 30, 30, 30, 30, 30, 30, 30, 30, 30, 30, 30, 30, 31, 31, 31, 31, 31, 31, 31, 31, 31, 31, 31, 31, 31, 31, 31};

constexpr int W_ITEMS_PER_LAYER = 64 * (NP / 64) + 2 * 32 * 64 + 64 * 64 + 2 * 64 * 2 + 2 * 2 * 2;
constexpr int W_ITEMS = DEPTH * W_ITEMS_PER_LAYER;
constexpr int W_TAIL_ITEMS = 0;
__device__ __forceinline__ int srcmap_in(int n) { return n < 5120 ? n : (n < 21504 ? n + 48 : (n < 21552 ? n - 21504 + 5120 : -1)); }
template <int MODE>
__device__ __forceinline__ void transpose_item(const float* __restrict__ W, int K, int N, bf16_t* __restrict__ WT, LAS3 float* scr, int item, int nblk, int lane) {
    int kb, nb;
    if ((nblk & 3) == 0) { const int g8 = item >> 3, sub = item & 7, q = nblk >> 2; const int gk = g8 / q, gn = g8 - gk * q; nb = gn * 4 + (sub & 3); kb = gk * 2 + (sub >> 2); }
    else { kb = item / nblk; nb = item - kb * nblk; }
    const int k0 = 64 * kb, n0 = 64 * nb;
    const int nn = n0 + 4 * (lane & 15); const int s = (MODE == 1) ? srcmap_in(nn) : nn;
    const float* src = W + (size_t)(k0 + (lane >> 4)) * N + (s >= 0 ? s : 0);
    f32x4 v[16];
#pragma unroll
    for (int i = 0; i < 16; ++i) v[i] = *(const f32x4*)(src + (size_t)(4 * i) * N);
    __builtin_amdgcn_sched_barrier(0);
#pragma unroll
    for (int i = 0; i < 16; ++i) { f32x4 x = v[i]; if (s < 0) x = (f32x4){0.f, 0.f, 0.f, 0.f};
        LAS3 float* d = scr + (4 * i + (lane >> 4)) * 65 + 4 * (lane & 15); d[0] = x[0]; d[1] = x[1]; d[2] = x[2]; d[3] = x[3]; }
    LDS_WAIT();
    const int c = lane & 7;
#pragma unroll
    for (int j = 0; j < 8; ++j) { const int n = (lane >> 3) + 8 * j; const LAS3 float* p = scr + (8 * c) * 65 + n;
        u32x4 o; o.x = pk2(p[0 * 65], p[1 * 65]); o.y = pk2(p[2 * 65], p[3 * 65]); o.z = pk2(p[4 * 65], p[5 * 65]); o.w = pk2(p[6 * 65], p[7 * 65]);
        if (MODE == 2) { const int k8 = (k0 >> 3) + c, na = n0 + n; *(u32x4*)(WT + (size_t)((((k8 >> 1) * (N >> 5) + (na >> 5)) * 64) + (k8 & 1) * 32 + (na & 31)) * 8) = o; }
        else *(u32x4*)(WT + (size_t)(n0 + n) * K + k0 + 8 * c) = o; }
    LDS_WAIT();
}
__device__ __forceinline__ void phase_weights(const Params& P, LAS3 unsigned char* lds, int gw, int NGW, int wave, int lane, int it_lo, int it_hi) {
    asm volatile("" : "+v"(lane));
    LAS3 float* scr = (LAS3 float*)(lds + LDS_STAGE + wave * 16640);
    constexpr int I_IN = 64 * (NP / 64), I_AB = 32 * 64, I_O = 64 * 64, I_W1 = 64 * 2, I_W2 = 2 * 2;
    constexpr int PER_LAYER = I_IN + 2 * I_AB + I_O + 2 * I_W1 + 2 * I_W2;
    static_assert(PER_LAYER == W_ITEMS_PER_LAYER, "item count");
    for (int it = it_lo + gw; it < it_hi; it += NGW) {
        const int L = it / PER_LAYER; int r = it - L * PER_LAYER;
        unsigned char* ws = P.ws;
        if (r < I_IN) { transpose_item<1>(P.w_in + (size_t)L * DM * NIN, DM, NIN, (bf16_t*)(ws + WS_WIN + L * SZ_WIN), scr, r, NP / 64, lane); continue; } r -= I_IN;
        if (r < I_AB) { transpose_item<0>(P.w_out_a + (size_t)L * AW * DM, AW, DM, (bf16_t*)(ws + WS_WA + L * SZ_WAB), scr, r, 64, lane); continue; } r -= I_AB;
        if (r < I_AB) { transpose_item<0>(P.w_out_b + (size_t)L * BW * DM, BW, DM, (bf16_t*)(ws + WS_WB + L * SZ_WAB), scr, r, 64, lane); continue; } r -= I_AB;
        if (r < I_O) { transpose_item<0>(P.w_out + (size_t)L * DM * DM, DM, DM, (bf16_t*)(ws + WS_WO + L * SZ_WO), scr, r, 64, lane); continue; } r -= I_O;
        if (r < I_W1) { transpose_item<2>(P.w1_k + (size_t)L * 4096 * HD, 4096, HD, (bf16_t*)(ws + WS_W1 + (L * 2 + 0) * SZ_W1), scr, r, 2, lane); continue; } r -= I_W1;
        if (r < I_W1) { transpose_item<2>(P.w1_v + (size_t)L * 4096 * HD, 4096, HD, (bf16_t*)(ws + WS_W1 + (L * 2 + 1) * SZ_W1), scr, r, 2, lane); continue; } r -= I_W1;
        if (r < I_W2) { transpose_item<0>(P.w2_k + (size_t)L * HD * HD, HD, HD, (bf16_t*)(ws + WS_W2 + (L * 2 + 0) * SZ_W2), scr, r, 2, lane); continue; } r -= I_W2;
        transpose_item<0>(P.w2_v + (size_t)L * HD * HD, HD, HD, (bf16_t*)(ws + WS_W2 + (L * 2 + 1) * SZ_W2), scr, r, 2, lane);
    }
}
__device__ __forceinline__ void phase_prenorm(const float* __restrict__ x, const float* __restrict__ g, bf16_t* __restrict__ h, int gw, int NGW, int lane) {
    asm volatile("" : "+v"(lane));
#pragma unroll 2
    for (int m = gw; m < T; m += NGW) {
        const f32x4* xr = (const f32x4*)(x + (size_t)m * DM) + lane; f32x4 v[16]; float ss = 0.f;
#pragma unroll
        for (int j = 0; j < 16; ++j) { v[j] = xr[64 * j]; ss += (v[j][0] * v[j][0] + v[j][1] * v[j][1]) + (v[j][2] * v[j][2] + v[j][3] * v[j][3]); }
        const float rs = 1.0f / sqrtf(wave_sum(ss) * (1.0f / DM) + NORM_EPS);
        u32x2* o = (u32x2*)(h + (size_t)m * DM) + lane; const f32x4* gr = (const f32x4*)g + lane;
#pragma unroll
        for (int j = 0; j < 16; ++j) { const f32x4 gg = gr[64 * j]; u32x2 w; w.x = pk2(v[j][0] * rs * gg[0], v[j][1] * rs * gg[1]); w.y = pk2(v[j][2] * rs * gg[2], v[j][3] * rs * gg[3]); o[64 * j] = w; }
    }
}
template <bool XOLD_BF16, bool XNEW_BF16>
__device__ __forceinline__ void phase_postnorm(const bf16_t* __restrict__ Y, const void* __restrict__ xold, const float* __restrict__ gpost, void* __restrict__ xnew,
                                               const float* __restrict__ gpre, bf16_t* __restrict__ h, bool next, int gw, int NGW, int lane) {
    asm volatile("" : "+v"(lane));
#pragma unroll 2
    for (int m = gw; m < T; m += NGW) {
        const u32x2* yr = (const u32x2*)(Y + (size_t)m * DM) + lane; f32x4 v[16]; float ss = 0.f;
#pragma unroll
        for (int j = 0; j < 16; ++j) { const u32x2 w = yr[64 * j]; v[j] = (f32x4){pg8::bf_lo(w.x), pg8::bf_hi(w.x), pg8::bf_lo(w.y), pg8::bf_hi(w.y)}; ss += (v[j][0] * v[j][0] + v[j][1] * v[j][1]) + (v[j][2] * v[j][2] + v[j][3] * v[j][3]); }
        const float rs = 1.0f / sqrtf(wave_sum(ss) * (1.0f / DM) + NORM_EPS);
        const f32x4* gr = (const f32x4*)gpost + lane;
        float s2 = 0.f;
#pragma unroll
        for (int j = 0; j < 16; ++j) { const f32x4 gg = gr[64 * j]; f32x4 xx;
            if (XOLD_BF16) { const u32x2 w = ((const u32x2*)((const bf16_t*)xold + (size_t)m * DM) + lane)[64 * j]; xx = (f32x4){pg8::bf_lo(w.x), pg8::bf_hi(w.x), pg8::bf_lo(w.y), pg8::bf_hi(w.y)}; }
            else xx = ((const f32x4*)((const float*)xold + (size_t)m * DM) + lane)[64 * j];
            const f32x4 r = xx + v[j] * rs * gg; v[j] = r;
            if (XNEW_BF16) { u32x2 w; w.x = pk2(r[0], r[1]); w.y = pk2(r[2], r[3]); ((u32x2*)((bf16_t*)xnew + (size_t)m * DM) + lane)[64 * j] = w; }
            else ((f32x4*)((float*)xnew + (size_t)m * DM) + lane)[64 * j] = r;
            s2 += (r[0] * r[0] + r[1] * r[1]) + (r[2] * r[2] + r[3] * r[3]); }
        if (next) {
            const float rs2 = 1.0f / sqrtf(wave_sum(s2) * (1.0f / DM) + NORM_EPS);
            u32x2* o = (u32x2*)(h + (size_t)m * DM) + lane; const f32x4* g2 = (const f32x4*)gpre + lane;
#pragma unroll
            for (int j = 0; j < 16; ++j) { const f32x4 gg = g2[64 * j]; u32x2 w; w.x = pk2(v[j][0] * rs2 * gg[0], v[j][1] * rs2 * gg[1]); w.y = pk2(v[j][2] * rs2 * gg[2], v[j][3] * rs2 * gg[3]); o[64 * j] = w; }
        }
    }
}
namespace att {
constexpr float SCALE = 0.08838834764831845f, LOG2E = 1.4426950408889634f, C2 = SCALE * LOG2E;
constexpr int SHM = 16384;
constexpr int NSLOT = 3;
constexpr int L_V = 0, L_K = NSLOT * SHM, L_IMP = 2 * NSLOT * SHM, L_SEL = LDS_ATT, L_WS = L_SEL + 1024, L_SC = L_WS + 2048, L_END = L_SC + 4096;
static_assert(L_IMP + 32768 <= 131072 && L_END <= LDS_ATT + 8192, "attention LDS");
#define KSWZ(row, colB) ((row) * 256 + ((colB) ^ (((row) & 7) << 4)))
#define SBAR() __builtin_amdgcn_sched_barrier(0)
__device__ __forceinline__ int v_st(int k, int c) { const int kk = (k & ~0xC) | ((k & 4) << 1) | ((k & 8) >> 1); return ((kk >> 3) * 4 + (c >> 5)) * 512 + ((kk & 7) * 32 + (c & 31)) * 2; }
__device__ __forceinline__ int v_rd_base(int lane) { return ((lane & 3) << 3) | (((lane >> 2) & 3) << 6) | (((lane >> 4) & 1) << 5) | (((lane >> 5) & 1) << 8); }
constexpr int v_rd_off(int d0, int ks, int half) { return d0 * 512 + ks * 4096 + half * 2048; }
__device__ __forceinline__ int crow(int r, int hi) { return (r & 3) + 8 * (r >> 2) + 4 * hi; }
__device__ __forceinline__ unsigned cvtpk(float lo, float hi) { return pg8::cvt_pk_bf16(lo, hi); }
enum { MODE_STAT = 0, MODE_IMP = 1, MODE_ONLINE = 2, MODE_ACC = 3, MODE_IMPACC = 4 };
#ifndef PP_STAT
#define PP_STAT false
#endif
#ifndef PP_ACC
#define PP_ACC false
#endif

struct Ctx {
    bf16x8 qr[8]; f32x16 o[4];
    int tq, r32, hi, wid, lane, tid, t0;
    const LAS3 float* tb; float bfar;
    LAS3 char* lds;
};
__device__ __forceinline__ void qkt(f32x16& p0, f32x16& p1, const LAS3 char* Kt, int r32, int hi, const bf16x8* qr) {
    p0 = f32x16{}; p1 = f32x16{};
    const LAS3 char* kb[4];
#pragma unroll
    for (int dd = 0; dd < 4; ++dd) kb[dd] = Kt + KSWZ(r32, (dd * 16 + hi * 8) * 2);
#pragma unroll
    for (int d0 = 0; d0 < 8; ++d0) { const LAS3 char* a = kb[d0 & 3] + (d0 >> 2) * 128;
        const bf16x8 b0 = *reinterpret_cast<const LAS3 bf16x8*>(a);
        const bf16x8 b1 = *reinterpret_cast<const LAS3 bf16x8*>(a + 32 * 256);
        p0 = __builtin_amdgcn_mfma_f32_32x32x16_bf16(b0, qr[d0], p0, 0, 0, 0);
        p1 = __builtin_amdgcn_mfma_f32_32x32x16_bf16(b1, qr[d0], p1, 0, 0, 0);
        if ((d0 & 3) == 3) SBAR(); }
}
__device__ __forceinline__ void pv_tile(f32x16* o, int vb0, bf16x8 pa0, bf16x8 pa1, bf16x8 pa2, bf16x8 pa3) {
#define TRRD(dst, off) asm volatile("ds_read_b64_tr_b16 %0, %1 offset:%2" : "=&v"(dst) : "v"(vb0), "i"(off) : "memory")
#define PV_KS(ks, PA) do { s16x4 l0, l1, l2, l3, h0, h1, h2, h3; constexpr int b_ = v_rd_off(0, ks, 0); \
        TRRD(l0, b_); TRRD(h0, b_ + 2048); TRRD(l1, b_ + 512); TRRD(h1, b_ + 512 + 2048); TRRD(l2, b_ + 1024); TRRD(h2, b_ + 1024 + 2048); TRRD(l3, b_ + 1536); TRRD(h3, b_ + 1536 + 2048); \
        asm volatile("s_waitcnt lgkmcnt(0)" ::: "memory"); SBAR(); \
        o[0] = __builtin_amdgcn_mfma_f32_32x32x16_bf16(PA, (bf16x8){l0[0], l0[1], l0[2], l0[3], h0[0], h0[1], h0[2], h0[3]}, o[0], 0, 0, 0); \
        o[1] = __builtin_amdgcn_mfma_f32_32x32x16_bf16(PA, (bf16x8){l1[0], l1[1], l1[2], l1[3], h1[0], h1[1], h1[2], h1[3]}, o[1], 0, 0, 0); \
        o[2] = __builtin_amdgcn_mfma_f32_32x32x16_bf16(PA, (bf16x8){l2[0], l2[1], l2[2], l2[3], h2[0], h2[1], h2[2], h2[3]}, o[2], 0, 0, 0); \
        o[3] = __builtin_amdgcn_mfma_f32_32x32x16_bf16(PA, (bf16x8){l3[0], l3[1], l3[2], l3[3], h3[0], h3[1], h3[2], h3[3]}, o[3], 0, 0, 0); } while (0)
    PV_KS(0, pa0); PV_KS(1, pa1); PV_KS(2, pa2); PV_KS(3, pa3);
#undef PV_KS
#undef TRRD
}
__device__ __forceinline__ void pack_p(const f32x16& p0, const f32x16& p1, bf16x8& pa0, bf16x8& pa1, bf16x8& pa2, bf16x8& pa3) {
#define PK4(P, B_, OUT) do { u32x4 w = {cvtpk(P[B_+0], P[B_+1]), cvtpk(P[B_+2], P[B_+3]), cvtpk(P[B_+4], P[B_+5]), cvtpk(P[B_+6], P[B_+7])}; OUT = *reinterpret_cast<bf16x8*>(&w); } while (0)
    PK4(p0, 0, pa0); PK4(p0, 8, pa1); PK4(p1, 0, pa2); PK4(p1, 8, pa3);
#undef PK4
}
__device__ __forceinline__ float half_max(float v) { auto rr = __builtin_amdgcn_permlane32_swap(__float_as_uint(v), __float_as_uint(v), false, false); return fmaxf(__uint_as_float(rr[0]), __uint_as_float(rr[1])); }
__device__ __forceinline__ float half_sum(float v) { auto rr = __builtin_amdgcn_permlane32_swap(__float_as_uint(v), __float_as_uint(v), false, false); return __uint_as_float(rr[0]) + __uint_as_float(rr[1]); }

template <int MODE, int STEP, int OFF, bool ROWSEL, bool PP>
__device__ __forceinline__ void run_pass(Ctx& c, const bf16_t* __restrict__ Kg, const bf16_t* __restrict__ Vg, const int ldk, const int j_lo, const int j_hi, const unsigned W,
                                         float& m_reg, float& l_reg, const float pscale, unsigned sm0, unsigned sm1, unsigned sm2, unsigned sm3, const float gate = 1.f, const bool rev = false) {
    constexpr bool HASV = (MODE == MODE_ONLINE || MODE == MODE_ACC || MODE == MODE_IMPACC), RUNMAX = (MODE == MODE_ONLINE || MODE == MODE_STAT);
    int tid = c.tid, r32 = c.r32, hi = c.hi, lane = c.lane;
    asm volatile("" : "+v"(tid), "+v"(r32), "+v"(hi), "+v"(lane));
    const int n = j_hi - j_lo + 1;
    if (n <= 0) return;
    LAS3 char* V_lds = c.lds + L_V; LAS3 char* K_lds = c.lds + L_K;
    LAS3 float* al_l = (LAS3 float*)(c.lds + L_WS) + c.wid * 64 + 32;
    const int krow = tid >> 4;
    const unsigned ko0 = (unsigned)(krow * ldk + (((tid & 15) ^ (krow & 7)) * 8)) * 2u;
    const int vkk = ((tid >> 7) * 8) + ((tid & 31) >> 2), vkey = vkk, vcol = ((tid >> 5) & 3) * 32 + (tid & 3) * 8;
    const unsigned vo0 = (unsigned)(vkey * ldk + vcol) * 2u;
    const unsigned half_step = (unsigned)(32 * ldk) * 2u;
    const int vbase = (int)(uintptr_t)V_lds + v_rd_base(lane);
#define LOADT(j, bf) do { const char* kp_ = (const char*)(Kg + (size_t)((j) * 64) * ldk); LAS3 char* kd_ = K_lds + (bf) * SHM + c.wid * 1024; \
        __builtin_amdgcn_global_load_lds((const unsigned*)(kp_ + ko0), (LAS3 unsigned*)kd_, 16, 0, 0); \
        __builtin_amdgcn_global_load_lds((const unsigned*)((kp_ + half_step) + ko0), (LAS3 unsigned*)(kd_ + 8192), 16, 0, 0); \
        if (HASV) { const char* vp_ = (const char*)(Vg + (size_t)((j) * 64) * ldk); LAS3 char* vd_ = V_lds + (bf) * SHM + c.wid * 1024; \
            __builtin_amdgcn_global_load_lds((const unsigned*)(vp_ + vo0), (LAS3 unsigned*)vd_, 16, 0, 0); \
            __builtin_amdgcn_global_load_lds((const unsigned*)((vp_ + half_step) + vo0), (LAS3 unsigned*)(vd_ + 8192), 16, 0, 0); } } while (0)
#define WAIT_OLDER(younger) do { if (younger) { if (HASV) asm volatile("s_waitcnt vmcnt(4)" ::: "memory"); else asm volatile("s_waitcnt vmcnt(2)" ::: "memory"); } else VM_WAIT(); } while (0)
#define STEP_END(oddstep, ldt) do { if (oddstep) WAIT_OLDER(ldt); LDS_WAIT(); __builtin_amdgcn_s_barrier(); asm volatile("" ::: "memory"); } while (0)
#define TJ(t_) (rev ? j_hi - (t_) : j_lo + (t_))
    LOADT(TJ(0), 0); if (n > 1) LOADT(TJ(1), 1);
    WAIT_OLDER(n > 1);
    __builtin_amdgcn_s_barrier(); asm volatile("" ::: "memory");
    const int role = PP ? (c.wid >> 2) : 0, tqw = c.t0 + 8 * c.wid;
    const float NEG = -__builtin_inff();
    const float lp = RUNMAX ? 0.f : __builtin_amdgcn_logf(pscale);
    if (PP && role == 1) { __builtin_amdgcn_s_barrier(); asm volatile("" ::: "memory"); }
    int slot = 0;
#pragma unroll 1
    for (int t = 0; t < n; ++t) {
        const int j = TJ(t);
        const bool ldt = (t + 2 < n); const int lslot = slot == 0 ? 2 : slot - 1;
        if ((!PP || role == 1) && ldt) LOADT(TJ(t + 2), lslot);
        f32x16 p0, p1; float mul = C2, off = 0.f, alpha = 1.f; bool resc = false;
        const int kpos0 = STEP * (j * 64) + OFF;
        const int dmin = tqw - (kpos0 + STEP * 63), dmax = tqw + 7 - kpos0;
        bool rowsel = true;
        if (ROWSEL) { const unsigned wsel = (j < 32) ? sm0 : (j < 64) ? sm1 : (j < 96) ? sm2 : sm3; rowsel = (wsel >> (j & 31)) & 1u; }
        bool act = (dmax >= 0) && (dmin < (int)W);
        if (ROWSEL) act = act && __any(rowsel);
        if (act) {
            SBAR(); __builtin_amdgcn_s_setprio(2); qkt(p0, p1, K_lds + slot * SHM, r32, hi, c.qr); __builtin_amdgcn_s_setprio(0); SBAR();
            const bool needmask = (dmin < 0) || ((unsigned)dmax >= W);
            const int d0 = c.tq - kpos0 - STEP * 4 * hi;
            float add0 = c.bfar;
            if (dmin < 113) {
                if (STEP == 1) {
                    const LAS3 float* tbase = c.tb + (d0 + 5);
#pragma unroll
                    for (int r = 0; r < 16; ++r) { const int cc = (r & 3) + 8 * (r >> 2);
                        p0[r] = fmaf(p0[r], C2, tbase[59 - cc]); p1[r] = fmaf(p1[r], C2, tbase[59 - cc - 32]);
                        if ((r & 3) == 3) SBAR(); }
                } else {
#pragma unroll
                    for (int r = 0; r < 16; ++r) { const int cc = (r & 3) + 8 * (r >> 2); const int da = d0 - STEP * cc, db = d0 - STEP * (cc + 32);
                        const float ba = c.tb[64 + min(max(da, 0), 127)], bb = c.tb[64 + min(max(db, 0), 127)];
                        p0[r] = fmaf(p0[r], C2, ba); p1[r] = fmaf(p1[r], C2, bb);
                        if ((r & 3) == 3) SBAR(); }
                }
                mul = 1.f; add0 = 0.f;
            }
            if (needmask) {
#pragma unroll
                for (int r = 0; r < 16; ++r) { const int cc = (r & 3) + 8 * (r >> 2); const int da = d0 - STEP * cc, db = d0 - STEP * (cc + 32);
                    if ((unsigned)da >= W) p0[r] = NEG; if ((unsigned)db >= W) p1[r] = NEG; }
            }
            SBAR();
            if (RUNMAX) {
                float pm = fmaxf(p0[0], p1[0]);
#pragma unroll
                for (int r = 1; r < 16; ++r) pm = fmaxf(fmaxf(pm, p0[r]), p1[r]);
                pm = half_max(pm);
                float xmax = fmaf(pm, mul, add0); if (ROWSEL) xmax = rowsel ? xmax : NEG;
                float mn = m_reg;
                if (MODE != MODE_ONLINE || !__all(xmax - m_reg <= 8.0f)) { mn = fmaxf(m_reg, xmax); alpha = __builtin_amdgcn_exp2f(m_reg - mn); m_reg = mn; }
                off = add0 - mn; if (ROWSEL) off = rowsel ? off : NEG;
                if (MODE == MODE_ONLINE) { resc = __any(alpha < 1.f); if (resc && hi == 0) al_l[r32] = alpha; }
            } else off = (add0 - m_reg) + lp;
        }
        if (PP) STEP_END(role == 1, ldt);
        if (PP && role == 0 && ldt) LOADT(TJ(t + 2), lslot);
        if (act) {
#pragma unroll
            for (int r = 0; r < 16; ++r) { p0[r] = __builtin_amdgcn_exp2f(fmaf(p0[r], mul, off)); p1[r] = __builtin_amdgcn_exp2f(fmaf(p1[r], mul, off)); }
            if (RUNMAX) {
                float ps = 0.f;
#pragma unroll
                for (int r = 0; r < 16; ++r) ps += p0[r] + p1[r];
                ps = half_sum(ps);
                l_reg = l_reg * alpha + ps;
            }
            if (MODE == MODE_IMP || MODE == MODE_IMPACC) {
                LAS3 float* imp = (LAS3 float*)(c.lds + L_IMP) + (c.wid * 8 + (r32 >> 2)) * 128;
#pragma unroll
                for (int hf = 0; hf < 2; ++hf)
#pragma unroll
                    for (int m = 0; m < 4; ++m) { const f32x16& P = hf ? p1 : p0;
                        float a = 2.f * (P[4 * m] + P[4 * m + 1] + P[4 * m + 2]) + P[4 * m + 3], b = P[4 * m + 3];
                        a += __shfl_xor(a, 1); b += __shfl_xor(b, 1); a += __shfl_xor(a, 2); b += __shfl_xor(b, 2);
                        const int jj = 16 * j + 8 * hf + 2 * m + hi;
                        if ((r32 & 3) == 0) { __hip_atomic_fetch_add(imp + jj, a, __ATOMIC_RELAXED, __HIP_MEMORY_SCOPE_WORKGROUP);
                            if (jj + 1 < 128) __hip_atomic_fetch_add(imp + jj + 1, b, __ATOMIC_RELAXED, __HIP_MEMORY_SCOPE_WORKGROUP); } }
            }
            if (MODE == MODE_IMPACC) {
#pragma unroll
                for (int r = 0; r < 16; ++r) { p0[r] *= gate; p1[r] *= gate; }
            }
            if (HASV) {
                bf16x8 pa0, pa1, pa2, pa3;
                SBAR(); pack_p(p0, p1, pa0, pa1, pa2, pa3); SBAR();
                if (MODE == MODE_ONLINE && resc) {
#pragma unroll
                    for (int d_ = 0; d_ < 4; ++d_)
#pragma unroll
                        for (int r = 0; r < 16; ++r) c.o[d_][r] *= al_l[crow(r, hi)];
                    SBAR(); }
                pv_tile(c.o, vbase + slot * SHM, pa0, pa1, pa2, pa3);
            }
        }
        STEP_END(role == 0, ldt);
        slot = slot == 2 ? 0 : slot + 1;
    }
    if (PP && role == 0) { __builtin_amdgcn_s_barrier(); asm volatile("" ::: "memory"); }
#undef TJ
#undef STEP_END
#undef WAIT_OLDER
#undef LOADT
}
__device__ __forceinline__ void attn_unit(LAS3 char* lds, const bf16_t* __restrict__ proj, const bf16_t* __restrict__ kc, const bf16_t* __restrict__ vc, bf16_t* __restrict__ oa, float* park, int qt, int g, bool rev) {
    int tid_ = threadIdx.x; asm volatile("" : "+v"(tid_));
    Ctx c; c.lds = lds; c.tid = tid_; c.lane = c.tid & 63; c.wid = __builtin_amdgcn_readfirstlane(c.tid >> 6); c.r32 = c.lane & 31; c.hi = c.lane >> 5;
    c.t0 = qt * 64; c.tq = c.t0 + 8 * c.wid + (c.r32 >> 2);
    const int head = g * 4 + (c.r32 & 3);
    c.tb = (const LAS3 float*)(lds + LDS_BIAS) + head * 256; c.bfar = c.tb[64 + 127];
    { const bf16_t* qp = proj + (size_t)c.tq * NP + C_Q + head * HD + c.hi * 8;
#pragma unroll
      for (int d0 = 0; d0 < 8; ++d0) c.qr[d0] = *(const bf16x8*)(qp + d0 * 16); }
    float ga[3];
    { const bf16_t* gp = proj + (size_t)c.tq * NP + C_GA + head * 3;
#pragma unroll
      for (int b = 0; b < 3; ++b) ga[b] = pg8::fast_sigmoid(__uint_as_float(((unsigned)gp[b]) << 16)); }
    { LAS3 f32x4* z = (LAS3 f32x4*)(lds + L_IMP);
#pragma unroll
      for (int i = 0; i < 4; ++i) z[c.tid + 512 * i] = (f32x4){0.f, 0.f, 0.f, 0.f}; }
    __syncthreads();
    const bf16_t* Kc = kc + g * HD; const bf16_t* Vc = vc + g * HD;
    const bf16_t* Ks = proj + C_KV + 2 * 512 + g * HD; const bf16_t* Vs = proj + C_KV + 3 * 512 + g * HD;
    const bf16_t* Kw = proj + C_KV + 4 * 512 + g * HD; const bf16_t* Vw = proj + C_KV + 5 * 512 + g * HD;
    const int ntc = (4 * qt + 2) / 64;
    constexpr unsigned WINF = 0x7fffffffu;
    LAS3 float* wsf = (LAS3 float*)(lds + L_WS) + c.wid * 64;
#define PARK_PTR(sl_) int pt_ = c.tid; asm volatile("" : "+v"(pt_)); char* pp_ = (char*)park + ((size_t)blockIdx.x * 32 * 512 + (size_t)(sl_) * 16 * 512 + pt_) * 16
#define PARK_STORE(sl_) do { PARK_PTR(sl_); _Pragma("unroll") for (int d_ = 0; d_ < 4; ++d_) _Pragma("unroll") for (int q_ = 0; q_ < 4; ++q_) { \
        *(f32x4*)pp_ = (f32x4){c.o[d_][4 * q_], c.o[d_][4 * q_ + 1], c.o[d_][4 * q_ + 2], c.o[d_][4 * q_ + 3]}; pp_ += 8192; } } while (0)
#define PARK_ADD(sl_) do { PARK_PTR(sl_); _Pragma("unroll") for (int hh_ = 0; hh_ < 2; ++hh_) { f32x4 t_[8]; _Pragma("unroll") for (int e_ = 0; e_ < 8; ++e_) { t_[e_] = *(const f32x4*)pp_; pp_ += 8192; } SBAR(); \
        _Pragma("unroll") for (int e_ = 0; e_ < 8; ++e_) { const int d_ = hh_ * 2 + (e_ >> 2), q_ = e_ & 3; \
        c.o[d_][4 * q_] += t_[e_][0]; c.o[d_][4 * q_ + 1] += t_[e_][1]; c.o[d_][4 * q_ + 2] += t_[e_][2]; c.o[d_][4 * q_ + 3] += t_[e_][3]; } SBAR(); } } while (0)
#define ROW_SCALE(f_) do { if (c.hi == 0) wsf[c.r32] = (f_); LDS_WAIT(); _Pragma("unroll") for (int d_ = 0; d_ < 4; ++d_) _Pragma("unroll") for (int r = 0; r < 16; ++r) c.o[d_][r] *= wsf[crow(r, c.hi)]; } while (0)
#ifndef AREP
#define AREP 0
#endif
    {
        float m_c = -1e30f, l_c = 0.f;
        run_pass<MODE_STAT, 16, 31, false, false>(c, Kc, Vc, 512, 0, ntc, WINF, m_c, l_c, 0.f, 0u, 0u, 0u, 0u);
        const float rl_c = l_c > 0.f ? 1.0f / l_c : 0.f;
#pragma unroll
        for (int d_ = 0; d_ < 4; ++d_) c.o[d_] = f32x16{};
        run_pass<MODE_IMPACC, 16, 31, false, false>(c, Kc, Vc, 512, 0, ntc, WINF, m_c, l_c, rl_c, 0u, 0u, 0u, 0u, ga[0]);
        PARK_STORE(0);
    }
    {
        LAS3 unsigned* selw = (LAS3 unsigned*)(lds + L_SEL);
#pragma unroll 1
        for (int tk = 0; tk < 8; ++tk) {
            const int tok = c.wid * 8 + tk; const LAS3 float* imp = (const LAS3 float*)(lds + L_IMP) + tok * 128;
            const int ja = c.lane, jb = c.lane + 64;
            unsigned ka = __float_as_uint(imp[ja]) + 1u, kb = __float_as_uint(imp[jb]) + 1u;
            ka = (ja == 0 || ja == qt || ja == qt - 1) ? 0xffffffffu : (ja > qt ? 0u : ka);
            kb = (jb == qt || jb == qt - 1) ? 0xffffffffu : (jb > qt ? 0u : kb);
            unsigned T = 0u;
#pragma unroll 1
            for (int bit = 31; bit >= 0; --bit) { const unsigned cand = T | (1u << bit);
                const int cnt = __popcll(__ballot(ka >= cand)) + __popcll(__ballot(kb >= cand));
                T = cnt >= 16 ? cand : T; }
            const int cgt = __popcll(__ballot(ka > T)) + __popcll(__ballot(kb > T)); const int rr = 16 - cgt;
            const unsigned long long ea = __ballot(ka == T), eb = __ballot(kb == T);
            const int ra = __builtin_amdgcn_mbcnt_hi((unsigned)(ea >> 32), __builtin_amdgcn_mbcnt_lo((unsigned)ea, 0u));
            const int rb = __popcll(ea) + (int)__builtin_amdgcn_mbcnt_hi((unsigned)(eb >> 32), __builtin_amdgcn_mbcnt_lo((unsigned)eb, 0u));
            const unsigned long long ba = __ballot(ka > T || (ka == T && ra < rr)), bb = __ballot(kb > T || (kb == T && rb < rr));
            if (c.lane == 0) { selw[tok * 4 + 0] = (unsigned)ba; selw[tok * 4 + 1] = (unsigned)(ba >> 32); selw[tok * 4 + 2] = (unsigned)bb; selw[tok * 4 + 3] = (unsigned)(bb >> 32); }
        }
        LDS_WAIT();
    }
    {
        float m_w = -1e30f, l_w = 0.f; const int jlo = qt >= 8 ? qt - 8 : 0;
#pragma unroll
        for (int d_ = 0; d_ < 4; ++d_) c.o[d_] = f32x16{};
        run_pass<MODE_ONLINE, 1, 0, false, false>(c, Kw, Vw, NP, jlo, qt, 512u, m_w, l_w, 0.f, 0u, 0u, 0u, 0u);
        ROW_SCALE(ga[2] / l_w);
        PARK_STORE(1);
    }
    {
        unsigned sm0, sm1, sm2, sm3;
        { const LAS3 unsigned* selw = (const LAS3 unsigned*)(lds + L_SEL) + (c.wid * 8 + (c.r32 >> 2)) * 4; sm0 = selw[0]; sm1 = selw[1]; sm2 = selw[2]; sm3 = selw[3]; }
        float m_s = -1e30f, l_s = 0.f;
#pragma unroll
        for (int d_ = 0; d_ < 4; ++d_) c.o[d_] = f32x16{};
        run_pass<MODE_ONLINE, 1, 0, true, true>(c, Ks, Vs, NP, 0, qt, WINF, m_s, l_s, 0.f, sm0, sm1, sm2, sm3, 1.f, rev);
        ROW_SCALE(ga[1] / l_s);
        PARK_ADD(0);
        PARK_ADD(1);
    }
#undef PARK_STORE
#undef PARK_ADD
#undef ROW_SCALE
#ifdef NO_EPI
    if (c.o[0][0] == 123.f && c.o[1][1] == 3.f && c.o[2][2] == 1.f && c.o[3][3] == 5.f) oa[0] = 1;
    if (false)
#endif
    {
        const int tw = c.t0 + 8 * c.wid;
        const char* zbase = (const char*)(proj + C_ZA + g * 4 * HD); char* obase = (char*)(oa + g * 4 * HD);
#pragma unroll
        for (int r = 0; r < 16; ++r) { const int row = crow(r, c.hi); const int tok = tw + (row >> 2), hd = row & 3;
            const unsigned zo = (unsigned)(tok * NP + hd * HD + c.r32) * 2u, oo = (unsigned)(tok * AW + hd * HD + c.r32) * 2u;
#pragma unroll
            for (int d0 = 0; d0 < 4; ++d0) { const float z = __uint_as_float(((unsigned)*(const bf16_t*)(zbase + zo + d0 * 64)) << 16);
                const float v = c.o[d0][r] * z * pg8::fast_sigmoid(z); const float vn = __shfl_xor(v, 1);
                if ((c.r32 & 1) == 0) *(unsigned*)(obase + oo + d0 * 64) = cvtpk(v, vn); }
            SBAR(); }
    }
    __syncthreads();
}
__device__ __forceinline__ void phase_attn(LAS3 char* lds, const bf16_t* proj, const bf16_t* kc, const bf16_t* vc, bf16_t* oa, float* park, int vcu, int G) {
#pragma unroll 1
    for (int item = vcu; item < 256; item += G) {
        const int g = item >> 6, p = item & 63;
#pragma unroll 1
        for (int s = 0; s < 2; ++s) attn_unit(lds, proj, kc, vc, oa, park, s ? p : 127 - p, g, s != 0);
    }
}
}
__device__ __forceinline__ float gelu_tanh(float x) { const float y = 1.5957691216057308f * (x + 0.044715f * x * x * x); return x * pg8::fast_sigmoid(y); }
__device__ __forceinline__ float silu_f(float x) { return x * pg8::fast_sigmoid(x); }
__device__ __forceinline__ void compress_unit(LAS3 char* lds, const bf16_t* __restrict__ proj, const float* __restrict__ pe, const bf16_t* __restrict__ w1t, const bf16_t* __restrict__ w2t,
                                              bf16_t* __restrict__ outc, int u, int which) {
    int tid_o = threadIdx.x; asm volatile("" : "+v"(tid_o));
    const int tid = tid_o, lane = tid & 63, wid = __builtin_amdgcn_readfirstlane(tid >> 6), r32 = lane & 31, hi = lane >> 5;
    const int i = 8 * u + (r32 >> 2), g = r32 & 3;
    f32x16 acc[4];
#pragma unroll
    for (int nb = 0; nb < 4; ++nb) acc[nb] = f32x16{};
    const bf16_t* abase = proj + C_KV + which * 512 + g * HD + hi * 8;
    const bf16_t* bbase = w1t + (size_t)(wid * 32) * 2048 + lane * 8;
#pragma unroll 1
    for (int lt = 0; lt < 4; ++lt) {
        const int l = wid * 4 + lt; int tokn = 16 * i + l; tokn = tokn < T ? tokn : T - 1;
        const bf16_t* ap = abase + (size_t)tokn * NP; const float* pp = pe + l * HD + hi * 8;
#pragma unroll
        for (int hf = 0; hf < 2; ++hf) {
            u32x4 araw[4]; f32x4 e0[4], e1[4]; bf16x8 bfr[4][4];
#pragma unroll
            for (int k = 0; k < 4; ++k) { const int k8 = hf * 4 + k; araw[k] = *(const u32x4*)(ap + k8 * 16); e0[k] = *(const f32x4*)(pp + k8 * 16); e1[k] = *(const f32x4*)(pp + k8 * 16 + 4);
#pragma unroll
                for (int nb = 0; nb < 4; ++nb) bfr[k][nb] = *(const bf16x8*)(bbase + (size_t)((lt * 8 + k8) * 4 + nb) * 512); }
            __builtin_amdgcn_sched_barrier(0);
#pragma unroll
            for (int k = 0; k < 4; ++k) { const u32x4 raw = araw[k];
                u32x4 aw; aw.x = pk2(pg8::bf_lo(raw.x) + e0[k][0], pg8::bf_hi(raw.x) + e0[k][1]); aw.y = pk2(pg8::bf_lo(raw.y) + e0[k][2], pg8::bf_hi(raw.y) + e0[k][3]);
                aw.z = pk2(pg8::bf_lo(raw.z) + e1[k][0], pg8::bf_hi(raw.z) + e1[k][1]); aw.w = pk2(pg8::bf_lo(raw.w) + e1[k][2], pg8::bf_hi(raw.w) + e1[k][3]);
                const bf16x8 a = *reinterpret_cast<const bf16x8*>(&aw);
#pragma unroll
                for (int nb = 0; nb < 4; ++nb) acc[nb] = __builtin_amdgcn_mfma_f32_32x32x16_bf16(a, bfr[k][nb], acc[nb], 0, 0, 0); }
            __builtin_amdgcn_sched_barrier(0);
        }
    }
    LAS3 float* part = (LAS3 float*)lds + wid * 4096;
#pragma unroll
    for (int nb = 0; nb < 4; ++nb)
#pragma unroll
        for (int r = 0; r < 16; ++r) part[att::crow(r, hi) * 128 + nb * 32 + r32] = acc[nb][r];
    __syncthreads();
    f32x4 s0 = {0.f, 0.f, 0.f, 0.f}, s1 = {0.f, 0.f, 0.f, 0.f};
#pragma unroll
    for (int w = 0; w < 8; ++w) { const LAS3 f32x4* p = (const LAS3 f32x4*)((LAS3 float*)lds + w * 4096 + tid * 8); s0 += p[0]; s1 += p[1]; }
    __syncthreads();
    {
        u32x4 hw; hw.x = pk2(silu_f(s0[0]), silu_f(s0[1])); hw.y = pk2(silu_f(s0[2]), silu_f(s0[3])); hw.z = pk2(silu_f(s1[0]), silu_f(s1[1])); hw.w = pk2(silu_f(s1[2]), silu_f(s1[3]));
        const int row = tid >> 4, col = (tid & 15) * 8;
        *(LAS3 u32x4*)(lds + (row * 136 + col) * 2) = hw;
    }
    __syncthreads();
    if (wid < 4) {
        f32x16 o2 = f32x16{};
#pragma unroll
        for (int ks = 0; ks < 8; ++ks) { const bf16x8 a = *(const LAS3 bf16x8*)(lds + (r32 * 136 + ks * 16 + hi * 8) * 2);
            const bf16x8 b = *(const bf16x8*)(w2t + (size_t)(wid * 32 + r32) * HD + ks * 16 + hi * 8);
            o2 = __builtin_amdgcn_mfma_f32_32x32x16_bf16(a, b, o2, 0, 0, 0); }
#pragma unroll
        for (int r = 0; r < 16; ++r) { const int row = att::crow(r, hi); const int ii = 8 * u + (row >> 2), gg = row & 3;
            const float v = ii < NCMP ? o2[r] : 0.f; const float vn = __shfl_xor(v, 1);
            if ((r32 & 1) == 0) *(unsigned*)(outc + (size_t)(ii * 4 + gg) * HD + wid * 32 + r32) = pk2(v, vn); }
    }
    __syncthreads();
}
__device__ __forceinline__ void gmlp_unit(LAS3 char* lds, const bf16_t* __restrict__ proj, const float* __restrict__ sspart, const float* __restrict__ gain, const float* __restrict__ sw, const float* __restrict__ sb,
                                          bf16_t* __restrict__ ob, int ch, int qd) {
    int tid_o = threadIdx.x; asm volatile("" : "+v"(tid_o));
    const int tid = tid_o, lane = tid & 63, wid = __builtin_amdgcn_readfirstlane(tid >> 6), r32 = lane & 31, hi = lane >> 5;
    const int tc0 = ch * 128;
    LAS3 float* rsl = (LAS3 float*)(lds + LDS_RS);
    {   const int vkk = ((tid >> 7) * 8) + ((tid & 31) >> 2), vkey = (vkk & ~0xC) | ((vkk & 4) << 1) | ((vkk & 8) >> 1), vcol = ((tid >> 5) & 3) * 32 + (tid & 3) * 8;
        const unsigned vo0 = (unsigned)(vkey * NP + vcol) * 2u; const unsigned half_step = (unsigned)(32 * NP) * 2u;
#pragma unroll
        for (int gg = 0; gg < 4; ++gg)
#pragma unroll
            for (int kt = 0; kt < 2; ++kt) { const char* vp_ = (const char*)(proj + (size_t)(tc0 + kt * 64) * NP + C_VB + (qd * 4 + gg) * 128); LAS3 char* vd_ = lds + (gg * 2 + kt) * att::SHM + wid * 1024;
                __builtin_amdgcn_global_load_lds((const unsigned*)(vp_ + vo0), (LAS3 unsigned*)vd_, 16, 0, 0);
                __builtin_amdgcn_global_load_lds((const unsigned*)((vp_ + half_step) + vo0), (LAS3 unsigned*)(vd_ + 8192), 16, 0, 0); } }
    if (tid < 128) { const f32x4* sp = (const f32x4*)(sspart + (size_t)(tc0 + tid) * 32); f32x4 s = sp[0];
#pragma unroll
        for (int i = 1; i < 8; ++i) s += sp[i];
        rsl[tid] = 1.0f / sqrtf(((s[0] + s[1]) + (s[2] + s[3])) * (1.0f / BW) + NORM_EPS); }
    VM_WAIT();
    __syncthreads();
    const int gg = wid >> 1, wd = wid & 1, G = qd * 4 + gg, cb = G * 128;
    const int vb1 = (int)(uintptr_t)(lds) + gg * 2 * att::SHM + att::v_rd_base(lane) + wd * 1024;
    f32x4 gn[2][4];
#pragma unroll
    for (int dd = 0; dd < 2; ++dd)
#pragma unroll
        for (int m = 0; m < 4; ++m) gn[dd][m] = *(const f32x4*)(gain + cb + (wd * 2 + dd) * 32 + 8 * m + 4 * hi);
#pragma unroll 1
    for (int pb = 0; pb < 4; ++pb) {
        const int p = pb * 32 + r32; const size_t tok = (size_t)(tc0 + p); const int nks = 2 * pb + 2;
        f32x4 wr0[8], wr1[8]; u32x2 uu[2][4], zz[2][4];
        const float* wrow = sw + ((size_t)G * 128 + p) * 128 + hi * 8;
#pragma unroll
        for (int ks = 0; ks < 8; ++ks) if (ks < nks) { wr0[ks] = *(const f32x4*)(wrow + ks * 16); wr1[ks] = *(const f32x4*)(wrow + ks * 16 + 4); }
        const char* ubase = (const char*)(proj + tok * NP + C_UB + cb); const char* zbase = (const char*)(proj + tok * NP + C_ZB + cb); char* obase = (char*)(ob + tok * BW + cb);
#pragma unroll
        for (int dd = 0; dd < 2; ++dd)
#pragma unroll
            for (int m = 0; m < 4; ++m) { const int d0 = (wd * 2 + dd) * 32 + 8 * m + 4 * hi; uu[dd][m] = *(const u32x2*)(ubase + d0 * 2); zz[dd][m] = *(const u32x2*)(zbase + d0 * 2); }
        const float bs = sb[G * 128 + p];
        __builtin_amdgcn_sched_barrier(0);
        bf16x8 af[8];
#pragma unroll
        for (int ks = 0; ks < 8; ++ks) { if (ks < nks) { const f32x4 a0 = wr0[ks], a1 = wr1[ks]; const int q0 = ks * 16 + hi * 8;
                const f32x4 r0 = *(const LAS3 f32x4*)(rsl + q0), r1 = *(const LAS3 f32x4*)(rsl + q0 + 4);
                u32x4 w; w.x = pk2(q0 + 0 <= p ? a0[0] * r0[0] : 0.f, q0 + 1 <= p ? a0[1] * r0[1] : 0.f); w.y = pk2(q0 + 2 <= p ? a0[2] * r0[2] : 0.f, q0 + 3 <= p ? a0[3] * r0[3] : 0.f);
                w.z = pk2(q0 + 4 <= p ? a1[0] * r1[0] : 0.f, q0 + 5 <= p ? a1[1] * r1[1] : 0.f); w.w = pk2(q0 + 6 <= p ? a1[2] * r1[2] : 0.f, q0 + 7 <= p ? a1[3] * r1[3] : 0.f);
                af[ks] = *reinterpret_cast<const bf16x8*>(&w); } else af[ks] = bf16x8{}; }
        f32x16 acc[2] = {f32x16{}, f32x16{}};
#define TRRD(dst, off) asm volatile("ds_read_b64_tr_b16 %0, %1 offset:%2" : "=&v"(dst) : "v"(vb1), "i"(off) : "memory")
#define GM_STEP(ks) do { if ((ks) < nks) { s16x4 l0, h0, l1, h1; constexpr int o_ = ((ks) >> 2) * att::SHM + att::v_rd_off(0, (ks) & 3, 0); \
            TRRD(l0, o_); TRRD(h0, o_ + 2048); TRRD(l1, o_ + 512); TRRD(h1, o_ + 512 + 2048); \
            asm volatile("s_waitcnt lgkmcnt(0)" ::: "memory"); __builtin_amdgcn_sched_barrier(0); \
            acc[0] = __builtin_amdgcn_mfma_f32_32x32x16_bf16((bf16x8){l0[0], l0[1], l0[2], l0[3], h0[0], h0[1], h0[2], h0[3]}, af[ks], acc[0], 0, 0, 0); \
            acc[1] = __builtin_amdgcn_mfma_f32_32x32x16_bf16((bf16x8){l1[0], l1[1], l1[2], l1[3], h1[0], h1[1], h1[2], h1[3]}, af[ks], acc[1], 0, 0, 0); } } while (0)
        GM_STEP(0); GM_STEP(1); GM_STEP(2); GM_STEP(3); GM_STEP(4); GM_STEP(5); GM_STEP(6); GM_STEP(7);
#undef GM_STEP
#undef TRRD
#pragma unroll
        for (int dd = 0; dd < 2; ++dd)
#pragma unroll
            for (int m = 0; m < 4; ++m) { const int d0 = (wd * 2 + dd) * 32 + 8 * m + 4 * hi; const u32x2 u2 = uu[dd][m], z2 = zz[dd][m]; const f32x4 g4 = gn[dd][m];
                const float o0 = gelu_tanh(pg8::bf_lo(u2.x)) * (acc[dd][4 * m + 0] * g4[0] + bs) * silu_f(pg8::bf_lo(z2.x));
                const float o1 = gelu_tanh(pg8::bf_hi(u2.x)) * (acc[dd][4 * m + 1] * g4[1] + bs) * silu_f(pg8::bf_hi(z2.x));
                const float o2 = gelu_tanh(pg8::bf_lo(u2.y)) * (acc[dd][4 * m + 2] * g4[2] + bs) * silu_f(pg8::bf_lo(z2.y));
                const float o3 = gelu_tanh(pg8::bf_hi(u2.y)) * (acc[dd][4 * m + 3] * g4[3] + bs) * silu_f(pg8::bf_hi(z2.y));
                u32x2 w; w.x = pk2(o0, o1); w.y = pk2(o2, o3); *(u32x2*)(obase + d0 * 2) = w; }
    }
    __syncthreads();
}
#ifndef N_LAUNCH_MODE
#define N_LAUNCH_MODE 1
#endif
constexpr int NPHASES = 1 + 6 * DEPTH;
#ifndef PHMASK
#define PHMASK 0x7f
#endif
#ifndef REPMASK
#define REPMASK 0
#endif
#define REPS(bit) ((REPMASK & (bit)) ? 2 : 1)
__global__ void __launch_bounds__(NTHREADS, 2) fwd_kernel(Params P) {
    extern __shared__ __attribute__((aligned(16))) unsigned char lds_raw[];
    LAS3 unsigned char* lds = (LAS3 unsigned char*)lds_raw;
    const int tid = threadIdx.x, wave = __builtin_amdgcn_readfirstlane(tid >> 6);
#define lane hw_lane_id()
    const int G = gridDim.x; const int bx = blockIdx.x; const int vcu = (G % 8 == 0) ? (bx % 8) * (G / 8) + bx / 8 : bx;
    const int gw = vcu * NWAVES + wave, NGW = G * NWAVES;
    unsigned char* ws = P.ws;
    if (tid < 16) ((LAS3 unsigned*)(lds + LDS_MISC))[tid] = 0u;
    __syncthreads();
    XcdBarrier bar; bar.bar = (unsigned*)(ws + WS_CTL); bar.x = 0; bar.st = nullptr;
    if (N_LAUNCH_MODE == 1) bar = xcd_barrier_post((unsigned*)(ws + WS_CTL), (volatile LAS unsigned*)(lds + LDS_MISC));
    const int lo = P.ph_lo, hi = P.ph_hi;
#define IN(k) (lo <= (k) && (k) < hi)
#define SEAM(k) do { if (IN(k) && IN((k) + 1)) xcd_barrier(bar); } while (0)
    bf16_t* hbuf = (bf16_t*)(ws + WS_H); bf16_t* proj = (bf16_t*)(ws + WS_PROJ); bf16_t* kc = (bf16_t*)(ws + WS_KC); bf16_t* vc = (bf16_t*)(ws + WS_VC);
    bf16_t* oa = (bf16_t*)(ws + WS_OA); bf16_t* ob = (bf16_t*)(ws + WS_OB); bf16_t* t1 = (bf16_t*)(ws + WS_T1); bf16_t* mg = (bf16_t*)(ws + WS_MG);
    bf16_t* Y = (bf16_t*)(ws + WS_Y); bf16_t* x1 = (bf16_t*)(ws + WS_X1);
    constexpr int NU_PROJ = (T / 256) * (NP / 256);
#pragma unroll 1
    for (int w = 0; w < 2; ++w) {
        const int rem = NU_PROJ % G; const bool tailcu = (rem != 0) && (bx >= rem);
        const bool doit = (w == 0) ? (IN(0) && (PHMASK & 1)) : (IN(1) && tailcu);
        const bool alltail = (rem == 0);
        if (doit) {
            const int lo_ = (w == 0) ? 0 : W_ITEMS - W_TAIL_ITEMS, hi_ = (w == 0) ? (alltail ? W_ITEMS : W_ITEMS - W_TAIL_ITEMS) : W_ITEMS;
            const int gw_ = (w == 0) ? gw : (bx - rem) * NWAVES + wave, ngw_ = (w == 0) ? NGW : (G - rem) * NWAVES;
            for (int rep = 0; rep < REPS(1); ++rep) phase_weights(P, lds, gw_, ngw_, wave, lane, lo_, hi_);
        }
        if (w == 0 && IN(0) && (PHMASK & 1)) for (int rep = 0; rep < REPS(128); ++rep) phase_prenorm(P.x, P.pre_norm, hbuf, gw, NGW, lane);
        __syncthreads();
        for (int i = tid; i < 16 * 256; i += NTHREADS) { const int hd = i >> 8; int dd = (i & 255) - 64; dd = dd < 0 ? 0 : (dd > 127 ? 127 : dd); ((LAS3 float*)(lds + LDS_BIAS))[i] = P.rel_bias[BUCKET[dd] * 16 + hd] * att::LOG2E; }
        __syncthreads();
        if (w == 0) SEAM(0);
    }
#pragma unroll 1
    for (int L = 0; L < DEPTH; ++L) {
        const int pb = 1 + 6 * L;
        constexpr int PN_EARLY = 80, PN_LATE = NP / 256 - PN_EARLY, N_LATE_UNITS = (T / 256) * PN_LATE;
#pragma unroll 1
        for (int half = 0; half < 2; ++half) {
            if (IN(pb + half) && (PHMASK & 2)) for (int rep = 0; rep < REPS(2); ++rep) {
                pg8::Gemm g{hbuf, (const bf16_t*)(ws + WS_WIN + L * SZ_WIN), T, NP, DM, nullptr, nullptr}; pg8::ProjOrder S; S.init2(T, PN_EARLY, PN_LATE, G, bx, half);
                pg8::EpiProj E{proj, NP, (float*)(ws + WS_SS)};
                pg8::gemm_phase<pg8::EpiProj, pg8::ProjOrder>(lds + LDS_STAGE, g, S, E, nullptr);
            }
            if (half == 0) SEAM(pb);
        }
        if (IN(pb + 1) && (PHMASK & 4)) for (int rep = 0; rep < REPS(4); ++rep) {
            int it0 = 0, it1 = 0, it2 = 0, nit = 0;
            if (G == 256) {
                if (bx >= N_LATE_UNITS) { const int k = bx - N_LATE_UNITS;
                    if (k < 64) { it0 = 3 * k; it1 = 3 * k + 1; it2 = 3 * k + 2; nit = 3; } else { it0 = 192 + 2 * (k - 64); it1 = it0 + 1; nit = 2; } }
                else if (bx < 128) { it0 = 256 + bx; nit = 1; }
            }
#pragma unroll 1
            for (int q = 0; ; ++q) {
                int item;
                if (G == 256) { if (q >= nit) break; item = q == 0 ? it0 : (q == 1 ? it1 : it2); }
                else { item = bx + q * G; if (item >= 384) break; }
                if (item < 256) gmlp_unit((LAS3 char*)lds, proj, (const float*)(ws + WS_SS), P.sgu_norm + L * BW, P.sgu_w + (size_t)L * 16 * 128 * 128, P.sgu_b + L * 16 * 128, ob, item >> 2, item & 3);
                else { const int ci = item - 256, which = ci & 1, u = ci >> 1;
                    compress_unit((LAS3 char*)lds, proj, (which ? P.pe_v : P.pe_k) + L * 32 * HD, (const bf16_t*)(ws + WS_W1 + (L * 2 + which) * SZ_W1), (const bf16_t*)(ws + WS_W2 + (L * 2 + which) * SZ_W2), which ? vc : kc, u, which); }
            }
        }
        SEAM(pb + 1);
        if (IN(pb + 2) && (PHMASK & 8)) for (int rep = 0; rep < REPS(8); ++rep) att::phase_attn((LAS3 char*)lds, proj, kc, vc, oa, (float*)(ws + WS_PARK), vcu, G);
        SEAM(pb + 2);
        if (IN(pb + 3) && (PHMASK & 16)) for (int rep = 0; rep < REPS(16); ++rep) {
            pg8::DualOrder S; S.init(T, DM, G, bx);
            pg8::Gemm g{oa, (const bf16_t*)(ws + WS_WA + L * SZ_WAB), T, DM, AW, ob, (const bf16_t*)(ws + WS_WB + L * SZ_WAB)};
            pg8::EpiMerge E{mg, DM, proj + C_MA, proj + C_MB, NP};
            pg8::gemm_phase<pg8::EpiMerge, pg8::DualOrder>(lds + LDS_STAGE, g, S, E, nullptr);
        }
        SEAM(pb + 3);
        if (IN(pb + 4) && (PHMASK & 32)) for (int rep = 0; rep < REPS(32); ++rep) {
            pg8::Gemm g{mg, (const bf16_t*)(ws + WS_WO + L * SZ_WO), T, DM, DM, nullptr, nullptr}; pg8::StaticOrder S; S.init(T, DM, G, bx);
            pg8::EpiBf16Plain E{Y, DM};
            pg8::gemm_phase<pg8::EpiBf16Plain, pg8::StaticOrder>(lds + LDS_STAGE, g, S, E, nullptr);
        }
        SEAM(pb + 4);
        if (IN(pb + 5) && (PHMASK & 64)) for (int rep = 0; rep < REPS(64); ++rep) {
            if (L == 0) phase_postnorm<false, true>(Y, P.x, P.post_norm, x1, P.pre_norm + DM, hbuf, true, gw, NGW, lane);
            else phase_postnorm<true, false>(Y, x1, P.post_norm + L * DM, P.out, P.pre_norm, hbuf, false, gw, NGW, lane);
        }
        SEAM(pb + 5);
    }
#undef IN
#undef SEAM
#undef lane
}
extern "C" void kernel_launch(void* const* d_in, const int* in_sizes, int n_in, void* d_out, int out_size, void* d_ws, size_t ws_size, hipStream_t stream) {
    static int grid = 0;
    if (grid == 0) {
        if (n_in != 17 || in_sizes[0] != T * DM || out_size != T * DM || ws_size < WS_END) { fprintf(stderr, "kernel_launch: unexpected shapes (n_in %d, in0 %d, out %d, ws %zu < %zu)\n", n_in, n_in > 0 ? in_sizes[0] : -1, out_size, ws_size, (size_t)WS_END); grid = -1; return; }
        int dev = 0, cus = 0, per_cu = 0;
        if (hipGetDevice(&dev) != hipSuccess || hipDeviceGetAttribute(&cus, hipDeviceAttributeMultiprocessorCount, dev) != hipSuccess) { grid = -1; return; }
        if (hipFuncSetAttribute((const void*)fwd_kernel, hipFuncAttributeMaxDynamicSharedMemorySize, LDS_BYTES) != hipSuccess) { fprintf(stderr, "kernel_launch: hipFuncSetAttribute failed\n"); grid = -1; return; }
        if (hipOccupancyMaxActiveBlocksPerMultiprocessor(&per_cu, (const void*)fwd_kernel, NTHREADS, LDS_BYTES) != hipSuccess || per_cu < 1) { fprintf(stderr, "kernel_launch: occupancy query says %d blocks per CU\n", per_cu); (void)hipGetLastError(); grid = -1; return; }
        grid = cus;
    }
    if (grid < 0) return;
    (void)hipMemsetAsync((char*)d_ws + WS_CTL, 0, CTL_BYTES, stream);
    Params p{};
    p.x = (const float*)d_in[0]; p.rel_bias = (const float*)d_in[1]; p.pre_norm = (const float*)d_in[2]; p.w_in = (const float*)d_in[3];
    p.pe_k = (const float*)d_in[4]; p.w1_k = (const float*)d_in[5]; p.w2_k = (const float*)d_in[6]; p.pe_v = (const float*)d_in[7]; p.w1_v = (const float*)d_in[8]; p.w2_v = (const float*)d_in[9];
    p.w_out_a = (const float*)d_in[10]; p.sgu_norm = (const float*)d_in[11]; p.sgu_w = (const float*)d_in[12]; p.sgu_b = (const float*)d_in[13]; p.w_out_b = (const float*)d_in[14]; p.w_out = (const float*)d_in[15]; p.post_norm = (const float*)d_in[16];
    p.out = (float*)d_out; p.ws = (unsigned char*)d_ws;
#if N_LAUNCH_MODE == 1
    p.ph_lo = 0; p.ph_hi = NPHASES;
    hipLaunchKernelGGL(fwd_kernel, dim3(grid), dim3(NTHREADS), LDS_BYTES, stream, p);
#else
    for (int k = 0; k < NPHASES; ++k) { p.ph_lo = k; p.ph_hi = k + 1; hipLaunchKernelGGL(fwd_kernel, dim3(grid), dim3(NTHREADS), LDS_BYTES, stream, p); }
#endif
}
```

```cpp
#include <hip/hip_runtime.h>
#include <cstdio>
#include <cstdint>
template <int CTRL> __device__ __forceinline__ float dpp_f(float v) { return __builtin_bit_cast(float, __builtin_amdgcn_update_dpp(0, __builtin_bit_cast(int, v), CTRL, 0xF, 0xF, true)); }
__device__ __forceinline__ float xor1_f(float v) { return dpp_f<0xB1>(v); }
__device__ __forceinline__ float xor2_f(float v) { return dpp_f<0x4E>(v); }
__device__ __forceinline__ float xor16_sum(float v) { const unsigned a = __builtin_bit_cast(unsigned, v); auto r = __builtin_amdgcn_permlane16_swap(a, a, false, false); const unsigned r0 = r[0], r1 = r[1]; return __builtin_bit_cast(float, r0) + __builtin_bit_cast(float, r1); }
__device__ __forceinline__ float xor32_sum(float v) { const unsigned a = __builtin_bit_cast(unsigned, v); auto r = __builtin_amdgcn_permlane32_swap(a, a, false, false); const unsigned r0 = r[0], r1 = r[1]; return __builtin_bit_cast(float, r0) + __builtin_bit_cast(float, r1); }
__device__ __forceinline__ int hw_lane_id() { int l; asm volatile("v_mbcnt_lo_u32_b32 %0, -1, 0\n\tv_mbcnt_hi_u32_b32 %0, -1, %0" : "=v"(l)); return l; }
namespace pg8 {
#define PG8_LAS __attribute__((address_space(3)))
typedef unsigned short bf16_t;
typedef short bf16x8 __attribute__((ext_vector_type(8)));
typedef float f32x4 __attribute__((ext_vector_type(4)));
typedef unsigned u32x4 __attribute__((ext_vector_type(4)));
constexpr int BM = 256, BK = 64, HALF = 128, HTB = HALF * BK * 2  , STAGE_BYTES = 8 * HTB, NXCD = 8, WGM = 8;

__host__ __device__ __forceinline__ int lds_byte(int r, int c) { const int st = (r >> 4) * 2 + (c >> 5), rr = r & 15, cc = c & 31, ob = rr * 64 + cc * 2; return st * 1024 + (ob ^ (((ob >> 9) & 1) << 5)); }
__host__ __device__ __forceinline__ void stage_rc(int b, int& R, int& C) { const int st = b / 1024, sb = b % 1024, swz = sb ^ (((sb >> 9) & 1) << 5); R = (st >> 1) * 16 + swz / 64; C = (st & 1) * 32 + (swz % 64) / 2; }
__host__ __device__ __forceinline__ int perm32(int rho) { const int n = rho >> 4, i = rho & 15; return 8 * (i >> 2) + 4 * n + (i & 3); }

struct Unit { int pm, pn, sub; };
struct Gemm { const bf16_t* A; const bf16_t* Bt; int M, N, K; const bf16_t* A2; const bf16_t* Bt2; };

struct StaticOrder {
    int nM, nN, nwg, G, c;
    __host__ __device__ void init(int M, int N, int G_, int c_) { nM = M / BM; nN = N / BM; nwg = nM * nN; G = G_; c = c_; }
    __host__ __device__ bool next(int i, Unit& u) const {
        const long L = (long)i * G + c; if (L >= nwg) return false;
        int wgid = (int)L; { const int q = nwg / NXCD, r = nwg % NXCD, xcd = wgid % NXCD, off = wgid / NXCD; wgid = (xcd < r ? xcd * (q + 1) : r * (q + 1) + (xcd - r) * q) + off; }
        const int nig = WGM * nN, gid = wgid / nig, fm = gid * WGM, gsz = (nM - fm) < WGM ? (nM - fm) : WGM;
        u.pm = fm + ((wgid % nig) % gsz); u.pn = (wgid % nig) / gsz; u.sub = 0; return true;
    }
    __device__ __forceinline__ void a_ready(const Unit&) const {}
    __device__ __forceinline__ void done(const Unit&) const {}
    static constexpr bool DUAL = false;
    __device__ __forceinline__ const bf16_t* baseA(const Gemm& g, const Unit&) const { return g.A; }
    __device__ __forceinline__ const bf16_t* baseB(const Gemm& g, const Unit&) const { return g.Bt; }
};
struct DualOrder : StaticOrder {
    static constexpr bool DUAL = true;
    __host__ __device__ bool next(int i, Unit& u) const { const bool ok = StaticOrder::next(i >> 1, u); u.sub = i & 1; return ok; }
    __device__ __forceinline__ const bf16_t* baseA(const Gemm& g, const Unit& u) const { return u.sub ? g.A2 : g.A; }
    __device__ __forceinline__ const bf16_t* baseB(const Gemm& g, const Unit& u) const { return u.sub ? g.Bt2 : g.Bt; }
};
typedef __bf16 bf16x2_t __attribute__((ext_vector_type(2)));
typedef float f32x2_t __attribute__((ext_vector_type(2)));
__device__ __forceinline__ unsigned cvt_pk_bf16(float lo, float hi) { const f32x2_t v = {lo, hi}; const bf16x2_t b = __builtin_convertvector(v, bf16x2_t); return __builtin_bit_cast(unsigned, b); }
typedef float f32x2 __attribute__((ext_vector_type(2)));
__device__ __forceinline__ float bf_lo(unsigned u) { return __uint_as_float(u << 16); }
__device__ __forceinline__ float bf_hi(unsigned u) { return __uint_as_float(u & 0xffff0000u); }
__device__ __forceinline__ float fast_sigmoid(float x) { return __builtin_amdgcn_rcpf(1.0f + __builtin_amdgcn_exp2f(-1.4426950408889634f * x)); }
struct EpiBf16Plain {
    static constexpr bool PERM = true, AFTER_DRAIN = false;
    bf16_t* O; int ldc;
    __device__ __forceinline__ void operator()(const f32x4 (&acc)[2][2][4][2], const Unit& u, int wr, int wc, int fr, int fq) const {
        const int row0 = u.pm * BM + wr * 64 + fr, col0 = u.pn * BM + wc * 32 + 8 * fq;
#pragma unroll
        for (int ai = 0; ai < 2; ++ai)
#pragma unroll
            for (int m = 0; m < 4; ++m) { bf16_t* rowp = O + (size_t)(row0 + ai * HALF + m * 16) * ldc + col0;
#pragma unroll
                for (int bj = 0; bj < 2; ++bj) { const f32x4 v0 = acc[ai][bj][m][0], v1 = acc[ai][bj][m][1];
                    u32x4 w; w.x = cvt_pk_bf16(v0[0], v0[1]); w.y = cvt_pk_bf16(v0[2], v0[3]); w.z = cvt_pk_bf16(v1[0], v1[1]); w.w = cvt_pk_bf16(v1[2], v1[3]);
                    *(u32x4*)(rowp + bj * HALF) = w; } }
    }
};
__device__ __forceinline__ float gelu_tanh_f(float x) { const float y = 1.5957691216057308f * (x + 0.044715f * x * x * x); return x * fast_sigmoid(y); }
struct EpiProj {
    static constexpr bool PERM = true, AFTER_DRAIN = false;
    static constexpr int PN_V0 = 36;
    bf16_t* O; int ldc; float* sspart;
    __device__ __forceinline__ void operator()(const f32x4 (&acc)[2][2][4][2], const Unit& u, int wr, int wc, int fr, int fq) const {
        const int row0 = u.pm * BM + wr * 64 + fr, col0 = u.pn * BM + wc * 32 + 8 * fq;
        const bool vtile = (u.pn >= PN_V0) && (u.pn < PN_V0 + 8);
        if (!vtile) {
#pragma unroll
            for (int ai = 0; ai < 2; ++ai)
#pragma unroll
                for (int m = 0; m < 4; ++m) { bf16_t* rowp = O + (size_t)(row0 + ai * HALF + m * 16) * ldc + col0;
#pragma unroll
                    for (int bj = 0; bj < 2; ++bj) { const f32x4 v0 = acc[ai][bj][m][0], v1 = acc[ai][bj][m][1];
                        u32x4 w; w.x = cvt_pk_bf16(v0[0], v0[1]); w.y = cvt_pk_bf16(v0[2], v0[3]); w.z = cvt_pk_bf16(v1[0], v1[1]); w.w = cvt_pk_bf16(v1[2], v1[3]);
                        *(u32x4*)(rowp + bj * HALF) = w; } }
        } else {
#pragma unroll
            for (int ai = 0; ai < 2; ++ai)
#pragma unroll
                for (int m = 0; m < 4; ++m) { const int row = row0 + ai * HALF + m * 16; bf16_t* rowp = O + (size_t)row * ldc + col0; float ss = 0.f;
#pragma unroll
                    for (int bj = 0; bj < 2; ++bj) { f32x4 v0 = acc[ai][bj][m][0], v1 = acc[ai][bj][m][1];
#pragma unroll
                        for (int e = 0; e < 4; ++e) { v0[e] = gelu_tanh_f(v0[e]); v1[e] = gelu_tanh_f(v1[e]); ss += v0[e] * v0[e] + v1[e] * v1[e]; }
                        u32x4 w; w.x = cvt_pk_bf16(v0[0], v0[1]); w.y = cvt_pk_bf16(v0[2], v0[3]); w.z = cvt_pk_bf16(v1[0], v1[1]); w.w = cvt_pk_bf16(v1[2], v1[3]);
                        *(u32x4*)(rowp + bj * HALF) = w; }
                    ss = xor16_sum(ss); ss = xor32_sum(ss);
                    if (fq == 0) sspart[(size_t)row * 32 + (u.pn - PN_V0) * 4 + wc] = ss; }
        }
    }
};
template <bool ADD> struct EpiGate {
    static constexpr bool PERM = true, AFTER_DRAIN = false;
    bf16_t* O; int ldc; const bf16_t* Mg; int ldm; const bf16_t* Prev;
    __device__ __forceinline__ void operator()(const f32x4 (&acc)[2][2][4][2], const Unit& u, int wr, int wc, int fr, int fq) const {
        const int row0 = u.pm * BM + wr * 64 + fr, col0 = u.pn * BM + wc * 32 + 8 * fq;
#pragma unroll
        for (int ai = 0; ai < 2; ++ai)
#pragma unroll
            for (int m = 0; m < 4; ++m) { const size_t row = (size_t)(row0 + ai * HALF + m * 16);
#pragma unroll
                for (int bj = 0; bj < 2; ++bj) { const f32x4 v0 = acc[ai][bj][m][0], v1 = acc[ai][bj][m][1];
                    const u32x4 mg = *(const u32x4*)(Mg + row * ldm + col0 + bj * HALF);
                    float r[8];
                    r[0] = v0[0] * fast_sigmoid(bf_lo(mg.x)); r[1] = v0[1] * fast_sigmoid(bf_hi(mg.x)); r[2] = v0[2] * fast_sigmoid(bf_lo(mg.y)); r[3] = v0[3] * fast_sigmoid(bf_hi(mg.y));
                    r[4] = v1[0] * fast_sigmoid(bf_lo(mg.z)); r[5] = v1[1] * fast_sigmoid(bf_hi(mg.z)); r[6] = v1[2] * fast_sigmoid(bf_lo(mg.w)); r[7] = v1[3] * fast_sigmoid(bf_hi(mg.w));
                    if (ADD) { const u32x4 pv = *(const u32x4*)(Prev + row * ldc + col0 + bj * HALF);
                        r[0] += bf_lo(pv.x); r[1] += bf_hi(pv.x); r[2] += bf_lo(pv.y); r[3] += bf_hi(pv.y); r[4] += bf_lo(pv.z); r[5] += bf_hi(pv.z); r[6] += bf_lo(pv.w); r[7] += bf_hi(pv.w); }
                    u32x4 w; w.x = cvt_pk_bf16(r[0], r[1]); w.y = cvt_pk_bf16(r[2], r[3]); w.z = cvt_pk_bf16(r[4], r[5]); w.w = cvt_pk_bf16(r[6], r[7]);
                    *(u32x4*)(O + row * ldc + col0 + bj * HALF) = w; } }
    }
};
struct EpiMerge {
    static constexpr bool PERM = true, AFTER_DRAIN = false;
    bf16_t* O; int ldc; const bf16_t* Ma; const bf16_t* Mb; int ldm;
    __device__ __forceinline__ void mid(f32x4 (&acc)[2][2][4][2], const Unit& u, int wr, int wc, int fr, int fq) const {
        const int row0 = u.pm * BM + wr * 64 + fr, col0 = u.pn * BM + wc * 32 + 8 * fq;
#pragma unroll
        for (int ai = 0; ai < 2; ++ai)
#pragma unroll
            for (int m = 0; m < 4; ++m) { const size_t row = (size_t)(row0 + ai * HALF + m * 16);
#pragma unroll
                for (int bj = 0; bj < 2; ++bj) { const u32x4 a = *(const u32x4*)(Ma + row * ldm + col0 + bj * HALF), b = *(const u32x4*)(Mb + row * ldm + col0 + bj * HALF);
                    const unsigned aw[4] = {a.x, a.y, a.z, a.w}, bw[4] = {b.x, b.y, b.z, b.w};
#pragma unroll
                    for (int e = 0; e < 4; ++e) {
                        const float r0 = (1.0f + __builtin_amdgcn_exp2f(-1.4426950408889634f * bf_lo(bw[e]))) * __builtin_amdgcn_rcpf(1.0f + __builtin_amdgcn_exp2f(-1.4426950408889634f * bf_lo(aw[e])));
                        const float r1 = (1.0f + __builtin_amdgcn_exp2f(-1.4426950408889634f * bf_hi(bw[e]))) * __builtin_amdgcn_rcpf(1.0f + __builtin_amdgcn_exp2f(-1.4426950408889634f * bf_hi(aw[e])));
                        acc[ai][bj][m][e >> 1][(e & 1) * 2] *= r0; acc[ai][bj][m][e >> 1][(e & 1) * 2 + 1] *= r1; } } }
    }
    __device__ __forceinline__ void operator()(const f32x4 (&acc)[2][2][4][2], const Unit& u, int wr, int wc, int fr, int fq) const {
        const int row0 = u.pm * BM + wr * 64 + fr, col0 = u.pn * BM + wc * 32 + 8 * fq;
#pragma unroll
        for (int ai = 0; ai < 2; ++ai)
#pragma unroll
            for (int m = 0; m < 4; ++m) { const size_t row = (size_t)(row0 + ai * HALF + m * 16);
#pragma unroll
                for (int bj = 0; bj < 2; ++bj) { const f32x4 v0 = acc[ai][bj][m][0], v1 = acc[ai][bj][m][1];
                    const u32x4 mg = *(const u32x4*)(Mb + row * ldm + col0 + bj * HALF);
                    u32x4 w; w.x = cvt_pk_bf16(v0[0] * fast_sigmoid(bf_lo(mg.x)), v0[1] * fast_sigmoid(bf_hi(mg.x))); w.y = cvt_pk_bf16(v0[2] * fast_sigmoid(bf_lo(mg.y)), v0[3] * fast_sigmoid(bf_hi(mg.y)));
                    w.z = cvt_pk_bf16(v1[0] * fast_sigmoid(bf_lo(mg.z)), v1[1] * fast_sigmoid(bf_hi(mg.z))); w.w = cvt_pk_bf16(v1[2] * fast_sigmoid(bf_lo(mg.w)), v1[3] * fast_sigmoid(bf_hi(mg.w)));
                    *(u32x4*)(O + row * ldc + col0 + bj * HALF) = w; } }
    }
};
struct EpiF32Plain {
    static constexpr bool PERM = false, AFTER_DRAIN = false;
    float* C; int ldc;
    __device__ __forceinline__ void operator()(const f32x4 (&acc)[2][2][4][2], const Unit& u, int wr, int wc, int fr, int fq) const {
        const int row0 = u.pm * BM + wr * 64 + fr, col0 = u.pn * BM + wc * 32 + 4 * fq;
#pragma unroll
        for (int ai = 0; ai < 2; ++ai)
#pragma unroll
            for (int m = 0; m < 4; ++m) { float* rowp = C + (size_t)(row0 + ai * HALF + m * 16) * ldc + col0;
#pragma unroll
                for (int bj = 0; bj < 2; ++bj)
#pragma unroll
                    for (int n = 0; n < 2; ++n) *(f32x4*)(rowp + bj * HALF + n * 16) = acc[ai][bj][m][n]; }
    }
};
struct ProjOrder : StaticOrder {
    int late, nearly, nlate;
    __host__ __device__ void init2(int M, int n_early, int n_late, int G_, int c_, int late_) { StaticOrder::init(M, n_early * BM, G_, c_); late = late_; nearly = n_early; nlate = n_late; }
    __host__ __device__ bool next(int i, Unit& u) const {
        if (!late) return StaticOrder::next(i, u);
        const long L = (long)i * G + c; if (L >= (long)nM * nlate) return false;
        u.pm = (int)(L % nM); u.pn = nearly + (int)(L / nM); u.sub = 0; return true;
    }
};
#ifndef PG8_SP2
#define PG8_SP2 true
#endif
#ifndef PG8_ALIGN
#define PG8_ALIGN true
#endif
template <class Epi, class Sched, bool STAMP = false, bool ALIGN_EPI = PG8_ALIGN, bool SP2 = PG8_SP2>
__device__ __forceinline__ void gemm_phase(PG8_LAS unsigned char* lds, const Gemm g, const Sched& S, const Epi& E, unsigned long long* stamps) {
    int tid_o = threadIdx.x; asm volatile("" : "+v"(tid_o));
    const int tid = tid_o, wid = __builtin_amdgcn_readfirstlane(tid >> 6), lane = tid & 63, wr = wid >> 2, wc = wid & 3, fr = lane & 15, fq = lane >> 4;
    const int K = g.K, nt = K / BK;
    int ts_lo = 0, ts_hi = 0, nts = 0; const unsigned long long rt_entry = STAMP ? (unsigned long long)wall_clock64() : 0ull;
#define PG8_STAMP() do { if (STAMP && wid == 0 && nts < 64) { const unsigned long long _c = (unsigned long long)clock64(); \
        ts_lo = (lane == nts) ? (int)(unsigned)_c : ts_lo; ts_hi = (lane == nts) ? (int)(unsigned)(_c >> 32) : ts_hi; ++nts; } } while (0)
    PG8_STAMP();
    unsigned voffA[2], voffB[2];
#pragma unroll
    for (int i = 0; i < 2; ++i) { int R, C; stage_rc(tid * 16 + i * 8192, R, C); const int Rb = Epi::PERM ? ((R & ~31) + perm32(R & 31)) : R;
        voffA[i] = (unsigned)(R * K + C) * 2u; voffB[i] = (unsigned)(Rb * K + C) * 2u; }
    const size_t kstep = (size_t)(BK * 2);
    const size_t hstep = (size_t)HALF * K * 2;
    const size_t tstep = 2 * hstep;
    const unsigned ldsw = (unsigned)wid * 1024u;
    const int aoff = lds_byte(wr * 64 + fr, fq * 8), boff = lds_byte(wc * 32 + fr, fq * 8);
#define PG8_SA(b, h) (((b) * 2 + (h)) * HTB)
#define PG8_SB(b, h) ((4 + (b) * 2 + (h)) * HTB)
#define PG8_STAGE(bufoff, gbase, voff) do { _Pragma("unroll") for (int _i = 0; _i < 2; ++_i) \
        __builtin_amdgcn_global_load_lds((const unsigned*)((const char*)(gbase) + (voff)[_i]), (PG8_LAS unsigned*)(lds + (bufoff) + ldsw + _i * 8192), 16, 0, 0); } while (0)
#define PG8_LDA(dst, b, h) do { _Pragma("unroll") for (int m = 0; m < 4; ++m) _Pragma("unroll") for (int k = 0; k < 2; ++k) dst[m][k] = *(const PG8_LAS bf16x8*)(lds + PG8_SA(b, h) + aoff + m * 2048 + k * 1024); } while (0)
#define PG8_LDB(dst, b, h) do { _Pragma("unroll") for (int n = 0; n < 2; ++n) _Pragma("unroll") for (int k = 0; k < 2; ++k) dst[n][k] = *(const PG8_LAS bf16x8*)(lds + PG8_SB(b, h) + boff + n * 2048 + k * 1024); } while (0)
#define PG8_MMA(ai, bj, At, Bt) do { __builtin_amdgcn_s_setprio(1); _Pragma("unroll") for (int m = 0; m < 4; ++m) _Pragma("unroll") for (int n = 0; n < 2; ++n) _Pragma("unroll") for (int k = 0; k < 2; ++k) \
        acc[ai][bj][m][n] = __builtin_amdgcn_mfma_f32_16x16x32_bf16(Bt[n][k], At[m][k], acc[ai][bj][m][n], 0, 0, 0); __builtin_amdgcn_s_setprio(0); } while (0)
#define PG8_WAIT_V(n) asm volatile("s_waitcnt vmcnt(" #n ")" ::: "memory")
#define PG8_WAIT_L(n) asm volatile("s_waitcnt lgkmcnt(" #n ")" ::: "memory")
#define PG8_BAR __builtin_amdgcn_s_barrier()
#define PG8_SCHED __builtin_amdgcn_sched_barrier(0)
    Unit cur, nxt; int ui = 0;
    if (!S.next(0, cur)) return;
    f32x4 acc[2][2][4][2];
#pragma unroll
    for (int a = 0; a < 2; ++a)
#pragma unroll
        for (int b = 0; b < 2; ++b)
#pragma unroll
            for (int m = 0; m < 4; ++m)
#pragma unroll
                for (int n = 0; n < 2; ++n) acc[a][b][m][n] = (f32x4){0.f, 0.f, 0.f, 0.f};
    bf16x8 At[4][2], B0[2][2], B1[2][2];
    const char* cA = (const char*)S.baseA(g, cur) + (size_t)cur.pm * tstep; const char* cB = (const char*)S.baseB(g, cur) + (size_t)cur.pn * tstep;
    S.a_ready(cur);
    if constexpr (SP2) {
        PG8_STAGE(PG8_SB(0, 0), cB, voffB); PG8_STAGE(PG8_SB(0, 1), cB + hstep, voffB); PG8_STAGE(PG8_SA(0, 0), cA, voffA); PG8_STAGE(PG8_SA(0, 1), cA + hstep, voffA);
        if (wr == 1) PG8_BAR;
        PG8_WAIT_V(2); PG8_BAR;
        PG8_STAGE(PG8_SB(1, 0), cB + kstep, voffB); PG8_STAGE(PG8_SA(1, 0), cA + kstep, voffA); PG8_STAGE(PG8_SB(1, 1), cB + hstep + kstep, voffB);
        PG8_WAIT_V(6); PG8_BAR;
    } else {
    PG8_STAGE(PG8_SB(0, 0), cB, voffB); PG8_STAGE(PG8_SA(0, 0), cA, voffA); PG8_STAGE(PG8_SB(0, 1), cB + hstep, voffB); PG8_STAGE(PG8_SA(0, 1), cA + hstep, voffA);
    if (wr == 1) PG8_BAR;
    PG8_WAIT_V(4); PG8_BAR;
    PG8_STAGE(PG8_SB(1, 0), cB + kstep, voffB); PG8_STAGE(PG8_SA(1, 0), cA + kstep, voffA); PG8_STAGE(PG8_SB(1, 1), cB + hstep + kstep, voffB);
    PG8_WAIT_V(6); PG8_BAR;
    }
    PG8_STAMP();
    for (;;) {
        const bool has_next = S.next(ui + 1, nxt);
        const char* nA = has_next ? (const char*)S.baseA(g, nxt) + (size_t)nxt.pm * tstep : cA; const char* nB = has_next ? (const char*)S.baseB(g, nxt) + (size_t)nxt.pn * tstep : cB;
        for (int t = 0; t < nt; t += 2) {
            const bool last = (t == nt - 2);
            const char* a1 = cA + (size_t)(t + 1) * kstep;
            const char* a2 = last ? nA : cA + (size_t)(t + 2) * kstep; const char* b2 = last ? nB : cB + (size_t)(t + 2) * kstep;
            const char* a3 = a2 + kstep; const char* b3 = b2 + kstep;
            if (last && has_next) S.a_ready(nxt);
            if constexpr (SP2) {
            PG8_LDB(B0, 0, 0); PG8_LDB(B1, 0, 1); PG8_SCHED; PG8_LDA(At, 0, 0); PG8_STAGE(PG8_SA(1, 1), a1 + hstep, voffA);
            PG8_WAIT_V(8); PG8_WAIT_L(0); PG8_BAR; PG8_MMA(0, 0, At, B0); PG8_MMA(0, 1, At, B1); PG8_BAR; PG8_SCHED;
            PG8_LDA(At, 0, 1); PG8_STAGE(PG8_SB(0, 0), b2, voffB); PG8_STAGE(PG8_SB(0, 1), b2 + hstep, voffB); PG8_STAGE(PG8_SA(0, 0), a2, voffA);
            PG8_WAIT_V(8); PG8_WAIT_L(0); PG8_BAR; PG8_MMA(1, 0, At, B0); PG8_MMA(1, 1, At, B1); PG8_BAR; PG8_SCHED;
            PG8_LDB(B0, 1, 0); PG8_LDB(B1, 1, 1); PG8_SCHED; PG8_LDA(At, 1, 0); PG8_STAGE(PG8_SA(0, 1), a2 + hstep, voffA);
            PG8_WAIT_V(8); PG8_WAIT_L(0); PG8_BAR; PG8_MMA(0, 0, At, B0); PG8_MMA(0, 1, At, B1); PG8_BAR; PG8_SCHED;
            PG8_LDA(At, 1, 1); PG8_STAGE(PG8_SB(1, 0), b3, voffB); PG8_STAGE(PG8_SB(1, 1), b3 + hstep, voffB); PG8_STAGE(PG8_SA(1, 0), a3, voffA);
            PG8_WAIT_V(8); PG8_WAIT_L(0); PG8_BAR; PG8_MMA(1, 0, At, B0); PG8_MMA(1, 1, At, B1); PG8_BAR; PG8_SCHED;
            } else {
            PG8_LDB(B0, 0, 0); PG8_SCHED; PG8_LDA(At, 0, 0); PG8_STAGE(PG8_SA(1, 1), a1 + hstep, voffA);
            PG8_WAIT_L(8); PG8_BAR; PG8_WAIT_L(0); PG8_MMA(0, 0, At, B0); PG8_BAR; PG8_SCHED;
            PG8_LDB(B1, 0, 1); PG8_STAGE(PG8_SB(0, 0), b2, voffB);
            PG8_BAR; PG8_WAIT_L(0); PG8_MMA(0, 1, At, B1); PG8_BAR;
            PG8_LDA(At, 0, 1); PG8_STAGE(PG8_SA(0, 0), a2, voffA);
            PG8_BAR; PG8_WAIT_L(0); PG8_MMA(1, 0, At, B0); PG8_BAR; PG8_SCHED;
            PG8_STAGE(PG8_SB(0, 1), b2 + hstep, voffB);
            PG8_WAIT_V(6); PG8_BAR; PG8_MMA(1, 1, At, B1); PG8_BAR;
            PG8_LDB(B0, 1, 0); PG8_SCHED; PG8_LDA(At, 1, 0); PG8_STAGE(PG8_SA(0, 1), a2 + hstep, voffA);
            PG8_WAIT_L(8); PG8_BAR; PG8_WAIT_L(0); PG8_MMA(0, 0, At, B0); PG8_BAR; PG8_SCHED;
            PG8_LDB(B1, 1, 1); PG8_STAGE(PG8_SB(1, 0), b3, voffB);
            PG8_BAR; PG8_WAIT_L(0); PG8_MMA(0, 1, At, B1); PG8_BAR;
            PG8_LDA(At, 1, 1); PG8_STAGE(PG8_SA(1, 0), a3, voffA);
            PG8_BAR; PG8_WAIT_L(0); PG8_MMA(1, 0, At, B0); PG8_BAR; PG8_SCHED;
            PG8_STAGE(PG8_SB(1, 1), b3 + hstep, voffB);
            PG8_WAIT_V(6); PG8_BAR; PG8_MMA(1, 1, At, B1); PG8_BAR;
                    }
        }
        PG8_STAMP();
        if constexpr (ALIGN_EPI) { if (wr == 0) PG8_BAR; }
        bool keep_acc = false;
        if constexpr (Sched::DUAL) { if (cur.sub == 0) { E.mid(acc, cur, wr, wc, fr, fq); keep_acc = true; } else E(acc, cur, wr, wc, fr, fq); }
        else if constexpr (!Epi::AFTER_DRAIN) { E(acc, cur, wr, wc, fr, fq); S.done(cur); }
        PG8_STAMP();
        if (!has_next) break;
        if (!keep_acc)
#pragma unroll
        for (int a = 0; a < 2; ++a)
#pragma unroll
            for (int b = 0; b < 2; ++b)
#pragma unroll
                for (int m = 0; m < 4; ++m)
#pragma unroll
                    for (int n = 0; n < 2; ++n) acc[a][b][m][n] = (f32x4){0.f, 0.f, 0.f, 0.f};
        cur = nxt; cA = nA; cB = nB; ++ui;
        if constexpr (ALIGN_EPI) { if (wr == 1) PG8_BAR; }
    }
    PG8_WAIT_V(0);
    if constexpr (!ALIGN_EPI) { if (wr == 0) PG8_BAR; }
    PG8_BAR;
    if constexpr (Epi::AFTER_DRAIN) { E.fused(acc, cur, wr, wc, fr, fq, lds, wid, lane); S.done(cur); }
    PG8_STAMP();
    if (STAMP && wid == 0) { stamps[lane] = lane < nts ? (((unsigned long long)(unsigned)ts_hi << 32) | (unsigned)ts_lo) : 0ull;
        if (lane == 62) stamps[62] = rt_entry; if (lane == 63) stamps[63] = (unsigned long long)wall_clock64(); }
#undef PG8_STAMP
#undef PG8_SA
#undef PG8_SB
#undef PG8_STAGE
#undef PG8_LDA
#undef PG8_LDB
#undef PG8_MMA
#undef PG8_WAIT_V
#undef PG8_WAIT_L
#undef PG8_BAR
#undef PG8_SCHED
}
}

#define XB_TMO      128
#define XB_XCNT(j)  (256  + 64 * (j))
#define XB_XSUB(j)  (1280 + 64 * (j))
#define XB_XGEN(j)  (2304 + 64 * (j))
#define XB_TOP      3328
#define XB_TOPGEN   3392
#define XCD_BAR_WORDS 3456
#define XB_SPIN_CAP (1u << 18)
#define LAS __attribute__((address_space(3)))

__device__ __forceinline__ unsigned xb_ld(unsigned* p)              { return __hip_atomic_load(p, __ATOMIC_RELAXED, __HIP_MEMORY_SCOPE_AGENT); }
__device__ __forceinline__ unsigned xb_add(unsigned* p, unsigned v) { return __hip_atomic_fetch_add(p, v, __ATOMIC_RELAXED, __HIP_MEMORY_SCOPE_AGENT); }
__device__ __forceinline__ unsigned xb_xcc_id() { return (unsigned)__builtin_amdgcn_s_getreg((3 << 11) | 20) & 0xFu; }
#define XB_SPIN(cond, bar) do { unsigned _sp = 0; while (cond) { __builtin_amdgcn_s_sleep(1); \
    if ((++_sp & 255u) == 0u) { if (xb_ld(&(bar)[XB_TMO])) break; if (_sp > XB_SPIN_CAP) { atomicAdd(&(bar)[XB_TMO], 1u); break; } } } } while (0)

struct XcdBarrier {
    unsigned* bar; unsigned x;
    volatile LAS unsigned* st;
};

__device__ __forceinline__ XcdBarrier xcd_barrier_post(unsigned* bar, volatile LAS unsigned* st) {
    XcdBarrier b; b.bar = bar; b.x = xb_xcc_id(); b.st = st;
    if (threadIdx.x == 0) (void)xb_add(&bar[XB_XCNT(b.x)], 1u);
    return b;
}
__device__ __forceinline__ void xcd_barrier_complete(unsigned* bar, unsigned x, unsigned& nloc, unsigned& nx) {
    const unsigned G = gridDim.x * gridDim.y * gridDim.z;
    unsigned sum, cnt, mine, sp = 0u;
    for (;;) {
        sum = 0u; cnt = 0u; mine = 0u;
#pragma unroll
        for (unsigned j = 0; j < 16; ++j) { const unsigned c = xb_ld(&bar[XB_XCNT(j)]); sum += c; cnt += (c > 0u) ? 1u : 0u; mine = (j == x) ? c : mine; }
        if (sum == G) break;
        __builtin_amdgcn_s_sleep(1);
        if ((++sp & 255u) == 0u) { if (xb_ld(&bar[XB_TMO])) break; if (sp > XB_SPIN_CAP) { atomicAdd(&bar[XB_TMO], 1u); break; } }
    }
    nloc = mine > 0u ? mine : 1u; nx = cnt > 0u ? cnt : 1u;
}

__device__ __forceinline__ void xcd_barrier(const XcdBarrier& b) {
    asm volatile("s_waitcnt vmcnt(0)" ::: "memory");
    __syncthreads();
    if (threadIdx.x == 0) {
        unsigned* bar = b.bar;
        __builtin_amdgcn_s_waitcnt(0);
        unsigned nloc = b.st[0], nx = b.st[1];
        if (nloc == 0u) { xcd_barrier_complete(bar, b.x, nloc, nx); b.st[0] = nloc; b.st[1] = nx; }
        const unsigned old = xb_add(&bar[XB_XSUB(b.x)], 1u);
        const unsigned gen = old / nloc;
        if (old + 1u == (gen + 1u) * nloc) {
            __builtin_amdgcn_fence(__ATOMIC_RELEASE, "agent");
            asm volatile("s_waitcnt vmcnt(0)" ::: "memory");
            const unsigned og = xb_add(&bar[XB_TOP], 1u);
            const unsigned tg = og / nx;
            if (og + 1u == (tg + 1u) * nx) xb_add(&bar[XB_TOPGEN], 1u);
            else XB_SPIN(xb_ld(&bar[XB_TOPGEN]) == tg, bar);
            __builtin_amdgcn_fence(__ATOMIC_ACQUIRE, "agent");
            xb_add(&bar[XB_XGEN(b.x)], 1u);
            asm volatile("s_waitcnt vmcnt(0)" ::: "memory");
        } else {
            XB_SPIN(xb_ld(&bar[XB_XGEN(b.x)]) == gen, bar);
            __builtin_amdgcn_fence(__ATOMIC_ACQUIRE, "agent");
            asm volatile("s_waitcnt vmcnt(0)" ::: "memory");
        }
    }
    __syncthreads();
}
typedef pg8::bf16_t bf16_t;
typedef short bf16x8 __attribute__((ext_vector_type(8)));
typedef short s16x4 __attribute__((ext_vector_type(4)));
typedef float f32x4 __attribute__((ext_vector_type(4)));
typedef float f32x16 __attribute__((ext_vector_type(16)));
typedef unsigned u32x4 __attribute__((ext_vector_type(4)));
typedef unsigned u32x2 __attribute__((ext_vector_type(2)));
constexpr int T = 8192, DM = 4096, NIN = 21552, NP = 21760, DEPTH = 2, NWAVES = 8, NTHREADS = 512;
constexpr int C_Q = 0, C_KV = 2048, C_ZA = 5120, C_UB = 7168, C_VB = 9216, C_ZB = 11264, C_MA = 13312, C_MB = 17408, C_GA = 21504;
constexpr int AW = 2048, BW = 2048, HD = 128, NCMP = 511, NCP = 512;
constexpr float NORM_EPS = 1e-6f;
constexpr size_t al256(size_t x) { return (x + 255) & ~(size_t)255; }
constexpr size_t WS_CTL = 0, CTL_BYTES = 1u << 20;
constexpr size_t SZ_WIN = (size_t)NP * DM * 2, SZ_WAB = (size_t)DM * AW * 2, SZ_WO = (size_t)DM * DM * 2, SZ_W1 = (size_t)HD * 4096 * 2, SZ_W2 = (size_t)HD * HD * 2;
constexpr size_t WS_WIN = WS_CTL + CTL_BYTES;
constexpr size_t WS_WA = WS_WIN + DEPTH * SZ_WIN;
constexpr size_t WS_WB = WS_WA + DEPTH * SZ_WAB;
constexpr size_t WS_WO = WS_WB + DEPTH * SZ_WAB;
constexpr size_t WS_W1 = WS_WO + DEPTH * SZ_WO;
constexpr size_t WS_W2 = WS_W1 + DEPTH * 2 * SZ_W1;
constexpr size_t WS_H = al256(WS_W2 + DEPTH * 2 * SZ_W2);
constexpr size_t WS_PROJ = WS_H + (size_t)T * DM * 2;
constexpr size_t WS_KC = WS_PROJ + (size_t)T * NP * 2;
constexpr size_t WS_VC = WS_KC + (size_t)NCP * 512 * 2;
constexpr size_t WS_OA = WS_VC + (size_t)NCP * 512 * 2;
constexpr size_t WS_OB = WS_OA + (size_t)T * AW * 2;
constexpr size_t WS_T1 = WS_OB + (size_t)T * BW * 2;
constexpr size_t WS_MG = WS_T1 + (size_t)T * DM * 2;
constexpr size_t WS_Y = WS_MG + (size_t)T * DM * 2;
constexpr size_t WS_X1 = WS_Y + (size_t)T * DM * 4;
constexpr size_t WS_SS = WS_X1 + (size_t)T * DM * 4;
constexpr size_t WS_PARK = WS_SS + (size_t)T * 32 * 4;
constexpr size_t WS_END = WS_PARK + (size_t)1024 * 32 * 512 * 16;
constexpr int LDS_STAGE = 0;
constexpr int LDS_BIAS = 131072;
constexpr int LDS_MISC = LDS_BIAS + 16 * 256 * 4;
constexpr int LDS_RS = LDS_MISC + 64;
constexpr int LDS_ATT = LDS_RS + 512;
constexpr int LDS_BYTES = LDS_ATT + 8192;
static_assert(LDS_BYTES <= 160 * 1024, "LDS");
#define LAS3 __attribute__((address_space(3)))
#define LDS_WAIT() asm volatile("s_waitcnt lgkmcnt(0)" ::: "memory")
#define VM_WAIT() asm volatile("s_waitcnt vmcnt(0)" ::: "memory")

struct Params {
    const float *x, *rel_bias, *pre_norm, *w_in, *pe_k, *w1_k, *w2_k, *pe_v, *w1_v, *w2_v, *w_out_a, *sgu_norm, *sgu_w, *sgu_b, *w_out_b, *w_out, *post_norm;
    float* out; unsigned char* ws; int ph_lo, ph_hi;
};
__device__ __forceinline__ unsigned pk2(float lo, float hi) { return pg8::cvt_pk_bf16(lo, hi); }
__device__ __forceinline__ float wave_sum(float v) {
    v += dpp_f<0xB1>(v); v += dpp_f<0x4E>(v); v += dpp_f<0x141>(v); v += dpp_f<0x140>(v);
    v = xor16_sum(v); v = xor32_sum(v);
    return v;
}
__device__ const unsigned char BUCKET[128] = {0, 1, 2, 3, 4, 5, 6, 7, 8, 9, 10, 11, 12, 13, 14, 15, 16, 16, 16, 17, 17, 18, 18, 18, 19, 19, 19, 20, 20, 20, 20, 21, 21, 21, 21, 22, 22, 22, 22, 22, 23, 23, 23, 23, 23, 23, 24, 24, 24, 24, 24, 24, 25, 25, 25, 25, 25, 25, 25, 26, 26, 26, 26, 26, 26, 26, 26, 27, 27, 27, 27, 27, 27, 27, 27, 27, 27, 28, 28, 28, 28, 28, 28, 28, 28, 28, 28, 29, 29, 29, 29, 29, 29, 29, 29, 29, 29, 29, 29, 30, 30, 30, 30, 30, 30, 30, 30, 30, 30, 30, 30, 30, 30, 31, 31, 31, 31, 31, 31, 31, 31, 31, 31, 31, 31, 31, 31, 31};

constexpr int W_ITEMS_PER_LAYER = 64 * (NP / 64) + 2 * 32 * 64 + 64 * 64 + 2 * 64 * 2 + 2 * 2 * 2;
constexpr int W_ITEMS = DEPTH * W_ITEMS_PER_LAYER;
constexpr int W_TAIL_ITEMS = 0;
__device__ __forceinline__ int srcmap_in(int n) { return n < 5120 ? n : (n < 21504 ? n + 48 : (n < 21552 ? n - 21504 + 5120 : -1)); }
template <int MODE>
__device__ __forceinline__ void transpose_item(const float* __restrict__ W, int K, int N, bf16_t* __restrict__ WT, LAS3 float* scr, int item, int nblk, int lane) {
    int kb, nb;
    if ((nblk & 3) == 0) { const int g8 = item >> 3, sub = item & 7, q = nblk >> 2; const int gk = g8 / q, gn = g8 - gk * q; nb = gn * 4 + (sub & 3); kb = gk * 2 + (sub >> 2); }
    else { kb = item / nblk; nb = item - kb * nblk; }
    const int k0 = 64 * kb, n0 = 64 * nb;
    const int nn = n0 + 4 * (lane & 15); const int s = (MODE == 1) ? srcmap_in(nn) : nn;
    const float* src = W + (size_t)(k0 + (lane >> 4)) * N + (s >= 0 ? s : 0);
    f32x4 v[16];
#pragma unroll
    for (int i = 0; i < 16; ++i) v[i] = *(const f32x4*)(src + (size_t)(4 * i) * N);
    __builtin_amdgcn_sched_barrier(0);
#pragma unroll
    for (int i = 0; i < 16; ++i) { f32x4 x = v[i]; if (s < 0) x = (f32x4){0.f, 0.f, 0.f, 0.f};
        LAS3 float* d = scr + (4 * i + (lane >> 4)) * 65 + 4 * (lane & 15); d[0] = x[0]; d[1] = x[1]; d[2] = x[2]; d[3] = x[3]; }
    LDS_WAIT();
    const int c = lane & 7;
#pragma unroll
    for (int j = 0; j < 8; ++j) { const int n = (lane >> 3) + 8 * j; const LAS3 float* p = scr + (8 * c) * 65 + n;
        u32x4 o; o.x = pk2(p[0 * 65], p[1 * 65]); o.y = pk2(p[2 * 65], p[3 * 65]); o.z = pk2(p[4 * 65], p[5 * 65]); o.w = pk2(p[6 * 65], p[7 * 65]);
        if (MODE == 2) { const int k8 = (k0 >> 3) + c, na = n0 + n; *(u32x4*)(WT + (size_t)((((k8 >> 1) * (N >> 5) + (na >> 5)) * 64) + (k8 & 1) * 32 + (na & 31)) * 8) = o; }
        else *(u32x4*)(WT + (size_t)(n0 + n) * K + k0 + 8 * c) = o; }
    LDS_WAIT();
}
__device__ __forceinline__ void phase_weights(const Params& P, LAS3 unsigned char* lds, int gw, int NGW, int wave, int lane, int it_lo, int it_hi) {
    asm volatile("" : "+v"(lane));
    LAS3 float* scr = (LAS3 float*)(lds + LDS_STAGE + wave * 16640);
    constexpr int I_IN = 64 * (NP / 64), I_AB = 32 * 64, I_O = 64 * 64, I_W1 = 64 * 2, I_W2 = 2 * 2;
    constexpr int PER_LAYER = I_IN + 2 * I_AB + I_O + 2 * I_W1 + 2 * I_W2;
    static_assert(PER_LAYER == W_ITEMS_PER_LAYER, "item count");
    for (int it = it_lo + gw; it < it_hi; it += NGW) {
        const int L = it / PER_LAYER; int r = it - L * PER_LAYER;
        unsigned char* ws = P.ws;
        if (r < I_IN) { transpose_item<1>(P.w_in + (size_t)L * DM * NIN, DM, NIN, (bf16_t*)(ws + WS_WIN + L * SZ_WIN), scr, r, NP / 64, lane); continue; } r -= I_IN;
        if (r < I_AB) { transpose_item<0>(P.w_out_a + (size_t)L * AW * DM, AW, DM, (bf16_t*)(ws + WS_WA + L * SZ_WAB), scr, r, 64, lane); continue; } r -= I_AB;
        if (r < I_AB) { transpose_item<0>(P.w_out_b + (size_t)L * BW * DM, BW, DM, (bf16_t*)(ws + WS_WB + L * SZ_WAB), scr, r, 64, lane); continue; } r -= I_AB;
        if (r < I_O) { transpose_item<0>(P.w_out + (size_t)L * DM * DM, DM, DM, (bf16_t*)(ws + WS_WO + L * SZ_WO), scr, r, 64, lane); continue; } r -= I_O;
        if (r < I_W1) { transpose_item<2>(P.w1_k + (size_t)L * 4096 * HD, 4096, HD, (bf16_t*)(ws + WS_W1 + (L * 2 + 0) * SZ_W1), scr, r, 2, lane); continue; } r -= I_W1;
        if (r < I_W1) { transpose_item<2>(P.w1_v + (size_t)L * 4096 * HD, 4096, HD, (bf16_t*)(ws + WS_W1 + (L * 2 + 1) * SZ_W1), scr, r, 2, lane); continue; } r -= I_W1;
        if (r < I_W2) { transpose_item<0>(P.w2_k + (size_t)L * HD * HD, HD, HD, (bf16_t*)(ws + WS_W2 + (L * 2 + 0) * SZ_W2), scr, r, 2, lane); continue; } r -= I_W2;
        transpose_item<0>(P.w2_v + (size_t)L * HD * HD, HD, HD, (bf16_t*)(ws + WS_W2 + (L * 2 + 1) * SZ_W2), scr, r, 2, lane);
    }
}
__device__ __forceinline__ void phase_prenorm(const float* __restrict__ x, const float* __restrict__ g, bf16_t* __restrict__ h, int gw, int NGW, int lane) {
    asm volatile("" : "+v"(lane));
#pragma unroll 1
    for (int m = gw; m < T; m += 2 * NGW) {
        const bool two = (m + NGW) < T; const int m2 = two ? m + NGW : m;
        const f32x4* xa = (const f32x4*)(x + (size_t)m * DM) + lane; const f32x4* xb = (const f32x4*)(x + (size_t)m2 * DM) + lane;
        f32x4 va[16], vb[16];
#pragma unroll
        for (int j = 0; j < 16; ++j) va[j] = xa[64 * j];
#pragma unroll
        for (int j = 0; j < 16; ++j) vb[j] = xb[64 * j];
        __builtin_amdgcn_sched_barrier(0);
        float sa = 0.f, sb = 0.f;
#pragma unroll
        for (int j = 0; j < 16; ++j) { sa += (va[j][0] * va[j][0] + va[j][1] * va[j][1]) + (va[j][2] * va[j][2] + va[j][3] * va[j][3]); sb += (vb[j][0] * vb[j][0] + vb[j][1] * vb[j][1]) + (vb[j][2] * vb[j][2] + vb[j][3] * vb[j][3]); }
        const float ra = 1.0f / sqrtf(wave_sum(sa) * (1.0f / DM) + NORM_EPS), rb = 1.0f / sqrtf(wave_sum(sb) * (1.0f / DM) + NORM_EPS);
        const f32x4* gr = (const f32x4*)g + lane;
        u32x2* oa = (u32x2*)(h + (size_t)m * DM) + lane; u32x2* ob = (u32x2*)(h + (size_t)m2 * DM) + lane;
#pragma unroll
        for (int j = 0; j < 16; ++j) { const f32x4 gg = gr[64 * j]; u32x2 w; w.x = pk2(va[j][0] * ra * gg[0], va[j][1] * ra * gg[1]); w.y = pk2(va[j][2] * ra * gg[2], va[j][3] * ra * gg[3]); oa[64 * j] = w;
            if (two) { u32x2 w2; w2.x = pk2(vb[j][0] * rb * gg[0], vb[j][1] * rb * gg[1]); w2.y = pk2(vb[j][2] * rb * gg[2], vb[j][3] * rb * gg[3]); ob[64 * j] = w2; } }
    }
}
template <bool XOLD_BF16, bool XNEW_BF16>
__device__ __forceinline__ void phase_postnorm(const bf16_t* __restrict__ Y, const void* __restrict__ xold, const float* __restrict__ gpost, void* __restrict__ xnew,
                                               const float* __restrict__ gpre, bf16_t* __restrict__ h, bool next, int gw, int NGW, int lane_) {
#pragma unroll 1
    for (int m = gw; m < T; m += NGW) {
        int lane = lane_; asm volatile("" : "+v"(lane));
        const u32x2* yr = (const u32x2*)(Y + (size_t)m * DM) + lane;
        u32x2 yw[16]; f32x4 xx[16]; u32x2 xw[16]; f32x4 gp[16];
#pragma unroll
        for (int j = 0; j < 16; ++j) yw[j] = yr[64 * j];
        if (XOLD_BF16) {
#pragma unroll
            for (int j = 0; j < 16; ++j) xw[j] = ((const u32x2*)((const bf16_t*)xold + (size_t)m * DM) + lane)[64 * j];
        } else {
#pragma unroll
            for (int j = 0; j < 16; ++j) xx[j] = ((const f32x4*)((const float*)xold + (size_t)m * DM) + lane)[64 * j];
        }
#pragma unroll
        for (int j = 0; j < 16; ++j) gp[j] = ((const f32x4*)gpost + lane)[64 * j];
        __builtin_amdgcn_sched_barrier(0);
        f32x4 v[16]; float ss = 0.f;
#pragma unroll
        for (int j = 0; j < 16; ++j) { const u32x2 w = yw[j]; v[j] = (f32x4){pg8::bf_lo(w.x), pg8::bf_hi(w.x), pg8::bf_lo(w.y), pg8::bf_hi(w.y)}; ss += (v[j][0] * v[j][0] + v[j][1] * v[j][1]) + (v[j][2] * v[j][2] + v[j][3] * v[j][3]); }
        const float rs = 1.0f / sqrtf(wave_sum(ss) * (1.0f / DM) + NORM_EPS);
        float s2 = 0.f;
#pragma unroll
        for (int j = 0; j < 16; ++j) { f32x4 xo;
            if (XOLD_BF16) { const u32x2 w = xw[j]; xo = (f32x4){pg8::bf_lo(w.x), pg8::bf_hi(w.x), pg8::bf_lo(w.y), pg8::bf_hi(w.y)}; } else xo = xx[j];
            const f32x4 r = xo + v[j] * rs * gp[j]; v[j] = r;
            if (XNEW_BF16) { u32x2 w; w.x = pk2(r[0], r[1]); w.y = pk2(r[2], r[3]); ((u32x2*)((bf16_t*)xnew + (size_t)m * DM) + lane)[64 * j] = w; }
            else ((f32x4*)((float*)xnew + (size_t)m * DM) + lane)[64 * j] = r;
            s2 += (r[0] * r[0] + r[1] * r[1]) + (r[2] * r[2] + r[3] * r[3]); }
        if (next) {
            f32x4 g2[16];
#pragma unroll
            for (int j = 0; j < 16; ++j) g2[j] = ((const f32x4*)gpre + lane)[64 * j];
            __builtin_amdgcn_sched_barrier(0);
            const float rs2 = 1.0f / sqrtf(wave_sum(s2) * (1.0f / DM) + NORM_EPS);
            u32x2* o = (u32x2*)(h + (size_t)m * DM) + lane;
#pragma unroll
            for (int j = 0; j < 16; ++j) { const f32x4 gg = g2[j]; u32x2 w; w.x = pk2(v[j][0] * rs2 * gg[0], v[j][1] * rs2 * gg[1]); w.y = pk2(v[j][2] * rs2 * gg[2], v[j][3] * rs2 * gg[3]); o[64 * j] = w; }
        }
    }
}
namespace att {
constexpr float SCALE = 0.08838834764831845f, LOG2E = 1.4426950408889634f, C2 = SCALE * LOG2E;
constexpr int SHM = 16384;
constexpr int NSLOT = 3;
constexpr int L_V = 0, L_K = NSLOT * SHM, L_IMP = 2 * NSLOT * SHM, L_SEL = LDS_ATT, L_WS = L_SEL + 1024, L_SC = L_WS + 2048, L_END = L_SC + 4096;
static_assert(L_IMP + 32768 <= 131072 && L_END <= LDS_ATT + 8192, "attention LDS");
#define KSWZ(row, colB) ((row) * 256 + ((colB) ^ (((row) & 7) << 4)))
#define SBAR() __builtin_amdgcn_sched_barrier(0)
__device__ __forceinline__ int v_st(int k, int c) { const int kk = (k & ~0xC) | ((k & 4) << 1) | ((k & 8) >> 1); return ((kk >> 3) * 4 + (c >> 5)) * 512 + ((kk & 7) * 32 + (c & 31)) * 2; }
__device__ __forceinline__ int v_rd_base(int lane) { return ((lane & 3) << 3) | (((lane >> 2) & 3) << 6) | (((lane >> 4) & 1) << 5) | (((lane >> 5) & 1) << 8); }
constexpr int v_rd_off(int d0, int ks, int half) { return d0 * 512 + ks * 4096 + half * 2048; }
__device__ __forceinline__ int crow(int r, int hi) { return (r & 3) + 8 * (r >> 2) + 4 * hi; }
__device__ __forceinline__ unsigned cvtpk(float lo, float hi) { return pg8::cvt_pk_bf16(lo, hi); }
enum { MODE_STAT = 0, MODE_IMP = 1, MODE_ONLINE = 2, MODE_ACC = 3, MODE_IMPACC = 4 };
#ifndef PP_STAT
#define PP_STAT false
#endif
#ifndef PP_ACC
#define PP_ACC false
#endif

struct Ctx {
    bf16x8 qr[8]; f32x16 o[4];
    int tq, r32, hi, wid, lane, tid, t0;
    const LAS3 float* tb; float bfar;
    LAS3 char* lds;
};
__device__ __forceinline__ void qkt(f32x16& p0, f32x16& p1, const LAS3 char* Kt, int r32, int hi, const bf16x8* qr) {
    p0 = f32x16{}; p1 = f32x16{};
    const LAS3 char* kb[4];
#pragma unroll
    for (int dd = 0; dd < 4; ++dd) kb[dd] = Kt + KSWZ(r32, (dd * 16 + hi * 8) * 2);
#pragma unroll
    for (int d0 = 0; d0 < 8; ++d0) { const LAS3 char* a = kb[d0 & 3] + (d0 >> 2) * 128;
        const bf16x8 b0 = *reinterpret_cast<const LAS3 bf16x8*>(a);
        const bf16x8 b1 = *reinterpret_cast<const LAS3 bf16x8*>(a + 32 * 256);
        p0 = __builtin_amdgcn_mfma_f32_32x32x16_bf16(b0, qr[d0], p0, 0, 0, 0);
        p1 = __builtin_amdgcn_mfma_f32_32x32x16_bf16(b1, qr[d0], p1, 0, 0, 0);
        if ((d0 & 3) == 3) SBAR(); }
}
__device__ __forceinline__ void pv_tile(f32x16* o, int vb0, bf16x8 pa0, bf16x8 pa1, bf16x8 pa2, bf16x8 pa3) {
#define TRRD(dst, off) asm volatile("ds_read_b64_tr_b16 %0, %1 offset:%2" : "=&v"(dst) : "v"(vb0), "i"(off) : "memory")
#define PV_KS(ks, PA) do { s16x4 l0, l1, l2, l3, h0, h1, h2, h3; constexpr int b_ = v_rd_off(0, ks, 0); \
        TRRD(l0, b_); TRRD(h0, b_ + 2048); TRRD(l1, b_ + 512); TRRD(h1, b_ + 512 + 2048); TRRD(l2, b_ + 1024); TRRD(h2, b_ + 1024 + 2048); TRRD(l3, b_ + 1536); TRRD(h3, b_ + 1536 + 2048); \
        asm volatile("s_waitcnt lgkmcnt(0)" ::: "memory"); SBAR(); \
        o[0] = __builtin_amdgcn_mfma_f32_32x32x16_bf16(PA, (bf16x8){l0[0], l0[1], l0[2], l0[3], h0[0], h0[1], h0[2], h0[3]}, o[0], 0, 0, 0); \
        o[1] = __builtin_amdgcn_mfma_f32_32x32x16_bf16(PA, (bf16x8){l1[0], l1[1], l1[2], l1[3], h1[0], h1[1], h1[2], h1[3]}, o[1], 0, 0, 0); \
        o[2] = __builtin_amdgcn_mfma_f32_32x32x16_bf16(PA, (bf16x8){l2[0], l2[1], l2[2], l2[3], h2[0], h2[1], h2[2], h2[3]}, o[2], 0, 0, 0); \
        o[3] = __builtin_amdgcn_mfma_f32_32x32x16_bf16(PA, (bf16x8){l3[0], l3[1], l3[2], l3[3], h3[0], h3[1], h3[2], h3[3]}, o[3], 0, 0, 0); } while (0)
    PV_KS(0, pa0); PV_KS(1, pa1); PV_KS(2, pa2); PV_KS(3, pa3);
#undef PV_KS
#undef TRRD
}
__device__ __forceinline__ void pack_p(const f32x16& p0, const f32x16& p1, bf16x8& pa0, bf16x8& pa1, bf16x8& pa2, bf16x8& pa3) {
#define PK4(P, B_, OUT) do { u32x4 w = {cvtpk(P[B_+0], P[B_+1]), cvtpk(P[B_+2], P[B_+3]), cvtpk(P[B_+4], P[B_+5]), cvtpk(P[B_+6], P[B_+7])}; OUT = *reinterpret_cast<bf16x8*>(&w); } while (0)
    PK4(p0, 0, pa0); PK4(p0, 8, pa1); PK4(p1, 0, pa2); PK4(p1, 8, pa3);
#undef PK4
}
__device__ __forceinline__ float half_max(float v) { auto rr = __builtin_amdgcn_permlane32_swap(__float_as_uint(v), __float_as_uint(v), false, false); return fmaxf(__uint_as_float(rr[0]), __uint_as_float(rr[1])); }
__device__ __forceinline__ float half_sum(float v) { auto rr = __builtin_amdgcn_permlane32_swap(__float_as_uint(v), __float_as_uint(v), false, false); return __uint_as_float(rr[0]) + __uint_as_float(rr[1]); }

template <int MODE, int STEP, int OFF, bool ROWSEL, bool PP>
__device__ __forceinline__ void run_pass(Ctx& c, const bf16_t* __restrict__ Kg, const bf16_t* __restrict__ Vg, const int ldk, const int j_lo, const int j_hi, const unsigned W,
                                         float& m_reg, float& l_reg, const float pscale, unsigned sm0, unsigned sm1, unsigned sm2, unsigned sm3, const float gate = 1.f, const bool rev = false) {
    constexpr bool HASV = (MODE == MODE_ONLINE || MODE == MODE_ACC || MODE == MODE_IMPACC), RUNMAX = (MODE == MODE_ONLINE || MODE == MODE_STAT);
    int tid = c.tid, r32 = c.r32, hi = c.hi, lane = c.lane;
    asm volatile("" : "+v"(tid), "+v"(r32), "+v"(hi), "+v"(lane));
    const int n = j_hi - j_lo + 1;
    if (n <= 0) return;
    LAS3 char* V_lds = c.lds + L_V; LAS3 char* K_lds = c.lds + L_K;
    LAS3 float* al_l = (LAS3 float*)(c.lds + L_WS) + c.wid * 64 + 32;
    const int krow = tid >> 4;
    const unsigned ko0 = (unsigned)(krow * ldk + (((tid & 15) ^ (krow & 7)) * 8)) * 2u;
    const int vkk = ((tid >> 7) * 8) + ((tid & 31) >> 2), vkey = vkk, vcol = ((tid >> 5) & 3) * 32 + (tid & 3) * 8;
    const unsigned vo0 = (unsigned)(vkey * ldk + vcol) * 2u;
    const unsigned half_step = (unsigned)(32 * ldk) * 2u;
    const int vbase = (int)(uintptr_t)V_lds + v_rd_base(lane);
#define LOADT(j, bf) do { const char* kp_ = (const char*)(Kg + (size_t)((j) * 64) * ldk); LAS3 char* kd_ = K_lds + (bf) * SHM + c.wid * 1024; \
        __builtin_amdgcn_global_load_lds((const unsigned*)(kp_ + ko0), (LAS3 unsigned*)kd_, 16, 0, 0); \
        __builtin_amdgcn_global_load_lds((const unsigned*)((kp_ + half_step) + ko0), (LAS3 unsigned*)(kd_ + 8192), 16, 0, 0); \
        if (HASV) { const char* vp_ = (const char*)(Vg + (size_t)((j) * 64) * ldk); LAS3 char* vd_ = V_lds + (bf) * SHM + c.wid * 1024; \
            __builtin_amdgcn_global_load_lds((const unsigned*)(vp_ + vo0), (LAS3 unsigned*)vd_, 16, 0, 0); \
            __builtin_amdgcn_global_load_lds((const unsigned*)((vp_ + half_step) + vo0), (LAS3 unsigned*)(vd_ + 8192), 16, 0, 0); } } while (0)
#define WAIT_OLDER(younger) do { if (younger) { if (HASV) asm volatile("s_waitcnt vmcnt(4)" ::: "memory"); else asm volatile("s_waitcnt vmcnt(2)" ::: "memory"); } else VM_WAIT(); } while (0)
#define STEP_END(oddstep, ldt) do { if (oddstep) WAIT_OLDER(ldt); LDS_WAIT(); __builtin_amdgcn_s_barrier(); asm volatile("" ::: "memory"); } while (0)
#define TJ(t_) (rev ? j_hi - (t_) : j_lo + (t_))
    LOADT(TJ(0), 0); if (n > 1) LOADT(TJ(1), 1);
    WAIT_OLDER(n > 1);
    __builtin_amdgcn_s_barrier(); asm volatile("" ::: "memory");
    const int role = PP ? (c.wid >> 2) : 0, tqw = c.t0 + 8 * c.wid;
    const float NEG = -__builtin_inff();
    const float lp = RUNMAX ? 0.f : __builtin_amdgcn_logf(pscale);
    if (PP && role == 1) { __builtin_amdgcn_s_barrier(); asm volatile("" ::: "memory"); }
    int slot = 0;
#pragma unroll 1
    for (int t = 0; t < n; ++t) {
        const int j = TJ(t);
        const bool ldt = (t + 2 < n); const int lslot = slot == 0 ? 2 : slot - 1;
        if ((!PP || role == 1) && ldt) LOADT(TJ(t + 2), lslot);
        f32x16 p0, p1; float mul = C2, off = 0.f, alpha = 1.f; bool resc = false;
        const int kpos0 = STEP * (j * 64) + OFF;
        const int dmin = tqw - (kpos0 + STEP * 63), dmax = tqw + 7 - kpos0;
        bool rowsel = true;
        if (ROWSEL) { const unsigned wsel = (j < 32) ? sm0 : (j < 64) ? sm1 : (j < 96) ? sm2 : sm3; rowsel = (wsel >> (j & 31)) & 1u; }
        bool act = (dmax >= 0) && (dmin < (int)W);
        if (ROWSEL) act = act && __any(rowsel);
        if (act) {
            SBAR(); __builtin_amdgcn_s_setprio(2); qkt(p0, p1, K_lds + slot * SHM, r32, hi, c.qr); __builtin_amdgcn_s_setprio(0); SBAR();
            const bool needmask = (dmin < 0) || ((unsigned)dmax >= W);
            const int d0 = c.tq - kpos0 - STEP * 4 * hi;
            float add0 = c.bfar;
            if (dmin < 113) {
                if (STEP == 1) {
                    const LAS3 float* tbase = c.tb + (d0 + 5);
#pragma unroll
                    for (int r = 0; r < 16; ++r) { const int cc = (r & 3) + 8 * (r >> 2);
                        p0[r] = fmaf(p0[r], C2, tbase[59 - cc]); p1[r] = fmaf(p1[r], C2, tbase[59 - cc - 32]);
                        if ((r & 3) == 3) SBAR(); }
                } else {
#pragma unroll
                    for (int r = 0; r < 16; ++r) { const int cc = (r & 3) + 8 * (r >> 2); const int da = d0 - STEP * cc, db = d0 - STEP * (cc + 32);
                        const float ba = c.tb[64 + min(max(da, 0), 127)], bb = c.tb[64 + min(max(db, 0), 127)];
                        p0[r] = fmaf(p0[r], C2, ba); p1[r] = fmaf(p1[r], C2, bb);
                        if ((r & 3) == 3) SBAR(); }
                }
                mul = 1.f; add0 = 0.f;
            }
            if (needmask) {
#pragma unroll
                for (int r = 0; r < 16; ++r) { const int cc = (r & 3) + 8 * (r >> 2); const int da = d0 - STEP * cc, db = d0 - STEP * (cc + 32);
                    if ((unsigned)da >= W) p0[r] = NEG; if ((unsigned)db >= W) p1[r] = NEG; }
            }
            SBAR();
            if (RUNMAX) {
                float pm = fmaxf(p0[0], p1[0]);
#pragma unroll
                for (int r = 1; r < 16; ++r) pm = fmaxf(fmaxf(pm, p0[r]), p1[r]);
                pm = half_max(pm);
                float xmax = fmaf(pm, mul, add0); if (ROWSEL) xmax = rowsel ? xmax : NEG;
                float mn = m_reg;
                if (MODE != MODE_ONLINE || !__all(xmax - m_reg <= 8.0f)) { mn = fmaxf(m_reg, xmax); alpha = __builtin_amdgcn_exp2f(m_reg - mn); m_reg = mn; }
                off = add0 - mn; if (ROWSEL) off = rowsel ? off : NEG;
                if (MODE == MODE_ONLINE) { resc = __any(alpha < 1.f); if (resc && hi == 0) al_l[r32] = alpha; }
            } else off = (add0 - m_reg) + lp;
        }
        if (PP) STEP_END(role == 1, ldt);
        if (PP && role == 0 && ldt) LOADT(TJ(t + 2), lslot);
        if (act) {
#pragma unroll
            for (int r = 0; r < 16; ++r) { p0[r] = __builtin_amdgcn_exp2f(fmaf(p0[r], mul, off)); p1[r] = __builtin_amdgcn_exp2f(fmaf(p1[r], mul, off)); }
            if (RUNMAX) {
                float ps = 0.f;
#pragma unroll
                for (int r = 0; r < 16; ++r) ps += p0[r] + p1[r];
                ps = half_sum(ps);
                l_reg = l_reg * alpha + ps;
            }
            if (MODE == MODE_IMP || MODE == MODE_IMPACC) {
                LAS3 float* imp = (LAS3 float*)(c.lds + L_IMP) + (c.wid * 8 + (r32 >> 2)) * 128;
#pragma unroll
                for (int hf = 0; hf < 2; ++hf)
#pragma unroll
                    for (int m = 0; m < 4; ++m) { const f32x16& P = hf ? p1 : p0;
                        float a = 2.f * (P[4 * m] + P[4 * m + 1] + P[4 * m + 2]) + P[4 * m + 3], b = P[4 * m + 3];
                        a += xor1_f(a); b += xor1_f(b); a += xor2_f(a); b += xor2_f(b);
                        const int jj = 16 * j + 8 * hf + 2 * m + hi;
                        if ((r32 & 3) == 0) { __hip_atomic_fetch_add(imp + jj, a, __ATOMIC_RELAXED, __HIP_MEMORY_SCOPE_WORKGROUP);
                            if (jj + 1 < 128) __hip_atomic_fetch_add(imp + jj + 1, b, __ATOMIC_RELAXED, __HIP_MEMORY_SCOPE_WORKGROUP); } }
            }
            if (MODE == MODE_IMPACC) {
#pragma unroll
                for (int r = 0; r < 16; ++r) { p0[r] *= gate; p1[r] *= gate; }
            }
            if (HASV) {
                bf16x8 pa0, pa1, pa2, pa3;
                SBAR(); pack_p(p0, p1, pa0, pa1, pa2, pa3); SBAR();
                if (MODE == MODE_ONLINE && resc) {
#pragma unroll
                    for (int d_ = 0; d_ < 4; ++d_)
#pragma unroll
                        for (int r = 0; r < 16; ++r) c.o[d_][r] *= al_l[crow(r, hi)];
                    SBAR(); }
                pv_tile(c.o, vbase + slot * SHM, pa0, pa1, pa2, pa3);
            }
        }
        STEP_END(role == 0, ldt);
        slot = slot == 2 ? 0 : slot + 1;
    }
    if (PP && role == 0) { __builtin_amdgcn_s_barrier(); asm volatile("" ::: "memory"); }
#undef TJ
#undef STEP_END
#undef WAIT_OLDER
#undef LOADT
}
__device__ __forceinline__ void attn_unit(LAS3 char* lds, const bf16_t* __restrict__ proj, const bf16_t* __restrict__ kc, const bf16_t* __restrict__ vc, bf16_t* __restrict__ oa, float* park, int qt, int g, bool rev) {
    int tid_ = threadIdx.x; asm volatile("" : "+v"(tid_));
    Ctx c; c.lds = lds; c.tid = tid_; c.lane = c.tid & 63; c.wid = __builtin_amdgcn_readfirstlane(c.tid >> 6); c.r32 = c.lane & 31; c.hi = c.lane >> 5;
    c.t0 = qt * 64; c.tq = c.t0 + 8 * c.wid + (c.r32 >> 2);
    const int head = g * 4 + (c.r32 & 3);
    c.tb = (const LAS3 float*)(lds + LDS_BIAS) + head * 256; c.bfar = c.tb[64 + 127];
    { const bf16_t* qp = proj + (size_t)c.tq * NP + C_Q + head * HD + c.hi * 8;
#pragma unroll
      for (int d0 = 0; d0 < 8; ++d0) c.qr[d0] = *(const bf16x8*)(qp + d0 * 16); }
    float ga[3];
    { const bf16_t* gp = proj + (size_t)c.tq * NP + C_GA + head * 3;
#pragma unroll
      for (int b = 0; b < 3; ++b) ga[b] = pg8::fast_sigmoid(__uint_as_float(((unsigned)gp[b]) << 16)); }
    { LAS3 f32x4* z = (LAS3 f32x4*)(lds + L_IMP);
#pragma unroll
      for (int i = 0; i < 4; ++i) z[c.tid + 512 * i] = (f32x4){0.f, 0.f, 0.f, 0.f}; }
    __syncthreads();
    const bf16_t* Kc = kc + g * HD; const bf16_t* Vc = vc + g * HD;
    const bf16_t* Ks = proj + C_KV + 2 * 512 + g * HD; const bf16_t* Vs = proj + C_KV + 3 * 512 + g * HD;
    const bf16_t* Kw = proj + C_KV + 4 * 512 + g * HD; const bf16_t* Vw = proj + C_KV + 5 * 512 + g * HD;
    const int ntc = (4 * qt + 2) / 64;
    constexpr unsigned WINF = 0x7fffffffu;
    LAS3 float* wsf = (LAS3 float*)(lds + L_WS) + c.wid * 64;
#define PARK_PTR(sl_) int pt_ = c.tid; asm volatile("" : "+v"(pt_)); char* pp_ = (char*)park + ((size_t)blockIdx.x * 32 * 512 + (size_t)(sl_) * 16 * 512 + pt_) * 16
#define PARK_STORE(sl_) do { PARK_PTR(sl_); _Pragma("unroll") for (int d_ = 0; d_ < 4; ++d_) _Pragma("unroll") for (int q_ = 0; q_ < 4; ++q_) { \
        *(f32x4*)pp_ = (f32x4){c.o[d_][4 * q_], c.o[d_][4 * q_ + 1], c.o[d_][4 * q_ + 2], c.o[d_][4 * q_ + 3]}; pp_ += 8192; } } while (0)
#define PARK_ADD(sl_) do { PARK_PTR(sl_); _Pragma("unroll") for (int hh_ = 0; hh_ < 2; ++hh_) { f32x4 t_[8]; _Pragma("unroll") for (int e_ = 0; e_ < 8; ++e_) { t_[e_] = *(const f32x4*)pp_; pp_ += 8192; } SBAR(); \
        _Pragma("unroll") for (int e_ = 0; e_ < 8; ++e_) { const int d_ = hh_ * 2 + (e_ >> 2), q_ = e_ & 3; \
        c.o[d_][4 * q_] += t_[e_][0]; c.o[d_][4 * q_ + 1] += t_[e_][1]; c.o[d_][4 * q_ + 2] += t_[e_][2]; c.o[d_][4 * q_ + 3] += t_[e_][3]; } SBAR(); } } while (0)
#define ROW_SCALE(f_) do { if (c.hi == 0) wsf[c.r32] = (f_); LDS_WAIT(); _Pragma("unroll") for (int d_ = 0; d_ < 4; ++d_) _Pragma("unroll") for (int r = 0; r < 16; ++r) c.o[d_][r] *= wsf[crow(r, c.hi)]; } while (0)
#ifndef AREP
#define AREP 0
#endif
    {
        float m_c = -1e30f, l_c = 0.f;
        run_pass<MODE_STAT, 16, 31, false, false>(c, Kc, Vc, 512, 0, ntc, WINF, m_c, l_c, 0.f, 0u, 0u, 0u, 0u);
        const float rl_c = l_c > 0.f ? 1.0f / l_c : 0.f;
#pragma unroll
        for (int d_ = 0; d_ < 4; ++d_) c.o[d_] = f32x16{};
        run_pass<MODE_IMPACC, 16, 31, false, false>(c, Kc, Vc, 512, 0, ntc, WINF, m_c, l_c, rl_c, 0u, 0u, 0u, 0u, ga[0]);
        PARK_STORE(0);
    }
    {
        LAS3 unsigned* selw = (LAS3 unsigned*)(lds + L_SEL);
#pragma unroll 1
        for (int tk = 0; tk < 8; ++tk) {
            const int tok = c.wid * 8 + tk; const LAS3 float* imp = (const LAS3 float*)(lds + L_IMP) + tok * 128;
            const int ja = c.lane, jb = c.lane + 64;
            unsigned ka = __float_as_uint(imp[ja]) + 1u, kb = __float_as_uint(imp[jb]) + 1u;
            ka = (ja == 0 || ja == qt || ja == qt - 1) ? 0xffffffffu : (ja > qt ? 0u : ka);
            kb = (jb == qt || jb == qt - 1) ? 0xffffffffu : (jb > qt ? 0u : kb);
            unsigned T = 0u;
#pragma unroll 1
            for (int bit = 31; bit >= 0; --bit) { const unsigned cand = T | (1u << bit);
                const int cnt = __popcll(__ballot(ka >= cand)) + __popcll(__ballot(kb >= cand));
                T = cnt >= 16 ? cand : T; }
            const int cgt = __popcll(__ballot(ka > T)) + __popcll(__ballot(kb > T)); const int rr = 16 - cgt;
            const unsigned long long ea = __ballot(ka == T), eb = __ballot(kb == T);
            const int ra = __builtin_amdgcn_mbcnt_hi((unsigned)(ea >> 32), __builtin_amdgcn_mbcnt_lo((unsigned)ea, 0u));
            const int rb = __popcll(ea) + (int)__builtin_amdgcn_mbcnt_hi((unsigned)(eb >> 32), __builtin_amdgcn_mbcnt_lo((unsigned)eb, 0u));
            const unsigned long long ba = __ballot(ka > T || (ka == T && ra < rr)), bb = __ballot(kb > T || (kb == T && rb < rr));
            if (c.lane == 0) { selw[tok * 4 + 0] = (unsigned)ba; selw[tok * 4 + 1] = (unsigned)(ba >> 32); selw[tok * 4 + 2] = (unsigned)bb; selw[tok * 4 + 3] = (unsigned)(bb >> 32); }
        }
        LDS_WAIT();
    }
    {
        float m_w = -1e30f, l_w = 0.f; const int jlo = qt >= 8 ? qt - 8 : 0;
#pragma unroll
        for (int d_ = 0; d_ < 4; ++d_) c.o[d_] = f32x16{};
        run_pass<MODE_ONLINE, 1, 0, false, false>(c, Kw, Vw, NP, jlo, qt, 512u, m_w, l_w, 0.f, 0u, 0u, 0u, 0u);
        ROW_SCALE(ga[2] / l_w);
        PARK_STORE(1);
    }
    unsigned zr[64];
    {
        unsigned sm0, sm1, sm2, sm3;
        { const LAS3 unsigned* selw = (const LAS3 unsigned*)(lds + L_SEL) + (c.wid * 8 + (c.r32 >> 2)) * 4; sm0 = selw[0]; sm1 = selw[1]; sm2 = selw[2]; sm3 = selw[3]; }
        float m_s = -1e30f, l_s = 0.f;
#pragma unroll
        for (int d_ = 0; d_ < 4; ++d_) c.o[d_] = f32x16{};
        run_pass<MODE_ONLINE, 1, 0, true, true>(c, Ks, Vs, NP, 0, qt, WINF, m_s, l_s, 0.f, sm0, sm1, sm2, sm3, 1.f, rev);
        { int r32_ = c.r32; asm volatile("" : "+v"(r32_));
          const char* zbase = (const char*)(proj + C_ZA + g * 4 * HD);
#pragma unroll
          for (int r = 0; r < 16; ++r) { const int row = crow(r, c.hi); const int tok = c.t0 + 8 * c.wid + (row >> 2), hd = row & 3; const unsigned zo = (unsigned)(tok * NP + hd * HD + r32_) * 2u;
#pragma unroll
              for (int d0 = 0; d0 < 4; ++d0) zr[r * 4 + d0] = *(const unsigned short*)(zbase + zo + d0 * 64); } }
        SBAR();
        ROW_SCALE(ga[1] / l_s);
        PARK_ADD(0);
        PARK_ADD(1);
    }
#undef PARK_STORE
#undef PARK_ADD
#undef ROW_SCALE
#ifdef NO_EPI
    if (c.o[0][0] == 123.f && c.o[1][1] == 3.f && c.o[2][2] == 1.f && c.o[3][3] == 5.f) oa[0] = 1;
    if (false)
#endif
    {
        const int tw = c.t0 + 8 * c.wid; const bool odd = (c.r32 & 1) != 0;
        char* obase = (char*)(oa + g * 4 * HD);
#pragma unroll
        for (int r = 0; r < 16; ++r) { const int row = crow(r, c.hi); const int tok = tw + (row >> 2), hd = row & 3;
            const unsigned oo = (unsigned)(tok * AW + hd * HD + c.r32) * 2u;
#pragma unroll
            for (int p = 0; p < 2; ++p) { const float za = __uint_as_float(zr[r * 4 + 2 * p] << 16), zb = __uint_as_float(zr[r * 4 + 2 * p + 1] << 16);
                const float a = c.o[2 * p][r] * za * pg8::fast_sigmoid(za), b = c.o[2 * p + 1][r] * zb * pg8::fast_sigmoid(zb);
                const float recv = xor1_f(odd ? a : b);
                const unsigned w = cvtpk(odd ? recv : a, odd ? b : recv);
                *(unsigned*)(obase + (odd ? oo + (2 * p + 1) * 64 - 2u : oo + (2 * p) * 64)) = w; }
        }
    }
    __syncthreads();
}
__device__ __forceinline__ void phase_attn(LAS3 char* lds, const bf16_t* proj, const bf16_t* kc, const bf16_t* vc, bf16_t* oa, float* park, int vcu, int G) {
#pragma unroll 1
    for (int item = vcu; item < 256; item += G) {
        const int g = item >> 6, p = item & 63;
#pragma unroll 1
        for (int s = 0; s < 2; ++s) attn_unit(lds, proj, kc, vc, oa, park, s ? p : 127 - p, g, s != 0);
    }
}
}
__device__ __forceinline__ float gelu_tanh(float x) { const float y = 1.5957691216057308f * (x + 0.044715f * x * x * x); return x * pg8::fast_sigmoid(y); }
__device__ __forceinline__ float silu_f(float x) { return x * pg8::fast_sigmoid(x); }
__device__ __forceinline__ void compress_unit(LAS3 char* lds, const bf16_t* __restrict__ proj, const float* __restrict__ pe, const bf16_t* __restrict__ w1t, const bf16_t* __restrict__ w2t,
                                              bf16_t* __restrict__ outc, int u, int which) {
    int tid_o = threadIdx.x; asm volatile("" : "+v"(tid_o));
    const int tid = tid_o, lane = tid & 63, wid = __builtin_amdgcn_readfirstlane(tid >> 6), r32 = lane & 31, hi = lane >> 5;
    const int i = 8 * u + (r32 >> 2), g = r32 & 3;
    f32x16 acc[4];
#pragma unroll
    for (int nb = 0; nb < 4; ++nb) acc[nb] = f32x16{};
    const bf16_t* abase = proj + C_KV + which * 512 + g * HD + hi * 8;
    const bf16_t* bbase = w1t + (size_t)(wid * 32) * 2048 + lane * 8;
#pragma unroll 1
    for (int lt = 0; lt < 4; ++lt) {
        const int l = wid * 4 + lt; int tokn = 16 * i + l; tokn = tokn < T ? tokn : T - 1;
        const bf16_t* ap = abase + (size_t)tokn * NP; const float* pp = pe + l * HD + hi * 8;
#pragma unroll
        for (int hf = 0; hf < 2; ++hf) {
            u32x4 araw[4]; f32x4 e0[4], e1[4]; bf16x8 bfr[4][4];
#pragma unroll
            for (int k = 0; k < 4; ++k) { const int k8 = hf * 4 + k; araw[k] = *(const u32x4*)(ap + k8 * 16); e0[k] = *(const f32x4*)(pp + k8 * 16); e1[k] = *(const f32x4*)(pp + k8 * 16 + 4);
#pragma unroll
                for (int nb = 0; nb < 4; ++nb) bfr[k][nb] = *(const bf16x8*)(bbase + (size_t)((lt * 8 + k8) * 4 + nb) * 512); }
            __builtin_amdgcn_sched_barrier(0);
#pragma unroll
            for (int k = 0; k < 4; ++k) { const u32x4 raw = araw[k];
                u32x4 aw; aw.x = pk2(pg8::bf_lo(raw.x) + e0[k][0], pg8::bf_hi(raw.x) + e0[k][1]); aw.y = pk2(pg8::bf_lo(raw.y) + e0[k][2], pg8::bf_hi(raw.y) + e0[k][3]);
                aw.z = pk2(pg8::bf_lo(raw.z) + e1[k][0], pg8::bf_hi(raw.z) + e1[k][1]); aw.w = pk2(pg8::bf_lo(raw.w) + e1[k][2], pg8::bf_hi(raw.w) + e1[k][3]);
                const bf16x8 a = *reinterpret_cast<const bf16x8*>(&aw);
#pragma unroll
                for (int nb = 0; nb < 4; ++nb) acc[nb] = __builtin_amdgcn_mfma_f32_32x32x16_bf16(a, bfr[k][nb], acc[nb], 0, 0, 0); }
            __builtin_amdgcn_sched_barrier(0);
        }
    }
    LAS3 float* part = (LAS3 float*)lds + wid * 4096;
#pragma unroll
    for (int nb = 0; nb < 4; ++nb)
#pragma unroll
        for (int r = 0; r < 16; ++r) part[att::crow(r, hi) * 128 + nb * 32 + r32] = acc[nb][r];
    __syncthreads();
    f32x4 s0 = {0.f, 0.f, 0.f, 0.f}, s1 = {0.f, 0.f, 0.f, 0.f};
#pragma unroll
    for (int w = 0; w < 8; ++w) { const LAS3 f32x4* p = (const LAS3 f32x4*)((LAS3 float*)lds + w * 4096 + tid * 8); s0 += p[0]; s1 += p[1]; }
    __syncthreads();
    {
        u32x4 hw; hw.x = pk2(silu_f(s0[0]), silu_f(s0[1])); hw.y = pk2(silu_f(s0[2]), silu_f(s0[3])); hw.z = pk2(silu_f(s1[0]), silu_f(s1[1])); hw.w = pk2(silu_f(s1[2]), silu_f(s1[3]));
        const int row = tid >> 4, col = (tid & 15) * 8;
        *(LAS3 u32x4*)(lds + (row * 136 + col) * 2) = hw;
    }
    __syncthreads();
    if (wid < 4) {
        f32x16 o2 = f32x16{};
#pragma unroll
        for (int ks = 0; ks < 8; ++ks) { const bf16x8 a = *(const LAS3 bf16x8*)(lds + (r32 * 136 + ks * 16 + hi * 8) * 2);
            const bf16x8 b = *(const bf16x8*)(w2t + (size_t)(wid * 32 + r32) * HD + ks * 16 + hi * 8);
            o2 = __builtin_amdgcn_mfma_f32_32x32x16_bf16(a, b, o2, 0, 0, 0); }
#pragma unroll
        for (int r = 0; r < 16; ++r) { const int row = att::crow(r, hi); const int ii = 8 * u + (row >> 2), gg = row & 3;
            const float v = ii < NCMP ? o2[r] : 0.f; const float vn = xor1_f(v);
            if ((r32 & 1) == 0) *(unsigned*)(outc + (size_t)(ii * 4 + gg) * HD + wid * 32 + r32) = pk2(v, vn); }
    }
    __syncthreads();
}
__device__ __forceinline__ void gmlp_unit(LAS3 char* lds, const bf16_t* __restrict__ proj, const float* __restrict__ sspart, const float* __restrict__ gain, const float* __restrict__ sw, const float* __restrict__ sb,
                                          bf16_t* __restrict__ ob, int ch, int qd) {
    int tid_o = threadIdx.x; asm volatile("" : "+v"(tid_o));
    const int tid = tid_o, lane = tid & 63, wid = __builtin_amdgcn_readfirstlane(tid >> 6), r32 = lane & 31, hi = lane >> 5;
    const int tc0 = ch * 128;
    LAS3 float* rsl = (LAS3 float*)(lds + LDS_RS);
    {   const int vkk = ((tid >> 7) * 8) + ((tid & 31) >> 2), vkey = (vkk & ~0xC) | ((vkk & 4) << 1) | ((vkk & 8) >> 1), vcol = ((tid >> 5) & 3) * 32 + (tid & 3) * 8;
        const unsigned vo0 = (unsigned)(vkey * NP + vcol) * 2u; const unsigned half_step = (unsigned)(32 * NP) * 2u;
#pragma unroll
        for (int gg = 0; gg < 4; ++gg)
#pragma unroll
            for (int kt = 0; kt < 2; ++kt) { const char* vp_ = (const char*)(proj + (size_t)(tc0 + kt * 64) * NP + C_VB + (qd * 4 + gg) * 128); LAS3 char* vd_ = lds + (gg * 2 + kt) * att::SHM + wid * 1024;
                __builtin_amdgcn_global_load_lds((const unsigned*)(vp_ + vo0), (LAS3 unsigned*)vd_, 16, 0, 0);
                __builtin_amdgcn_global_load_lds((const unsigned*)((vp_ + half_step) + vo0), (LAS3 unsigned*)(vd_ + 8192), 16, 0, 0); } }
    if (tid < 128) { const f32x4* sp = (const f32x4*)(sspart + (size_t)(tc0 + tid) * 32); f32x4 s = sp[0];
#pragma unroll
        for (int i = 1; i < 8; ++i) s += sp[i];
        rsl[tid] = 1.0f / sqrtf(((s[0] + s[1]) + (s[2] + s[3])) * (1.0f / BW) + NORM_EPS); }
    VM_WAIT();
    __syncthreads();
    const int gg = wid >> 1, wd = wid & 1, G = qd * 4 + gg, cb = G * 128;
    const int vb1 = (int)(uintptr_t)(lds) + gg * 2 * att::SHM + att::v_rd_base(lane) + wd * 1024;
    f32x4 gn[2][4];
#pragma unroll
    for (int dd = 0; dd < 2; ++dd)
#pragma unroll
        for (int m = 0; m < 4; ++m) gn[dd][m] = *(const f32x4*)(gain + cb + (wd * 2 + dd) * 32 + 8 * m + 4 * hi);
#pragma unroll 1
    for (int pb = 0; pb < 4; ++pb) {
        const int p = pb * 32 + r32; const size_t tok = (size_t)(tc0 + p); const int nks = 2 * pb + 2;
        f32x4 wr0[8], wr1[8]; u32x2 uu[2][4], zz[2][4];
        const float* wrow = sw + ((size_t)G * 128 + p) * 128 + hi * 8;
#pragma unroll
        for (int ks = 0; ks < 8; ++ks) if (ks < nks) { wr0[ks] = *(const f32x4*)(wrow + ks * 16); wr1[ks] = *(const f32x4*)(wrow + ks * 16 + 4); }
        const char* ubase = (const char*)(proj + tok * NP + C_UB + cb); const char* zbase = (const char*)(proj + tok * NP + C_ZB + cb); char* obase = (char*)(ob + tok * BW + cb);
#pragma unroll
        for (int dd = 0; dd < 2; ++dd)
#pragma unroll
            for (int m = 0; m < 4; ++m) { const int d0 = (wd * 2 + dd) * 32 + 8 * m + 4 * hi; uu[dd][m] = *(const u32x2*)(ubase + d0 * 2); zz[dd][m] = *(const u32x2*)(zbase + d0 * 2); }
        const float bs = sb[G * 128 + p];
        __builtin_amdgcn_sched_barrier(0);
        bf16x8 af[8];
#pragma unroll
        for (int ks = 0; ks < 8; ++ks) { if (ks < nks) { const f32x4 a0 = wr0[ks], a1 = wr1[ks]; const int q0 = ks * 16 + hi * 8;
                const f32x4 r0 = *(const LAS3 f32x4*)(rsl + q0), r1 = *(const LAS3 f32x4*)(rsl + q0 + 4);
                u32x4 w; w.x = pk2(q0 + 0 <= p ? a0[0] * r0[0] : 0.f, q0 + 1 <= p ? a0[1] * r0[1] : 0.f); w.y = pk2(q0 + 2 <= p ? a0[2] * r0[2] : 0.f, q0 + 3 <= p ? a0[3] * r0[3] : 0.f);
                w.z = pk2(q0 + 4 <= p ? a1[0] * r1[0] : 0.f, q0 + 5 <= p ? a1[1] * r1[1] : 0.f); w.w = pk2(q0 + 6 <= p ? a1[2] * r1[2] : 0.f, q0 + 7 <= p ? a1[3] * r1[3] : 0.f);
                af[ks] = *reinterpret_cast<const bf16x8*>(&w); } else af[ks] = bf16x8{}; }
        f32x16 acc[2] = {f32x16{}, f32x16{}};
#define TRRD(dst, off) asm volatile("ds_read_b64_tr_b16 %0, %1 offset:%2" : "=&v"(dst) : "v"(vb1), "i"(off) : "memory")
#define GM_STEP(ks) do { if ((ks) < nks) { s16x4 l0, h0, l1, h1; constexpr int o_ = ((ks) >> 2) * att::SHM + att::v_rd_off(0, (ks) & 3, 0); \
            TRRD(l0, o_); TRRD(h0, o_ + 2048); TRRD(l1, o_ + 512); TRRD(h1, o_ + 512 + 2048); \
            asm volatile("s_waitcnt lgkmcnt(0)" ::: "memory"); __builtin_amdgcn_sched_barrier(0); \
            acc[0] = __builtin_amdgcn_mfma_f32_32x32x16_bf16((bf16x8){l0[0], l0[1], l0[2], l0[3], h0[0], h0[1], h0[2], h0[3]}, af[ks], acc[0], 0, 0, 0); \
            acc[1] = __builtin_amdgcn_mfma_f32_32x32x16_bf16((bf16x8){l1[0], l1[1], l1[2], l1[3], h1[0], h1[1], h1[2], h1[3]}, af[ks], acc[1], 0, 0, 0); } } while (0)
        GM_STEP(0); GM_STEP(1); GM_STEP(2); GM_STEP(3); GM_STEP(4); GM_STEP(5); GM_STEP(6); GM_STEP(7);
#undef GM_STEP
#undef TRRD
#pragma unroll
        for (int dd = 0; dd < 2; ++dd)
#pragma unroll
            for (int m = 0; m < 4; ++m) { const int d0 = (wd * 2 + dd) * 32 + 8 * m + 4 * hi; const u32x2 u2 = uu[dd][m], z2 = zz[dd][m]; const f32x4 g4 = gn[dd][m];
                const float o0 = gelu_tanh(pg8::bf_lo(u2.x)) * (acc[dd][4 * m + 0] * g4[0] + bs) * silu_f(pg8::bf_lo(z2.x));
                const float o1 = gelu_tanh(pg8::bf_hi(u2.x)) * (acc[dd][4 * m + 1] * g4[1] + bs) * silu_f(pg8::bf_hi(z2.x));
                const float o2 = gelu_tanh(pg8::bf_lo(u2.y)) * (acc[dd][4 * m + 2] * g4[2] + bs) * silu_f(pg8::bf_lo(z2.y));
                const float o3 = gelu_tanh(pg8::bf_hi(u2.y)) * (acc[dd][4 * m + 3] * g4[3] + bs) * silu_f(pg8::bf_hi(z2.y));
                u32x2 w; w.x = pk2(o0, o1); w.y = pk2(o2, o3); *(u32x2*)(obase + d0 * 2) = w; }
    }
    __syncthreads();
}
#ifndef N_LAUNCH_MODE
#define N_LAUNCH_MODE 1
#endif
constexpr int NPHASES = 1 + 6 * DEPTH;
#ifndef PHMASK
#define PHMASK 0x7f
#endif
#ifndef REPMASK
#define REPMASK 0
#endif
#define REPS(bit) ((REPMASK & (bit)) ? 2 : 1)
__global__ void __launch_bounds__(NTHREADS, 2) fwd_kernel(Params P) {
    extern __shared__ __attribute__((aligned(16))) unsigned char lds_raw[];
    LAS3 unsigned char* lds = (LAS3 unsigned char*)lds_raw;
    const int tid = threadIdx.x, wave = __builtin_amdgcn_readfirstlane(tid >> 6);
#define lane hw_lane_id()
    const int G = gridDim.x; const int bx = blockIdx.x; const int vcu = (G % 8 == 0) ? (bx % 8) * (G / 8) + bx / 8 : bx;
    const int gw = vcu * NWAVES + wave, NGW = G * NWAVES;
    unsigned char* ws = P.ws;
    if (tid < 16) ((LAS3 unsigned*)(lds + LDS_MISC))[tid] = 0u;
    __syncthreads();
    XcdBarrier bar; bar.bar = (unsigned*)(ws + WS_CTL); bar.x = 0; bar.st = nullptr;
    if (N_LAUNCH_MODE == 1) bar = xcd_barrier_post((unsigned*)(ws + WS_CTL), (volatile LAS unsigned*)(lds + LDS_MISC));
    const int lo = P.ph_lo, hi = P.ph_hi;
#define IN(k) (lo <= (k) && (k) < hi)
#define SEAM(k) do { if (IN(k) && IN((k) + 1)) xcd_barrier(bar); } while (0)
    bf16_t* hbuf = (bf16_t*)(ws + WS_H); bf16_t* proj = (bf16_t*)(ws + WS_PROJ); bf16_t* kc = (bf16_t*)(ws + WS_KC); bf16_t* vc = (bf16_t*)(ws + WS_VC);
    bf16_t* oa = (bf16_t*)(ws + WS_OA); bf16_t* ob = (bf16_t*)(ws + WS_OB); bf16_t* t1 = (bf16_t*)(ws + WS_T1); bf16_t* mg = (bf16_t*)(ws + WS_MG);
    bf16_t* Y = (bf16_t*)(ws + WS_Y); bf16_t* x1 = (bf16_t*)(ws + WS_X1);
    constexpr int NU_PROJ = (T / 256) * (NP / 256);
#pragma unroll 1
    for (int w = 0; w < 2; ++w) {
        const int rem = NU_PROJ % G; const bool tailcu = (rem != 0) && (bx >= rem);
        const bool doit = (w == 0) ? (IN(0) && (PHMASK & 1)) : (IN(1) && tailcu);
        const bool alltail = (rem == 0);
        if (doit) {
            const int lo_ = (w == 0) ? 0 : W_ITEMS - W_TAIL_ITEMS, hi_ = (w == 0) ? (alltail ? W_ITEMS : W_ITEMS - W_TAIL_ITEMS) : W_ITEMS;
            const int gw_ = (w == 0) ? gw : (bx - rem) * NWAVES + wave, ngw_ = (w == 0) ? NGW : (G - rem) * NWAVES;
            for (int rep = 0; rep < REPS(1); ++rep) phase_weights(P, lds, gw_, ngw_, wave, lane, lo_, hi_);
        }
        if (w == 0 && IN(0) && (PHMASK & 1)) for (int rep = 0; rep < REPS(128); ++rep) phase_prenorm(P.x, P.pre_norm, hbuf, gw, NGW, lane);
        __syncthreads();
        for (int i = tid; i < 16 * 256; i += NTHREADS) { const int hd = i >> 8; int dd = (i & 255) - 64; dd = dd < 0 ? 0 : (dd > 127 ? 127 : dd); ((LAS3 float*)(lds + LDS_BIAS))[i] = P.rel_bias[BUCKET[dd] * 16 + hd] * att::LOG2E; }
        __syncthreads();
        if (w == 0) SEAM(0);
    }
#pragma unroll 1
    for (int L = 0; L < DEPTH; ++L) {
        const int pb = 1 + 6 * L;
        constexpr int PN_EARLY = 80, PN_LATE = NP / 256 - PN_EARLY, N_LATE_UNITS = (T / 256) * PN_LATE;
#pragma unroll 1
        for (int half = 0; half < 2; ++half) {
            if (IN(pb + half) && (PHMASK & 2)) for (int rep = 0; rep < REPS(2); ++rep) {
                pg8::Gemm g{hbuf, (const bf16_t*)(ws + WS_WIN + L * SZ_WIN), T, NP, DM, nullptr, nullptr}; pg8::ProjOrder S; S.init2(T, PN_EARLY, PN_LATE, G, bx, half);
                pg8::EpiProj E{proj, NP, (float*)(ws + WS_SS)};
                pg8::gemm_phase<pg8::EpiProj, pg8::ProjOrder>(lds + LDS_STAGE, g, S, E, nullptr);
            }
            if (half == 0) SEAM(pb);
        }
        if (IN(pb + 1) && (PHMASK & 4)) for (int rep = 0; rep < REPS(4); ++rep) {
#pragma unroll 1
            for (int q = 0; ; ++q) {
                int item;
                if (G == 256) {
                    if (bx >= N_LATE_UNITS) { const int k = bx - N_LATE_UNITS;
                        if (k < 64) { if (q >= 3) break; item = 3 * k + q; } else { if (q >= 2) break; item = 192 + 2 * (k - 64) + q; } }
                    else { if (q >= 1 || bx >= 128) break; item = 256 + bx; }
                }
                else { item = bx + q * G; if (item >= 384) break; }
                if (item < 256) gmlp_unit((LAS3 char*)lds, proj, (const float*)(ws + WS_SS), P.sgu_norm + L * BW, P.sgu_w + (size_t)L * 16 * 128 * 128, P.sgu_b + L * 16 * 128, ob, item >> 2, item & 3);
                else { const int ci = item - 256, which = ci & 1, u = ci >> 1;
                    compress_unit((LAS3 char*)lds, proj, (which ? P.pe_v : P.pe_k) + L * 32 * HD, (const bf16_t*)(ws + WS_W1 + (L * 2 + which) * SZ_W1), (const bf16_t*)(ws + WS_W2 + (L * 2 + which) * SZ_W2), which ? vc : kc, u, which); }
            }
        }
        SEAM(pb + 1);
        if (IN(pb + 2) && (PHMASK & 8)) for (int rep = 0; rep < REPS(8); ++rep) att::phase_attn((LAS3 char*)lds, proj, kc, vc, oa, (float*)(ws + WS_PARK), vcu, G);
        SEAM(pb + 2);
        if (IN(pb + 3) && (PHMASK & 16)) for (int rep = 0; rep < REPS(16); ++rep) {
            pg8::DualOrder S; S.init(T, DM, G, bx);
            pg8::Gemm g{oa, (const bf16_t*)(ws + WS_WA + L * SZ_WAB), T, DM, AW, ob, (const bf16_t*)(ws + WS_WB + L * SZ_WAB)};
            pg8::EpiMerge E{mg, DM, proj + C_MA, proj + C_MB, NP};
            pg8::gemm_phase<pg8::EpiMerge, pg8::DualOrder>(lds + LDS_STAGE, g, S, E, nullptr);
        }
        SEAM(pb + 3);
        if (IN(pb + 4) && (PHMASK & 32)) for (int rep = 0; rep < REPS(32); ++rep) {
            pg8::Gemm g{mg, (const bf16_t*)(ws + WS_WO + L * SZ_WO), T, DM, DM, nullptr, nullptr}; pg8::StaticOrder S; S.init(T, DM, G, bx);
            pg8::EpiBf16Plain E{Y, DM};
            pg8::gemm_phase<pg8::EpiBf16Plain, pg8::StaticOrder>(lds + LDS_STAGE, g, S, E, nullptr);
        }
        SEAM(pb + 4);
        if (IN(pb + 5) && (PHMASK & 64)) for (int rep = 0; rep < REPS(64); ++rep) {
            if (L == 0) phase_postnorm<false, true>(Y, P.x, P.post_norm, x1, P.pre_norm + DM, hbuf, true, gw, NGW, lane);
            else phase_postnorm<true, false>(Y, x1, P.post_norm + L * DM, P.out, P.pre_norm, hbuf, false, gw, NGW, lane);
        }
        SEAM(pb + 5);
    }
#undef IN
#undef SEAM
#undef lane
}
extern "C" void kernel_launch(void* const* d_in, const int* in_sizes, int n_in, void* d_out, int out_size, void* d_ws, size_t ws_size, hipStream_t stream) {
    static int grid = 0;
    if (grid == 0) {
        if (n_in != 17 || in_sizes[0] != T * DM || out_size != T * DM || ws_size < WS_END) { fprintf(stderr, "kernel_launch: unexpected shapes (n_in %d, in0 %d, out %d, ws %zu < %zu)\n", n_in, n_in > 0 ? in_sizes[0] : -1, out_size, ws_size, (size_t)WS_END); grid = -1; return; }
        int dev = 0, cus = 0, per_cu = 0;
        if (hipGetDevice(&dev) != hipSuccess || hipDeviceGetAttribute(&cus, hipDeviceAttributeMultiprocessorCount, dev) != hipSuccess) { grid = -1; return; }
        if (hipFuncSetAttribute((const void*)fwd_kernel, hipFuncAttributeMaxDynamicSharedMemorySize, LDS_BYTES) != hipSuccess) { fprintf(stderr, "kernel_launch: hipFuncSetAttribute failed\n"); grid = -1; return; }
        if (hipOccupancyMaxActiveBlocksPerMultiprocessor(&per_cu, (const void*)fwd_kernel, NTHREADS, LDS_BYTES) != hipSuccess || per_cu < 1) { fprintf(stderr, "kernel_launch: occupancy query says %d blocks per CU\n", per_cu); (void)hipGetLastError(); grid = -1; return; }
        grid = cus;
    }
    if (grid < 0) return;
    (void)hipMemsetAsync((char*)d_ws + WS_CTL, 0, CTL_BYTES, stream);
    Params p{};
    p.x = (const float*)d_in[0]; p.rel_bias = (const float*)d_in[1]; p.pre_norm = (const float*)d_in[2]; p.w_in = (const float*)d_in[3];
    p.pe_k = (const float*)d_in[4]; p.w1_k = (const float*)d_in[5]; p.w2_k = (const float*)d_in[6]; p.pe_v = (const float*)d_in[7]; p.w1_v = (const float*)d_in[8]; p.w2_v = (const float*)d_in[9];
    p.w_out_a = (const float*)d_in[10]; p.sgu_norm = (const float*)d_in[11]; p.sgu_w = (const float*)d_in[12]; p.sgu_b = (const float*)d_in[13]; p.w_out_b = (const float*)d_in[14]; p.w_out = (const float*)d_in[15]; p.post_norm = (const float*)d_in[16];
    p.out = (float*)d_out; p.ws = (unsigned char*)d_ws;
#if N_LAUNCH_MODE == 1
    p.ph_lo = 0; p.ph_hi = NPHASES;
    hipLaunchKernelGGL(fwd_kernel, dim3(grid), dim3(NTHREADS), LDS_BYTES, stream, p);
#else
    for (int k = 0; k < NPHASES; ++k) { p.ph_lo = k; p.ph_hi = k + 1; hipLaunchKernelGGL(fwd_kernel, dim3(grid), dim3(NTHREADS), LDS_BYTES, stream, p); }
#endif
}
```

```cpp
#include <hip/hip_runtime.h>
#include <cstdio>
#include <cstdint>
template <int CTRL> __device__ __forceinline__ float dpp_f(float v) { return __builtin_bit_cast(float, __builtin_amdgcn_update_dpp(0, __builtin_bit_cast(int, v), CTRL, 0xF, 0xF, true)); }
__device__ __forceinline__ float xor1_f(float v) { return dpp_f<0xB1>(v); }
__device__ __forceinline__ float xor2_f(float v) { return dpp_f<0x4E>(v); }
__device__ __forceinline__ float xor16_sum(float v) { const unsigned a = __builtin_bit_cast(unsigned, v); auto r = __builtin_amdgcn_permlane16_swap(a, a, false, false); const unsigned r0 = r[0], r1 = r[1]; return __builtin_bit_cast(float, r0) + __builtin_bit_cast(float, r1); }
__device__ __forceinline__ float xor32_sum(float v) { const unsigned a = __builtin_bit_cast(unsigned, v); auto r = __builtin_amdgcn_permlane32_swap(a, a, false, false); const unsigned r0 = r[0], r1 = r[1]; return __builtin_bit_cast(float, r0) + __builtin_bit_cast(float, r1); }
__device__ __forceinline__ int hw_lane_id() { int l; asm volatile("v_mbcnt_lo_u32_b32 %0, -1, 0\n\tv_mbcnt_hi_u32_b32 %0, -1, %0" : "=v"(l)); return l; }
namespace pg8 {
#define PG8_LAS __attribute__((address_space(3)))
typedef unsigned short bf16_t;
typedef short bf16x8 __attribute__((ext_vector_type(8)));
typedef float f32x4 __attribute__((ext_vector_type(4)));
typedef unsigned u32x4 __attribute__((ext_vector_type(4)));
constexpr int BM = 256, BK = 64, HALF = 128, HTB = HALF * BK * 2  , STAGE_BYTES = 8 * HTB, NXCD = 8, WGM = 8;

__host__ __device__ __forceinline__ int lds_byte(int r, int c) { const int st = (r >> 4) * 2 + (c >> 5), rr = r & 15, cc = c & 31, ob = rr * 64 + cc * 2; return st * 1024 + (ob ^ (((ob >> 9) & 1) << 5)); }
__host__ __device__ __forceinline__ void stage_rc(int b, int& R, int& C) { const int st = b / 1024, sb = b % 1024, swz = sb ^ (((sb >> 9) & 1) << 5); R = (st >> 1) * 16 + swz / 64; C = (st & 1) * 32 + (swz % 64) / 2; }
__host__ __device__ __forceinline__ int perm32(int rho) { const int n = rho >> 4, i = rho & 15; return 8 * (i >> 2) + 4 * n + (i & 3); }

struct Unit { int pm, pn, sub; };
struct Gemm { const bf16_t* A; const bf16_t* Bt; int M, N, K; const bf16_t* A2; const bf16_t* Bt2; };

struct StaticOrder {
    int nM, nN, nwg, G, c;
    __host__ __device__ void init(int M, int N, int G_, int c_) { nM = M / BM; nN = N / BM; nwg = nM * nN; G = G_; c = c_; }
    __host__ __device__ bool next(int i, Unit& u) const {
        const long L = (long)i * G + c; if (L >= nwg) return false;
        int wgid = (int)L; { const int q = nwg / NXCD, r = nwg % NXCD, xcd = wgid % NXCD, off = wgid / NXCD; wgid = (xcd < r ? xcd * (q + 1) : r * (q + 1) + (xcd - r) * q) + off; }
        const int nig = WGM * nN, gid = wgid / nig, fm = gid * WGM, gsz = (nM - fm) < WGM ? (nM - fm) : WGM;
        u.pm = fm + ((wgid % nig) % gsz); u.pn = (wgid % nig) / gsz; u.sub = 0; return true;
    }
    __device__ __forceinline__ void a_ready(const Unit&) const {}
    __device__ __forceinline__ void done(const Unit&) const {}
    static constexpr bool DUAL = false;
    __device__ __forceinline__ const bf16_t* baseA(const Gemm& g, const Unit&) const { return g.A; }
    __device__ __forceinline__ const bf16_t* baseB(const Gemm& g, const Unit&) const { return g.Bt; }
};
struct DualOrder : StaticOrder {
    static constexpr bool DUAL = true;
    __host__ __device__ bool next(int i, Unit& u) const { const bool ok = StaticOrder::next(i >> 1, u); u.sub = i & 1; return ok; }
    __device__ __forceinline__ const bf16_t* baseA(const Gemm& g, const Unit& u) const { return u.sub ? g.A2 : g.A; }
    __device__ __forceinline__ const bf16_t* baseB(const Gemm& g, const Unit& u) const { return u.sub ? g.Bt2 : g.Bt; }
};
typedef __bf16 bf16x2_t __attribute__((ext_vector_type(2)));
typedef float f32x2_t __attribute__((ext_vector_type(2)));
__device__ __forceinline__ unsigned cvt_pk_bf16(float lo, float hi) { const f32x2_t v = {lo, hi}; const bf16x2_t b = __builtin_convertvector(v, bf16x2_t); return __builtin_bit_cast(unsigned, b); }
typedef float f32x2 __attribute__((ext_vector_type(2)));
__device__ __forceinline__ float bf_lo(unsigned u) { return __uint_as_float(u << 16); }
__device__ __forceinline__ float bf_hi(unsigned u) { return __uint_as_float(u & 0xffff0000u); }
__device__ __forceinline__ float fast_sigmoid(float x) { return __builtin_amdgcn_rcpf(1.0f + __builtin_amdgcn_exp2f(-1.4426950408889634f * x)); }
struct EpiBf16Plain {
    static constexpr bool PERM = true, AFTER_DRAIN = false;
    bf16_t* O; int ldc;
    __device__ __forceinline__ void operator()(const f32x4 (&acc)[2][2][4][2], const Unit& u, int wr, int wc, int fr, int fq) const {
        const int row0 = u.pm * BM + wr * 64 + fr, col0 = u.pn * BM + wc * 32 + 8 * fq;
#pragma unroll
        for (int ai = 0; ai < 2; ++ai)
#pragma unroll
            for (int m = 0; m < 4; ++m) { bf16_t* rowp = O + (size_t)(row0 + ai * HALF + m * 16) * ldc + col0;
#pragma unroll
                for (int bj = 0; bj < 2; ++bj) { const f32x4 v0 = acc[ai][bj][m][0], v1 = acc[ai][bj][m][1];
                    u32x4 w; w.x = cvt_pk_bf16(v0[0], v0[1]); w.y = cvt_pk_bf16(v0[2], v0[3]); w.z = cvt_pk_bf16(v1[0], v1[1]); w.w = cvt_pk_bf16(v1[2], v1[3]);
                    *(u32x4*)(rowp + bj * HALF) = w; } }
    }
};
__device__ __forceinline__ float gelu_tanh_f(float x) { const float y = 1.5957691216057308f * (x + 0.044715f * x * x * x); return x * fast_sigmoid(y); }
struct EpiProj {
    static constexpr bool PERM = true, AFTER_DRAIN = false;
    static constexpr int PN_V0 = 36;
    bf16_t* O; int ldc; float* sspart;
    __device__ __forceinline__ void operator()(const f32x4 (&acc)[2][2][4][2], const Unit& u, int wr, int wc, int fr, int fq) const {
        const int row0 = u.pm * BM + wr * 64 + fr, col0 = u.pn * BM + wc * 32 + 8 * fq;
        const bool vtile = (u.pn >= PN_V0) && (u.pn < PN_V0 + 8);
        if (!vtile) {
#pragma unroll
            for (int ai = 0; ai < 2; ++ai)
#pragma unroll
                for (int m = 0; m < 4; ++m) { bf16_t* rowp = O + (size_t)(row0 + ai * HALF + m * 16) * ldc + col0;
#pragma unroll
                    for (int bj = 0; bj < 2; ++bj) { const f32x4 v0 = acc[ai][bj][m][0], v1 = acc[ai][bj][m][1];
                        u32x4 w; w.x = cvt_pk_bf16(v0[0], v0[1]); w.y = cvt_pk_bf16(v0[2], v0[3]); w.z = cvt_pk_bf16(v1[0], v1[1]); w.w = cvt_pk_bf16(v1[2], v1[3]);
                        *(u32x4*)(rowp + bj * HALF) = w; } }
        } else {
#pragma unroll
            for (int ai = 0; ai < 2; ++ai)
#pragma unroll
                for (int m = 0; m < 4; ++m) { const int row = row0 + ai * HALF + m * 16; bf16_t* rowp = O + (size_t)row * ldc + col0; float ss = 0.f;
#pragma unroll
                    for (int bj = 0; bj < 2; ++bj) { f32x4 v0 = acc[ai][bj][m][0], v1 = acc[ai][bj][m][1];
#pragma unroll
                        for (int e = 0; e < 4; ++e) { v0[e] = gelu_tanh_f(v0[e]); v1[e] = gelu_tanh_f(v1[e]); ss += v0[e] * v0[e] + v1[e] * v1[e]; }
                        u32x4 w; w.x = cvt_pk_bf16(v0[0], v0[1]); w.y = cvt_pk_bf16(v0[2], v0[3]); w.z = cvt_pk_bf16(v1[0], v1[1]); w.w = cvt_pk_bf16(v1[2], v1[3]);
                        *(u32x4*)(rowp + bj * HALF) = w; }
                    ss = xor16_sum(ss); ss = xor32_sum(ss);
                    if (fq == 0) sspart[(size_t)row * 32 + (u.pn - PN_V0) * 4 + wc] = ss; }
        }
    }
};
template <bool ADD> struct EpiGate {
    static constexpr bool PERM = true, AFTER_DRAIN = false;
    bf16_t* O; int ldc; const bf16_t* Mg; int ldm; const bf16_t* Prev;
    __device__ __forceinline__ void operator()(const f32x4 (&acc)[2][2][4][2], const Unit& u, int wr, int wc, int fr, int fq) const {
        const int row0 = u.pm * BM + wr * 64 + fr, col0 = u.pn * BM + wc * 32 + 8 * fq;
#pragma unroll
        for (int ai = 0; ai < 2; ++ai)
#pragma unroll
            for (int m = 0; m < 4; ++m) { const size_t row = (size_t)(row0 + ai * HALF + m * 16);
#pragma unroll
                for (int bj = 0; bj < 2; ++bj) { const f32x4 v0 = acc[ai][bj][m][0], v1 = acc[ai][bj][m][1];
                    const u32x4 mg = *(const u32x4*)(Mg + row * ldm + col0 + bj * HALF);
                    float r[8];
                    r[0] = v0[0] * fast_sigmoid(bf_lo(mg.x)); r[1] = v0[1] * fast_sigmoid(bf_hi(mg.x)); r[2] = v0[2] * fast_sigmoid(bf_lo(mg.y)); r[3] = v0[3] * fast_sigmoid(bf_hi(mg.y));
                    r[4] = v1[0] * fast_sigmoid(bf_lo(mg.z)); r[5] = v1[1] * fast_sigmoid(bf_hi(mg.z)); r[6] = v1[2] * fast_sigmoid(bf_lo(mg.w)); r[7] = v1[3] * fast_sigmoid(bf_hi(mg.w));
                    if (ADD) { const u32x4 pv = *(const u32x4*)(Prev + row * ldc + col0 + bj * HALF);
                        r[0] += bf_lo(pv.x); r[1] += bf_hi(pv.x); r[2] += bf_lo(pv.y); r[3] += bf_hi(pv.y); r[4] += bf_lo(pv.z); r[5] += bf_hi(pv.z); r[6] += bf_lo(pv.w); r[7] += bf_hi(pv.w); }
                    u32x4 w; w.x = cvt_pk_bf16(r[0], r[1]); w.y = cvt_pk_bf16(r[2], r[3]); w.z = cvt_pk_bf16(r[4], r[5]); w.w = cvt_pk_bf16(r[6], r[7]);
                    *(u32x4*)(O + row * ldc + col0 + bj * HALF) = w; } }
    }
};
struct EpiMerge {
    static constexpr bool PERM = true, AFTER_DRAIN = false;
    bf16_t* O; int ldc; const bf16_t* Ma; const bf16_t* Mb; int ldm;
    __device__ __forceinline__ void mid(f32x4 (&acc)[2][2][4][2], const Unit& u, int wr, int wc, int fr, int fq) const {
        const int row0 = u.pm * BM + wr * 64 + fr, col0 = u.pn * BM + wc * 32 + 8 * fq;
#pragma unroll
        for (int ai = 0; ai < 2; ++ai) {
            u32x4 ga[8], gb[8];
#pragma unroll
            for (int m = 0; m < 4; ++m) { const size_t row = (size_t)(row0 + ai * HALF + m * 16);
#pragma unroll
                for (int bj = 0; bj < 2; ++bj) { ga[m * 2 + bj] = *(const u32x4*)(Ma + row * ldm + col0 + bj * HALF); gb[m * 2 + bj] = *(const u32x4*)(Mb + row * ldm + col0 + bj * HALF); } }
            __builtin_amdgcn_sched_barrier(0);
#pragma unroll
            for (int m = 0; m < 4; ++m)
#pragma unroll
                for (int bj = 0; bj < 2; ++bj) { const u32x4 a = ga[m * 2 + bj], b = gb[m * 2 + bj];
                    const unsigned aw[4] = {a.x, a.y, a.z, a.w}, bw[4] = {b.x, b.y, b.z, b.w};
#pragma unroll
                    for (int e = 0; e < 4; ++e) {
                        const float r0 = (1.0f + __builtin_amdgcn_exp2f(-1.4426950408889634f * bf_lo(bw[e]))) * __builtin_amdgcn_rcpf(1.0f + __builtin_amdgcn_exp2f(-1.4426950408889634f * bf_lo(aw[e])));
                        const float r1 = (1.0f + __builtin_amdgcn_exp2f(-1.4426950408889634f * bf_hi(bw[e]))) * __builtin_amdgcn_rcpf(1.0f + __builtin_amdgcn_exp2f(-1.4426950408889634f * bf_hi(aw[e])));
                        acc[ai][bj][m][e >> 1][(e & 1) * 2] *= r0; acc[ai][bj][m][e >> 1][(e & 1) * 2 + 1] *= r1; } }
            __builtin_amdgcn_sched_barrier(0);
        }
    }
    __device__ __forceinline__ void operator()(const f32x4 (&acc)[2][2][4][2], const Unit& u, int wr, int wc, int fr, int fq) const {
        const int row0 = u.pm * BM + wr * 64 + fr, col0 = u.pn * BM + wc * 32 + 8 * fq;
        u32x4 mgs[16];
#pragma unroll
        for (int ai = 0; ai < 2; ++ai)
#pragma unroll
            for (int m = 0; m < 4; ++m) { const size_t row = (size_t)(row0 + ai * HALF + m * 16);
#pragma unroll
                for (int bj = 0; bj < 2; ++bj) mgs[(ai * 4 + m) * 2 + bj] = *(const u32x4*)(Mb + row * ldm + col0 + bj * HALF); }
        __builtin_amdgcn_sched_barrier(0);
#pragma unroll
        for (int ai = 0; ai < 2; ++ai)
#pragma unroll
            for (int m = 0; m < 4; ++m) { const size_t row = (size_t)(row0 + ai * HALF + m * 16);
#pragma unroll
                for (int bj = 0; bj < 2; ++bj) { const f32x4 v0 = acc[ai][bj][m][0], v1 = acc[ai][bj][m][1];
                    const u32x4 mg = mgs[(ai * 4 + m) * 2 + bj];
                    u32x4 w; w.x = cvt_pk_bf16(v0[0] * fast_sigmoid(bf_lo(mg.x)), v0[1] * fast_sigmoid(bf_hi(mg.x))); w.y = cvt_pk_bf16(v0[2] * fast_sigmoid(bf_lo(mg.y)), v0[3] * fast_sigmoid(bf_hi(mg.y)));
                    w.z = cvt_pk_bf16(v1[0] * fast_sigmoid(bf_lo(mg.z)), v1[1] * fast_sigmoid(bf_hi(mg.z))); w.w = cvt_pk_bf16(v1[2] * fast_sigmoid(bf_lo(mg.w)), v1[3] * fast_sigmoid(bf_hi(mg.w)));
                    *(u32x4*)(O + row * ldc + col0 + bj * HALF) = w; } }
    }
};
struct EpiF32Plain {
    static constexpr bool PERM = false, AFTER_DRAIN = false;
    float* C; int ldc;
    __device__ __forceinline__ void operator()(const f32x4 (&acc)[2][2][4][2], const Unit& u, int wr, int wc, int fr, int fq) const {
        const int row0 = u.pm * BM + wr * 64 + fr, col0 = u.pn * BM + wc * 32 + 4 * fq;
#pragma unroll
        for (int ai = 0; ai < 2; ++ai)
#pragma unroll
            for (int m = 0; m < 4; ++m) { float* rowp = C + (size_t)(row0 + ai * HALF + m * 16) * ldc + col0;
#pragma unroll
                for (int bj = 0; bj < 2; ++bj)
#pragma unroll
                    for (int n = 0; n < 2; ++n) *(f32x4*)(rowp + bj * HALF + n * 16) = acc[ai][bj][m][n]; }
    }
};
struct ProjOrder : StaticOrder {
    int late, nearly, nlate;
    __host__ __device__ void init2(int M, int n_early, int n_late, int G_, int c_, int late_) { StaticOrder::init(M, n_early * BM, G_, c_); late = late_; nearly = n_early; nlate = n_late; }
    __host__ __device__ bool next(int i, Unit& u) const {
        if (!late) return StaticOrder::next(i, u);
        const long L = (long)i * G + c; if (L >= (long)nM * nlate) return false;
        u.pm = (int)(L % nM); u.pn = nearly + (int)(L / nM); u.sub = 0; return true;
    }
};
#ifndef PG8_SP2
#define PG8_SP2 true
#endif
#ifndef PG8_ALIGN
#define PG8_ALIGN true
#endif
template <class Epi, class Sched, bool STAMP = false, bool ALIGN_EPI = PG8_ALIGN, bool SP2 = PG8_SP2>
__device__ __forceinline__ void gemm_phase(PG8_LAS unsigned char* lds, const Gemm g, const Sched& S, const Epi& E, unsigned long long* stamps) {
    int tid_o = threadIdx.x; asm volatile("" : "+v"(tid_o));
    const int tid = tid_o, wid = __builtin_amdgcn_readfirstlane(tid >> 6), lane = tid & 63, wr = wid >> 2, wc = wid & 3, fr = lane & 15, fq = lane >> 4;
    const int K = g.K, nt = K / BK;
    int ts_lo = 0, ts_hi = 0, nts = 0; const unsigned long long rt_entry = STAMP ? (unsigned long long)wall_clock64() : 0ull;
#define PG8_STAMP() do { if (STAMP && wid == 0 && nts < 64) { const unsigned long long _c = (unsigned long long)clock64(); \
        ts_lo = (lane == nts) ? (int)(unsigned)_c : ts_lo; ts_hi = (lane == nts) ? (int)(unsigned)(_c >> 32) : ts_hi; ++nts; } } while (0)
    PG8_STAMP();
    unsigned voffA[2], voffB[2];
#pragma unroll
    for (int i = 0; i < 2; ++i) { int R, C; stage_rc(tid * 16 + i * 8192, R, C); const int Rb = Epi::PERM ? ((R & ~31) + perm32(R & 31)) : R;
        voffA[i] = (unsigned)(R * K + C) * 2u; voffB[i] = (unsigned)(Rb * K + C) * 2u; }
    const size_t kstep = (size_t)(BK * 2);
    const size_t hstep = (size_t)HALF * K * 2;
    const size_t tstep = 2 * hstep;
    const unsigned ldsw = (unsigned)wid * 1024u;
    const int aoff = lds_byte(wr * 64 + fr, fq * 8), boff = lds_byte(wc * 32 + fr, fq * 8);
#define PG8_SA(b, h) (((b) * 2 + (h)) * HTB)
#define PG8_SB(b, h) ((4 + (b) * 2 + (h)) * HTB)
#define PG8_STAGE(bufoff, gbase, voff) do { _Pragma("unroll") for (int _i = 0; _i < 2; ++_i) \
        __builtin_amdgcn_global_load_lds((const unsigned*)((const char*)(gbase) + (voff)[_i]), (PG8_LAS unsigned*)(lds + (bufoff) + ldsw + _i * 8192), 16, 0, 0); } while (0)
#define PG8_LDA(dst, b, h) do { _Pragma("unroll") for (int m = 0; m < 4; ++m) _Pragma("unroll") for (int k = 0; k < 2; ++k) dst[m][k] = *(const PG8_LAS bf16x8*)(lds + PG8_SA(b, h) + aoff + m * 2048 + k * 1024); } while (0)
#define PG8_LDB(dst, b, h) do { _Pragma("unroll") for (int n = 0; n < 2; ++n) _Pragma("unroll") for (int k = 0; k < 2; ++k) dst[n][k] = *(const PG8_LAS bf16x8*)(lds + PG8_SB(b, h) + boff + n * 2048 + k * 1024); } while (0)
#define PG8_MMA(ai, bj, At, Bt) do { __builtin_amdgcn_s_setprio(1); _Pragma("unroll") for (int m = 0; m < 4; ++m) _Pragma("unroll") for (int n = 0; n < 2; ++n) _Pragma("unroll") for (int k = 0; k < 2; ++k) \
        acc[ai][bj][m][n] = __builtin_amdgcn_mfma_f32_16x16x32_bf16(Bt[n][k], At[m][k], acc[ai][bj][m][n], 0, 0, 0); __builtin_amdgcn_s_setprio(0); } while (0)
#define PG8_WAIT_V(n) asm volatile("s_waitcnt vmcnt(" #n ")" ::: "memory")
#define PG8_WAIT_L(n) asm volatile("s_waitcnt lgkmcnt(" #n ")" ::: "memory")
#define PG8_BAR __builtin_amdgcn_s_barrier()
#define PG8_SCHED __builtin_amdgcn_sched_barrier(0)
    Unit cur, nxt; int ui = 0;
    if (!S.next(0, cur)) return;
    f32x4 acc[2][2][4][2];
#pragma unroll
    for (int a = 0; a < 2; ++a)
#pragma unroll
        for (int b = 0; b < 2; ++b)
#pragma unroll
            for (int m = 0; m < 4; ++m)
#pragma unroll
                for (int n = 0; n < 2; ++n) acc[a][b][m][n] = (f32x4){0.f, 0.f, 0.f, 0.f};
    bf16x8 At[4][2], B0[2][2], B1[2][2];
    const char* cA = (const char*)S.baseA(g, cur) + (size_t)cur.pm * tstep; const char* cB = (const char*)S.baseB(g, cur) + (size_t)cur.pn * tstep;
    S.a_ready(cur);
    if constexpr (SP2) {
        PG8_STAGE(PG8_SB(0, 0), cB, voffB); PG8_STAGE(PG8_SB(0, 1), cB + hstep, voffB); PG8_STAGE(PG8_SA(0, 0), cA, voffA); PG8_STAGE(PG8_SA(0, 1), cA + hstep, voffA);
        if (wr == 1) PG8_BAR;
        PG8_WAIT_V(2); PG8_BAR;
        PG8_STAGE(PG8_SB(1, 0), cB + kstep, voffB); PG8_STAGE(PG8_SA(1, 0), cA + kstep, voffA); PG8_STAGE(PG8_SB(1, 1), cB + hstep + kstep, voffB);
        PG8_WAIT_V(6); PG8_BAR;
    } else {
    PG8_STAGE(PG8_SB(0, 0), cB, voffB); PG8_STAGE(PG8_SA(0, 0), cA, voffA); PG8_STAGE(PG8_SB(0, 1), cB + hstep, voffB); PG8_STAGE(PG8_SA(0, 1), cA + hstep, voffA);
    if (wr == 1) PG8_BAR;
    PG8_WAIT_V(4); PG8_BAR;
    PG8_STAGE(PG8_SB(1, 0), cB + kstep, voffB); PG8_STAGE(PG8_SA(1, 0), cA + kstep, voffA); PG8_STAGE(PG8_SB(1, 1), cB + hstep + kstep, voffB);
    PG8_WAIT_V(6); PG8_BAR;
    }
    PG8_STAMP();
    for (;;) {
        const bool has_next = S.next(ui + 1, nxt);
        const char* nA = has_next ? (const char*)S.baseA(g, nxt) + (size_t)nxt.pm * tstep : cA; const char* nB = has_next ? (const char*)S.baseB(g, nxt) + (size_t)nxt.pn * tstep : cB;
        for (int t = 0; t < nt; t += 2) {
            const bool last = (t == nt - 2);
            const char* a1 = cA + (size_t)(t + 1) * kstep;
            const char* a2 = last ? nA : cA + (size_t)(t + 2) * kstep; const char* b2 = last ? nB : cB + (size_t)(t + 2) * kstep;
            const char* a3 = a2 + kstep; const char* b3 = b2 + kstep;
            if (last && has_next) S.a_ready(nxt);
            if constexpr (SP2) {
            PG8_LDB(B0, 0, 0); PG8_LDB(B1, 0, 1); PG8_SCHED; PG8_LDA(At, 0, 0); PG8_STAGE(PG8_SA(1, 1), a1 + hstep, voffA);
            PG8_WAIT_V(8); PG8_WAIT_L(0); PG8_BAR; PG8_MMA(0, 0, At, B0); PG8_MMA(0, 1, At, B1); PG8_BAR; PG8_SCHED;
            PG8_LDA(At, 0, 1); PG8_STAGE(PG8_SB(0, 0), b2, voffB); PG8_STAGE(PG8_SB(0, 1), b2 + hstep, voffB); PG8_STAGE(PG8_SA(0, 0), a2, voffA);
            PG8_WAIT_V(8); PG8_WAIT_L(0); PG8_BAR; PG8_MMA(1, 0, At, B0); PG8_MMA(1, 1, At, B1); PG8_BAR; PG8_SCHED;
            PG8_LDB(B0, 1, 0); PG8_LDB(B1, 1, 1); PG8_SCHED; PG8_LDA(At, 1, 0); PG8_STAGE(PG8_SA(0, 1), a2 + hstep, voffA);
            PG8_WAIT_V(8); PG8_WAIT_L(0); PG8_BAR; PG8_MMA(0, 0, At, B0); PG8_MMA(0, 1, At, B1); PG8_BAR; PG8_SCHED;
            PG8_LDA(At, 1, 1); PG8_STAGE(PG8_SB(1, 0), b3, voffB); PG8_STAGE(PG8_SB(1, 1), b3 + hstep, voffB); PG8_STAGE(PG8_SA(1, 0), a3, voffA);
            PG8_WAIT_V(8); PG8_WAIT_L(0); PG8_BAR; PG8_MMA(1, 0, At, B0); PG8_MMA(1, 1, At, B1); PG8_BAR; PG8_SCHED;
            } else {
            PG8_LDB(B0, 0, 0); PG8_SCHED; PG8_LDA(At, 0, 0); PG8_STAGE(PG8_SA(1, 1), a1 + hstep, voffA);
            PG8_WAIT_L(8); PG8_BAR; PG8_WAIT_L(0); PG8_MMA(0, 0, At, B0); PG8_BAR; PG8_SCHED;
            PG8_LDB(B1, 0, 1); PG8_STAGE(PG8_SB(0, 0), b2, voffB);
            PG8_BAR; PG8_WAIT_L(0); PG8_MMA(0, 1, At, B1); PG8_BAR;
            PG8_LDA(At, 0, 1); PG8_STAGE(PG8_SA(0, 0), a2, voffA);
            PG8_BAR; PG8_WAIT_L(0); PG8_MMA(1, 0, At, B0); PG8_BAR; PG8_SCHED;
            PG8_STAGE(PG8_SB(0, 1), b2 + hstep, voffB);
            PG8_WAIT_V(6); PG8_BAR; PG8_MMA(1, 1, At, B1); PG8_BAR;
            PG8_LDB(B0, 1, 0); PG8_SCHED; PG8_LDA(At, 1, 0); PG8_STAGE(PG8_SA(0, 1), a2 + hstep, voffA);
            PG8_WAIT_L(8); PG8_BAR; PG8_WAIT_L(0); PG8_MMA(0, 0, At, B0); PG8_BAR; PG8_SCHED;
            PG8_LDB(B1, 1, 1); PG8_STAGE(PG8_SB(1, 0), b3, voffB);
            PG8_BAR; PG8_WAIT_L(0); PG8_MMA(0, 1, At, B1); PG8_BAR;
            PG8_LDA(At, 1, 1); PG8_STAGE(PG8_SA(1, 0), a3, voffA);
            PG8_BAR; PG8_WAIT_L(0); PG8_MMA(1, 0, At, B0); PG8_BAR; PG8_SCHED;
            PG8_STAGE(PG8_SB(1, 1), b3 + hstep, voffB);
            PG8_WAIT_V(6); PG8_BAR; PG8_MMA(1, 1, At, B1); PG8_BAR;
                    }
        }
        PG8_STAMP();
        if constexpr (ALIGN_EPI) { if (wr == 0) PG8_BAR; }
        bool keep_acc = false;
        if constexpr (Sched::DUAL) { if (cur.sub == 0) { E.mid(acc, cur, wr, wc, fr, fq); keep_acc = true; } else E(acc, cur, wr, wc, fr, fq); }
        else if constexpr (!Epi::AFTER_DRAIN) { E(acc, cur, wr, wc, fr, fq); S.done(cur); }
        PG8_STAMP();
        if (!has_next) break;
        if (!keep_acc)
#pragma unroll
        for (int a = 0; a < 2; ++a)
#pragma unroll
            for (int b = 0; b < 2; ++b)
#pragma unroll
                for (int m = 0; m < 4; ++m)
#pragma unroll
                    for (int n = 0; n < 2; ++n) acc[a][b][m][n] = (f32x4){0.f, 0.f, 0.f, 0.f};
        cur = nxt; cA = nA; cB = nB; ++ui;
        if constexpr (ALIGN_EPI) { if (wr == 1) PG8_BAR; }
    }
    PG8_WAIT_V(0);
    if constexpr (!ALIGN_EPI) { if (wr == 0) PG8_BAR; }
    PG8_BAR;
    if constexpr (Epi::AFTER_DRAIN) { E.fused(acc, cur, wr, wc, fr, fq, lds, wid, lane); S.done(cur); }
    PG8_STAMP();
    if (STAMP && wid == 0) { stamps[lane] = lane < nts ? (((unsigned long long)(unsigned)ts_hi << 32) | (unsigned)ts_lo) : 0ull;
        if (lane == 62) stamps[62] = rt_entry; if (lane == 63) stamps[63] = (unsigned long long)wall_clock64(); }
#undef PG8_STAMP
#undef PG8_SA
#undef PG8_SB
#undef PG8_STAGE
#undef PG8_LDA
#undef PG8_LDB
#undef PG8_MMA
#undef PG8_WAIT_V
#undef PG8_WAIT_L
#undef PG8_BAR
#undef PG8_SCHED
}
}

#define XB_TMO      128
#define XB_XCNT(j)  (256  + 64 * (j))
#define XB_XSUB(j)  (1280 + 64 * (j))
#define XB_XGEN(j)  (2304 + 64 * (j))
#define XB_TOP      3328
#define XB_TOPGEN   3392
#define XCD_BAR_WORDS 3456
#define XB_SPIN_CAP (1u << 18)
#define LAS __attribute__((address_space(3)))

__device__ __forceinline__ unsigned xb_ld(unsigned* p)              { return __hip_atomic_load(p, __ATOMIC_RELAXED, __HIP_MEMORY_SCOPE_AGENT); }
__device__ __forceinline__ unsigned xb_add(unsigned* p, unsigned v) { return __hip_atomic_fetch_add(p, v, __ATOMIC_RELAXED, __HIP_MEMORY_SCOPE_AGENT); }
__device__ __forceinline__ unsigned xb_xcc_id() { return (unsigned)__builtin_amdgcn_s_getreg((3 << 11) | 20) & 0xFu; }
#define XB_SPIN(cond, bar) do { unsigned _sp = 0; while (cond) { __builtin_amdgcn_s_sleep(1); \
    if ((++_sp & 255u) == 0u) { if (xb_ld(&(bar)[XB_TMO])) break; if (_sp > XB_SPIN_CAP) { atomicAdd(&(bar)[XB_TMO], 1u); break; } } } } while (0)

struct XcdBarrier {
    unsigned* bar; unsigned x;
    volatile LAS unsigned* st;
};

__device__ __forceinline__ XcdBarrier xcd_barrier_post(unsigned* bar, volatile LAS unsigned* st) {
    XcdBarrier b; b.bar = bar; b.x = xb_xcc_id(); b.st = st;
    if (threadIdx.x == 0) (void)xb_add(&bar[XB_XCNT(b.x)], 1u);
    return b;
}
__device__ __forceinline__ void xcd_barrier_complete(unsigned* bar, unsigned x, unsigned& nloc, unsigned& nx) {
    const unsigned G = gridDim.x * gridDim.y * gridDim.z;
    unsigned sum, cnt, mine, sp = 0u;
    for (;;) {
        sum = 0u; cnt = 0u; mine = 0u;
#pragma unroll
        for (unsigned j = 0; j < 16; ++j) { const unsigned c = xb_ld(&bar[XB_XCNT(j)]); sum += c; cnt += (c > 0u) ? 1u : 0u; mine = (j == x) ? c : mine; }
        if (sum == G) break;
        __builtin_amdgcn_s_sleep(1);
        if ((++sp & 255u) == 0u) { if (xb_ld(&bar[XB_TMO])) break; if (sp > XB_SPIN_CAP) { atomicAdd(&bar[XB_TMO], 1u); break; } }
    }
    nloc = mine > 0u ? mine : 1u; nx = cnt > 0u ? cnt : 1u;
}

__device__ __forceinline__ void xcd_barrier(const XcdBarrier& b) {
    asm volatile("s_waitcnt vmcnt(0)" ::: "memory");
    __syncthreads();
    if (threadIdx.x == 0) {
        unsigned* bar = b.bar;
        __builtin_amdgcn_s_waitcnt(0);
        unsigned nloc = b.st[0], nx = b.st[1];
        if (nloc == 0u) { xcd_barrier_complete(bar, b.x, nloc, nx); b.st[0] = nloc; b.st[1] = nx; }
        const unsigned old = xb_add(&bar[XB_XSUB(b.x)], 1u);
        const unsigned gen = old / nloc;
        if (old + 1u == (gen + 1u) * nloc) {
            __builtin_amdgcn_fence(__ATOMIC_RELEASE, "agent");
            asm volatile("s_waitcnt vmcnt(0)" ::: "memory");
            const unsigned og = xb_add(&bar[XB_TOP], 1u);
            const unsigned tg = og / nx;
            if (og + 1u == (tg + 1u) * nx) xb_add(&bar[XB_TOPGEN], 1u);
            else XB_SPIN(xb_ld(&bar[XB_TOPGEN]) == tg, bar);
            __builtin_amdgcn_fence(__ATOMIC_ACQUIRE, "agent");
            xb_add(&bar[XB_XGEN(b.x)], 1u);
            asm volatile("s_waitcnt vmcnt(0)" ::: "memory");
        } else {
            XB_SPIN(xb_ld(&bar[XB_XGEN(b.x)]) == gen, bar);
            __builtin_amdgcn_fence(__ATOMIC_ACQUIRE, "agent");
            asm volatile("s_waitcnt vmcnt(0)" ::: "memory");
        }
    }
    __syncthreads();
}
typedef pg8::bf16_t bf16_t;
typedef short bf16x8 __attribute__((ext_vector_type(8)));
typedef short s16x4 __attribute__((ext_vector_type(4)));
typedef float f32x4 __attribute__((ext_vector_type(4)));
typedef float f32x16 __attribute__((ext_vector_type(16)));
typedef unsigned u32x4 __attribute__((ext_vector_type(4)));
typedef unsigned u32x2 __attribute__((ext_vector_type(2)));
constexpr int T = 8192, DM = 4096, NIN = 21552, NP = 21760, DEPTH = 2, NWAVES = 8, NTHREADS = 512;
constexpr int C_Q = 0, C_KV = 2048, C_ZA = 5120, C_UB = 7168, C_VB = 9216, C_ZB = 11264, C_MA = 13312, C_MB = 17408, C_GA = 21504;
constexpr int AW = 2048, BW = 2048, HD = 128, NCMP = 511, NCP = 512;
constexpr float NORM_EPS = 1e-6f;
constexpr size_t al256(size_t x) { return (x + 255) & ~(size_t)255; }
constexpr size_t WS_CTL = 0, CTL_BYTES = 1u << 20;
constexpr size_t SZ_WIN = (size_t)NP * DM * 2, SZ_WAB = (size_t)DM * AW * 2, SZ_WO = (size_t)DM * DM * 2, SZ_W1 = (size_t)HD * 4096 * 2, SZ_W2 = (size_t)HD * HD * 2;
constexpr size_t WS_WIN = WS_CTL + CTL_BYTES;
constexpr size_t WS_WA = WS_WIN + DEPTH * SZ_WIN;
constexpr size_t WS_WB = WS_WA + DEPTH * SZ_WAB;
constexpr size_t WS_WO = WS_WB + DEPTH * SZ_WAB;
constexpr size_t WS_W1 = WS_WO + DEPTH * SZ_WO;
constexpr size_t WS_W2 = WS_W1 + DEPTH * 2 * SZ_W1;
constexpr size_t WS_H = al256(WS_W2 + DEPTH * 2 * SZ_W2);
constexpr size_t WS_PROJ = WS_H + (size_t)T * DM * 2;
constexpr size_t WS_KC = WS_PROJ + (size_t)T * NP * 2;
constexpr size_t WS_VC = WS_KC + (size_t)NCP * 512 * 2;
constexpr size_t WS_OA = WS_VC + (size_t)NCP * 512 * 2;
constexpr size_t WS_OB = WS_OA + (size_t)T * AW * 2;
constexpr size_t WS_T1 = WS_OB + (size_t)T * BW * 2;
constexpr size_t WS_MG = WS_T1 + (size_t)T * DM * 2;
constexpr size_t WS_Y = WS_MG + (size_t)T * DM * 2;
constexpr size_t WS_X1 = WS_Y + (size_t)T * DM * 4;
constexpr size_t WS_SS = WS_X1 + (size_t)T * DM * 4;
constexpr size_t WS_PARK = WS_SS + (size_t)T * 32 * 4;
constexpr size_t WS_END = WS_PARK + (size_t)1024 * 32 * 512 * 16;
constexpr int LDS_STAGE = 0;
constexpr int LDS_BIAS = 131072;
constexpr int LDS_MISC = LDS_BIAS + 16 * 256 * 4;
constexpr int LDS_RS = LDS_MISC + 64;
constexpr int LDS_ATT = LDS_RS + 512;
constexpr int LDS_BYTES = LDS_ATT + 8192;
static_assert(LDS_BYTES <= 160 * 1024, "LDS");
#define LAS3 __attribute__((address_space(3)))
#define LDS_WAIT() asm volatile("s_waitcnt lgkmcnt(0)" ::: "memory")
#define VM_WAIT() asm volatile("s_waitcnt vmcnt(0)" ::: "memory")

struct Params {
    const float *x, *rel_bias, *pre_norm, *w_in, *pe_k, *w1_k, *w2_k, *pe_v, *w1_v, *w2_v, *w_out_a, *sgu_norm, *sgu_w, *sgu_b, *w_out_b, *w_out, *post_norm;
    float* out; unsigned char* ws; int ph_lo, ph_hi;
};
__device__ __forceinline__ unsigned pk2(float lo, float hi) { return pg8::cvt_pk_bf16(lo, hi); }
__device__ __forceinline__ float wave_sum(float v) {
    v += dpp_f<0xB1>(v); v += dpp_f<0x4E>(v); v += dpp_f<0x141>(v); v += dpp_f<0x140>(v);
    v = xor16_sum(v); v = xor32_sum(v);
    return v;
}
__device__ const unsigned char BUCKET[128] = {0, 1, 2, 3, 4, 5, 6, 7, 8, 9, 10, 11, 12, 13, 14, 15, 16, 16, 16, 17, 17, 18, 18, 18, 19, 19, 19, 20, 20, 20, 20, 21, 21, 21, 21, 22, 22, 22, 22, 22, 23, 23, 23, 23, 23, 23, 24, 24, 24, 24, 24, 24, 25, 25, 25, 25, 25, 25, 25, 26, 26, 26, 26, 26, 26, 26, 26, 27, 27, 27, 27, 27, 27, 27, 27, 27, 27, 28, 28, 28, 28, 28, 28, 28, 28, 28, 28, 29, 29, 29, 29, 29, 29, 29, 29, 29, 29, 29, 29, 30, 30, 30, 30, 30, 30, 30, 30, 30, 30, 30, 30, 30, 30, 31, 31, 31, 31, 31, 31, 31, 31, 31, 31, 31, 31, 31, 31, 31};

constexpr int W_ITEMS_PER_LAYER = 64 * (NP / 64) + 2 * 32 * 64 + 64 * 64 + 2 * 64 * 2 + 2 * 2 * 2;
constexpr int W_ITEMS = DEPTH * W_ITEMS_PER_LAYER;
constexpr int W_TAIL_ITEMS = 0;
__device__ __forceinline__ int srcmap_in(int n) { return n < 5120 ? n : (n < 21504 ? n + 48 : (n < 21552 ? n - 21504 + 5120 : -1)); }
template <int MODE>
__device__ __forceinline__ void transpose_item(const float* __restrict__ W, int K, int N, bf16_t* __restrict__ WT, LAS3 float* scr, int item, int nblk, int lane) {
    int kb, nb;
    if ((nblk & 3) == 0) { const int g8 = item >> 3, sub = item & 7, q = nblk >> 2; const int gk = g8 / q, gn = g8 - gk * q; nb = gn * 4 + (sub & 3); kb = gk * 2 + (sub >> 2); }
    else { kb = item / nblk; nb = item - kb * nblk; }
    const int k0 = 64 * kb, n0 = 64 * nb;
    const int nn = n0 + 4 * (lane & 15); const int s = (MODE == 1) ? srcmap_in(nn) : nn;
    const float* src = W + (size_t)(k0 + (lane >> 4)) * N + (s >= 0 ? s : 0);
    f32x4 v[16];
#pragma unroll
    for (int i = 0; i < 16; ++i) v[i] = *(const f32x4*)(src + (size_t)(4 * i) * N);
    __builtin_amdgcn_sched_barrier(0);
#pragma unroll
    for (int i = 0; i < 16; ++i) { f32x4 x = v[i]; if (s < 0) x = (f32x4){0.f, 0.f, 0.f, 0.f};
        LAS3 float* d = scr + (4 * i + (lane >> 4)) * 65 + 4 * (lane & 15); d[0] = x[0]; d[1] = x[1]; d[2] = x[2]; d[3] = x[3]; }
    LDS_WAIT();
    const int c = lane & 7;
#pragma unroll
    for (int j = 0; j < 8; ++j) { const int n = (lane >> 3) + 8 * j; const LAS3 float* p = scr + (8 * c) * 65 + n;
        u32x4 o; o.x = pk2(p[0 * 65], p[1 * 65]); o.y = pk2(p[2 * 65], p[3 * 65]); o.z = pk2(p[4 * 65], p[5 * 65]); o.w = pk2(p[6 * 65], p[7 * 65]);
        if (MODE == 2) { const int k8 = (k0 >> 3) + c, na = n0 + n; *(u32x4*)(WT + (size_t)((((k8 >> 1) * (N >> 5) + (na >> 5)) * 64) + (k8 & 1) * 32 + (na & 31)) * 8) = o; }
        else *(u32x4*)(WT + (size_t)(n0 + n) * K + k0 + 8 * c) = o; }
    LDS_WAIT();
}
__device__ __forceinline__ void phase_weights(const Params& P, LAS3 unsigned char* lds, int gw, int NGW, int wave, int lane, int it_lo, int it_hi) {
    asm volatile("" : "+v"(lane));
    LAS3 float* scr = (LAS3 float*)(lds + LDS_STAGE + wave * 16640);
    constexpr int I_IN = 64 * (NP / 64), I_AB = 32 * 64, I_O = 64 * 64, I_W1 = 64 * 2, I_W2 = 2 * 2;
    constexpr int PER_LAYER = I_IN + 2 * I_AB + I_O + 2 * I_W1 + 2 * I_W2;
    static_assert(PER_LAYER == W_ITEMS_PER_LAYER, "item count");
    for (int it = it_lo + gw; it < it_hi; it += NGW) {
        const int L = it / PER_LAYER; int r = it - L * PER_LAYER;
        unsigned char* ws = P.ws;
        if (r < I_IN) { transpose_item<1>(P.w_in + (size_t)L * DM * NIN, DM, NIN, (bf16_t*)(ws + WS_WIN + L * SZ_WIN), scr, r, NP / 64, lane); continue; } r -= I_IN;
        if (r < I_AB) { transpose_item<0>(P.w_out_a + (size_t)L * AW * DM, AW, DM, (bf16_t*)(ws + WS_WA + L * SZ_WAB), scr, r, 64, lane); continue; } r -= I_AB;
        if (r < I_AB) { transpose_item<0>(P.w_out_b + (size_t)L * BW * DM, BW, DM, (bf16_t*)(ws + WS_WB + L * SZ_WAB), scr, r, 64, lane); continue; } r -= I_AB;
        if (r < I_O) { transpose_item<0>(P.w_out + (size_t)L * DM * DM, DM, DM, (bf16_t*)(ws + WS_WO + L * SZ_WO), scr, r, 64, lane); continue; } r -= I_O;
        if (r < I_W1) { transpose_item<2>(P.w1_k + (size_t)L * 4096 * HD, 4096, HD, (bf16_t*)(ws + WS_W1 + (L * 2 + 0) * SZ_W1), scr, r, 2, lane); continue; } r -= I_W1;
        if (r < I_W1) { transpose_item<2>(P.w1_v + (size_t)L * 4096 * HD, 4096, HD, (bf16_t*)(ws + WS_W1 + (L * 2 + 1) * SZ_W1), scr, r, 2, lane); continue; } r -= I_W1;
        if (r < I_W2) { transpose_item<0>(P.w2_k + (size_t)L * HD * HD, HD, HD, (bf16_t*)(ws + WS_W2 + (L * 2 + 0) * SZ_W2), scr, r, 2, lane); continue; } r -= I_W2;
        transpose_item<0>(P.w2_v + (size_t)L * HD * HD, HD, HD, (bf16_t*)(ws + WS_W2 + (L * 2 + 1) * SZ_W2), scr, r, 2, lane);
    }
}
__device__ __forceinline__ void phase_prenorm(const float* __restrict__ x, const float* __restrict__ g, bf16_t* __restrict__ h, int gw, int NGW, int lane) {
    asm volatile("" : "+v"(lane));
#pragma unroll 1
    for (int m = gw; m < T; m += 2 * NGW) {
        const bool two = (m + NGW) < T; const int m2 = two ? m + NGW : m;
        const f32x4* xa = (const f32x4*)(x + (size_t)m * DM) + lane; const f32x4* xb = (const f32x4*)(x + (size_t)m2 * DM) + lane;
        f32x4 va[16], vb[16];
#pragma unroll
        for (int j = 0; j < 16; ++j) va[j] = xa[64 * j];
#pragma unroll
        for (int j = 0; j < 16; ++j) vb[j] = xb[64 * j];
        __builtin_amdgcn_sched_barrier(0);
        float sa = 0.f, sb = 0.f;
#pragma unroll
        for (int j = 0; j < 16; ++j) { sa += (va[j][0] * va[j][0] + va[j][1] * va[j][1]) + (va[j][2] * va[j][2] + va[j][3] * va[j][3]); sb += (vb[j][0] * vb[j][0] + vb[j][1] * vb[j][1]) + (vb[j][2] * vb[j][2] + vb[j][3] * vb[j][3]); }
        const float ra = 1.0f / sqrtf(wave_sum(sa) * (1.0f / DM) + NORM_EPS), rb = 1.0f / sqrtf(wave_sum(sb) * (1.0f / DM) + NORM_EPS);
        const f32x4* gr = (const f32x4*)g + lane;
        u32x2* oa = (u32x2*)(h + (size_t)m * DM) + lane; u32x2* ob = (u32x2*)(h + (size_t)m2 * DM) + lane;
#pragma unroll
        for (int j = 0; j < 16; ++j) { const f32x4 gg = gr[64 * j]; u32x2 w; w.x = pk2(va[j][0] * ra * gg[0], va[j][1] * ra * gg[1]); w.y = pk2(va[j][2] * ra * gg[2], va[j][3] * ra * gg[3]); oa[64 * j] = w;
            if (two) { u32x2 w2; w2.x = pk2(vb[j][0] * rb * gg[0], vb[j][1] * rb * gg[1]); w2.y = pk2(vb[j][2] * rb * gg[2], vb[j][3] * rb * gg[3]); ob[64 * j] = w2; } }
    }
}
template <bool XOLD_BF16, bool XNEW_BF16>
__device__ __forceinline__ void phase_postnorm(const bf16_t* __restrict__ Y, const void* __restrict__ xold, const float* __restrict__ gpost, void* __restrict__ xnew,
                                               const float* __restrict__ gpre, bf16_t* __restrict__ h, bool next, int gw, int NGW, int lane_) {
#pragma unroll 1
    for (int m = gw; m < T; m += NGW) {
        int lane = lane_; asm volatile("" : "+v"(lane));
        const u32x2* yr = (const u32x2*)(Y + (size_t)m * DM) + lane;
        u32x2 yw[16]; f32x4 xx[16]; u32x2 xw[16]; f32x4 gp[16];
#pragma unroll
        for (int j = 0; j < 16; ++j) yw[j] = yr[64 * j];
        if (XOLD_BF16) {
#pragma unroll
            for (int j = 0; j < 16; ++j) xw[j] = ((const u32x2*)((const bf16_t*)xold + (size_t)m * DM) + lane)[64 * j];
        } else {
#pragma unroll
            for (int j = 0; j < 16; ++j) xx[j] = ((const f32x4*)((const float*)xold + (size_t)m * DM) + lane)[64 * j];
        }
#pragma unroll
        for (int j = 0; j < 16; ++j) gp[j] = ((const f32x4*)gpost + lane)[64 * j];
        __builtin_amdgcn_sched_barrier(0);
        f32x4 v[16]; float ss = 0.f;
#pragma unroll
        for (int j = 0; j < 16; ++j) { const u32x2 w = yw[j]; v[j] = (f32x4){pg8::bf_lo(w.x), pg8::bf_hi(w.x), pg8::bf_lo(w.y), pg8::bf_hi(w.y)}; ss += (v[j][0] * v[j][0] + v[j][1] * v[j][1]) + (v[j][2] * v[j][2] + v[j][3] * v[j][3]); }
        const float rs = 1.0f / sqrtf(wave_sum(ss) * (1.0f / DM) + NORM_EPS);
        float s2 = 0.f;
#pragma unroll
        for (int j = 0; j < 16; ++j) { f32x4 xo;
            if (XOLD_BF16) { const u32x2 w = xw[j]; xo = (f32x4){pg8::bf_lo(w.x), pg8::bf_hi(w.x), pg8::bf_lo(w.y), pg8::bf_hi(w.y)}; } else xo = xx[j];
            const f32x4 r = xo + v[j] * rs * gp[j]; v[j] = r;
            if (XNEW_BF16) { u32x2 w; w.x = pk2(r[0], r[1]); w.y = pk2(r[2], r[3]); ((u32x2*)((bf16_t*)xnew + (size_t)m * DM) + lane)[64 * j] = w; }
            else ((f32x4*)((float*)xnew + (size_t)m * DM) + lane)[64 * j] = r;
            s2 += (r[0] * r[0] + r[1] * r[1]) + (r[2] * r[2] + r[3] * r[3]); }
        if (next) {
            f32x4 g2[16];
#pragma unroll
            for (int j = 0; j < 16; ++j) g2[j] = ((const f32x4*)gpre + lane)[64 * j];
            __builtin_amdgcn_sched_barrier(0);
            const float rs2 = 1.0f / sqrtf(wave_sum(s2) * (1.0f / DM) + NORM_EPS);
            u32x2* o = (u32x2*)(h + (size_t)m * DM) + lane;
#pragma unroll
            for (int j = 0; j < 16; ++j) { const f32x4 gg = g2[j]; u32x2 w; w.x = pk2(v[j][0] * rs2 * gg[0], v[j][1] * rs2 * gg[1]); w.y = pk2(v[j][2] * rs2 * gg[2], v[j][3] * rs2 * gg[3]); o[64 * j] = w; }
        }
    }
}
namespace att {
constexpr float SCALE = 0.08838834764831845f, LOG2E = 1.4426950408889634f, C2 = SCALE * LOG2E;
constexpr int SHM = 16384;
constexpr int NSLOT = 3;
constexpr int L_V = 0, L_K = NSLOT * SHM, L_IMP = 2 * NSLOT * SHM, L_SEL = LDS_ATT, L_WS = L_SEL + 1024, L_SC = L_WS + 2048, L_END = L_SC + 4096;
static_assert(L_IMP + 32768 <= 131072 && L_END <= LDS_ATT + 8192, "attention LDS");
#define KSWZ(row, colB) ((row) * 256 + ((colB) ^ (((row) & 7) << 4)))
#define SBAR() __builtin_amdgcn_sched_barrier(0)
__device__ __forceinline__ int v_st(int k, int c) { const int kk = (k & ~0xC) | ((k & 4) << 1) | ((k & 8) >> 1); return ((kk >> 3) * 4 + (c >> 5)) * 512 + ((kk & 7) * 32 + (c & 31)) * 2; }
__device__ __forceinline__ int v_rd_base(int lane) { return ((lane & 3) << 3) | (((lane >> 2) & 3) << 6) | (((lane >> 4) & 1) << 5) | (((lane >> 5) & 1) << 8); }
constexpr int v_rd_off(int d0, int ks, int half) { return d0 * 512 + ks * 4096 + half * 2048; }
__device__ __forceinline__ int crow(int r, int hi) { return (r & 3) + 8 * (r >> 2) + 4 * hi; }
__device__ __forceinline__ unsigned cvtpk(float lo, float hi) { return pg8::cvt_pk_bf16(lo, hi); }
enum { MODE_STAT = 0, MODE_IMP = 1, MODE_ONLINE = 2, MODE_ACC = 3, MODE_IMPACC = 4 };
#ifndef PP_STAT
#define PP_STAT false
#endif
#ifndef PP_ACC
#define PP_ACC false
#endif

struct Ctx {
    bf16x8 qr[8]; f32x16 o[4];
    int tq, r32, hi, wid, lane, tid, t0;
    const LAS3 float* tb; float bfar;
    LAS3 char* lds;
};
__device__ __forceinline__ void qkt(f32x16& p0, f32x16& p1, const LAS3 char* Kt, int r32, int hi, const bf16x8* qr) {
    p0 = f32x16{}; p1 = f32x16{};
    const LAS3 char* kb[4];
#pragma unroll
    for (int dd = 0; dd < 4; ++dd) kb[dd] = Kt + KSWZ(r32, (dd * 16 + hi * 8) * 2);
#pragma unroll
    for (int d0 = 0; d0 < 8; ++d0) { const LAS3 char* a = kb[d0 & 3] + (d0 >> 2) * 128;
        const bf16x8 b0 = *reinterpret_cast<const LAS3 bf16x8*>(a);
        const bf16x8 b1 = *reinterpret_cast<const LAS3 bf16x8*>(a + 32 * 256);
        p0 = __builtin_amdgcn_mfma_f32_32x32x16_bf16(b0, qr[d0], p0, 0, 0, 0);
        p1 = __builtin_amdgcn_mfma_f32_32x32x16_bf16(b1, qr[d0], p1, 0, 0, 0);
        if ((d0 & 3) == 3) SBAR(); }
}
__device__ __forceinline__ void pv_tile(f32x16* o, int vb0, bf16x8 pa0, bf16x8 pa1, bf16x8 pa2, bf16x8 pa3) {
#define TRRD(dst, off) asm volatile("ds_read_b64_tr_b16 %0, %1 offset:%2" : "=&v"(dst) : "v"(vb0), "i"(off) : "memory")
#define PV_KS(ks, PA) do { s16x4 l0, l1, l2, l3, h0, h1, h2, h3; constexpr int b_ = v_rd_off(0, ks, 0); \
        TRRD(l0, b_); TRRD(h0, b_ + 2048); TRRD(l1, b_ + 512); TRRD(h1, b_ + 512 + 2048); TRRD(l2, b_ + 1024); TRRD(h2, b_ + 1024 + 2048); TRRD(l3, b_ + 1536); TRRD(h3, b_ + 1536 + 2048); \
        asm volatile("s_waitcnt lgkmcnt(0)" ::: "memory"); SBAR(); \
        o[0] = __builtin_amdgcn_mfma_f32_32x32x16_bf16(PA, (bf16x8){l0[0], l0[1], l0[2], l0[3], h0[0], h0[1], h0[2], h0[3]}, o[0], 0, 0, 0); \
        o[1] = __builtin_amdgcn_mfma_f32_32x32x16_bf16(PA, (bf16x8){l1[0], l1[1], l1[2], l1[3], h1[0], h1[1], h1[2], h1[3]}, o[1], 0, 0, 0); \
        o[2] = __builtin_amdgcn_mfma_f32_32x32x16_bf16(PA, (bf16x8){l2[0], l2[1], l2[2], l2[3], h2[0], h2[1], h2[2], h2[3]}, o[2], 0, 0, 0); \
        o[3] = __builtin_amdgcn_mfma_f32_32x32x16_bf16(PA, (bf16x8){l3[0], l3[1], l3[2], l3[3], h3[0], h3[1], h3[2], h3[3]}, o[3], 0, 0, 0); } while (0)
    PV_KS(0, pa0); PV_KS(1, pa1); PV_KS(2, pa2); PV_KS(3, pa3);
#undef PV_KS
#undef TRRD
}
__device__ __forceinline__ void pack_p(const f32x16& p0, const f32x16& p1, bf16x8& pa0, bf16x8& pa1, bf16x8& pa2, bf16x8& pa3) {
#define PK4(P, B_, OUT) do { u32x4 w = {cvtpk(P[B_+0], P[B_+1]), cvtpk(P[B_+2], P[B_+3]), cvtpk(P[B_+4], P[B_+5]), cvtpk(P[B_+6], P[B_+7])}; OUT = *reinterpret_cast<bf16x8*>(&w); } while (0)
    PK4(p0, 0, pa0); PK4(p0, 8, pa1); PK4(p1, 0, pa2); PK4(p1, 8, pa3);
#undef PK4
}
__device__ __forceinline__ float half_max(float v) { auto rr = __builtin_amdgcn_permlane32_swap(__float_as_uint(v), __float_as_uint(v), false, false); return fmaxf(__uint_as_float(rr[0]), __uint_as_float(rr[1])); }
__device__ __forceinline__ float half_sum(float v) { auto rr = __builtin_amdgcn_permlane32_swap(__float_as_uint(v), __float_as_uint(v), false, false); return __uint_as_float(rr[0]) + __uint_as_float(rr[1]); }

template <int MODE, int STEP, int OFF, bool ROWSEL, bool PP>
__device__ __forceinline__ void run_pass(Ctx& c, const bf16_t* __restrict__ Kg, const bf16_t* __restrict__ Vg, const int ldk, const int j_lo, const int j_hi, const unsigned W,
                                         float& m_reg, float& l_reg, const float pscale, unsigned sm0, unsigned sm1, unsigned sm2, unsigned sm3, const float gate = 1.f, const bool rev = false) {
    constexpr bool HASV = (MODE == MODE_ONLINE || MODE == MODE_ACC || MODE == MODE_IMPACC), RUNMAX = (MODE == MODE_ONLINE || MODE == MODE_STAT);
    int tid = c.tid, r32 = c.r32, hi = c.hi, lane = c.lane;
    asm volatile("" : "+v"(tid), "+v"(r32), "+v"(hi), "+v"(lane));
    const int n = j_hi - j_lo + 1;
    if (n <= 0) return;
    LAS3 char* V_lds = c.lds + L_V; LAS3 char* K_lds = c.lds + L_K;
    LAS3 float* al_l = (LAS3 float*)(c.lds + L_WS) + c.wid * 64 + 32;
    const int krow = tid >> 4;
    const unsigned ko0 = (unsigned)(krow * ldk + (((tid & 15) ^ (krow & 7)) * 8)) * 2u;
    const int vkk = ((tid >> 7) * 8) + ((tid & 31) >> 2), vkey = vkk, vcol = ((tid >> 5) & 3) * 32 + (tid & 3) * 8;
    const unsigned vo0 = (unsigned)(vkey * ldk + vcol) * 2u;
    const unsigned half_step = (unsigned)(32 * ldk) * 2u;
    const int vbase = (int)(uintptr_t)V_lds + v_rd_base(lane);
#define LOADT(j, bf) do { const char* kp_ = (const char*)(Kg + (size_t)((j) * 64) * ldk); LAS3 char* kd_ = K_lds + (bf) * SHM + c.wid * 1024; \
        __builtin_amdgcn_global_load_lds((const unsigned*)(kp_ + ko0), (LAS3 unsigned*)kd_, 16, 0, 0); \
        __builtin_amdgcn_global_load_lds((const unsigned*)((kp_ + half_step) + ko0), (LAS3 unsigned*)(kd_ + 8192), 16, 0, 0); \
        if (HASV) { const char* vp_ = (const char*)(Vg + (size_t)((j) * 64) * ldk); LAS3 char* vd_ = V_lds + (bf) * SHM + c.wid * 1024; \
            __builtin_amdgcn_global_load_lds((const unsigned*)(vp_ + vo0), (LAS3 unsigned*)vd_, 16, 0, 0); \
            __builtin_amdgcn_global_load_lds((const unsigned*)((vp_ + half_step) + vo0), (LAS3 unsigned*)(vd_ + 8192), 16, 0, 0); } } while (0)
#define WAIT_OLDER(younger) do { if (younger) { if (HASV) asm volatile("s_waitcnt vmcnt(4)" ::: "memory"); else asm volatile("s_waitcnt vmcnt(2)" ::: "memory"); } else VM_WAIT(); } while (0)
#define STEP_END(oddstep, ldt) do { if (oddstep) WAIT_OLDER(ldt); LDS_WAIT(); __builtin_amdgcn_s_barrier(); asm volatile("" ::: "memory"); } while (0)
#define TJ(t_) (rev ? j_hi - (t_) : j_lo + (t_))
    LOADT(TJ(0), 0); if (n > 1) LOADT(TJ(1), 1);
    WAIT_OLDER(n > 1);
    __builtin_amdgcn_s_barrier(); asm volatile("" ::: "memory");
    const int role = PP ? (c.wid >> 2) : 0, tqw = c.t0 + 8 * c.wid;
    const float NEG = -__builtin_inff();
    const float lp = RUNMAX ? 0.f : __builtin_amdgcn_logf(pscale);
    if (PP && role == 1) { __builtin_amdgcn_s_barrier(); asm volatile("" ::: "memory"); }
    int slot = 0;
#pragma unroll 1
    for (int t = 0; t < n; ++t) {
        const int j = TJ(t);
        const bool ldt = (t + 2 < n); const int lslot = slot == 0 ? 2 : slot - 1;
        if ((!PP || role == 1) && ldt) LOADT(TJ(t + 2), lslot);
        f32x16 p0, p1; float mul = C2, off = 0.f, alpha = 1.f; bool resc = false;
        const int kpos0 = STEP * (j * 64) + OFF;
        const int dmin = tqw - (kpos0 + STEP * 63), dmax = tqw + 7 - kpos0;
        bool rowsel = true;
        if (ROWSEL) { const unsigned wsel = (j < 32) ? sm0 : (j < 64) ? sm1 : (j < 96) ? sm2 : sm3; rowsel = (wsel >> (j & 31)) & 1u; }
        bool act = (dmax >= 0) && (dmin < (int)W);
        if (ROWSEL) act = act && __any(rowsel);
        if (act) {
            SBAR(); __builtin_amdgcn_s_setprio(2); qkt(p0, p1, K_lds + slot * SHM, r32, hi, c.qr); __builtin_amdgcn_s_setprio(0); SBAR();
            const bool needmask = (dmin < 0) || ((unsigned)dmax >= W);
            const int d0 = c.tq - kpos0 - STEP * 4 * hi;
            float add0 = c.bfar;
            if (dmin < 113) {
                if (STEP == 1) {
                    const LAS3 float* tbase = c.tb + (d0 + 5);
#pragma unroll
                    for (int r = 0; r < 16; ++r) { const int cc = (r & 3) + 8 * (r >> 2);
                        p0[r] = fmaf(p0[r], C2, tbase[59 - cc]); p1[r] = fmaf(p1[r], C2, tbase[59 - cc - 32]);
                        if ((r & 3) == 3) SBAR(); }
                } else {
#pragma unroll
                    for (int r = 0; r < 16; ++r) { const int cc = (r & 3) + 8 * (r >> 2); const int da = d0 - STEP * cc, db = d0 - STEP * (cc + 32);
                        const float ba = c.tb[64 + min(max(da, 0), 127)], bb = c.tb[64 + min(max(db, 0), 127)];
                        p0[r] = fmaf(p0[r], C2, ba); p1[r] = fmaf(p1[r], C2, bb);
                        if ((r & 3) == 3) SBAR(); }
                }
                mul = 1.f; add0 = 0.f;
            }
            if (needmask) {
#pragma unroll
                for (int r = 0; r < 16; ++r) { const int cc = (r & 3) + 8 * (r >> 2); const int da = d0 - STEP * cc, db = d0 - STEP * (cc + 32);
                    if ((unsigned)da >= W) p0[r] = NEG; if ((unsigned)db >= W) p1[r] = NEG; }
            }
            SBAR();
            if (RUNMAX) {
                float pm = fmaxf(p0[0], p1[0]);
#pragma unroll
                for (int r = 1; r < 16; ++r) pm = fmaxf(fmaxf(pm, p0[r]), p1[r]);
                pm = half_max(pm);
                float xmax = fmaf(pm, mul, add0); if (ROWSEL) xmax = rowsel ? xmax : NEG;
                float mn = m_reg;
                if (MODE != MODE_ONLINE || !__all(xmax - m_reg <= 8.0f)) { mn = fmaxf(m_reg, xmax); alpha = __builtin_amdgcn_exp2f(m_reg - mn); m_reg = mn; }
                off = add0 - mn; if (ROWSEL) off = rowsel ? off : NEG;
                if (MODE == MODE_ONLINE) { resc = __any(alpha < 1.f); if (resc && hi == 0) al_l[r32] = alpha; }
            } else off = (add0 - m_reg) + lp;
        }
        if (PP) STEP_END(role == 1, ldt);
        if (PP && role == 0 && ldt) LOADT(TJ(t + 2), lslot);
        if (act) {
#pragma unroll
            for (int r = 0; r < 16; ++r) { p0[r] = __builtin_amdgcn_exp2f(fmaf(p0[r], mul, off)); p1[r] = __builtin_amdgcn_exp2f(fmaf(p1[r], mul, off)); }
            if (RUNMAX) {
                float ps = 0.f;
#pragma unroll
                for (int r = 0; r < 16; ++r) ps += p0[r] + p1[r];
                ps = half_sum(ps);
                l_reg = l_reg * alpha + ps;
            }
            if (MODE == MODE_IMP || MODE == MODE_IMPACC) {
                LAS3 float* imp = (LAS3 float*)(c.lds + L_IMP) + (c.wid * 8 + (r32 >> 2)) * 128;
#pragma unroll
                for (int hf = 0; hf < 2; ++hf)
#pragma unroll
                    for (int m = 0; m < 4; ++m) { const f32x16& P = hf ? p1 : p0;
                        float a = 2.f * (P[4 * m] + P[4 * m + 1] + P[4 * m + 2]) + P[4 * m + 3], b = P[4 * m + 3];
                        a += xor1_f(a); b += xor1_f(b); a += xor2_f(a); b += xor2_f(b);
                        const int jj = 16 * j + 8 * hf + 2 * m + hi;
                        if ((r32 & 3) == 0) { __hip_atomic_fetch_add(imp + jj, a, __ATOMIC_RELAXED, __HIP_MEMORY_SCOPE_WORKGROUP);
                            if (jj + 1 < 128) __hip_atomic_fetch_add(imp + jj + 1, b, __ATOMIC_RELAXED, __HIP_MEMORY_SCOPE_WORKGROUP); } }
            }
            if (MODE == MODE_IMPACC) {
#pragma unroll
                for (int r = 0; r < 16; ++r) { p0[r] *= gate; p1[r] *= gate; }
            }
            if (HASV) {
                bf16x8 pa0, pa1, pa2, pa3;
                SBAR(); pack_p(p0, p1, pa0, pa1, pa2, pa3); SBAR();
                if (MODE == MODE_ONLINE && resc) {
#pragma unroll
                    for (int d_ = 0; d_ < 4; ++d_)
#pragma unroll
                        for (int r = 0; r < 16; ++r) c.o[d_][r] *= al_l[crow(r, hi)];
                    SBAR(); }
                pv_tile(c.o, vbase + slot * SHM, pa0, pa1, pa2, pa3);
            }
        }
        STEP_END(role == 0, ldt);
        slot = slot == 2 ? 0 : slot + 1;
    }
    if (PP && role == 0) { __builtin_amdgcn_s_barrier(); asm volatile("" ::: "memory"); }
#undef TJ
#undef STEP_END
#undef WAIT_OLDER
#undef LOADT
}
__device__ __forceinline__ void attn_unit(LAS3 char* lds, const bf16_t* __restrict__ proj, const bf16_t* __restrict__ kc, const bf16_t* __restrict__ vc, bf16_t* __restrict__ oa, float* park, int qt, int g, bool rev) {
    int tid_ = threadIdx.x; asm volatile("" : "+v"(tid_));
    Ctx c; c.lds = lds; c.tid = tid_; c.lane = c.tid & 63; c.wid = __builtin_amdgcn_readfirstlane(c.tid >> 6); c.r32 = c.lane & 31; c.hi = c.lane >> 5;
    c.t0 = qt * 64; c.tq = c.t0 + 8 * c.wid + (c.r32 >> 2);
    const int head = g * 4 + (c.r32 & 3);
    c.tb = (const LAS3 float*)(lds + LDS_BIAS) + head * 256; c.bfar = c.tb[64 + 127];
    { const bf16_t* qp = proj + (size_t)c.tq * NP + C_Q + head * HD + c.hi * 8;
#pragma unroll
      for (int d0 = 0; d0 < 8; ++d0) c.qr[d0] = *(const bf16x8*)(qp + d0 * 16); }
    float ga[3];
    { const bf16_t* gp = proj + (size_t)c.tq * NP + C_GA + head * 3;
#pragma unroll
      for (int b = 0; b < 3; ++b) ga[b] = pg8::fast_sigmoid(__uint_as_float(((unsigned)gp[b]) << 16)); }
    { LAS3 f32x4* z = (LAS3 f32x4*)(lds + L_IMP);
#pragma unroll
      for (int i = 0; i < 4; ++i) z[c.tid + 512 * i] = (f32x4){0.f, 0.f, 0.f, 0.f}; }
    __syncthreads();
    const bf16_t* Kc = kc + g * HD; const bf16_t* Vc = vc + g * HD;
    const bf16_t* Ks = proj + C_KV + 2 * 512 + g * HD; const bf16_t* Vs = proj + C_KV + 3 * 512 + g * HD;
    const bf16_t* Kw = proj + C_KV + 4 * 512 + g * HD; const bf16_t* Vw = proj + C_KV + 5 * 512 + g * HD;
    const int ntc = (4 * qt + 2) / 64;
    constexpr unsigned WINF = 0x7fffffffu;
    LAS3 float* wsf = (LAS3 float*)(lds + L_WS) + c.wid * 64;
#define PARK_PTR(sl_) int pt_ = c.tid; asm volatile("" : "+v"(pt_)); char* pp_ = (char*)park + ((size_t)blockIdx.x * 32 * 512 + (size_t)(sl_) * 16 * 512 + pt_) * 16
#define PARK_STORE(sl_) do { PARK_PTR(sl_); _Pragma("unroll") for (int d_ = 0; d_ < 4; ++d_) _Pragma("unroll") for (int q_ = 0; q_ < 4; ++q_) { \
        *(f32x4*)pp_ = (f32x4){c.o[d_][4 * q_], c.o[d_][4 * q_ + 1], c.o[d_][4 * q_ + 2], c.o[d_][4 * q_ + 3]}; pp_ += 8192; } } while (0)
#define PARK_ADD(sl_) do { PARK_PTR(sl_); _Pragma("unroll") for (int hh_ = 0; hh_ < 2; ++hh_) { f32x4 t_[8]; _Pragma("unroll") for (int e_ = 0; e_ < 8; ++e_) { t_[e_] = *(const f32x4*)pp_; pp_ += 8192; } SBAR(); \
        _Pragma("unroll") for (int e_ = 0; e_ < 8; ++e_) { const int d_ = hh_ * 2 + (e_ >> 2), q_ = e_ & 3; \
        c.o[d_][4 * q_] += t_[e_][0]; c.o[d_][4 * q_ + 1] += t_[e_][1]; c.o[d_][4 * q_ + 2] += t_[e_][2]; c.o[d_][4 * q_ + 3] += t_[e_][3]; } SBAR(); } } while (0)
#define ROW_SCALE(f_) do { if (c.hi == 0) wsf[c.r32] = (f_); LDS_WAIT(); _Pragma("unroll") for (int d_ = 0; d_ < 4; ++d_) _Pragma("unroll") for (int r = 0; r < 16; ++r) c.o[d_][r] *= wsf[crow(r, c.hi)]; } while (0)
#ifndef AREP
#define AREP 0
#endif
    {
        float m_c = -1e30f, l_c = 0.f;
        run_pass<MODE_STAT, 16, 31, false, false>(c, Kc, Vc, 512, 0, ntc, WINF, m_c, l_c, 0.f, 0u, 0u, 0u, 0u);
        const float rl_c = l_c > 0.f ? 1.0f / l_c : 0.f;
#pragma unroll
        for (int d_ = 0; d_ < 4; ++d_) c.o[d_] = f32x16{};
        run_pass<MODE_IMPACC, 16, 31, false, false>(c, Kc, Vc, 512, 0, ntc, WINF, m_c, l_c, rl_c, 0u, 0u, 0u, 0u, ga[0]);
        PARK_STORE(0);
    }
    {
        LAS3 unsigned* selw = (LAS3 unsigned*)(lds + L_SEL);
#pragma unroll 1
        for (int tk = 0; tk < 8; ++tk) {
            const int tok = c.wid * 8 + tk; const LAS3 float* imp = (const LAS3 float*)(lds + L_IMP) + tok * 128;
            const int ja = c.lane, jb = c.lane + 64;
            unsigned ka = __float_as_uint(imp[ja]) + 1u, kb = __float_as_uint(imp[jb]) + 1u;
            ka = (ja == 0 || ja == qt || ja == qt - 1) ? 0xffffffffu : (ja > qt ? 0u : ka);
            kb = (jb == qt || jb == qt - 1) ? 0xffffffffu : (jb > qt ? 0u : kb);
            unsigned T = 0u;
#pragma unroll 1
            for (int bit = 31; bit >= 0; --bit) { const unsigned cand = T | (1u << bit);
                const int cnt = __popcll(__ballot(ka >= cand)) + __popcll(__ballot(kb >= cand));
                T = cnt >= 16 ? cand : T; }
            const int cgt = __popcll(__ballot(ka > T)) + __popcll(__ballot(kb > T)); const int rr = 16 - cgt;
            const unsigned long long ea = __ballot(ka == T), eb = __ballot(kb == T);
            const int ra = __builtin_amdgcn_mbcnt_hi((unsigned)(ea >> 32), __builtin_amdgcn_mbcnt_lo((unsigned)ea, 0u));
            const int rb = __popcll(ea) + (int)__builtin_amdgcn_mbcnt_hi((unsigned)(eb >> 32), __builtin_amdgcn_mbcnt_lo((unsigned)eb, 0u));
            const unsigned long long ba = __ballot(ka > T || (ka == T && ra < rr)), bb = __ballot(kb > T || (kb == T && rb < rr));
            if (c.lane == 0) { selw[tok * 4 + 0] = (unsigned)ba; selw[tok * 4 + 1] = (unsigned)(ba >> 32); selw[tok * 4 + 2] = (unsigned)bb; selw[tok * 4 + 3] = (unsigned)(bb >> 32); }
        }
        LDS_WAIT();
    }
    {
        float m_w = -1e30f, l_w = 0.f; const int jlo = qt >= 8 ? qt - 8 : 0;
#pragma unroll
        for (int d_ = 0; d_ < 4; ++d_) c.o[d_] = f32x16{};
        run_pass<MODE_ONLINE, 1, 0, false, false>(c, Kw, Vw, NP, jlo, qt, 512u, m_w, l_w, 0.f, 0u, 0u, 0u, 0u);
        ROW_SCALE(ga[2] / l_w);
        PARK_STORE(1);
    }
    unsigned zr[64];
    {
        unsigned sm0, sm1, sm2, sm3;
        { const LAS3 unsigned* selw = (const LAS3 unsigned*)(lds + L_SEL) + (c.wid * 8 + (c.r32 >> 2)) * 4; sm0 = selw[0]; sm1 = selw[1]; sm2 = selw[2]; sm3 = selw[3]; }
        float m_s = -1e30f, l_s = 0.f;
#pragma unroll
        for (int d_ = 0; d_ < 4; ++d_) c.o[d_] = f32x16{};
        run_pass<MODE_ONLINE, 1, 0, true, true>(c, Ks, Vs, NP, 0, qt, WINF, m_s, l_s, 0.f, sm0, sm1, sm2, sm3, 1.f, rev);
        { int r32_ = c.r32; asm volatile("" : "+v"(r32_));
          const char* zbase = (const char*)(proj + C_ZA + g * 4 * HD);
#pragma unroll
          for (int r = 0; r < 16; ++r) { const int row = crow(r, c.hi); const int tok = c.t0 + 8 * c.wid + (row >> 2), hd = row & 3; const unsigned zo = (unsigned)(tok * NP + hd * HD + r32_) * 2u;
#pragma unroll
              for (int d0 = 0; d0 < 4; ++d0) zr[r * 4 + d0] = *(const unsigned short*)(zbase + zo + d0 * 64); } }
        SBAR();
        ROW_SCALE(ga[1] / l_s);
        PARK_ADD(0);
        PARK_ADD(1);
    }
#undef PARK_STORE
#undef PARK_ADD
#undef ROW_SCALE
#ifdef NO_EPI
    if (c.o[0][0] == 123.f && c.o[1][1] == 3.f && c.o[2][2] == 1.f && c.o[3][3] == 5.f) oa[0] = 1;
    if (false)
#endif
    {
        const int tw = c.t0 + 8 * c.wid; const bool odd = (c.r32 & 1) != 0;
        char* obase = (char*)(oa + g * 4 * HD);
#pragma unroll
        for (int r = 0; r < 16; ++r) { const int row = crow(r, c.hi); const int tok = tw + (row >> 2), hd = row & 3;
            const unsigned oo = (unsigned)(tok * AW + hd * HD + c.r32) * 2u;
#pragma unroll
            for (int p = 0; p < 2; ++p) { const float za = __uint_as_float(zr[r * 4 + 2 * p] << 16), zb = __uint_as_float(zr[r * 4 + 2 * p + 1] << 16);
                const float a = c.o[2 * p][r] * za * pg8::fast_sigmoid(za), b = c.o[2 * p + 1][r] * zb * pg8::fast_sigmoid(zb);
                const float recv = xor1_f(odd ? a : b);
                const unsigned w = cvtpk(odd ? recv : a, odd ? b : recv);
                *(unsigned*)(obase + (odd ? oo + (2 * p + 1) * 64 - 2u : oo + (2 * p) * 64)) = w; }
        }
    }
    __syncthreads();
}
__device__ __forceinline__ void phase_attn(LAS3 char* lds, const bf16_t* proj, const bf16_t* kc, const bf16_t* vc, bf16_t* oa, float* park, int vcu, int G) {
#pragma unroll 1
    for (int item = vcu; item < 256; item += G) {
        const int g = item >> 6, p = item & 63;
#pragma unroll 1
        for (int s = 0; s < 2; ++s) attn_unit(lds, proj, kc, vc, oa, park, s ? p : 127 - p, g, s != 0);
    }
}
}
__device__ __forceinline__ float gelu_tanh(float x) { const float y = 1.5957691216057308f * (x + 0.044715f * x * x * x); return x * pg8::fast_sigmoid(y); }
__device__ __forceinline__ float silu_f(float x) { return x * pg8::fast_sigmoid(x); }
__device__ __forceinline__ void compress_unit(LAS3 char* lds, const bf16_t* __restrict__ proj, const float* __restrict__ pe, const bf16_t* __restrict__ w1t, const bf16_t* __restrict__ w2t,
                                              bf16_t* __restrict__ outc, int u, int which) {
    int tid_o = threadIdx.x; asm volatile("" : "+v"(tid_o));
    const int tid = tid_o, lane = tid & 63, wid = __builtin_amdgcn_readfirstlane(tid >> 6), r32 = lane & 31, hi = lane >> 5;
    const int i = 8 * u + (r32 >> 2), g = r32 & 3;
    f32x16 acc[4];
#pragma unroll
    for (int nb = 0; nb < 4; ++nb) acc[nb] = f32x16{};
    const bf16_t* abase = proj + C_KV + which * 512 + g * HD + hi * 8;
    const bf16_t* bbase = w1t + (size_t)(wid * 32) * 2048 + lane * 8;
#pragma unroll 1
    for (int lt = 0; lt < 4; ++lt) {
        const int l = wid * 4 + lt; int tokn = 16 * i + l; tokn = tokn < T ? tokn : T - 1;
        const bf16_t* ap = abase + (size_t)tokn * NP; const float* pp = pe + l * HD + hi * 8;
#pragma unroll
        for (int hf = 0; hf < 2; ++hf) {
            u32x4 araw[4]; f32x4 e0[4], e1[4]; bf16x8 bfr[4][4];
#pragma unroll
            for (int k = 0; k < 4; ++k) { const int k8 = hf * 4 + k; araw[k] = *(const u32x4*)(ap + k8 * 16); e0[k] = *(const f32x4*)(pp + k8 * 16); e1[k] = *(const f32x4*)(pp + k8 * 16 + 4);
#pragma unroll
                for (int nb = 0; nb < 4; ++nb) bfr[k][nb] = *(const bf16x8*)(bbase + (size_t)((lt * 8 + k8) * 4 + nb) * 512); }
            __builtin_amdgcn_sched_barrier(0);
#pragma unroll
            for (int k = 0; k < 4; ++k) { const u32x4 raw = araw[k];
                u32x4 aw; aw.x = pk2(pg8::bf_lo(raw.x) + e0[k][0], pg8::bf_hi(raw.x) + e0[k][1]); aw.y = pk2(pg8::bf_lo(raw.y) + e0[k][2], pg8::bf_hi(raw.y) + e0[k][3]);
                aw.z = pk2(pg8::bf_lo(raw.z) + e1[k][0], pg8::bf_hi(raw.z) + e1[k][1]); aw.w = pk2(pg8::bf_lo(raw.w) + e1[k][2], pg8::bf_hi(raw.w) + e1[k][3]);
                const bf16x8 a = *reinterpret_cast<const bf16x8*>(&aw);
#pragma unroll
                for (int nb = 0; nb < 4; ++nb) acc[nb] = __builtin_amdgcn_mfma_f32_32x32x16_bf16(a, bfr[k][nb], acc[nb], 0, 0, 0); }
            __builtin_amdgcn_sched_barrier(0);
        }
    }
    bf16x8 b2[8];
#pragma unroll
    for (int ks = 0; ks < 8; ++ks) b2[ks] = *(const bf16x8*)(w2t + (size_t)((wid & 3) * 32 + r32) * HD + ks * 16 + hi * 8);
    LAS3 float* part = (LAS3 float*)lds + wid * 4096;
#pragma unroll
    for (int nb = 0; nb < 4; ++nb)
#pragma unroll
        for (int r = 0; r < 16; ++r) part[att::crow(r, hi) * 128 + nb * 32 + r32] = acc[nb][r];
    __syncthreads();
    f32x4 s0 = {0.f, 0.f, 0.f, 0.f}, s1 = {0.f, 0.f, 0.f, 0.f};
#pragma unroll
    for (int w = 0; w < 8; ++w) { const LAS3 f32x4* p = (const LAS3 f32x4*)((LAS3 float*)lds + w * 4096 + tid * 8); s0 += p[0]; s1 += p[1]; }
    __syncthreads();
    {
        u32x4 hw; hw.x = pk2(silu_f(s0[0]), silu_f(s0[1])); hw.y = pk2(silu_f(s0[2]), silu_f(s0[3])); hw.z = pk2(silu_f(s1[0]), silu_f(s1[1])); hw.w = pk2(silu_f(s1[2]), silu_f(s1[3]));
        const int row = tid >> 4, col = (tid & 15) * 8;
        *(LAS3 u32x4*)(lds + (row * 136 + col) * 2) = hw;
    }
    __syncthreads();
    if (wid < 4) {
        f32x16 o2 = f32x16{};
#pragma unroll
        for (int ks = 0; ks < 8; ++ks) { const bf16x8 a = *(const LAS3 bf16x8*)(lds + (r32 * 136 + ks * 16 + hi * 8) * 2);
            o2 = __builtin_amdgcn_mfma_f32_32x32x16_bf16(a, b2[ks], o2, 0, 0, 0); }
#pragma unroll
        for (int r = 0; r < 16; ++r) { const int row = att::crow(r, hi); const int ii = 8 * u + (row >> 2), gg = row & 3;
            const float v = ii < NCMP ? o2[r] : 0.f; const float vn = xor1_f(v);
            if ((r32 & 1) == 0) *(unsigned*)(outc + (size_t)(ii * 4 + gg) * HD + wid * 32 + r32) = pk2(v, vn); }
    }
    __syncthreads();
}
__device__ __forceinline__ void gmlp_unit(LAS3 char* lds, const bf16_t* __restrict__ proj, const float* __restrict__ sspart, const float* __restrict__ gain, const float* __restrict__ sw, const float* __restrict__ sb,
                                          bf16_t* __restrict__ ob, int ch, int qd) {
    int tid_o = threadIdx.x; asm volatile("" : "+v"(tid_o));
    const int tid = tid_o, lane = tid & 63, wid = __builtin_amdgcn_readfirstlane(tid >> 6), r32 = lane & 31, hi = lane >> 5;
    const int tc0 = ch * 128;
    LAS3 float* rsl = (LAS3 float*)(lds + LDS_RS);
    {   const int vkk = ((tid >> 7) * 8) + ((tid & 31) >> 2), vkey = (vkk & ~0xC) | ((vkk & 4) << 1) | ((vkk & 8) >> 1), vcol = ((tid >> 5) & 3) * 32 + (tid & 3) * 8;
        const unsigned vo0 = (unsigned)(vkey * NP + vcol) * 2u; const unsigned half_step = (unsigned)(32 * NP) * 2u;
#pragma unroll
        for (int gg = 0; gg < 4; ++gg)
#pragma unroll
            for (int kt = 0; kt < 2; ++kt) { const char* vp_ = (const char*)(proj + (size_t)(tc0 + kt * 64) * NP + C_VB + (qd * 4 + gg) * 128); LAS3 char* vd_ = lds + (gg * 2 + kt) * att::SHM + wid * 1024;
                __builtin_amdgcn_global_load_lds((const unsigned*)(vp_ + vo0), (LAS3 unsigned*)vd_, 16, 0, 0);
                __builtin_amdgcn_global_load_lds((const unsigned*)((vp_ + half_step) + vo0), (LAS3 unsigned*)(vd_ + 8192), 16, 0, 0); } }
    if (tid < 128) { const f32x4* sp = (const f32x4*)(sspart + (size_t)(tc0 + tid) * 32); f32x4 s = sp[0];
#pragma unroll
        for (int i = 1; i < 8; ++i) s += sp[i];
        rsl[tid] = 1.0f / sqrtf(((s[0] + s[1]) + (s[2] + s[3])) * (1.0f / BW) + NORM_EPS); }
    VM_WAIT();
    __syncthreads();
    const int gg = wid >> 1, wd = wid & 1, G = qd * 4 + gg, cb = G * 128;
    const int vb1 = (int)(uintptr_t)(lds) + gg * 2 * att::SHM + att::v_rd_base(lane) + wd * 1024;
    f32x4 gn[2][4];
#pragma unroll
    for (int dd = 0; dd < 2; ++dd)
#pragma unroll
        for (int m = 0; m < 4; ++m) gn[dd][m] = *(const f32x4*)(gain + cb + (wd * 2 + dd) * 32 + 8 * m + 4 * hi);
#pragma unroll 1
    for (int pb = 0; pb < 4; ++pb) {
        const int p = pb * 32 + r32; const size_t tok = (size_t)(tc0 + p); const int nks = 2 * pb + 2;
        f32x4 wr0[8], wr1[8]; u32x2 uu[2][4], zz[2][4];
        const float* wrow = sw + ((size_t)G * 128 + p) * 128 + hi * 8;
#pragma unroll
        for (int ks = 0; ks < 8; ++ks) if (ks < nks) { wr0[ks] = *(const f32x4*)(wrow + ks * 16); wr1[ks] = *(const f32x4*)(wrow + ks * 16 + 4); }
        const char* ubase = (const char*)(proj + tok * NP + C_UB + cb); const char* zbase = (const char*)(proj + tok * NP + C_ZB + cb); char* obase = (char*)(ob + tok * BW + cb);
#pragma unroll
        for (int dd = 0; dd < 2; ++dd)
#pragma unroll
            for (int m = 0; m < 4; ++m) { const int d0 = (wd * 2 + dd) * 32 + 8 * m + 4 * hi; uu[dd][m] = *(const u32x2*)(ubase + d0 * 2); zz[dd][m] = *(const u32x2*)(zbase + d0 * 2); }
        const float bs = sb[G * 128 + p];
        __builtin_amdgcn_sched_barrier(0);
        bf16x8 af[8];
#pragma unroll
        for (int ks = 0; ks < 8; ++ks) { if (ks < nks) { const f32x4 a0 = wr0[ks], a1 = wr1[ks]; const int q0 = ks * 16 + hi * 8;
                const f32x4 r0 = *(const LAS3 f32x4*)(rsl + q0), r1 = *(const LAS3 f32x4*)(rsl + q0 + 4);
                u32x4 w; w.x = pk2(q0 + 0 <= p ? a0[0] * r0[0] : 0.f, q0 + 1 <= p ? a0[1] * r0[1] : 0.f); w.y = pk2(q0 + 2 <= p ? a0[2] * r0[2] : 0.f, q0 + 3 <= p ? a0[3] * r0[3] : 0.f);
                w.z = pk2(q0 + 4 <= p ? a1[0] * r1[0] : 0.f, q0 + 5 <= p ? a1[1] * r1[1] : 0.f); w.w = pk2(q0 + 6 <= p ? a1[2] * r1[2] : 0.f, q0 + 7 <= p ? a1[3] * r1[3] : 0.f);
                af[ks] = *reinterpret_cast<const bf16x8*>(&w); } else af[ks] = bf16x8{}; }
        f32x16 acc[2] = {f32x16{}, f32x16{}};
#define TRRD(dst, off) asm volatile("ds_read_b64_tr_b16 %0, %1 offset:%2" : "=&v"(dst) : "v"(vb1), "i"(off) : "memory")
#define GM_STEP(ks) do { if ((ks) < nks) { s16x4 l0, h0, l1, h1; constexpr int o_ = ((ks) >> 2) * att::SHM + att::v_rd_off(0, (ks) & 3, 0); \
            TRRD(l0, o_); TRRD(h0, o_ + 2048); TRRD(l1, o_ + 512); TRRD(h1, o_ + 512 + 2048); \
            asm volatile("s_waitcnt lgkmcnt(0)" ::: "memory"); __builtin_amdgcn_sched_barrier(0); \
            acc[0] = __builtin_amdgcn_mfma_f32_32x32x16_bf16((bf16x8){l0[0], l0[1], l0[2], l0[3], h0[0], h0[1], h0[2], h0[3]}, af[ks], acc[0], 0, 0, 0); \
            acc[1] = __builtin_amdgcn_mfma_f32_32x32x16_bf16((bf16x8){l1[0], l1[1], l1[2], l1[3], h1[0], h1[1], h1[2], h1[3]}, af[ks], acc[1], 0, 0, 0); } } while (0)
        GM_STEP(0); GM_STEP(1); GM_STEP(2); GM_STEP(3); GM_STEP(4); GM_STEP(5); GM_STEP(6); GM_STEP(7);
#undef GM_STEP
#undef TRRD
#pragma unroll
        for (int dd = 0; dd < 2; ++dd)
#pragma unroll
            for (int m = 0; m < 4; ++m) { const int d0 = (wd * 2 + dd) * 32 + 8 * m + 4 * hi; const u32x2 u2 = uu[dd][m], z2 = zz[dd][m]; const f32x4 g4 = gn[dd][m];
                const float o0 = gelu_tanh(pg8::bf_lo(u2.x)) * (acc[dd][4 * m + 0] * g4[0] + bs) * silu_f(pg8::bf_lo(z2.x));
                const float o1 = gelu_tanh(pg8::bf_hi(u2.x)) * (acc[dd][4 * m + 1] * g4[1] + bs) * silu_f(pg8::bf_hi(z2.x));
                const float o2 = gelu_tanh(pg8::bf_lo(u2.y)) * (acc[dd][4 * m + 2] * g4[2] + bs) * silu_f(pg8::bf_lo(z2.y));
                const float o3 = gelu_tanh(pg8::bf_hi(u2.y)) * (acc[dd][4 * m + 3] * g4[3] + bs) * silu_f(pg8::bf_hi(z2.y));
                u32x2 w; w.x = pk2(o0, o1); w.y = pk2(o2, o3); *(u32x2*)(obase + d0 * 2) = w; }
    }
    __syncthreads();
}
#ifndef N_LAUNCH_MODE
#define N_LAUNCH_MODE 1
#endif
constexpr int NPHASES = 1 + 6 * DEPTH;
#ifndef PHMASK
#define PHMASK 0x7f
#endif
#ifndef REPMASK
#define REPMASK 0
#endif
#define REPS(bit) ((REPMASK & (bit)) ? 2 : 1)
__global__ void __launch_bounds__(NTHREADS, 2) fwd_kernel(Params P) {
    extern __shared__ __attribute__((aligned(16))) unsigned char lds_raw[];
    LAS3 unsigned char* lds = (LAS3 unsigned char*)lds_raw;
    const int tid = threadIdx.x, wave = __builtin_amdgcn_readfirstlane(tid >> 6);
#define lane hw_lane_id()
    const int G = gridDim.x; const int bx = blockIdx.x; const int vcu = (G % 8 == 0) ? (bx % 8) * (G / 8) + bx / 8 : bx;
    const int gw = vcu * NWAVES + wave, NGW = G * NWAVES;
    unsigned char* ws = P.ws;
    if (tid < 16) ((LAS3 unsigned*)(lds + LDS_MISC))[tid] = 0u;
    __syncthreads();
    XcdBarrier bar; bar.bar = (unsigned*)(ws + WS_CTL); bar.x = 0; bar.st = nullptr;
    if (N_LAUNCH_MODE == 1) bar = xcd_barrier_post((unsigned*)(ws + WS_CTL), (volatile LAS unsigned*)(lds + LDS_MISC));
    const int lo = P.ph_lo, hi = P.ph_hi;
#define IN(k) (lo <= (k) && (k) < hi)
#define SEAM(k) do { if (IN(k) && IN((k) + 1)) xcd_barrier(bar); } while (0)
    bf16_t* hbuf = (bf16_t*)(ws + WS_H); bf16_t* proj = (bf16_t*)(ws + WS_PROJ); bf16_t* kc = (bf16_t*)(ws + WS_KC); bf16_t* vc = (bf16_t*)(ws + WS_VC);
    bf16_t* oa = (bf16_t*)(ws + WS_OA); bf16_t* ob = (bf16_t*)(ws + WS_OB); bf16_t* t1 = (bf16_t*)(ws + WS_T1); bf16_t* mg = (bf16_t*)(ws + WS_MG);
    bf16_t* Y = (bf16_t*)(ws + WS_Y); bf16_t* x1 = (bf16_t*)(ws + WS_X1);
    constexpr int NU_PROJ = (T / 256) * (NP / 256);
#pragma unroll 1
    for (int w = 0; w < 2; ++w) {
        const int rem = NU_PROJ % G; const bool tailcu = (rem != 0) && (bx >= rem);
        const bool doit = (w == 0) ? (IN(0) && (PHMASK & 1)) : (IN(1) && tailcu);
        const bool alltail = (rem == 0);
        if (doit) {
            const int lo_ = (w == 0) ? 0 : W_ITEMS - W_TAIL_ITEMS, hi_ = (w == 0) ? (alltail ? W_ITEMS : W_ITEMS - W_TAIL_ITEMS) : W_ITEMS;
            const int gw_ = (w == 0) ? gw : (bx - rem) * NWAVES + wave, ngw_ = (w == 0) ? NGW : (G - rem) * NWAVES;
            for (int rep = 0; rep < REPS(1); ++rep) phase_weights(P, lds, gw_, ngw_, wave, lane, lo_, hi_);
        }
        if (w == 0 && IN(0) && (PHMASK & 1)) for (int rep = 0; rep < REPS(128); ++rep) phase_prenorm(P.x, P.pre_norm, hbuf, gw, NGW, lane);
        __syncthreads();
        {   unsigned bk[8]; float bv[8];
#pragma unroll
            for (int q = 0; q < 8; ++q) { const int i = tid + q * NTHREADS; int dd = (i & 255) - 64; dd = dd < 0 ? 0 : (dd > 127 ? 127 : dd); bk[q] = BUCKET[dd]; }
            __builtin_amdgcn_sched_barrier(0);
#pragma unroll
            for (int q = 0; q < 8; ++q) { const int i = tid + q * NTHREADS; bv[q] = P.rel_bias[bk[q] * 16 + (i >> 8)]; }
            __builtin_amdgcn_sched_barrier(0);
#pragma unroll
            for (int q = 0; q < 8; ++q) ((LAS3 float*)(lds + LDS_BIAS))[tid + q * NTHREADS] = bv[q] * att::LOG2E; }
        __syncthreads();
        if (w == 0) SEAM(0);
    }
#pragma unroll 1
    for (int L = 0; L < DEPTH; ++L) {
        const int pb = 1 + 6 * L;
        constexpr int PN_EARLY = 80, PN_LATE = NP / 256 - PN_EARLY, N_LATE_UNITS = (T / 256) * PN_LATE;
#pragma unroll 1
        for (int half = 0; half < 2; ++half) {
            if (IN(pb + half) && (PHMASK & 2)) for (int rep = 0; rep < REPS(2); ++rep) {
                pg8::Gemm g{hbuf, (const bf16_t*)(ws + WS_WIN + L * SZ_WIN), T, NP, DM, nullptr, nullptr}; pg8::ProjOrder S; S.init2(T, PN_EARLY, PN_LATE, G, bx, half);
                pg8::EpiProj E{proj, NP, (float*)(ws + WS_SS)};
                pg8::gemm_phase<pg8::EpiProj, pg8::ProjOrder>(lds + LDS_STAGE, g, S, E, nullptr);
            }
            if (half == 0) SEAM(pb);
        }
        if (IN(pb + 1) && (PHMASK & 4)) for (int rep = 0; rep < REPS(4); ++rep) {
#pragma unroll 1
            for (int q = 0; ; ++q) {
                int item;
                if (G == 256) {
                    if (bx >= N_LATE_UNITS) { const int k = bx - N_LATE_UNITS;
                        if (k < 64) { if (q >= 3) break; item = 3 * k + q; } else { if (q >= 2) break; item = 192 + 2 * (k - 64) + q; } }
                    else { if (q >= 1 || bx >= 128) break; item = 256 + bx; }
                }
                else { item = bx + q * G; if (item >= 384) break; }
                if (item < 256) gmlp_unit((LAS3 char*)lds, proj, (const float*)(ws + WS_SS), P.sgu_norm + L * BW, P.sgu_w + (size_t)L * 16 * 128 * 128, P.sgu_b + L * 16 * 128, ob, item >> 2, item & 3);
                else { const int ci = item - 256, which = ci & 1, u = ci >> 1;
                    compress_unit((LAS3 char*)lds, proj, (which ? P.pe_v : P.pe_k) + L * 32 * HD, (const bf16_t*)(ws + WS_W1 + (L * 2 + which) * SZ_W1), (const bf16_t*)(ws + WS_W2 + (L * 2 + which) * SZ_W2), which ? vc : kc, u, which); }
            }
        }
        SEAM(pb + 1);
        if (IN(pb + 2) && (PHMASK & 8)) for (int rep = 0; rep < REPS(8); ++rep) att::phase_attn((LAS3 char*)lds, proj, kc, vc, oa, (float*)(ws + WS_PARK), vcu, G);
        SEAM(pb + 2);
        if (IN(pb + 3) && (PHMASK & 16)) for (int rep = 0; rep < REPS(16); ++rep) {
            pg8::DualOrder S; S.init(T, DM, G, bx);
            pg8::Gemm g{oa, (const bf16_t*)(ws + WS_WA + L * SZ_WAB), T, DM, AW, ob, (const bf16_t*)(ws + WS_WB + L * SZ_WAB)};
            pg8::EpiMerge E{mg, DM, proj + C_MA, proj + C_MB, NP};
            pg8::gemm_phase<pg8::EpiMerge, pg8::DualOrder>(lds + LDS_STAGE, g, S, E, nullptr);
        }
        SEAM(pb + 3);
        if (IN(pb + 4) && (PHMASK & 32)) for (int rep = 0; rep < REPS(32); ++rep) {
            pg8::Gemm g{mg, (const bf16_t*)(ws + WS_WO + L * SZ_WO), T, DM, DM, nullptr, nullptr}; pg8::StaticOrder S; S.init(T, DM, G, bx);
            pg8::EpiBf16Plain E{Y, DM};
            pg8::gemm_phase<pg8::EpiBf16Plain, pg8::StaticOrder>(lds + LDS_STAGE, g, S, E, nullptr);
        }
        SEAM(pb + 4);
        if (IN(pb + 5) && (PHMASK & 64)) for (int rep = 0; rep < REPS(64); ++rep) {
            if (L == 0) phase_postnorm<false, true>(Y, P.x, P.post_norm, x1, P.pre_norm + DM, hbuf, true, gw, NGW, lane);
            else phase_postnorm<true, false>(Y, x1, P.post_norm + L * DM, P.out, P.pre_norm, hbuf, false, gw, NGW, lane);
        }
        SEAM(pb + 5);
    }
#undef IN
#undef SEAM
#undef lane
}
extern "C" void kernel_launch(void* const* d_in, const int* in_sizes, int n_in, void* d_out, int out_size, void* d_ws, size_t ws_size, hipStream_t stream) {
    static int grid = 0;
    if (grid == 0) {
        if (n_in != 17 || in_sizes[0] != T * DM || out_size != T * DM || ws_size < WS_END) { fprintf(stderr, "kernel_launch: unexpected shapes (n_in %d, in0 %d, out %d, ws %zu < %zu)\n", n_in, n_in > 0 ? in_sizes[0] : -1, out_size, ws_size, (size_t)WS_END); grid = -1; return; }
        int dev = 0, cus = 0, per_cu = 0;
        if (hipGetDevice(&dev) != hipSuccess || hipDeviceGetAttribute(&cus, hipDeviceAttributeMultiprocessorCount, dev) != hipSuccess) { grid = -1; return; }
        if (hipFuncSetAttribute((const void*)fwd_kernel, hipFuncAttributeMaxDynamicSharedMemorySize, LDS_BYTES) != hipSuccess) { fprintf(stderr, "kernel_launch: hipFuncSetAttribute failed\n"); grid = -1; return; }
        if (hipOccupancyMaxActiveBlocksPerMultiprocessor(&per_cu, (const void*)fwd_kernel, NTHREADS, LDS_BYTES) != hipSuccess || per_cu < 1) { fprintf(stderr, "kernel_launch: occupancy query says %d blocks per CU\n", per_cu); (void)hipGetLastError(); grid = -1; return; }
        grid = cus;
    }
    if (grid < 0) return;
    (void)hipMemsetAsync((char*)d_ws + WS_CTL, 0, CTL_BYTES, stream);
    Params p{};
    p.x = (const float*)d_in[0]; p.rel_bias = (const float*)d_in[1]; p.pre_norm = (const float*)d_in[2]; p.w_in = (const float*)d_in[3];
    p.pe_k = (const float*)d_in[4]; p.w1_k = (const float*)d_in[5]; p.w2_k = (const float*)d_in[6]; p.pe_v = (const float*)d_in[7]; p.w1_v = (const float*)d_in[8]; p.w2_v = (const float*)d_in[9];
    p.w_out_a = (const float*)d_in[10]; p.sgu_norm = (const float*)d_in[11]; p.sgu_w = (const float*)d_in[12]; p.sgu_b = (const float*)d_in[13]; p.w_out_b = (const float*)d_in[14]; p.w_out = (const float*)d_in[15]; p.post_norm = (const float*)d_in[16];
    p.out = (float*)d_out; p.ws = (unsigned char*)d_ws;
#if N_LAUNCH_MODE == 1
    p.ph_lo = 0; p.ph_hi = NPHASES;
    hipLaunchKernelGGL(fwd_kernel, dim3(grid), dim3(NTHREADS), LDS_BYTES, stream, p);
#else
    for (int k = 0; k < NPHASES; ++k) { p.ph_lo = k; p.ph_hi = k + 1; hipLaunchKernelGGL(fwd_kernel, dim3(grid), dim3(NTHREADS), LDS_BYTES, stream, p); }
#endif
}
```

```cpp
#include <hip/hip_runtime.h>
#include <cstdio>
#include <cstdint>
template <int CTRL> __device__ __forceinline__ float dpp_f(float v) { return __builtin_bit_cast(float, __builtin_amdgcn_update_dpp(0, __builtin_bit_cast(int, v), CTRL, 0xF, 0xF, true)); }
__device__ __forceinline__ float xor1_f(float v) { return dpp_f<0xB1>(v); }
__device__ __forceinline__ float xor2_f(float v) { return dpp_f<0x4E>(v); }
__device__ __forceinline__ float xor16_sum(float v) { const unsigned a = __builtin_bit_cast(unsigned, v); auto r = __builtin_amdgcn_permlane16_swap(a, a, false, false); const unsigned r0 = r[0], r1 = r[1]; return __builtin_bit_cast(float, r0) + __builtin_bit_cast(float, r1); }
__device__ __forceinline__ float xor32_sum(float v) { const unsigned a = __builtin_bit_cast(unsigned, v); auto r = __builtin_amdgcn_permlane32_swap(a, a, false, false); const unsigned r0 = r[0], r1 = r[1]; return __builtin_bit_cast(float, r0) + __builtin_bit_cast(float, r1); }
__device__ __forceinline__ int hw_lane_id() { int l; asm volatile("v_mbcnt_lo_u32_b32 %0, -1, 0\n\tv_mbcnt_hi_u32_b32 %0, -1, %0" : "=v"(l)); return l; }
namespace pg8 {
#define PG8_LAS __attribute__((address_space(3)))
typedef unsigned short bf16_t;
typedef short bf16x8 __attribute__((ext_vector_type(8)));
typedef float f32x4 __attribute__((ext_vector_type(4)));
typedef unsigned u32x4 __attribute__((ext_vector_type(4)));
constexpr int BM = 256, BK = 64, HALF = 128, HTB = HALF * BK * 2  , STAGE_BYTES = 8 * HTB, NXCD = 8, WGM = 8;

__host__ __device__ __forceinline__ int lds_byte(int r, int c) { const int st = (r >> 4) * 2 + (c >> 5), rr = r & 15, cc = c & 31, ob = rr * 64 + cc * 2; return st * 1024 + (ob ^ (((ob >> 9) & 1) << 5)); }
__host__ __device__ __forceinline__ void stage_rc(int b, int& R, int& C) { const int st = b / 1024, sb = b % 1024, swz = sb ^ (((sb >> 9) & 1) << 5); R = (st >> 1) * 16 + swz / 64; C = (st & 1) * 32 + (swz % 64) / 2; }
__host__ __device__ __forceinline__ int perm32(int rho) { const int n = rho >> 4, i = rho & 15; return 8 * (i >> 2) + 4 * n + (i & 3); }

struct Unit { int pm, pn, sub; };
struct Gemm { const bf16_t* A; const bf16_t* Bt; int M, N, K; const bf16_t* A2; const bf16_t* Bt2; };

struct StaticOrder {
    int nM, nN, nwg, G, c;
    __host__ __device__ void init(int M, int N, int G_, int c_) { nM = M / BM; nN = N / BM; nwg = nM * nN; G = G_; c = c_; }
    __host__ __device__ bool next(int i, Unit& u) const {
        const long L = (long)i * G + c; if (L >= nwg) return false;
        int wgid = (int)L; { const int q = nwg / NXCD, r = nwg % NXCD, xcd = wgid % NXCD, off = wgid / NXCD; wgid = (xcd < r ? xcd * (q + 1) : r * (q + 1) + (xcd - r) * q) + off; }
        const int nig = WGM * nN, gid = wgid / nig, fm = gid * WGM, gsz = (nM - fm) < WGM ? (nM - fm) : WGM;
        u.pm = fm + ((wgid % nig) % gsz); u.pn = (wgid % nig) / gsz; u.sub = 0; return true;
    }
    __device__ __forceinline__ void a_ready(const Unit&) const {}
    __device__ __forceinline__ void done(const Unit&) const {}
    static constexpr bool DUAL = false;
    __device__ __forceinline__ const bf16_t* baseA(const Gemm& g, const Unit&) const { return g.A; }
    __device__ __forceinline__ const bf16_t* baseB(const Gemm& g, const Unit&) const { return g.Bt; }
};
struct DualOrder : StaticOrder {
    static constexpr bool DUAL = true;
    __host__ __device__ bool next(int i, Unit& u) const { const bool ok = StaticOrder::next(i >> 1, u); u.sub = i & 1; return ok; }
    __device__ __forceinline__ const bf16_t* baseA(const Gemm& g, const Unit& u) const { return u.sub ? g.A2 : g.A; }
    __device__ __forceinline__ const bf16_t* baseB(const Gemm& g, const Unit& u) const { return u.sub ? g.Bt2 : g.Bt; }
};
typedef __bf16 bf16x2_t __attribute__((ext_vector_type(2)));
typedef float f32x2_t __attribute__((ext_vector_type(2)));
__device__ __forceinline__ unsigned cvt_pk_bf16(float lo, float hi) { const f32x2_t v = {lo, hi}; const bf16x2_t b = __builtin_convertvector(v, bf16x2_t); return __builtin_bit_cast(unsigned, b); }
typedef float f32x2 __attribute__((ext_vector_type(2)));
__device__ __forceinline__ float bf_lo(unsigned u) { return __uint_as_float(u << 16); }
__device__ __forceinline__ float bf_hi(unsigned u) { return __uint_as_float(u & 0xffff0000u); }
__device__ __forceinline__ float fast_sigmoid(float x) { return __builtin_amdgcn_rcpf(1.0f + __builtin_amdgcn_exp2f(-1.4426950408889634f * x)); }
struct EpiBf16Plain {
    static constexpr bool PERM = true, AFTER_DRAIN = false;
    bf16_t* O; int ldc;
    __device__ __forceinline__ void operator()(const f32x4 (&acc)[2][2][4][2], const Unit& u, int wr, int wc, int fr, int fq) const {
        const int row0 = u.pm * BM + wr * 64 + fr, col0 = u.pn * BM + wc * 32 + 8 * fq;
#pragma unroll
        for (int ai = 0; ai < 2; ++ai)
#pragma unroll
            for (int m = 0; m < 4; ++m) { bf16_t* rowp = O + (size_t)(row0 + ai * HALF + m * 16) * ldc + col0;
#pragma unroll
                for (int bj = 0; bj < 2; ++bj) { const f32x4 v0 = acc[ai][bj][m][0], v1 = acc[ai][bj][m][1];
                    u32x4 w; w.x = cvt_pk_bf16(v0[0], v0[1]); w.y = cvt_pk_bf16(v0[2], v0[3]); w.z = cvt_pk_bf16(v1[0], v1[1]); w.w = cvt_pk_bf16(v1[2], v1[3]);
                    *(u32x4*)(rowp + bj * HALF) = w; } }
    }
};
__device__ __forceinline__ float gelu_tanh_f(float x) { const float y = 1.5957691216057308f * (x + 0.044715f * x * x * x); return x * fast_sigmoid(y); }
struct EpiProj {
    static constexpr bool PERM = true, AFTER_DRAIN = false;
    static constexpr int PN_V0 = 36;
    bf16_t* O; int ldc; float* sspart;
    __device__ __forceinline__ void operator()(const f32x4 (&acc)[2][2][4][2], const Unit& u, int wr, int wc, int fr, int fq) const {
        const int row0 = u.pm * BM + wr * 64 + fr, col0 = u.pn * BM + wc * 32 + 8 * fq;
        const bool vtile = (u.pn >= PN_V0) && (u.pn < PN_V0 + 8);
        if (!vtile) {
#pragma unroll
            for (int ai = 0; ai < 2; ++ai)
#pragma unroll
                for (int m = 0; m < 4; ++m) { bf16_t* rowp = O + (size_t)(row0 + ai * HALF + m * 16) * ldc + col0;
#pragma unroll
                    for (int bj = 0; bj < 2; ++bj) { const f32x4 v0 = acc[ai][bj][m][0], v1 = acc[ai][bj][m][1];
                        u32x4 w; w.x = cvt_pk_bf16(v0[0], v0[1]); w.y = cvt_pk_bf16(v0[2], v0[3]); w.z = cvt_pk_bf16(v1[0], v1[1]); w.w = cvt_pk_bf16(v1[2], v1[3]);
                        *(u32x4*)(rowp + bj * HALF) = w; } }
        } else {
#pragma unroll
            for (int ai = 0; ai < 2; ++ai)
#pragma unroll
                for (int m = 0; m < 4; ++m) { const int row = row0 + ai * HALF + m * 16; bf16_t* rowp = O + (size_t)row * ldc + col0; float ss = 0.f;
#pragma unroll
                    for (int bj = 0; bj < 2; ++bj) { f32x4 v0 = acc[ai][bj][m][0], v1 = acc[ai][bj][m][1];
#pragma unroll
                        for (int e = 0; e < 4; ++e) { v0[e] = gelu_tanh_f(v0[e]); v1[e] = gelu_tanh_f(v1[e]); ss += v0[e] * v0[e] + v1[e] * v1[e]; }
                        u32x4 w; w.x = cvt_pk_bf16(v0[0], v0[1]); w.y = cvt_pk_bf16(v0[2], v0[3]); w.z = cvt_pk_bf16(v1[0], v1[1]); w.w = cvt_pk_bf16(v1[2], v1[3]);
                        *(u32x4*)(rowp + bj * HALF) = w; }
                    ss = xor16_sum(ss); ss = xor32_sum(ss);
                    if (fq == 0) sspart[(size_t)row * 32 + (u.pn - PN_V0) * 4 + wc] = ss; }
        }
    }
};
template <bool ADD> struct EpiGate {
    static constexpr bool PERM = true, AFTER_DRAIN = false;
    bf16_t* O; int ldc; const bf16_t* Mg; int ldm; const bf16_t* Prev;
    __device__ __forceinline__ void operator()(const f32x4 (&acc)[2][2][4][2], const Unit& u, int wr, int wc, int fr, int fq) const {
        const int row0 = u.pm * BM + wr * 64 + fr, col0 = u.pn * BM + wc * 32 + 8 * fq;
#pragma unroll
        for (int ai = 0; ai < 2; ++ai)
#pragma unroll
            for (int m = 0; m < 4; ++m) { const size_t row = (size_t)(row0 + ai * HALF + m * 16);
#pragma unroll
                for (int bj = 0; bj < 2; ++bj) { const f32x4 v0 = acc[ai][bj][m][0], v1 = acc[ai][bj][m][1];
                    const u32x4 mg = *(const u32x4*)(Mg + row * ldm + col0 + bj * HALF);
                    float r[8];
                    r[0] = v0[0] * fast_sigmoid(bf_lo(mg.x)); r[1] = v0[1] * fast_sigmoid(bf_hi(mg.x)); r[2] = v0[2] * fast_sigmoid(bf_lo(mg.y)); r[3] = v0[3] * fast_sigmoid(bf_hi(mg.y));
                    r[4] = v1[0] * fast_sigmoid(bf_lo(mg.z)); r[5] = v1[1] * fast_sigmoid(bf_hi(mg.z)); r[6] = v1[2] * fast_sigmoid(bf_lo(mg.w)); r[7] = v1[3] * fast_sigmoid(bf_hi(mg.w));
                    if (ADD) { const u32x4 pv = *(const u32x4*)(Prev + row * ldc + col0 + bj * HALF);
                        r[0] += bf_lo(pv.x); r[1] += bf_hi(pv.x); r[2] += bf_lo(pv.y); r[3] += bf_hi(pv.y); r[4] += bf_lo(pv.z); r[5] += bf_hi(pv.z); r[6] += bf_lo(pv.w); r[7] += bf_hi(pv.w); }
                    u32x4 w; w.x = cvt_pk_bf16(r[0], r[1]); w.y = cvt_pk_bf16(r[2], r[3]); w.z = cvt_pk_bf16(r[4], r[5]); w.w = cvt_pk_bf16(r[6], r[7]);
                    *(u32x4*)(O + row * ldc + col0 + bj * HALF) = w; } }
    }
};
struct EpiMerge {
    static constexpr bool PERM = true, AFTER_DRAIN = false;
    bf16_t* O; int ldc; const bf16_t* Ma; const bf16_t* Mb; int ldm;
    __device__ __forceinline__ void mid(f32x4 (&acc)[2][2][4][2], const Unit& u, int wr, int wc, int fr, int fq) const {
        const int row0 = u.pm * BM + wr * 64 + fr, col0 = u.pn * BM + wc * 32 + 8 * fq;
#pragma unroll
        for (int ai = 0; ai < 2; ++ai) {
            u32x4 ga[8], gb[8];
#pragma unroll
            for (int m = 0; m < 4; ++m) { const size_t row = (size_t)(row0 + ai * HALF + m * 16);
#pragma unroll
                for (int bj = 0; bj < 2; ++bj) { ga[m * 2 + bj] = *(const u32x4*)(Ma + row * ldm + col0 + bj * HALF); gb[m * 2 + bj] = *(const u32x4*)(Mb + row * ldm + col0 + bj * HALF); } }
            __builtin_amdgcn_sched_barrier(0);
#pragma unroll
            for (int m = 0; m < 4; ++m)
#pragma unroll
                for (int bj = 0; bj < 2; ++bj) { const u32x4 a = ga[m * 2 + bj], b = gb[m * 2 + bj];
                    const unsigned aw[4] = {a.x, a.y, a.z, a.w}, bw[4] = {b.x, b.y, b.z, b.w};
#pragma unroll
                    for (int e = 0; e < 4; ++e) {
                        const float r0 = (1.0f + __builtin_amdgcn_exp2f(-1.4426950408889634f * bf_lo(bw[e]))) * __builtin_amdgcn_rcpf(1.0f + __builtin_amdgcn_exp2f(-1.4426950408889634f * bf_lo(aw[e])));
                        const float r1 = (1.0f + __builtin_amdgcn_exp2f(-1.4426950408889634f * bf_hi(bw[e]))) * __builtin_amdgcn_rcpf(1.0f + __builtin_amdgcn_exp2f(-1.4426950408889634f * bf_hi(aw[e])));
                        acc[ai][bj][m][e >> 1][(e & 1) * 2] *= r0; acc[ai][bj][m][e >> 1][(e & 1) * 2 + 1] *= r1; } }
            __builtin_amdgcn_sched_barrier(0);
        }
    }
    __device__ __forceinline__ void operator()(const f32x4 (&acc)[2][2][4][2], const Unit& u, int wr, int wc, int fr, int fq) const {
        const int row0 = u.pm * BM + wr * 64 + fr, col0 = u.pn * BM + wc * 32 + 8 * fq;
        u32x4 mgs[16];
#pragma unroll
        for (int ai = 0; ai < 2; ++ai)
#pragma unroll
            for (int m = 0; m < 4; ++m) { const size_t row = (size_t)(row0 + ai * HALF + m * 16);
#pragma unroll
                for (int bj = 0; bj < 2; ++bj) mgs[(ai * 4 + m) * 2 + bj] = *(const u32x4*)(Mb + row * ldm + col0 + bj * HALF); }
        __builtin_amdgcn_sched_barrier(0);
#pragma unroll
        for (int ai = 0; ai < 2; ++ai)
#pragma unroll
            for (int m = 0; m < 4; ++m) { const size_t row = (size_t)(row0 + ai * HALF + m * 16);
#pragma unroll
                for (int bj = 0; bj < 2; ++bj) { const f32x4 v0 = acc[ai][bj][m][0], v1 = acc[ai][bj][m][1];
                    const u32x4 mg = mgs[(ai * 4 + m) * 2 + bj];
                    u32x4 w; w.x = cvt_pk_bf16(v0[0] * fast_sigmoid(bf_lo(mg.x)), v0[1] * fast_sigmoid(bf_hi(mg.x))); w.y = cvt_pk_bf16(v0[2] * fast_sigmoid(bf_lo(mg.y)), v0[3] * fast_sigmoid(bf_hi(mg.y)));
                    w.z = cvt_pk_bf16(v1[0] * fast_sigmoid(bf_lo(mg.z)), v1[1] * fast_sigmoid(bf_hi(mg.z))); w.w = cvt_pk_bf16(v1[2] * fast_sigmoid(bf_lo(mg.w)), v1[3] * fast_sigmoid(bf_hi(mg.w)));
                    *(u32x4*)(O + row * ldc + col0 + bj * HALF) = w; } }
    }
};
struct EpiF32Plain {
    static constexpr bool PERM = false, AFTER_DRAIN = false;
    float* C; int ldc;
    __device__ __forceinline__ void operator()(const f32x4 (&acc)[2][2][4][2], const Unit& u, int wr, int wc, int fr, int fq) const {
        const int row0 = u.pm * BM + wr * 64 + fr, col0 = u.pn * BM + wc * 32 + 4 * fq;
#pragma unroll
        for (int ai = 0; ai < 2; ++ai)
#pragma unroll
            for (int m = 0; m < 4; ++m) { float* rowp = C + (size_t)(row0 + ai * HALF + m * 16) * ldc + col0;
#pragma unroll
                for (int bj = 0; bj < 2; ++bj)
#pragma unroll
                    for (int n = 0; n < 2; ++n) *(f32x4*)(rowp + bj * HALF + n * 16) = acc[ai][bj][m][n]; }
    }
};
struct ProjOrder : StaticOrder {
    int late, nearly, nlate;
    __host__ __device__ void init2(int M, int n_early, int n_late, int G_, int c_, int late_) { StaticOrder::init(M, n_early * BM, G_, c_); late = late_; nearly = n_early; nlate = n_late; }
    __host__ __device__ bool next(int i, Unit& u) const {
        if (!late) return StaticOrder::next(i, u);
        const long L = (long)i * G + c; if (L >= (long)nM * nlate) return false;
        u.pm = (int)(L % nM); u.pn = nearly + (int)(L / nM); u.sub = 0; return true;
    }
};
#ifndef PG8_SP2
#define PG8_SP2 true
#endif
#ifndef PG8_ALIGN
#define PG8_ALIGN true
#endif
template <class Epi, class Sched, bool STAMP = false, bool ALIGN_EPI = PG8_ALIGN, bool SP2 = PG8_SP2>
__device__ __forceinline__ void gemm_phase(PG8_LAS unsigned char* lds, const Gemm g, const Sched& S, const Epi& E, unsigned long long* stamps) {
    int tid_o = threadIdx.x; asm volatile("" : "+v"(tid_o));
    const int tid = tid_o, wid = __builtin_amdgcn_readfirstlane(tid >> 6), lane = tid & 63, wr = wid >> 2, wc = wid & 3, fr = lane & 15, fq = lane >> 4;
    const int K = g.K, nt = K / BK;
    int ts_lo = 0, ts_hi = 0, nts = 0; const unsigned long long rt_entry = STAMP ? (unsigned long long)wall_clock64() : 0ull;
#define PG8_STAMP() do { if (STAMP && wid == 0 && nts < 64) { const unsigned long long _c = (unsigned long long)clock64(); \
        ts_lo = (lane == nts) ? (int)(unsigned)_c : ts_lo; ts_hi = (lane == nts) ? (int)(unsigned)(_c >> 32) : ts_hi; ++nts; } } while (0)
    PG8_STAMP();
    unsigned voffA[2], voffB[2];
#pragma unroll
    for (int i = 0; i < 2; ++i) { int R, C; stage_rc(tid * 16 + i * 8192, R, C); const int Rb = Epi::PERM ? ((R & ~31) + perm32(R & 31)) : R;
        voffA[i] = (unsigned)(R * K + C) * 2u; voffB[i] = (unsigned)(Rb * K + C) * 2u; }
    const size_t kstep = (size_t)(BK * 2);
    const size_t hstep = (size_t)HALF * K * 2;
    const size_t tstep = 2 * hstep;
    const unsigned ldsw = (unsigned)wid * 1024u;
    const int aoff = lds_byte(wr * 64 + fr, fq * 8), boff = lds_byte(wc * 32 + fr, fq * 8);
#define PG8_SA(b, h) (((b) * 2 + (h)) * HTB)
#define PG8_SB(b, h) ((4 + (b) * 2 + (h)) * HTB)
#define PG8_STAGE(bufoff, gbase, voff) do { _Pragma("unroll") for (int _i = 0; _i < 2; ++_i) \
        __builtin_amdgcn_global_load_lds((const unsigned*)((const char*)(gbase) + (voff)[_i]), (PG8_LAS unsigned*)(lds + (bufoff) + ldsw + _i * 8192), 16, 0, 0); } while (0)
#define PG8_LDA(dst, b, h) do { _Pragma("unroll") for (int m = 0; m < 4; ++m) _Pragma("unroll") for (int k = 0; k < 2; ++k) dst[m][k] = *(const PG8_LAS bf16x8*)(lds + PG8_SA(b, h) + aoff + m * 2048 + k * 1024); } while (0)
#define PG8_LDB(dst, b, h) do { _Pragma("unroll") for (int n = 0; n < 2; ++n) _Pragma("unroll") for (int k = 0; k < 2; ++k) dst[n][k] = *(const PG8_LAS bf16x8*)(lds + PG8_SB(b, h) + boff + n * 2048 + k * 1024); } while (0)
#define PG8_MMA(ai, bj, At, Bt) do { __builtin_amdgcn_s_setprio(1); _Pragma("unroll") for (int m = 0; m < 4; ++m) _Pragma("unroll") for (int n = 0; n < 2; ++n) _Pragma("unroll") for (int k = 0; k < 2; ++k) \
        acc[ai][bj][m][n] = __builtin_amdgcn_mfma_f32_16x16x32_bf16(Bt[n][k], At[m][k], acc[ai][bj][m][n], 0, 0, 0); __builtin_amdgcn_s_setprio(0); } while (0)
#define PG8_WAIT_V(n) asm volatile("s_waitcnt vmcnt(" #n ")" ::: "memory")
#define PG8_WAIT_L(n) asm volatile("s_waitcnt lgkmcnt(" #n ")" ::: "memory")
#define PG8_BAR __builtin_amdgcn_s_barrier()
#define PG8_SCHED __builtin_amdgcn_sched_barrier(0)
    Unit cur, nxt; int ui = 0;
    if (!S.next(0, cur)) return;
    f32x4 acc[2][2][4][2];
#pragma unroll
    for (int a = 0; a < 2; ++a)
#pragma unroll
        for (int b = 0; b < 2; ++b)
#pragma unroll
            for (int m = 0; m < 4; ++m)
#pragma unroll
                for (int n = 0; n < 2; ++n) acc[a][b][m][n] = (f32x4){0.f, 0.f, 0.f, 0.f};
    bf16x8 At[4][2], B0[2][2], B1[2][2];
    const char* cA = (const char*)S.baseA(g, cur) + (size_t)cur.pm * tstep; const char* cB = (const char*)S.baseB(g, cur) + (size_t)cur.pn * tstep;
    S.a_ready(cur);
    if constexpr (SP2) {
        PG8_STAGE(PG8_SB(0, 0), cB, voffB); PG8_STAGE(PG8_SB(0, 1), cB + hstep, voffB); PG8_STAGE(PG8_SA(0, 0), cA, voffA); PG8_STAGE(PG8_SA(0, 1), cA + hstep, voffA);
        if (wr == 1) PG8_BAR;
        PG8_WAIT_V(2); PG8_BAR;
        PG8_STAGE(PG8_SB(1, 0), cB + kstep, voffB); PG8_STAGE(PG8_SA(1, 0), cA + kstep, voffA); PG8_STAGE(PG8_SB(1, 1), cB + hstep + kstep, voffB);
        PG8_WAIT_V(6); PG8_BAR;
    } else {
    PG8_STAGE(PG8_SB(0, 0), cB, voffB); PG8_STAGE(PG8_SA(0, 0), cA, voffA); PG8_STAGE(PG8_SB(0, 1), cB + hstep, voffB); PG8_STAGE(PG8_SA(0, 1), cA + hstep, voffA);
    if (wr == 1) PG8_BAR;
    PG8_WAIT_V(4); PG8_BAR;
    PG8_STAGE(PG8_SB(1, 0), cB + kstep, voffB); PG8_STAGE(PG8_SA(1, 0), cA + kstep, voffA); PG8_STAGE(PG8_SB(1, 1), cB + hstep + kstep, voffB);
    PG8_WAIT_V(6); PG8_BAR;
    }
    PG8_STAMP();
    for (;;) {
        const bool has_next = S.next(ui + 1, nxt);
        const char* nA = has_next ? (const char*)S.baseA(g, nxt) + (size_t)nxt.pm * tstep : cA; const char* nB = has_next ? (const char*)S.baseB(g, nxt) + (size_t)nxt.pn * tstep : cB;
        for (int t = 0; t < nt; t += 2) {
            const bool last = (t == nt - 2);
            const char* a1 = cA + (size_t)(t + 1) * kstep;
            const char* a2 = last ? nA : cA + (size_t)(t + 2) * kstep; const char* b2 = last ? nB : cB + (size_t)(t + 2) * kstep;
            const char* a3 = a2 + kstep; const char* b3 = b2 + kstep;
            if (last && has_next) S.a_ready(nxt);
            if constexpr (SP2) {
            PG8_LDB(B0, 0, 0); PG8_LDB(B1, 0, 1); PG8_SCHED; PG8_LDA(At, 0, 0); PG8_STAGE(PG8_SA(1, 1), a1 + hstep, voffA);
            PG8_WAIT_V(8); PG8_WAIT_L(0); PG8_BAR; PG8_MMA(0, 0, At, B0); PG8_MMA(0, 1, At, B1); PG8_BAR; PG8_SCHED;
            PG8_LDA(At, 0, 1); PG8_STAGE(PG8_SB(0, 0), b2, voffB); PG8_STAGE(PG8_SB(0, 1), b2 + hstep, voffB); PG8_STAGE(PG8_SA(0, 0), a2, voffA);
            PG8_WAIT_V(8); PG8_WAIT_L(0); PG8_BAR; PG8_MMA(1, 0, At, B0); PG8_MMA(1, 1, At, B1); PG8_BAR; PG8_SCHED;
            PG8_LDB(B0, 1, 0); PG8_LDB(B1, 1, 1); PG8_SCHED; PG8_LDA(At, 1, 0); PG8_STAGE(PG8_SA(0, 1), a2 + hstep, voffA);
            PG8_WAIT_V(8); PG8_WAIT_L(0); PG8_BAR; PG8_MMA(0, 0, At, B0); PG8_MMA(0, 1, At, B1); PG8_BAR; PG8_SCHED;
            PG8_LDA(At, 1, 1); PG8_STAGE(PG8_SB(1, 0), b3, voffB); PG8_STAGE(PG8_SB(1, 1), b3 + hstep, voffB); PG8_STAGE(PG8_SA(1, 0), a3, voffA);
            PG8_WAIT_V(8); PG8_WAIT_L(0); PG8_BAR; PG8_MMA(1, 0, At, B0); PG8_MMA(1, 1, At, B1); PG8_BAR; PG8_SCHED;
            } else {
            PG8_LDB(B0, 0, 0); PG8_SCHED; PG8_LDA(At, 0, 0); PG8_STAGE(PG8_SA(1, 1), a1 + hstep, voffA);
            PG8_WAIT_L(8); PG8_BAR; PG8_WAIT_L(0); PG8_MMA(0, 0, At, B0); PG8_BAR; PG8_SCHED;
            PG8_LDB(B1, 0, 1); PG8_STAGE(PG8_SB(0, 0), b2, voffB);
            PG8_BAR; PG8_WAIT_L(0); PG8_MMA(0, 1, At, B1); PG8_BAR;
            PG8_LDA(At, 0, 1); PG8_STAGE(PG8_SA(0, 0), a2, voffA);
            PG8_BAR; PG8_WAIT_L(0); PG8_MMA(1, 0, At, B0); PG8_BAR; PG8_SCHED;
            PG8_STAGE(PG8_SB(0, 1), b2 + hstep, voffB);
            PG8_WAIT_V(6); PG8_BAR; PG8_MMA(1, 1, At, B1); PG8_BAR;
            PG8_LDB(B0, 1, 0); PG8_SCHED; PG8_LDA(At, 1, 0); PG8_STAGE(PG8_SA(0, 1), a2 + hstep, voffA);
            PG8_WAIT_L(8); PG8_BAR; PG8_WAIT_L(0); PG8_MMA(0, 0, At, B0); PG8_BAR; PG8_SCHED;
            PG8_LDB(B1, 1, 1); PG8_STAGE(PG8_SB(1, 0), b3, voffB);
            PG8_BAR; PG8_WAIT_L(0); PG8_MMA(0, 1, At, B1); PG8_BAR;
            PG8_LDA(At, 1, 1); PG8_STAGE(PG8_SA(1, 0), a3, voffA);
            PG8_BAR; PG8_WAIT_L(0); PG8_MMA(1, 0, At, B0); PG8_BAR; PG8_SCHED;
            PG8_STAGE(PG8_SB(1, 1), b3 + hstep, voffB);
            PG8_WAIT_V(6); PG8_BAR; PG8_MMA(1, 1, At, B1); PG8_BAR;
                    }
        }
        PG8_STAMP();
        if constexpr (ALIGN_EPI) { if (wr == 0) PG8_BAR; }
        bool keep_acc = false;
        if constexpr (Sched::DUAL) { if (cur.sub == 0) { E.mid(acc, cur, wr, wc, fr, fq); keep_acc = true; } else E(acc, cur, wr, wc, fr, fq); }
        else if constexpr (!Epi::AFTER_DRAIN) { E(acc, cur, wr, wc, fr, fq); S.done(cur); }
        PG8_STAMP();
        if (!has_next) break;
        if (!keep_acc)
#pragma unroll
        for (int a = 0; a < 2; ++a)
#pragma unroll
            for (int b = 0; b < 2; ++b)
#pragma unroll
                for (int m = 0; m < 4; ++m)
#pragma unroll
                    for (int n = 0; n < 2; ++n) acc[a][b][m][n] = (f32x4){0.f, 0.f, 0.f, 0.f};
        cur = nxt; cA = nA; cB = nB; ++ui;
        if constexpr (ALIGN_EPI) { if (wr == 1) PG8_BAR; }
    }
    PG8_WAIT_V(0);
    if constexpr (!ALIGN_EPI) { if (wr == 0) PG8_BAR; }
    PG8_BAR;
    if constexpr (Epi::AFTER_DRAIN) { E.fused(acc, cur, wr, wc, fr, fq, lds, wid, lane); S.done(cur); }
    PG8_STAMP();
    if (STAMP && wid == 0) { stamps[lane] = lane < nts ? (((unsigned long long)(unsigned)ts_hi << 32) | (unsigned)ts_lo) : 0ull;
        if (lane == 62) stamps[62] = rt_entry; if (lane == 63) stamps[63] = (unsigned long long)wall_clock64(); }
#undef PG8_STAMP
#undef PG8_SA
#undef PG8_SB
#undef PG8_STAGE
#undef PG8_LDA
#undef PG8_LDB
#undef PG8_MMA
#undef PG8_WAIT_V
#undef PG8_WAIT_L
#undef PG8_BAR
#undef PG8_SCHED
}
}

#define XB_TMO      128
#define XB_XCNT(j)  (256  + 64 * (j))
#define XB_XSUB(j)  (1280 + 64 * (j))
#define XB_XGEN(j)  (2304 + 64 * (j))
#define XB_TOP      3328
#define XB_TOPGEN   3392
#define XCD_BAR_WORDS 3456
#define XB_SPIN_CAP (1u << 18)
#define LAS __attribute__((address_space(3)))

__device__ __forceinline__ unsigned xb_ld(unsigned* p)              { return __hip_atomic_load(p, __ATOMIC_RELAXED, __HIP_MEMORY_SCOPE_AGENT); }
__device__ __forceinline__ unsigned xb_add(unsigned* p, unsigned v) { return __hip_atomic_fetch_add(p, v, __ATOMIC_RELAXED, __HIP_MEMORY_SCOPE_AGENT); }
__device__ __forceinline__ unsigned xb_xcc_id() { return (unsigned)__builtin_amdgcn_s_getreg((3 << 11) | 20) & 0xFu; }
#define XB_SPIN(cond, bar) do { unsigned _sp = 0; while (cond) { __builtin_amdgcn_s_sleep(1); \
    if ((++_sp & 255u) == 0u) { if (xb_ld(&(bar)[XB_TMO])) break; if (_sp > XB_SPIN_CAP) { atomicAdd(&(bar)[XB_TMO], 1u); break; } } } } while (0)

struct XcdBarrier {
    unsigned* bar; unsigned x;
    volatile LAS unsigned* st;
};

__device__ __forceinline__ XcdBarrier xcd_barrier_post(unsigned* bar, volatile LAS unsigned* st) {
    XcdBarrier b; b.bar = bar; b.x = xb_xcc_id(); b.st = st;
    if (threadIdx.x == 0) (void)xb_add(&bar[XB_XCNT(b.x)], 1u);
    return b;
}
__device__ __forceinline__ void xcd_barrier_complete(unsigned* bar, unsigned x, unsigned& nloc, unsigned& nx) {
    const unsigned G = gridDim.x * gridDim.y * gridDim.z;
    unsigned sum, cnt, mine, sp = 0u;
    for (;;) {
        sum = 0u; cnt = 0u; mine = 0u;
#pragma unroll
        for (unsigned j = 0; j < 16; ++j) { const unsigned c = xb_ld(&bar[XB_XCNT(j)]); sum += c; cnt += (c > 0u) ? 1u : 0u; mine = (j == x) ? c : mine; }
        if (sum == G) break;
        __builtin_amdgcn_s_sleep(1);
        if ((++sp & 255u) == 0u) { if (xb_ld(&bar[XB_TMO])) break; if (sp > XB_SPIN_CAP) { atomicAdd(&bar[XB_TMO], 1u); break; } }
    }
    nloc = mine > 0u ? mine : 1u; nx = cnt > 0u ? cnt : 1u;
}

__device__ __forceinline__ void xcd_barrier(const XcdBarrier& b) {
    asm volatile("s_waitcnt vmcnt(0)" ::: "memory");
    __syncthreads();
    if (threadIdx.x == 0) {
        unsigned* bar = b.bar;
        __builtin_amdgcn_s_waitcnt(0);
        unsigned nloc = b.st[0], nx = b.st[1];
        if (nloc == 0u) { xcd_barrier_complete(bar, b.x, nloc, nx); b.st[0] = nloc; b.st[1] = nx; }
        const unsigned old = xb_add(&bar[XB_XSUB(b.x)], 1u);
        const unsigned gen = old / nloc;
        if (old + 1u == (gen + 1u) * nloc) {
            __builtin_amdgcn_fence(__ATOMIC_RELEASE, "agent");
            asm volatile("s_waitcnt vmcnt(0)" ::: "memory");
            const unsigned og = xb_add(&bar[XB_TOP], 1u);
            const unsigned tg = og / nx;
            if (og + 1u == (tg + 1u) * nx) xb_add(&bar[XB_TOPGEN], 1u);
            else XB_SPIN(xb_ld(&bar[XB_TOPGEN]) == tg, bar);
            __builtin_amdgcn_fence(__ATOMIC_ACQUIRE, "agent");
            xb_add(&bar[XB_XGEN(b.x)], 1u);
            asm volatile("s_waitcnt vmcnt(0)" ::: "memory");
        } else {
            XB_SPIN(xb_ld(&bar[XB_XGEN(b.x)]) == gen, bar);
            __builtin_amdgcn_fence(__ATOMIC_ACQUIRE, "agent");
            asm volatile("s_waitcnt vmcnt(0)" ::: "memory");
        }
    }
    __syncthreads();
}
typedef pg8::bf16_t bf16_t;
typedef short bf16x8 __attribute__((ext_vector_type(8)));
typedef short s16x4 __attribute__((ext_vector_type(4)));
typedef float f32x4 __attribute__((ext_vector_type(4)));
typedef float f32x16 __attribute__((ext_vector_type(16)));
typedef unsigned u32x4 __attribute__((ext_vector_type(4)));
typedef unsigned u32x2 __attribute__((ext_vector_type(2)));
constexpr int T = 8192, DM = 4096, NIN = 21552, NP = 21760, DEPTH = 2, NWAVES = 8, NTHREADS = 512;
constexpr int C_Q = 0, C_KV = 2048, C_ZA = 5120, C_UB = 7168, C_VB = 9216, C_ZB = 11264, C_MA = 13312, C_MB = 17408, C_GA = 21504;
constexpr int AW = 2048, BW = 2048, HD = 128, NCMP = 511, NCP = 512;
constexpr float NORM_EPS = 1e-6f;
constexpr size_t al256(size_t x) { return (x + 255) & ~(size_t)255; }
constexpr size_t WS_CTL = 0, CTL_BYTES = 1u << 20;
constexpr size_t SZ_WIN = (size_t)NP * DM * 2, SZ_WAB = (size_t)DM * AW * 2, SZ_WO = (size_t)DM * DM * 2, SZ_W1 = (size_t)HD * 4096 * 2, SZ_W2 = (size_t)HD * HD * 2;
constexpr size_t WS_WIN = WS_CTL + CTL_BYTES;
constexpr size_t WS_WA = WS_WIN + DEPTH * SZ_WIN;
constexpr size_t WS_WB = WS_WA + DEPTH * SZ_WAB;
constexpr size_t WS_WO = WS_WB + DEPTH * SZ_WAB;
constexpr size_t WS_W1 = WS_WO + DEPTH * SZ_WO;
constexpr size_t WS_W2 = WS_W1 + DEPTH * 2 * SZ_W1;
constexpr size_t WS_H = al256(WS_W2 + DEPTH * 2 * SZ_W2);
constexpr size_t WS_PROJ = WS_H + (size_t)T * DM * 2;
constexpr size_t WS_KC = WS_PROJ + (size_t)T * NP * 2;
constexpr size_t WS_VC = WS_KC + (size_t)NCP * 512 * 2;
constexpr size_t WS_OA = WS_VC + (size_t)NCP * 512 * 2;
constexpr size_t WS_OB = WS_OA + (size_t)T * AW * 2;
constexpr size_t WS_T1 = WS_OB + (size_t)T * BW * 2;
constexpr size_t WS_MG = WS_T1 + (size_t)T * DM * 2;
constexpr size_t WS_Y = WS_MG + (size_t)T * DM * 2;
constexpr size_t WS_X1 = WS_Y + (size_t)T * DM * 4;
constexpr size_t WS_SS = WS_X1 + (size_t)T * DM * 4;
constexpr size_t WS_PARK = WS_SS + (size_t)T * 32 * 4;
constexpr size_t WS_SGW = WS_PARK + (size_t)1024 * 32 * 512 * 16;
constexpr size_t WS_END = WS_SGW + (size_t)DEPTH * 16 * 128 * 128 * 4;
constexpr int LDS_STAGE = 0;
constexpr int LDS_BIAS = 131072;
constexpr int LDS_MISC = LDS_BIAS + 16 * 256 * 4;
constexpr int LDS_RS = LDS_MISC + 64;
constexpr int LDS_ATT = LDS_RS + 512;
constexpr int LDS_BYTES = LDS_ATT + 8192;
static_assert(LDS_BYTES <= 160 * 1024, "LDS");
#define LAS3 __attribute__((address_space(3)))
#define LDS_WAIT() asm volatile("s_waitcnt lgkmcnt(0)" ::: "memory")
#define VM_WAIT() asm volatile("s_waitcnt vmcnt(0)" ::: "memory")

struct Params {
    const float *x, *rel_bias, *pre_norm, *w_in, *pe_k, *w1_k, *w2_k, *pe_v, *w1_v, *w2_v, *w_out_a, *sgu_norm, *sgu_w, *sgu_b, *w_out_b, *w_out, *post_norm;
    float* out; unsigned char* ws; int ph_lo, ph_hi;
};
__device__ __forceinline__ unsigned pk2(float lo, float hi) { return pg8::cvt_pk_bf16(lo, hi); }
__device__ __forceinline__ float wave_sum(float v) {
    v += dpp_f<0xB1>(v); v += dpp_f<0x4E>(v); v += dpp_f<0x141>(v); v += dpp_f<0x140>(v);
    v = xor16_sum(v); v = xor32_sum(v);
    return v;
}
__device__ const unsigned char BUCKET[128] = {0, 1, 2, 3, 4, 5, 6, 7, 8, 9, 10, 11, 12, 13, 14, 15, 16, 16, 16, 17, 17, 18, 18, 18, 19, 19, 19, 20, 20, 20, 20, 21, 21, 21, 21, 22, 22, 22, 22, 22, 23, 23, 23, 23, 23, 23, 24, 24, 24, 24, 24, 24, 25, 25, 25, 25, 25, 25, 25, 26, 26, 26, 26, 26, 26, 26, 26, 27, 27, 27, 27, 27, 27, 27, 27, 27, 27, 28, 28, 28, 28, 28, 28, 28, 28, 28, 28, 29, 29, 29, 29, 29, 29, 29, 29, 29, 29, 29, 29, 30, 30, 30, 30, 30, 30, 30, 30, 30, 30, 30, 30, 30, 30, 31, 31, 31, 31, 31, 31, 31, 31, 31, 31, 31, 31, 31, 31, 31};

constexpr int W_ITEMS_PER_LAYER = 64 * (NP / 64) + 2 * 32 * 64 + 64 * 64 + 2 * 64 * 2 + 2 * 2 * 2;
constexpr int W_ITEMS = DEPTH * W_ITEMS_PER_LAYER;
constexpr int W_TAIL_ITEMS = 0;
__device__ __forceinline__ int srcmap_in(int n) { return n < 5120 ? n : (n < 21504 ? n + 48 : (n < 21552 ? n - 21504 + 5120 : -1)); }
template <int MODE>
__device__ __forceinline__ void transpose_item(const float* __restrict__ W, int K, int N, bf16_t* __restrict__ WT, LAS3 float* scr, int item, int nblk, int lane) {
    int kb, nb;
    if ((nblk & 3) == 0) { const int g8 = item >> 3, sub = item & 7, q = nblk >> 2; const int gk = g8 / q, gn = g8 - gk * q; nb = gn * 4 + (sub & 3); kb = gk * 2 + (sub >> 2); }
    else { kb = item / nblk; nb = item - kb * nblk; }
    const int k0 = 64 * kb, n0 = 64 * nb;
    const int nn = n0 + 4 * (lane & 15); const int s = (MODE == 1) ? srcmap_in(nn) : nn;
    const float* src = W + (size_t)(k0 + (lane >> 4)) * N + (s >= 0 ? s : 0);
    f32x4 v[16];
#pragma unroll
    for (int i = 0; i < 16; ++i) v[i] = *(const f32x4*)(src + (size_t)(4 * i) * N);
    __builtin_amdgcn_sched_barrier(0);
#pragma unroll
    for (int i = 0; i < 16; ++i) { f32x4 x = v[i]; if (s < 0) x = (f32x4){0.f, 0.f, 0.f, 0.f};
        LAS3 float* d = scr + (4 * i + (lane >> 4)) * 65 + 4 * (lane & 15); d[0] = x[0]; d[1] = x[1]; d[2] = x[2]; d[3] = x[3]; }
    LDS_WAIT();
    const int c = lane & 7;
#pragma unroll
    for (int j = 0; j < 8; ++j) { const int n = (lane >> 3) + 8 * j; const LAS3 float* p = scr + (8 * c) * 65 + n;
        u32x4 o; o.x = pk2(p[0 * 65], p[1 * 65]); o.y = pk2(p[2 * 65], p[3 * 65]); o.z = pk2(p[4 * 65], p[5 * 65]); o.w = pk2(p[6 * 65], p[7 * 65]);
        if (MODE == 2) { const int k8 = (k0 >> 3) + c, na = n0 + n; *(u32x4*)(WT + (size_t)((((k8 >> 1) * (N >> 5) + (na >> 5)) * 64) + (k8 & 1) * 32 + (na & 31)) * 8) = o; }
        else *(u32x4*)(WT + (size_t)(n0 + n) * K + k0 + 8 * c) = o; }
    LDS_WAIT();
}
__device__ __forceinline__ void phase_weights(const Params& P, LAS3 unsigned char* lds, int gw, int NGW, int wave, int lane, int it_lo, int it_hi) {
    asm volatile("" : "+v"(lane));
    LAS3 float* scr = (LAS3 float*)(lds + LDS_STAGE + wave * 16640);
    constexpr int I_IN = 64 * (NP / 64), I_AB = 32 * 64, I_O = 64 * 64, I_W1 = 64 * 2, I_W2 = 2 * 2;
    constexpr int PER_LAYER = I_IN + 2 * I_AB + I_O + 2 * I_W1 + 2 * I_W2;
    static_assert(PER_LAYER == W_ITEMS_PER_LAYER, "item count");
    for (int it = it_lo + gw; it < it_hi; it += NGW) {
        const int L = it / PER_LAYER; int r = it - L * PER_LAYER;
        unsigned char* ws = P.ws;
        if (r < I_IN) { transpose_item<1>(P.w_in + (size_t)L * DM * NIN, DM, NIN, (bf16_t*)(ws + WS_WIN + L * SZ_WIN), scr, r, NP / 64, lane); continue; } r -= I_IN;
        if (r < I_AB) { transpose_item<0>(P.w_out_a + (size_t)L * AW * DM, AW, DM, (bf16_t*)(ws + WS_WA + L * SZ_WAB), scr, r, 64, lane); continue; } r -= I_AB;
        if (r < I_AB) { transpose_item<0>(P.w_out_b + (size_t)L * BW * DM, BW, DM, (bf16_t*)(ws + WS_WB + L * SZ_WAB), scr, r, 64, lane); continue; } r -= I_AB;
        if (r < I_O) { transpose_item<0>(P.w_out + (size_t)L * DM * DM, DM, DM, (bf16_t*)(ws + WS_WO + L * SZ_WO), scr, r, 64, lane); continue; } r -= I_O;
        if (r < I_W1) { transpose_item<2>(P.w1_k + (size_t)L * 4096 * HD, 4096, HD, (bf16_t*)(ws + WS_W1 + (L * 2 + 0) * SZ_W1), scr, r, 2, lane); continue; } r -= I_W1;
        if (r < I_W1) { transpose_item<2>(P.w1_v + (size_t)L * 4096 * HD, 4096, HD, (bf16_t*)(ws + WS_W1 + (L * 2 + 1) * SZ_W1), scr, r, 2, lane); continue; } r -= I_W1;
        if (r < I_W2) { transpose_item<0>(P.w2_k + (size_t)L * HD * HD, HD, HD, (bf16_t*)(ws + WS_W2 + (L * 2 + 0) * SZ_W2), scr, r, 2, lane); continue; } r -= I_W2;
        transpose_item<0>(P.w2_v + (size_t)L * HD * HD, HD, HD, (bf16_t*)(ws + WS_W2 + (L * 2 + 1) * SZ_W2), scr, r, 2, lane);
    }
}
__device__ __forceinline__ void phase_prenorm(const float* __restrict__ x, const float* __restrict__ g, bf16_t* __restrict__ h, int gw, int NGW, int lane) {
    asm volatile("" : "+v"(lane));
#pragma unroll 1
    for (int m = gw; m < T; m += 2 * NGW) {
        const bool two = (m + NGW) < T; const int m2 = two ? m + NGW : m;
        const f32x4* xa = (const f32x4*)(x + (size_t)m * DM) + lane; const f32x4* xb = (const f32x4*)(x + (size_t)m2 * DM) + lane;
        f32x4 va[16], vb[16];
#pragma unroll
        for (int j = 0; j < 16; ++j) va[j] = xa[64 * j];
#pragma unroll
        for (int j = 0; j < 16; ++j) vb[j] = xb[64 * j];
        __builtin_amdgcn_sched_barrier(0);
        float sa = 0.f, sb = 0.f;
#pragma unroll
        for (int j = 0; j < 16; ++j) { sa += (va[j][0] * va[j][0] + va[j][1] * va[j][1]) + (va[j][2] * va[j][2] + va[j][3] * va[j][3]); sb += (vb[j][0] * vb[j][0] + vb[j][1] * vb[j][1]) + (vb[j][2] * vb[j][2] + vb[j][3] * vb[j][3]); }
        const float ra = 1.0f / sqrtf(wave_sum(sa) * (1.0f / DM) + NORM_EPS), rb = 1.0f / sqrtf(wave_sum(sb) * (1.0f / DM) + NORM_EPS);
        const f32x4* gr = (const f32x4*)g + lane;
        u32x2* oa = (u32x2*)(h + (size_t)m * DM) + lane; u32x2* ob = (u32x2*)(h + (size_t)m2 * DM) + lane;
#pragma unroll
        for (int j = 0; j < 16; ++j) { const f32x4 gg = gr[64 * j]; u32x2 w; w.x = pk2(va[j][0] * ra * gg[0], va[j][1] * ra * gg[1]); w.y = pk2(va[j][2] * ra * gg[2], va[j][3] * ra * gg[3]); oa[64 * j] = w;
            if (two) { u32x2 w2; w2.x = pk2(vb[j][0] * rb * gg[0], vb[j][1] * rb * gg[1]); w2.y = pk2(vb[j][2] * rb * gg[2], vb[j][3] * rb * gg[3]); ob[64 * j] = w2; } }
    }
}
template <bool XOLD_BF16, bool XNEW_BF16>
__device__ __forceinline__ void phase_postnorm(const bf16_t* __restrict__ Y, const void* __restrict__ xold, const float* __restrict__ gpost, void* __restrict__ xnew,
                                               const float* __restrict__ gpre, bf16_t* __restrict__ h, bool next, int gw, int NGW, int lane_) {
#pragma unroll 1
    for (int m = gw; m < T; m += NGW) {
        int lane = lane_; asm volatile("" : "+v"(lane));
        const u32x2* yr = (const u32x2*)(Y + (size_t)m * DM) + lane;
        u32x2 yw[16]; f32x4 xx[16]; u32x2 xw[16]; f32x4 gp[16];
#pragma unroll
        for (int j = 0; j < 16; ++j) yw[j] = yr[64 * j];
        if (XOLD_BF16) {
#pragma unroll
            for (int j = 0; j < 16; ++j) xw[j] = ((const u32x2*)((const bf16_t*)xold + (size_t)m * DM) + lane)[64 * j];
        } else {
#pragma unroll
            for (int j = 0; j < 16; ++j) xx[j] = ((const f32x4*)((const float*)xold + (size_t)m * DM) + lane)[64 * j];
        }
#pragma unroll
        for (int j = 0; j < 16; ++j) gp[j] = ((const f32x4*)gpost + lane)[64 * j];
        __builtin_amdgcn_sched_barrier(0);
        f32x4 v[16]; float ss = 0.f;
#pragma unroll
        for (int j = 0; j < 16; ++j) { const u32x2 w = yw[j]; v[j] = (f32x4){pg8::bf_lo(w.x), pg8::bf_hi(w.x), pg8::bf_lo(w.y), pg8::bf_hi(w.y)}; ss += (v[j][0] * v[j][0] + v[j][1] * v[j][1]) + (v[j][2] * v[j][2] + v[j][3] * v[j][3]); }
        const float rs = 1.0f / sqrtf(wave_sum(ss) * (1.0f / DM) + NORM_EPS);
        float s2 = 0.f;
#pragma unroll
        for (int j = 0; j < 16; ++j) { f32x4 xo;
            if (XOLD_BF16) { const u32x2 w = xw[j]; xo = (f32x4){pg8::bf_lo(w.x), pg8::bf_hi(w.x), pg8::bf_lo(w.y), pg8::bf_hi(w.y)}; } else xo = xx[j];
            const f32x4 r = xo + v[j] * rs * gp[j]; v[j] = r;
            if (XNEW_BF16) { u32x2 w; w.x = pk2(r[0], r[1]); w.y = pk2(r[2], r[3]); ((u32x2*)((bf16_t*)xnew + (size_t)m * DM) + lane)[64 * j] = w; }
            else ((f32x4*)((float*)xnew + (size_t)m * DM) + lane)[64 * j] = r;
            s2 += (r[0] * r[0] + r[1] * r[1]) + (r[2] * r[2] + r[3] * r[3]); }
        if (next) {
            f32x4 g2[16];
#pragma unroll
            for (int j = 0; j < 16; ++j) g2[j] = ((const f32x4*)gpre + lane)[64 * j];
            __builtin_amdgcn_sched_barrier(0);
            const float rs2 = 1.0f / sqrtf(wave_sum(s2) * (1.0f / DM) + NORM_EPS);
            u32x2* o = (u32x2*)(h + (size_t)m * DM) + lane;
#pragma unroll
            for (int j = 0; j < 16; ++j) { const f32x4 gg = g2[j]; u32x2 w; w.x = pk2(v[j][0] * rs2 * gg[0], v[j][1] * rs2 * gg[1]); w.y = pk2(v[j][2] * rs2 * gg[2], v[j][3] * rs2 * gg[3]); o[64 * j] = w; }
        }
    }
}
namespace att {
constexpr float SCALE = 0.08838834764831845f, LOG2E = 1.4426950408889634f, C2 = SCALE * LOG2E;
constexpr int SHM = 16384;
constexpr int NSLOT = 3;
constexpr int L_V = 0, L_K = NSLOT * SHM, L_IMP = 2 * NSLOT * SHM, L_SEL = LDS_ATT, L_WS = L_SEL + 1024, L_SC = L_WS + 2048, L_END = L_SC + 4096;
static_assert(L_IMP + 32768 <= 131072 && L_END <= LDS_ATT + 8192, "attention LDS");
#define KSWZ(row, colB) ((row) * 256 + ((colB) ^ (((row) & 7) << 4)))
#define SBAR() __builtin_amdgcn_sched_barrier(0)
__device__ __forceinline__ int v_st(int k, int c) { const int kk = (k & ~0xC) | ((k & 4) << 1) | ((k & 8) >> 1); return ((kk >> 3) * 4 + (c >> 5)) * 512 + ((kk & 7) * 32 + (c & 31)) * 2; }
__device__ __forceinline__ int v_rd_base(int lane) { return ((lane & 3) << 3) | (((lane >> 2) & 3) << 6) | (((lane >> 4) & 1) << 5) | (((lane >> 5) & 1) << 8); }
constexpr int v_rd_off(int d0, int ks, int half) { return d0 * 512 + ks * 4096 + half * 2048; }
__device__ __forceinline__ int crow(int r, int hi) { return (r & 3) + 8 * (r >> 2) + 4 * hi; }
__device__ __forceinline__ unsigned cvtpk(float lo, float hi) { return pg8::cvt_pk_bf16(lo, hi); }
enum { MODE_STAT = 0, MODE_IMP = 1, MODE_ONLINE = 2, MODE_ACC = 3, MODE_IMPACC = 4 };
#ifndef PP_STAT
#define PP_STAT false
#endif
#ifndef PP_ACC
#define PP_ACC false
#endif

struct Ctx {
    bf16x8 qr[8]; f32x16 o[4];
    int tq, r32, hi, wid, lane, tid, t0;
    const LAS3 float* tb; float bfar;
    LAS3 char* lds;
};
__device__ __forceinline__ void qkt(f32x16& p0, f32x16& p1, const LAS3 char* Kt, int r32, int hi, const bf16x8* qr) {
    p0 = f32x16{}; p1 = f32x16{};
    const LAS3 char* kb[4];
#pragma unroll
    for (int dd = 0; dd < 4; ++dd) kb[dd] = Kt + KSWZ(r32, (dd * 16 + hi * 8) * 2);
#pragma unroll
    for (int d0 = 0; d0 < 8; ++d0) { const LAS3 char* a = kb[d0 & 3] + (d0 >> 2) * 128;
        const bf16x8 b0 = *reinterpret_cast<const LAS3 bf16x8*>(a);
        const bf16x8 b1 = *reinterpret_cast<const LAS3 bf16x8*>(a + 32 * 256);
        p0 = __builtin_amdgcn_mfma_f32_32x32x16_bf16(b0, qr[d0], p0, 0, 0, 0);
        p1 = __builtin_amdgcn_mfma_f32_32x32x16_bf16(b1, qr[d0], p1, 0, 0, 0);
        if ((d0 & 3) == 3) SBAR(); }
}
__device__ __forceinline__ void pv_tile(f32x16* o, int vb0, bf16x8 pa0, bf16x8 pa1, bf16x8 pa2, bf16x8 pa3) {
#define TRRD(dst, off) asm volatile("ds_read_b64_tr_b16 %0, %1 offset:%2" : "=&v"(dst) : "v"(vb0), "i"(off) : "memory")
#define PV_KS(ks, PA) do { s16x4 l0, l1, l2, l3, h0, h1, h2, h3; constexpr int b_ = v_rd_off(0, ks, 0); \
        TRRD(l0, b_); TRRD(h0, b_ + 2048); TRRD(l1, b_ + 512); TRRD(h1, b_ + 512 + 2048); TRRD(l2, b_ + 1024); TRRD(h2, b_ + 1024 + 2048); TRRD(l3, b_ + 1536); TRRD(h3, b_ + 1536 + 2048); \
        asm volatile("s_waitcnt lgkmcnt(0)" ::: "memory"); SBAR(); \
        o[0] = __builtin_amdgcn_mfma_f32_32x32x16_bf16(PA, (bf16x8){l0[0], l0[1], l0[2], l0[3], h0[0], h0[1], h0[2], h0[3]}, o[0], 0, 0, 0); \
        o[1] = __builtin_amdgcn_mfma_f32_32x32x16_bf16(PA, (bf16x8){l1[0], l1[1], l1[2], l1[3], h1[0], h1[1], h1[2], h1[3]}, o[1], 0, 0, 0); \
        o[2] = __builtin_amdgcn_mfma_f32_32x32x16_bf16(PA, (bf16x8){l2[0], l2[1], l2[2], l2[3], h2[0], h2[1], h2[2], h2[3]}, o[2], 0, 0, 0); \
        o[3] = __builtin_amdgcn_mfma_f32_32x32x16_bf16(PA, (bf16x8){l3[0], l3[1], l3[2], l3[3], h3[0], h3[1], h3[2], h3[3]}, o[3], 0, 0, 0); } while (0)
    PV_KS(0, pa0); PV_KS(1, pa1); PV_KS(2, pa2); PV_KS(3, pa3);
#undef PV_KS
#undef TRRD
}
__device__ __forceinline__ void pack_p(const f32x16& p0, const f32x16& p1, bf16x8& pa0, bf16x8& pa1, bf16x8& pa2, bf16x8& pa3) {
#define PK4(P, B_, OUT) do { u32x4 w = {cvtpk(P[B_+0], P[B_+1]), cvtpk(P[B_+2], P[B_+3]), cvtpk(P[B_+4], P[B_+5]), cvtpk(P[B_+6], P[B_+7])}; OUT = *reinterpret_cast<bf16x8*>(&w); } while (0)
    PK4(p0, 0, pa0); PK4(p0, 8, pa1); PK4(p1, 0, pa2); PK4(p1, 8, pa3);
#undef PK4
}
__device__ __forceinline__ float half_max(float v) { auto rr = __builtin_amdgcn_permlane32_swap(__float_as_uint(v), __float_as_uint(v), false, false); return fmaxf(__uint_as_float(rr[0]), __uint_as_float(rr[1])); }
__device__ __forceinline__ float half_sum(float v) { auto rr = __builtin_amdgcn_permlane32_swap(__float_as_uint(v), __float_as_uint(v), false, false); return __uint_as_float(rr[0]) + __uint_as_float(rr[1]); }

template <int MODE, int STEP, int OFF, bool ROWSEL, bool PP>
__device__ __forceinline__ void run_pass(Ctx& c, const bf16_t* __restrict__ Kg, const bf16_t* __restrict__ Vg, const int ldk, const int j_lo, const int j_hi, const unsigned W,
                                         float& m_reg, float& l_reg, const float pscale, unsigned sm0, unsigned sm1, unsigned sm2, unsigned sm3, const float gate = 1.f, const bool rev = false) {
    constexpr bool HASV = (MODE == MODE_ONLINE || MODE == MODE_ACC || MODE == MODE_IMPACC), RUNMAX = (MODE == MODE_ONLINE || MODE == MODE_STAT);
    int tid = c.tid, r32 = c.r32, hi = c.hi, lane = c.lane;
    asm volatile("" : "+v"(tid), "+v"(r32), "+v"(hi), "+v"(lane));
    const int n = j_hi - j_lo + 1;
    if (n <= 0) return;
    LAS3 char* V_lds = c.lds + L_V; LAS3 char* K_lds = c.lds + L_K;
    LAS3 float* al_l = (LAS3 float*)(c.lds + L_WS) + c.wid * 64 + 32;
    const int krow = tid >> 4;
    const unsigned ko0 = (unsigned)(krow * ldk + (((tid & 15) ^ (krow & 7)) * 8)) * 2u;
    const int vkk = ((tid >> 7) * 8) + ((tid & 31) >> 2), vkey = vkk, vcol = ((tid >> 5) & 3) * 32 + (tid & 3) * 8;
    const unsigned vo0 = (unsigned)(vkey * ldk + vcol) * 2u;
    const unsigned half_step = (unsigned)(32 * ldk) * 2u;
    const int vbase = (int)(uintptr_t)V_lds + v_rd_base(lane);
#define LOADT(j, bf) do { const char* kp_ = (const char*)(Kg + (size_t)((j) * 64) * ldk); LAS3 char* kd_ = K_lds + (bf) * SHM + c.wid * 1024; \
        __builtin_amdgcn_global_load_lds((const unsigned*)(kp_ + ko0), (LAS3 unsigned*)kd_, 16, 0, 0); \
        __builtin_amdgcn_global_load_lds((const unsigned*)((kp_ + half_step) + ko0), (LAS3 unsigned*)(kd_ + 8192), 16, 0, 0); \
        if (HASV) { const char* vp_ = (const char*)(Vg + (size_t)((j) * 64) * ldk); LAS3 char* vd_ = V_lds + (bf) * SHM + c.wid * 1024; \
            __builtin_amdgcn_global_load_lds((const unsigned*)(vp_ + vo0), (LAS3 unsigned*)vd_, 16, 0, 0); \
            __builtin_amdgcn_global_load_lds((const unsigned*)((vp_ + half_step) + vo0), (LAS3 unsigned*)(vd_ + 8192), 16, 0, 0); } } while (0)
#define WAIT_OLDER(younger) do { if (younger) { if (HASV) asm volatile("s_waitcnt vmcnt(4)" ::: "memory"); else asm volatile("s_waitcnt vmcnt(2)" ::: "memory"); } else VM_WAIT(); } while (0)
#define STEP_END(oddstep, ldt) do { if (oddstep) WAIT_OLDER(ldt); LDS_WAIT(); __builtin_amdgcn_s_barrier(); asm volatile("" ::: "memory"); } while (0)
#define TJ(t_) (rev ? j_hi - (t_) : j_lo + (t_))
    LOADT(TJ(0), 0); if (n > 1) LOADT(TJ(1), 1);
    WAIT_OLDER(n > 1);
    __builtin_amdgcn_s_barrier(); asm volatile("" ::: "memory");
    const int role = PP ? (c.wid >> 2) : 0, tqw = c.t0 + 8 * c.wid;
    const float NEG = -__builtin_inff();
    const float lp = RUNMAX ? 0.f : __builtin_amdgcn_logf(pscale);
    if (PP && role == 1) { __builtin_amdgcn_s_barrier(); asm volatile("" ::: "memory"); }
    int slot = 0;
#pragma unroll 1
    for (int t = 0; t < n; ++t) {
        const int j = TJ(t);
        const bool ldt = (t + 2 < n); const int lslot = slot == 0 ? 2 : slot - 1;
        if ((!PP || role == 1) && ldt) LOADT(TJ(t + 2), lslot);
        f32x16 p0, p1; float mul = C2, off = 0.f, alpha = 1.f; bool resc = false;
        const int kpos0 = STEP * (j * 64) + OFF;
        const int dmin = tqw - (kpos0 + STEP * 63), dmax = tqw + 7 - kpos0;
        bool rowsel = true;
        if (ROWSEL) { const unsigned wsel = (j < 32) ? sm0 : (j < 64) ? sm1 : (j < 96) ? sm2 : sm3; rowsel = (wsel >> (j & 31)) & 1u; }
        bool act = (dmax >= 0) && (dmin < (int)W);
        if (ROWSEL) act = act && __any(rowsel);
        if (act) {
            SBAR(); __builtin_amdgcn_s_setprio(2); qkt(p0, p1, K_lds + slot * SHM, r32, hi, c.qr); __builtin_amdgcn_s_setprio(0); SBAR();
            const bool needmask = (dmin < 0) || ((unsigned)dmax >= W);
            const int d0 = c.tq - kpos0 - STEP * 4 * hi;
            float add0 = c.bfar;
            if (dmin < 113) {
                if (STEP == 1) {
                    const LAS3 float* tbase = c.tb + (d0 + 5);
#pragma unroll
                    for (int r = 0; r < 16; ++r) { const int cc = (r & 3) + 8 * (r >> 2);
                        p0[r] = fmaf(p0[r], C2, tbase[59 - cc]); p1[r] = fmaf(p1[r], C2, tbase[59 - cc - 32]);
                        if ((r & 3) == 3) SBAR(); }
                } else {
#pragma unroll
                    for (int r = 0; r < 16; ++r) { const int cc = (r & 3) + 8 * (r >> 2); const int da = d0 - STEP * cc, db = d0 - STEP * (cc + 32);
                        const float ba = c.tb[64 + min(max(da, 0), 127)], bb = c.tb[64 + min(max(db, 0), 127)];
                        p0[r] = fmaf(p0[r], C2, ba); p1[r] = fmaf(p1[r], C2, bb);
                        if ((r & 3) == 3) SBAR(); }
                }
                mul = 1.f; add0 = 0.f;
            }
            if (needmask) {
#pragma unroll
                for (int r = 0; r < 16; ++r) { const int cc = (r & 3) + 8 * (r >> 2); const int da = d0 - STEP * cc, db = d0 - STEP * (cc + 32);
                    if ((unsigned)da >= W) p0[r] = NEG; if ((unsigned)db >= W) p1[r] = NEG; }
            }
            SBAR();
            if (RUNMAX) {
                float pm = fmaxf(p0[0], p1[0]);
#pragma unroll
                for (int r = 1; r < 16; ++r) pm = fmaxf(fmaxf(pm, p0[r]), p1[r]);
                pm = half_max(pm);
                float xmax = fmaf(pm, mul, add0); if (ROWSEL) xmax = rowsel ? xmax : NEG;
                float mn = m_reg;
                if (MODE != MODE_ONLINE || !__all(xmax - m_reg <= 8.0f)) { mn = fmaxf(m_reg, xmax); alpha = __builtin_amdgcn_exp2f(m_reg - mn); m_reg = mn; }
                off = add0 - mn; if (ROWSEL) off = rowsel ? off : NEG;
                if (MODE == MODE_ONLINE) { resc = __any(alpha < 1.f); if (resc && hi == 0) al_l[r32] = alpha; }
            } else off = (add0 - m_reg) + lp;
        }
        if (PP) STEP_END(role == 1, ldt);
        if (PP && role == 0 && ldt) LOADT(TJ(t + 2), lslot);
        if (act) {
#pragma unroll
            for (int r = 0; r < 16; ++r) { p0[r] = __builtin_amdgcn_exp2f(fmaf(p0[r], mul, off)); p1[r] = __builtin_amdgcn_exp2f(fmaf(p1[r], mul, off)); }
            if (RUNMAX) {
                float ps = 0.f;
#pragma unroll
                for (int r = 0; r < 16; ++r) ps += p0[r] + p1[r];
                ps = half_sum(ps);
                l_reg = l_reg * alpha + ps;
            }
            if (MODE == MODE_IMP || MODE == MODE_IMPACC) {
                LAS3 float* imp = (LAS3 float*)(c.lds + L_IMP) + (c.wid * 8 + (r32 >> 2)) * 128;
#pragma unroll
                for (int hf = 0; hf < 2; ++hf)
#pragma unroll
                    for (int m = 0; m < 4; ++m) { const f32x16& P = hf ? p1 : p0;
                        float a = 2.f * (P[4 * m] + P[4 * m + 1] + P[4 * m + 2]) + P[4 * m + 3], b = P[4 * m + 3];
                        a += xor1_f(a); b += xor1_f(b); a += xor2_f(a); b += xor2_f(b);
                        const int jj = 16 * j + 8 * hf + 2 * m + hi;
                        if ((r32 & 3) == 0) { __hip_atomic_fetch_add(imp + jj, a, __ATOMIC_RELAXED, __HIP_MEMORY_SCOPE_WORKGROUP);
                            if (jj + 1 < 128) __hip_atomic_fetch_add(imp + jj + 1, b, __ATOMIC_RELAXED, __HIP_MEMORY_SCOPE_WORKGROUP); } }
            }
            if (MODE == MODE_IMPACC) {
#pragma unroll
                for (int r = 0; r < 16; ++r) { p0[r] *= gate; p1[r] *= gate; }
            }
            if (HASV) {
                bf16x8 pa0, pa1, pa2, pa3;
                SBAR(); pack_p(p0, p1, pa0, pa1, pa2, pa3); SBAR();
                if (MODE == MODE_ONLINE && resc) {
#pragma unroll
                    for (int d_ = 0; d_ < 4; ++d_)
#pragma unroll
                        for (int r = 0; r < 16; ++r) c.o[d_][r] *= al_l[crow(r, hi)];
                    SBAR(); }
                pv_tile(c.o, vbase + slot * SHM, pa0, pa1, pa2, pa3);
            }
        }
        STEP_END(role == 0, ldt);
        slot = slot == 2 ? 0 : slot + 1;
    }
    if (PP && role == 0) { __builtin_amdgcn_s_barrier(); asm volatile("" ::: "memory"); }
#undef TJ
#undef STEP_END
#undef WAIT_OLDER
#undef LOADT
}
__device__ __forceinline__ void attn_unit(LAS3 char* lds, const bf16_t* __restrict__ proj, const bf16_t* __restrict__ kc, const bf16_t* __restrict__ vc, bf16_t* __restrict__ oa, float* park, int qt, int g, bool rev) {
    int tid_ = threadIdx.x; asm volatile("" : "+v"(tid_));
    Ctx c; c.lds = lds; c.tid = tid_; c.lane = c.tid & 63; c.wid = __builtin_amdgcn_readfirstlane(c.tid >> 6); c.r32 = c.lane & 31; c.hi = c.lane >> 5;
    c.t0 = qt * 64; c.tq = c.t0 + 8 * c.wid + (c.r32 >> 2);
    const int head = g * 4 + (c.r32 & 3);
    c.tb = (const LAS3 float*)(lds + LDS_BIAS) + head * 256; c.bfar = c.tb[64 + 127];
    { const bf16_t* qp = proj + (size_t)c.tq * NP + C_Q + head * HD + c.hi * 8;
#pragma unroll
      for (int d0 = 0; d0 < 8; ++d0) c.qr[d0] = *(const bf16x8*)(qp + d0 * 16); }
    float ga[3];
    { const bf16_t* gp = proj + (size_t)c.tq * NP + C_GA + head * 3;
#pragma unroll
      for (int b = 0; b < 3; ++b) ga[b] = pg8::fast_sigmoid(__uint_as_float(((unsigned)gp[b]) << 16)); }
    { LAS3 f32x4* z = (LAS3 f32x4*)(lds + L_IMP);
#pragma unroll
      for (int i = 0; i < 4; ++i) z[c.tid + 512 * i] = (f32x4){0.f, 0.f, 0.f, 0.f}; }
    __syncthreads();
    const bf16_t* Kc = kc + g * HD; const bf16_t* Vc = vc + g * HD;
    const bf16_t* Ks = proj + C_KV + 2 * 512 + g * HD; const bf16_t* Vs = proj + C_KV + 3 * 512 + g * HD;
    const bf16_t* Kw = proj + C_KV + 4 * 512 + g * HD; const bf16_t* Vw = proj + C_KV + 5 * 512 + g * HD;
    const int ntc = (4 * qt + 2) / 64;
    constexpr unsigned WINF = 0x7fffffffu;
    LAS3 float* wsf = (LAS3 float*)(lds + L_WS) + c.wid * 64;
#define PARK_PTR(sl_) int pt_ = c.tid; asm volatile("" : "+v"(pt_)); char* pp_ = (char*)park + ((size_t)blockIdx.x * 32 * 512 + (size_t)(sl_) * 16 * 512 + pt_) * 16
#define PARK_STORE(sl_) do { PARK_PTR(sl_); _Pragma("unroll") for (int d_ = 0; d_ < 4; ++d_) _Pragma("unroll") for (int q_ = 0; q_ < 4; ++q_) { \
        *(f32x4*)pp_ = (f32x4){c.o[d_][4 * q_], c.o[d_][4 * q_ + 1], c.o[d_][4 * q_ + 2], c.o[d_][4 * q_ + 3]}; pp_ += 8192; } } while (0)
#define PARK_ADD(sl_) do { PARK_PTR(sl_); _Pragma("unroll") for (int hh_ = 0; hh_ < 2; ++hh_) { f32x4 t_[8]; _Pragma("unroll") for (int e_ = 0; e_ < 8; ++e_) { t_[e_] = *(const f32x4*)pp_; pp_ += 8192; } SBAR(); \
        _Pragma("unroll") for (int e_ = 0; e_ < 8; ++e_) { const int d_ = hh_ * 2 + (e_ >> 2), q_ = e_ & 3; \
        c.o[d_][4 * q_] += t_[e_][0]; c.o[d_][4 * q_ + 1] += t_[e_][1]; c.o[d_][4 * q_ + 2] += t_[e_][2]; c.o[d_][4 * q_ + 3] += t_[e_][3]; } SBAR(); } } while (0)
#define ROW_SCALE(f_) do { if (c.hi == 0) wsf[c.r32] = (f_); LDS_WAIT(); _Pragma("unroll") for (int d_ = 0; d_ < 4; ++d_) _Pragma("unroll") for (int r = 0; r < 16; ++r) c.o[d_][r] *= wsf[crow(r, c.hi)]; } while (0)
#ifndef AREP
#define AREP 0
#endif
    {
        float m_c = -1e30f, l_c = 0.f;
        run_pass<MODE_STAT, 16, 31, false, false>(c, Kc, Vc, 512, 0, ntc, WINF, m_c, l_c, 0.f, 0u, 0u, 0u, 0u);
        const float rl_c = l_c > 0.f ? 1.0f / l_c : 0.f;
#pragma unroll
        for (int d_ = 0; d_ < 4; ++d_) c.o[d_] = f32x16{};
        run_pass<MODE_IMPACC, 16, 31, false, false>(c, Kc, Vc, 512, 0, ntc, WINF, m_c, l_c, rl_c, 0u, 0u, 0u, 0u, ga[0]);
        PARK_STORE(0);
    }
    {
        LAS3 unsigned* selw = (LAS3 unsigned*)(lds + L_SEL);
#pragma unroll 1
        for (int tk = 0; tk < 8; ++tk) {
            const int tok = c.wid * 8 + tk; const LAS3 float* imp = (const LAS3 float*)(lds + L_IMP) + tok * 128;
            const int ja = c.lane, jb = c.lane + 64;
            unsigned ka = __float_as_uint(imp[ja]) + 1u, kb = __float_as_uint(imp[jb]) + 1u;
            ka = (ja == 0 || ja == qt || ja == qt - 1) ? 0xffffffffu : (ja > qt ? 0u : ka);
            kb = (jb == qt || jb == qt - 1) ? 0xffffffffu : (jb > qt ? 0u : kb);
            unsigned T = 0u;
#pragma unroll 1
            for (int bit = 31; bit >= 0; --bit) { const unsigned cand = T | (1u << bit);
                const int cnt = __popcll(__ballot(ka >= cand)) + __popcll(__ballot(kb >= cand));
                T = cnt >= 16 ? cand : T; }
            const int cgt = __popcll(__ballot(ka > T)) + __popcll(__ballot(kb > T)); const int rr = 16 - cgt;
            const unsigned long long ea = __ballot(ka == T), eb = __ballot(kb == T);
            const int ra = __builtin_amdgcn_mbcnt_hi((unsigned)(ea >> 32), __builtin_amdgcn_mbcnt_lo((unsigned)ea, 0u));
            const int rb = __popcll(ea) + (int)__builtin_amdgcn_mbcnt_hi((unsigned)(eb >> 32), __builtin_amdgcn_mbcnt_lo((unsigned)eb, 0u));
            const unsigned long long ba = __ballot(ka > T || (ka == T && ra < rr)), bb = __ballot(kb > T || (kb == T && rb < rr));
            if (c.lane == 0) { selw[tok * 4 + 0] = (unsigned)ba; selw[tok * 4 + 1] = (unsigned)(ba >> 32); selw[tok * 4 + 2] = (unsigned)bb; selw[tok * 4 + 3] = (unsigned)(bb >> 32); }
        }
        LDS_WAIT();
    }
    {
        float m_w = -1e30f, l_w = 0.f; const int jlo = qt >= 8 ? qt - 8 : 0;
#pragma unroll
        for (int d_ = 0; d_ < 4; ++d_) c.o[d_] = f32x16{};
        run_pass<MODE_ONLINE, 1, 0, false, false>(c, Kw, Vw, NP, jlo, qt, 512u, m_w, l_w, 0.f, 0u, 0u, 0u, 0u);
        ROW_SCALE(ga[2] / l_w);
        PARK_STORE(1);
    }
    unsigned zr[64];
    {
        unsigned sm0, sm1, sm2, sm3;
        { const LAS3 unsigned* selw = (const LAS3 unsigned*)(lds + L_SEL) + (c.wid * 8 + (c.r32 >> 2)) * 4; sm0 = selw[0]; sm1 = selw[1]; sm2 = selw[2]; sm3 = selw[3]; }
        float m_s = -1e30f, l_s = 0.f;
#pragma unroll
        for (int d_ = 0; d_ < 4; ++d_) c.o[d_] = f32x16{};
        run_pass<MODE_ONLINE, 1, 0, true, true>(c, Ks, Vs, NP, 0, qt, WINF, m_s, l_s, 0.f, sm0, sm1, sm2, sm3, 1.f, rev);
        { int r32_ = c.r32; asm volatile("" : "+v"(r32_));
          const char* zbase = (const char*)(proj + C_ZA + g * 4 * HD);
#pragma unroll
          for (int r = 0; r < 16; ++r) { const int row = crow(r, c.hi); const int tok = c.t0 + 8 * c.wid + (row >> 2), hd = row & 3; const unsigned zo = (unsigned)(tok * NP + hd * HD + r32_) * 2u;
#pragma unroll
              for (int d0 = 0; d0 < 4; ++d0) zr[r * 4 + d0] = *(const unsigned short*)(zbase + zo + d0 * 64); } }
        SBAR();
        ROW_SCALE(ga[1] / l_s);
        PARK_ADD(0);
        PARK_ADD(1);
    }
#undef PARK_STORE
#undef PARK_ADD
#undef ROW_SCALE
#ifdef NO_EPI
    if (c.o[0][0] == 123.f && c.o[1][1] == 3.f && c.o[2][2] == 1.f && c.o[3][3] == 5.f) oa[0] = 1;
    if (false)
#endif
    {
        const int tw = c.t0 + 8 * c.wid; const bool odd = (c.r32 & 1) != 0;
        char* obase = (char*)(oa + g * 4 * HD);
#pragma unroll
        for (int r = 0; r < 16; ++r) { const int row = crow(r, c.hi); const int tok = tw + (row >> 2), hd = row & 3;
            const unsigned oo = (unsigned)(tok * AW + hd * HD + c.r32) * 2u;
#pragma unroll
            for (int p = 0; p < 2; ++p) { const float za = __uint_as_float(zr[r * 4 + 2 * p] << 16), zb = __uint_as_float(zr[r * 4 + 2 * p + 1] << 16);
                const float a = c.o[2 * p][r] * za * pg8::fast_sigmoid(za), b = c.o[2 * p + 1][r] * zb * pg8::fast_sigmoid(zb);
                const float recv = xor1_f(odd ? a : b);
                const unsigned w = cvtpk(odd ? recv : a, odd ? b : recv);
                *(unsigned*)(obase + (odd ? oo + (2 * p + 1) * 64 - 2u : oo + (2 * p) * 64)) = w; }
        }
    }
    __syncthreads();
}
__device__ __forceinline__ void phase_attn(LAS3 char* lds, const bf16_t* proj, const bf16_t* kc, const bf16_t* vc, bf16_t* oa, float* park, int vcu, int G) {
#pragma unroll 1
    for (int item = vcu; item < 256; item += G) {
        const int g = item >> 6, p = item & 63;
#pragma unroll 1
        for (int s = 0; s < 2; ++s) attn_unit(lds, proj, kc, vc, oa, park, s ? p : 127 - p, g, s != 0);
    }
}
}
__device__ __forceinline__ float gelu_tanh(float x) { const float y = 1.5957691216057308f * (x + 0.044715f * x * x * x); return x * pg8::fast_sigmoid(y); }
__device__ __forceinline__ float silu_f(float x) { return x * pg8::fast_sigmoid(x); }
__device__ __forceinline__ void compress_unit(LAS3 char* lds, const bf16_t* __restrict__ proj, const float* __restrict__ pe, const bf16_t* __restrict__ w1t, const bf16_t* __restrict__ w2t,
                                              bf16_t* __restrict__ outc, int u, int which) {
    int tid_o = threadIdx.x; asm volatile("" : "+v"(tid_o));
    const int tid = tid_o, lane = tid & 63, wid = __builtin_amdgcn_readfirstlane(tid >> 6), r32 = lane & 31, hi = lane >> 5;
    const int i = 8 * u + (r32 >> 2), g = r32 & 3;
    f32x16 acc[4];
#pragma unroll
    for (int nb = 0; nb < 4; ++nb) acc[nb] = f32x16{};
    const bf16_t* abase = proj + C_KV + which * 512 + g * HD + hi * 8;
    const bf16_t* bbase = w1t + (size_t)(wid * 32) * 2048 + lane * 8;
#pragma unroll 1
    for (int lt = 0; lt < 4; ++lt) {
        const int l = wid * 4 + lt; int tokn = 16 * i + l; tokn = tokn < T ? tokn : T - 1;
        const bf16_t* ap = abase + (size_t)tokn * NP; const float* pp = pe + l * HD + hi * 8;
#pragma unroll
        for (int hf = 0; hf < 2; ++hf) {
            u32x4 araw[4]; f32x4 e0[4], e1[4]; bf16x8 bfr[4][4];
#pragma unroll
            for (int k = 0; k < 4; ++k) { const int k8 = hf * 4 + k; araw[k] = *(const u32x4*)(ap + k8 * 16); e0[k] = *(const f32x4*)(pp + k8 * 16); e1[k] = *(const f32x4*)(pp + k8 * 16 + 4);
#pragma unroll
                for (int nb = 0; nb < 4; ++nb) bfr[k][nb] = *(const bf16x8*)(bbase + (size_t)((lt * 8 + k8) * 4 + nb) * 512); }
            __builtin_amdgcn_sched_barrier(0);
#pragma unroll
            for (int k = 0; k < 4; ++k) { const u32x4 raw = araw[k];
                u32x4 aw; aw.x = pk2(pg8::bf_lo(raw.x) + e0[k][0], pg8::bf_hi(raw.x) + e0[k][1]); aw.y = pk2(pg8::bf_lo(raw.y) + e0[k][2], pg8::bf_hi(raw.y) + e0[k][3]);
                aw.z = pk2(pg8::bf_lo(raw.z) + e1[k][0], pg8::bf_hi(raw.z) + e1[k][1]); aw.w = pk2(pg8::bf_lo(raw.w) + e1[k][2], pg8::bf_hi(raw.w) + e1[k][3]);
                const bf16x8 a = *reinterpret_cast<const bf16x8*>(&aw);
#pragma unroll
                for (int nb = 0; nb < 4; ++nb) acc[nb] = __builtin_amdgcn_mfma_f32_32x32x16_bf16(a, bfr[k][nb], acc[nb], 0, 0, 0); }
            __builtin_amdgcn_sched_barrier(0);
        }
    }
    bf16x8 b2[8];
#pragma unroll
    for (int ks = 0; ks < 8; ++ks) b2[ks] = *(const bf16x8*)(w2t + (size_t)((wid & 3) * 32 + r32) * HD + ks * 16 + hi * 8);
    LAS3 float* part = (LAS3 float*)lds + wid * 4096;
#pragma unroll
    for (int nb = 0; nb < 4; ++nb)
#pragma unroll
        for (int r = 0; r < 16; ++r) part[att::crow(r, hi) * 128 + nb * 32 + r32] = acc[nb][r];
    __syncthreads();
    f32x4 s0 = {0.f, 0.f, 0.f, 0.f}, s1 = {0.f, 0.f, 0.f, 0.f};
#pragma unroll
    for (int w = 0; w < 8; ++w) { const LAS3 f32x4* p = (const LAS3 f32x4*)((LAS3 float*)lds + w * 4096 + tid * 8); s0 += p[0]; s1 += p[1]; }
    __syncthreads();
    {
        u32x4 hw; hw.x = pk2(silu_f(s0[0]), silu_f(s0[1])); hw.y = pk2(silu_f(s0[2]), silu_f(s0[3])); hw.z = pk2(silu_f(s1[0]), silu_f(s1[1])); hw.w = pk2(silu_f(s1[2]), silu_f(s1[3]));
        const int row = tid >> 4, col = (tid & 15) * 8;
        *(LAS3 u32x4*)(lds + (row * 136 + col) * 2) = hw;
    }
    __syncthreads();
    if (wid < 4) {
        f32x16 o2 = f32x16{};
#pragma unroll
        for (int ks = 0; ks < 8; ++ks) { const bf16x8 a = *(const LAS3 bf16x8*)(lds + (r32 * 136 + ks * 16 + hi * 8) * 2);
            o2 = __builtin_amdgcn_mfma_f32_32x32x16_bf16(a, b2[ks], o2, 0, 0, 0); }
#pragma unroll
        for (int r = 0; r < 16; ++r) { const int row = att::crow(r, hi); const int ii = 8 * u + (row >> 2), gg = row & 3;
            const float v = ii < NCMP ? o2[r] : 0.f; const float vn = xor1_f(v);
            if ((r32 & 1) == 0) *(unsigned*)(outc + (size_t)(ii * 4 + gg) * HD + wid * 32 + r32) = pk2(v, vn); }
    }
    __syncthreads();
}
#define SWAP32(A_, B_) do { const unsigned a__ = (A_), b__ = (B_); auto r__ = __builtin_amdgcn_permlane32_swap(a__, b__, false, false); const unsigned r0__ = r__[0], r1__ = r__[1]; (A_) = r0__; (B_) = r1__; } while (0)
__device__ __forceinline__ void gmlp_unit(LAS3 char* lds, const bf16_t* __restrict__ proj, const float* __restrict__ sspart, const float* __restrict__ gain, const float* __restrict__ sw, const float* __restrict__ sb,
                                          bf16_t* __restrict__ ob, int ch, int qd) {
    int tid_o = threadIdx.x; asm volatile("" : "+v"(tid_o));
    const int tid = tid_o, lane = tid & 63, wid = __builtin_amdgcn_readfirstlane(tid >> 6), r32 = lane & 31, hi = lane >> 5;
    const int tc0 = ch * 128;
    LAS3 float* rsl = (LAS3 float*)(lds + LDS_RS);
    {   const int vkk = ((tid >> 7) * 8) + ((tid & 31) >> 2), vkey = (vkk & ~0xC) | ((vkk & 4) << 1) | ((vkk & 8) >> 1), vcol = ((tid >> 5) & 3) * 32 + (tid & 3) * 8;
        const unsigned vo0 = (unsigned)(vkey * NP + vcol) * 2u; const unsigned half_step = (unsigned)(32 * NP) * 2u;
#pragma unroll
        for (int gg = 0; gg < 4; ++gg)
#pragma unroll
            for (int kt = 0; kt < 2; ++kt) { const char* vp_ = (const char*)(proj + (size_t)(tc0 + kt * 64) * NP + C_VB + (qd * 4 + gg) * 128); LAS3 char* vd_ = lds + (gg * 2 + kt) * att::SHM + wid * 1024;
                __builtin_amdgcn_global_load_lds((const unsigned*)(vp_ + vo0), (LAS3 unsigned*)vd_, 16, 0, 0);
                __builtin_amdgcn_global_load_lds((const unsigned*)((vp_ + half_step) + vo0), (LAS3 unsigned*)(vd_ + 8192), 16, 0, 0); } }
    if (tid < 128) { const f32x4* sp = (const f32x4*)(sspart + (size_t)(tc0 + tid) * 32); f32x4 s = sp[0];
#pragma unroll
        for (int i = 1; i < 8; ++i) s += sp[i];
        rsl[tid] = 1.0f / sqrtf(((s[0] + s[1]) + (s[2] + s[3])) * (1.0f / BW) + NORM_EPS); }
    VM_WAIT();
    __syncthreads();
    const int gg = wid >> 1, wd = wid & 1, G = qd * 4 + gg, cb = G * 128;
    const int vb1 = (int)(uintptr_t)(lds) + gg * 2 * att::SHM + att::v_rd_base(lane) + wd * 1024;
    f32x4 gn[2][4];
#pragma unroll
    for (int dd = 0; dd < 2; ++dd)
#pragma unroll
        for (int m = 0; m < 4; ++m) gn[dd][m] = *(const f32x4*)(gain + cb + (wd * 2 + dd) * 32 + 8 * m + 4 * hi);
#pragma unroll 1
    for (int pb = 0; pb < 4; ++pb) {
        const int p = pb * 32 + r32; const size_t tok = (size_t)(tc0 + p); const int nks = 2 * pb + 2;
        f32x4 wr0[8], wr1[8];
        const float* wrow = sw + ((size_t)((G * 4 + pb) * 8) * 64 + lane) * 8;
#pragma unroll
        for (int ks = 0; ks < 8; ++ks) if (ks < nks) { wr0[ks] = *(const f32x4*)(wrow + ks * 512); wr1[ks] = *(const f32x4*)(wrow + ks * 512 + 4); }
        const char* ubase = (const char*)(proj + tok * NP + C_UB + cb); const char* zbase = (const char*)(proj + tok * NP + C_ZB + cb); char* obase = (char*)(ob + tok * BW + cb);
        u32x4 uq[4], zq[4];
#pragma unroll
        for (int m = 0; m < 4; ++m) { const int dq = wd * 64 + 8 * m + 32 * hi; uq[m] = *(const u32x4*)(ubase + dq * 2); zq[m] = *(const u32x4*)(zbase + dq * 2); }
        const float bs = sb[G * 128 + p];
        __builtin_amdgcn_sched_barrier(0);
        bf16x8 af[8];
#pragma unroll
        for (int ks = 0; ks < 8; ++ks) { if (ks < nks) { const f32x4 a0 = wr0[ks], a1 = wr1[ks]; const int q0 = ks * 16 + hi * 8;
                const f32x4 r0 = *(const LAS3 f32x4*)(rsl + q0), r1 = *(const LAS3 f32x4*)(rsl + q0 + 4);
                u32x4 w; w.x = pk2(q0 + 0 <= p ? a0[0] * r0[0] : 0.f, q0 + 1 <= p ? a0[1] * r0[1] : 0.f); w.y = pk2(q0 + 2 <= p ? a0[2] * r0[2] : 0.f, q0 + 3 <= p ? a0[3] * r0[3] : 0.f);
                w.z = pk2(q0 + 4 <= p ? a1[0] * r1[0] : 0.f, q0 + 5 <= p ? a1[1] * r1[1] : 0.f); w.w = pk2(q0 + 6 <= p ? a1[2] * r1[2] : 0.f, q0 + 7 <= p ? a1[3] * r1[3] : 0.f);
                af[ks] = *reinterpret_cast<const bf16x8*>(&w); } else af[ks] = bf16x8{}; }
        f32x16 acc[2] = {f32x16{}, f32x16{}};
#define TRRD(dst, off) asm volatile("ds_read_b64_tr_b16 %0, %1 offset:%2" : "=&v"(dst) : "v"(vb1), "i"(off) : "memory")
#define GM_STEP(ks) do { if ((ks) < nks) { s16x4 l0, h0, l1, h1; constexpr int o_ = ((ks) >> 2) * att::SHM + att::v_rd_off(0, (ks) & 3, 0); \
            TRRD(l0, o_); TRRD(h0, o_ + 2048); TRRD(l1, o_ + 512); TRRD(h1, o_ + 512 + 2048); \
            asm volatile("s_waitcnt lgkmcnt(0)" ::: "memory"); __builtin_amdgcn_sched_barrier(0); \
            acc[0] = __builtin_amdgcn_mfma_f32_32x32x16_bf16((bf16x8){l0[0], l0[1], l0[2], l0[3], h0[0], h0[1], h0[2], h0[3]}, af[ks], acc[0], 0, 0, 0); \
            acc[1] = __builtin_amdgcn_mfma_f32_32x32x16_bf16((bf16x8){l1[0], l1[1], l1[2], l1[3], h1[0], h1[1], h1[2], h1[3]}, af[ks], acc[1], 0, 0, 0); } } while (0)
        GM_STEP(0); GM_STEP(1); GM_STEP(2); GM_STEP(3); GM_STEP(4); GM_STEP(5); GM_STEP(6); GM_STEP(7);
#undef GM_STEP
#undef TRRD
#pragma unroll
        for (int m = 0; m < 4; ++m) { SWAP32(uq[m].x, uq[m].z); SWAP32(uq[m].y, uq[m].w); SWAP32(zq[m].x, zq[m].z); SWAP32(zq[m].y, zq[m].w); }
#pragma unroll
        for (int m = 0; m < 4; ++m) { u32x4 ow;
#pragma unroll
            for (int dd = 0; dd < 2; ++dd) { const unsigned ux = dd ? uq[m].z : uq[m].x, uy = dd ? uq[m].w : uq[m].y, zx = dd ? zq[m].z : zq[m].x, zy = dd ? zq[m].w : zq[m].y; const f32x4 g4 = gn[dd][m];
                const float o0 = gelu_tanh(pg8::bf_lo(ux)) * (acc[dd][4 * m + 0] * g4[0] + bs) * silu_f(pg8::bf_lo(zx));
                const float o1 = gelu_tanh(pg8::bf_hi(ux)) * (acc[dd][4 * m + 1] * g4[1] + bs) * silu_f(pg8::bf_hi(zx));
                const float o2 = gelu_tanh(pg8::bf_lo(uy)) * (acc[dd][4 * m + 2] * g4[2] + bs) * silu_f(pg8::bf_lo(zy));
                const float o3 = gelu_tanh(pg8::bf_hi(uy)) * (acc[dd][4 * m + 3] * g4[3] + bs) * silu_f(pg8::bf_hi(zy));
                if (dd == 0) { ow.x = pk2(o0, o1); ow.y = pk2(o2, o3); } else { ow.z = pk2(o0, o1); ow.w = pk2(o2, o3); } }
            SWAP32(ow.x, ow.z); SWAP32(ow.y, ow.w);
            *(u32x4*)(obase + (wd * 64 + 8 * m + 32 * hi) * 2) = ow; }
    }
    __syncthreads();
}
#ifndef N_LAUNCH_MODE
#define N_LAUNCH_MODE 1
#endif
constexpr int NPHASES = 1 + 6 * DEPTH;
#ifndef PHMASK
#define PHMASK 0x7f
#endif
#ifndef REPMASK
#define REPMASK 0
#endif
#define REPS(bit) ((REPMASK & (bit)) ? 2 : 1)
__global__ void __launch_bounds__(NTHREADS, 2) fwd_kernel(Params P) {
    extern __shared__ __attribute__((aligned(16))) unsigned char lds_raw[];
    LAS3 unsigned char* lds = (LAS3 unsigned char*)lds_raw;
    const int tid = threadIdx.x, wave = __builtin_amdgcn_readfirstlane(tid >> 6);
#define lane hw_lane_id()
    const int G = gridDim.x; const int bx = blockIdx.x; const int vcu = (G % 8 == 0) ? (bx % 8) * (G / 8) + bx / 8 : bx;
    const int gw = vcu * NWAVES + wave, NGW = G * NWAVES;
    unsigned char* ws = P.ws;
    if (tid < 16) ((LAS3 unsigned*)(lds + LDS_MISC))[tid] = 0u;
    __syncthreads();
    XcdBarrier bar; bar.bar = (unsigned*)(ws + WS_CTL); bar.x = 0; bar.st = nullptr;
    if (N_LAUNCH_MODE == 1) bar = xcd_barrier_post((unsigned*)(ws + WS_CTL), (volatile LAS unsigned*)(lds + LDS_MISC));
    const int lo = P.ph_lo, hi = P.ph_hi;
#define IN(k) (lo <= (k) && (k) < hi)
#define SEAM(k) do { if (IN(k) && IN((k) + 1)) xcd_barrier(bar); } while (0)
    bf16_t* hbuf = (bf16_t*)(ws + WS_H); bf16_t* proj = (bf16_t*)(ws + WS_PROJ); bf16_t* kc = (bf16_t*)(ws + WS_KC); bf16_t* vc = (bf16_t*)(ws + WS_VC);
    bf16_t* oa = (bf16_t*)(ws + WS_OA); bf16_t* ob = (bf16_t*)(ws + WS_OB); bf16_t* t1 = (bf16_t*)(ws + WS_T1); bf16_t* mg = (bf16_t*)(ws + WS_MG);
    bf16_t* Y = (bf16_t*)(ws + WS_Y); bf16_t* x1 = (bf16_t*)(ws + WS_X1);
    constexpr int NU_PROJ = (T / 256) * (NP / 256);
#pragma unroll 1
    for (int w = 0; w < 2; ++w) {
        const int rem = NU_PROJ % G; const bool tailcu = (rem != 0) && (bx >= rem);
        const bool doit = (w == 0) ? (IN(0) && (PHMASK & 1)) : (IN(1) && tailcu);
        const bool alltail = (rem == 0);
        if (doit) {
            const int lo_ = (w == 0) ? 0 : W_ITEMS - W_TAIL_ITEMS, hi_ = (w == 0) ? (alltail ? W_ITEMS : W_ITEMS - W_TAIL_ITEMS) : W_ITEMS;
            const int gw_ = (w == 0) ? gw : (bx - rem) * NWAVES + wave, ngw_ = (w == 0) ? NGW : (G - rem) * NWAVES;
            for (int rep = 0; rep < REPS(1); ++rep) phase_weights(P, lds, gw_, ngw_, wave, lane, lo_, hi_);
        }
        if (w == 0 && IN(0) && (PHMASK & 1)) {
            for (int i = bx * NTHREADS + tid; i < DEPTH * 16 * 4 * 8 * 64; i += G * NTHREADS) { const int ln = i & 63, ks = (i >> 6) & 7, pbk = (i >> 9) & 3, lg = i >> 11;
                const float* src = P.sgu_w + ((size_t)lg * 128 + 32 * pbk + (ln & 31)) * 128 + 16 * ks + 8 * (ln >> 5);
                float* dst = (float*)(ws + WS_SGW) + (size_t)i * 8;
                const f32x4 a = *(const f32x4*)src, b = *(const f32x4*)(src + 4); *(f32x4*)dst = a; *(f32x4*)(dst + 4) = b; } }
        if (w == 0 && IN(0) && (PHMASK & 1)) for (int rep = 0; rep < REPS(128); ++rep) phase_prenorm(P.x, P.pre_norm, hbuf, gw, NGW, lane);
        __syncthreads();
        {   unsigned bk[8]; float bv[8];
#pragma unroll
            for (int q = 0; q < 8; ++q) { const int i = tid + q * NTHREADS; int dd = (i & 255) - 64; dd = dd < 0 ? 0 : (dd > 127 ? 127 : dd); bk[q] = BUCKET[dd]; }
            __builtin_amdgcn_sched_barrier(0);
#pragma unroll
            for (int q = 0; q < 8; ++q) { const int i = tid + q * NTHREADS; bv[q] = P.rel_bias[bk[q] * 16 + (i >> 8)]; }
            __builtin_amdgcn_sched_barrier(0);
#pragma unroll
            for (int q = 0; q < 8; ++q) ((LAS3 float*)(lds + LDS_BIAS))[tid + q * NTHREADS] = bv[q] * att::LOG2E; }
        __syncthreads();
        if (w == 0) SEAM(0);
    }
#pragma unroll 1
    for (int L = 0; L < DEPTH; ++L) {
        const int pb = 1 + 6 * L;
        constexpr int PN_EARLY = 80, PN_LATE = NP / 256 - PN_EARLY, N_LATE_UNITS = (T / 256) * PN_LATE;
#pragma unroll 1
        for (int half = 0; half < 2; ++half) {
            if (IN(pb + half) && (PHMASK & 2)) for (int rep = 0; rep < REPS(2); ++rep) {
                pg8::Gemm g{hbuf, (const bf16_t*)(ws + WS_WIN + L * SZ_WIN), T, NP, DM, nullptr, nullptr}; pg8::ProjOrder S; S.init2(T, PN_EARLY, PN_LATE, G, bx, half);
                pg8::EpiProj E{proj, NP, (float*)(ws + WS_SS)};
                pg8::gemm_phase<pg8::EpiProj, pg8::ProjOrder>(lds + LDS_STAGE, g, S, E, nullptr);
            }
            if (half == 0) SEAM(pb);
        }
        if (IN(pb + 1) && (PHMASK & 4)) for (int rep = 0; rep < REPS(4); ++rep) {
#pragma unroll 1
            for (int q = 0; ; ++q) {
                int item;
                if (G == 256) {
                    if (bx >= N_LATE_UNITS) { const int k = bx - N_LATE_UNITS;
                        if (k < 64) { if (q >= 4) break; item = q < 3 ? 3 * k + q : 256 + k; }
                        else { if (q >= 4) break; item = q < 2 ? 192 + 2 * (k - 64) + q : 256 + 64 + 2 * (k - 64) + (q - 2); } }
                    else break;
                }
                else { item = bx + q * G; if (item >= 384) break; }
                if (item < 256) gmlp_unit((LAS3 char*)lds, proj, (const float*)(ws + WS_SS), P.sgu_norm + L * BW, (const float*)(ws + WS_SGW) + (size_t)L * 16 * 128 * 128, P.sgu_b + L * 16 * 128, ob, item >> 2, item & 3);
                else { const int ci = item - 256, which = ci & 1, u = ci >> 1;
                    compress_unit((LAS3 char*)lds, proj, (which ? P.pe_v : P.pe_k) + L * 32 * HD, (const bf16_t*)(ws + WS_W1 + (L * 2 + which) * SZ_W1), (const bf16_t*)(ws + WS_W2 + (L * 2 + which) * SZ_W2), which ? vc : kc, u, which); }
            }
        }
        SEAM(pb + 1);
        if (IN(pb + 2) && (PHMASK & 8)) for (int rep = 0; rep < REPS(8); ++rep) att::phase_attn((LAS3 char*)lds, proj, kc, vc, oa, (float*)(ws + WS_PARK), vcu, G);
        SEAM(pb + 2);
        if (IN(pb + 3) && (PHMASK & 16)) for (int rep = 0; rep < REPS(16); ++rep) {
            pg8::DualOrder S; S.init(T, DM, G, bx);
            pg8::Gemm g{oa, (const bf16_t*)(ws + WS_WA + L * SZ_WAB), T, DM, AW, ob, (const bf16_t*)(ws + WS_WB + L * SZ_WAB)};
            pg8::EpiMerge E{mg, DM, proj + C_MA, proj + C_MB, NP};
            pg8::gemm_phase<pg8::EpiMerge, pg8::DualOrder>(lds + LDS_STAGE, g, S, E, nullptr);
        }
        SEAM(pb + 3);
        if (IN(pb + 4) && (PHMASK & 32)) for (int rep = 0; rep < REPS(32); ++rep) {
            pg8::Gemm g{mg, (const bf16_t*)(ws + WS_WO + L * SZ_WO), T, DM, DM, nullptr, nullptr}; pg8::StaticOrder S; S.init(T, DM, G, bx);
            pg8::EpiBf16Plain E{Y, DM};
            pg8::gemm_phase<pg8::EpiBf16Plain, pg8::StaticOrder>(lds + LDS_STAGE, g, S, E, nullptr);
        }
        SEAM(pb + 4);
        if (IN(pb + 5) && (PHMASK & 64)) for (int rep = 0; rep < REPS(64); ++rep) {
            if (L == 0) phase_postnorm<false, true>(Y, P.x, P.post_norm, x1, P.pre_norm + DM, hbuf, true, gw, NGW, lane);
            else phase_postnorm<true, false>(Y, x1, P.post_norm + L * DM, P.out, P.pre_norm, hbuf, false, gw, NGW, lane);
        }
        SEAM(pb + 5);
    }
#undef IN
#undef SEAM
#undef lane
}
extern "C" void kernel_launch(void* const* d_in, const int* in_sizes, int n_in, void* d_out, int out_size, void* d_ws, size_t ws_size, hipStream_t stream) {
    static int grid = 0;
    if (grid == 0) {
        if (n_in != 17 || in_sizes[0] != T * DM || out_size != T * DM || ws_size < WS_END) { fprintf(stderr, "kernel_launch: unexpected shapes (n_in %d, in0 %d, out %d, ws %zu < %zu)\n", n_in, n_in > 0 ? in_sizes[0] : -1, out_size, ws_size, (size_t)WS_END); grid = -1; return; }
        int dev = 0, cus = 0, per_cu = 0;
        if (hipGetDevice(&dev) != hipSuccess || hipDeviceGetAttribute(&cus, hipDeviceAttributeMultiprocessorCount, dev) != hipSuccess) { grid = -1; return; }
        if (hipFuncSetAttribute((const void*)fwd_kernel, hipFuncAttributeMaxDynamicSharedMemorySize, LDS_BYTES) != hipSuccess) { fprintf(stderr, "kernel_launch: hipFuncSetAttribute failed\n"); grid = -1; return; }
        if (hipOccupancyMaxActiveBlocksPerMultiprocessor(&per_cu, (const void*)fwd_kernel, NTHREADS, LDS_BYTES) != hipSuccess || per_cu < 1) { fprintf(stderr, "kernel_launch: occupancy query says %d blocks per CU\n", per_cu); (void)hipGetLastError(); grid = -1; return; }
        grid = cus;
    }
    if (grid < 0) return;
    (void)hipMemsetAsync((char*)d_ws + WS_CTL, 0, CTL_BYTES, stream);
    Params p{};
    p.x = (const float*)d_in[0]; p.rel_bias = (const float*)d_in[1]; p.pre_norm = (const float*)d_in[2]; p.w_in = (const float*)d_in[3];
    p.pe_k = (const float*)d_in[4]; p.w1_k = (const float*)d_in[5]; p.w2_k = (const float*)d_in[6]; p.pe_v = (const float*)d_in[7]; p.w1_v = (const float*)d_in[8]; p.w2_v = (const float*)d_in[9];
    p.w_out_a = (const float*)d_in[10]; p.sgu_norm = (const float*)d_in[11]; p.sgu_w = (const float*)d_in[12]; p.sgu_b = (const float*)d_in[13]; p.w_out_b = (const float*)d_in[14]; p.w_out = (const float*)d_in[15]; p.post_norm = (const float*)d_in[16];
    p.out = (float*)d_out; p.ws = (unsigned char*)d_ws;
#if N_LAUNCH_MODE == 1
    p.ph_lo = 0; p.ph_hi = NPHASES;
    hipLaunchKernelGGL(fwd_kernel, dim3(grid), dim3(NTHREADS), LDS_BYTES, stream, p);
#else
    for (int k = 0; k < NPHASES; ++k) { p.ph_lo = k; p.ph_hi = k + 1; hipLaunchKernelGGL(fwd_kernel, dim3(grid), dim3(NTHREADS), LDS_BYTES, stream, p); }
#endif
}
```

```cpp
#include <hip/hip_runtime.h>
#include <cstdio>
#include <cstdint>
template <int CTRL> __device__ __forceinline__ float dpp_f(float v) { return __builtin_bit_cast(float, __builtin_amdgcn_update_dpp(0, __builtin_bit_cast(int, v), CTRL, 0xF, 0xF, true)); }
__device__ __forceinline__ float xor1_f(float v) { return dpp_f<0xB1>(v); }
__device__ __forceinline__ float xor2_f(float v) { return dpp_f<0x4E>(v); }
__device__ __forceinline__ float xor16_sum(float v) { const unsigned a = __builtin_bit_cast(unsigned, v); auto r = __builtin_amdgcn_permlane16_swap(a, a, false, false); const unsigned r0 = r[0], r1 = r[1]; return __builtin_bit_cast(float, r0) + __builtin_bit_cast(float, r1); }
__device__ __forceinline__ float xor32_sum(float v) { const unsigned a = __builtin_bit_cast(unsigned, v); auto r = __builtin_amdgcn_permlane32_swap(a, a, false, false); const unsigned r0 = r[0], r1 = r[1]; return __builtin_bit_cast(float, r0) + __builtin_bit_cast(float, r1); }
__device__ __forceinline__ int hw_lane_id() { int l; asm volatile("v_mbcnt_lo_u32_b32 %0, -1, 0\n\tv_mbcnt_hi_u32_b32 %0, -1, %0" : "=v"(l)); return l; }
namespace pg8 {
#define PG8_LAS __attribute__((address_space(3)))
typedef unsigned short bf16_t;
typedef short bf16x8 __attribute__((ext_vector_type(8)));
typedef float f32x4 __attribute__((ext_vector_type(4)));
typedef unsigned u32x4 __attribute__((ext_vector_type(4)));
constexpr int BM = 256, BK = 64, HALF = 128, HTB = HALF * BK * 2  , STAGE_BYTES = 8 * HTB, NXCD = 8, WGM = 8;

__host__ __device__ __forceinline__ int lds_byte(int r, int c) { const int st = (r >> 4) * 2 + (c >> 5), rr = r & 15, cc = c & 31, ob = rr * 64 + cc * 2; return st * 1024 + (ob ^ (((ob >> 9) & 1) << 5)); }
__host__ __device__ __forceinline__ void stage_rc(int b, int& R, int& C) { const int st = b / 1024, sb = b % 1024, swz = sb ^ (((sb >> 9) & 1) << 5); R = (st >> 1) * 16 + swz / 64; C = (st & 1) * 32 + (swz % 64) / 2; }
__host__ __device__ __forceinline__ int perm32(int rho) { const int n = rho >> 4, i = rho & 15; return 8 * (i >> 2) + 4 * n + (i & 3); }

struct Unit { int pm, pn, sub; };
struct Gemm { const bf16_t* A; const bf16_t* Bt; int M, N, K; const bf16_t* A2; const bf16_t* Bt2; };

struct StaticOrder {
    int nM, nN, nwg, G, c;
    __host__ __device__ void init(int M, int N, int G_, int c_) { nM = M / BM; nN = N / BM; nwg = nM * nN; G = G_; c = c_; }
    __host__ __device__ bool next(int i, Unit& u) const {
        const long L = (long)i * G + c; if (L >= nwg) return false;
        int wgid = (int)L; { const int q = nwg / NXCD, r = nwg % NXCD, xcd = wgid % NXCD, off = wgid / NXCD; wgid = (xcd < r ? xcd * (q + 1) : r * (q + 1) + (xcd - r) * q) + off; }
        const int nig = WGM * nN, gid = wgid / nig, fm = gid * WGM, gsz = (nM - fm) < WGM ? (nM - fm) : WGM;
        u.pm = fm + ((wgid % nig) % gsz); u.pn = (wgid % nig) / gsz; u.sub = 0; return true;
    }
    __device__ __forceinline__ void a_ready(const Unit&) const {}
    __device__ __forceinline__ void done(const Unit&) const {}
    static constexpr bool DUAL = false;
    __device__ __forceinline__ const bf16_t* baseA(const Gemm& g, const Unit&) const { return g.A; }
    __device__ __forceinline__ const bf16_t* baseB(const Gemm& g, const Unit&) const { return g.Bt; }
};
struct DualOrder : StaticOrder {
    static constexpr bool DUAL = true;
    __host__ __device__ bool next(int i, Unit& u) const { const bool ok = StaticOrder::next(i >> 1, u); u.sub = i & 1; return ok; }
    __device__ __forceinline__ const bf16_t* baseA(const Gemm& g, const Unit& u) const { return u.sub ? g.A2 : g.A; }
    __device__ __forceinline__ const bf16_t* baseB(const Gemm& g, const Unit& u) const { return u.sub ? g.Bt2 : g.Bt; }
};
typedef __bf16 bf16x2_t __attribute__((ext_vector_type(2)));
typedef float f32x2_t __attribute__((ext_vector_type(2)));
__device__ __forceinline__ unsigned cvt_pk_bf16(float lo, float hi) { const f32x2_t v = {lo, hi}; const bf16x2_t b = __builtin_convertvector(v, bf16x2_t); return __builtin_bit_cast(unsigned, b); }
typedef float f32x2 __attribute__((ext_vector_type(2)));
__device__ __forceinline__ float bf_lo(unsigned u) { return __uint_as_float(u << 16); }
__device__ __forceinline__ float bf_hi(unsigned u) { return __uint_as_float(u & 0xffff0000u); }
__device__ __forceinline__ float fast_sigmoid(float x) { return __builtin_amdgcn_rcpf(1.0f + __builtin_amdgcn_exp2f(-1.4426950408889634f * x)); }
struct EpiBf16Plain {
    static constexpr bool PERM = true, AFTER_DRAIN = false;
    bf16_t* O; int ldc;
    __device__ __forceinline__ void operator()(const f32x4 (&acc)[2][2][4][2], const Unit& u, int wr, int wc, int fr, int fq) const {
        const int row0 = u.pm * BM + wr * 64 + fr, col0 = u.pn * BM + wc * 32 + 8 * fq;
#pragma unroll
        for (int ai = 0; ai < 2; ++ai)
#pragma unroll
            for (int m = 0; m < 4; ++m) { bf16_t* rowp = O + (size_t)(row0 + ai * HALF + m * 16) * ldc + col0;
#pragma unroll
                for (int bj = 0; bj < 2; ++bj) { const f32x4 v0 = acc[ai][bj][m][0], v1 = acc[ai][bj][m][1];
                    u32x4 w; w.x = cvt_pk_bf16(v0[0], v0[1]); w.y = cvt_pk_bf16(v0[2], v0[3]); w.z = cvt_pk_bf16(v1[0], v1[1]); w.w = cvt_pk_bf16(v1[2], v1[3]);
                    *(u32x4*)(rowp + bj * HALF) = w; } }
    }
};
__device__ __forceinline__ float gelu_tanh_f(float x) { const float y = 1.5957691216057308f * (x + 0.044715f * x * x * x); return x * fast_sigmoid(y); }
struct EpiProj {
    static constexpr bool PERM = true, AFTER_DRAIN = false;
    static constexpr int PN_V0 = 36, PN_G0 = 52;
    bf16_t* O; int ldc; float* sspart; bf16_t* G;
    __device__ __forceinline__ void operator()(const f32x4 (&acc)[2][2][4][2], const Unit& u, int wr, int wc, int fr, int fq) const {
        const int row0 = u.pm * BM + wr * 64 + fr, col0 = u.pn * BM + wc * 32 + 8 * fq;
        const bool vtile = (u.pn >= PN_V0) && (u.pn < PN_V0 + 8);
        if (u.pn >= PN_G0 && u.pn < PN_G0 + 32) {
            const int tid_ = ((wr * 4 + wc) * 4 + fq) * 16 + fr;
            char* gp = (char*)G + ((size_t)((u.pn - PN_G0) * 32 + u.pm) * 16 * 512 + tid_) * 16;
#pragma unroll
            for (int ai = 0; ai < 2; ++ai)
#pragma unroll
                for (int m = 0; m < 4; ++m)
#pragma unroll
                    for (int bj = 0; bj < 2; ++bj) { const f32x4 v0 = acc[ai][bj][m][0], v1 = acc[ai][bj][m][1];
                        u32x4 w; w.x = cvt_pk_bf16(v0[0], v0[1]); w.y = cvt_pk_bf16(v0[2], v0[3]); w.z = cvt_pk_bf16(v1[0], v1[1]); w.w = cvt_pk_bf16(v1[2], v1[3]);
                        *(u32x4*)(gp + (size_t)((ai * 4 + m) * 2 + bj) * 8192) = w; }
        } else if (!vtile) {
#pragma unroll
            for (int ai = 0; ai < 2; ++ai)
#pragma unroll
                for (int m = 0; m < 4; ++m) { bf16_t* rowp = O + (size_t)(row0 + ai * HALF + m * 16) * ldc + col0;
#pragma unroll
                    for (int bj = 0; bj < 2; ++bj) { const f32x4 v0 = acc[ai][bj][m][0], v1 = acc[ai][bj][m][1];
                        u32x4 w; w.x = cvt_pk_bf16(v0[0], v0[1]); w.y = cvt_pk_bf16(v0[2], v0[3]); w.z = cvt_pk_bf16(v1[0], v1[1]); w.w = cvt_pk_bf16(v1[2], v1[3]);
                        *(u32x4*)(rowp + bj * HALF) = w; } }
        } else {
#pragma unroll
            for (int ai = 0; ai < 2; ++ai)
#pragma unroll
                for (int m = 0; m < 4; ++m) { const int row = row0 + ai * HALF + m * 16; bf16_t* rowp = O + (size_t)row * ldc + col0; float ss = 0.f;
#pragma unroll
                    for (int bj = 0; bj < 2; ++bj) { f32x4 v0 = acc[ai][bj][m][0], v1 = acc[ai][bj][m][1];
#pragma unroll
                        for (int e = 0; e < 4; ++e) { v0[e] = gelu_tanh_f(v0[e]); v1[e] = gelu_tanh_f(v1[e]); ss += v0[e] * v0[e] + v1[e] * v1[e]; }
                        u32x4 w; w.x = cvt_pk_bf16(v0[0], v0[1]); w.y = cvt_pk_bf16(v0[2], v0[3]); w.z = cvt_pk_bf16(v1[0], v1[1]); w.w = cvt_pk_bf16(v1[2], v1[3]);
                        *(u32x4*)(rowp + bj * HALF) = w; }
                    ss = xor16_sum(ss); ss = xor32_sum(ss);
                    if (fq == 0) sspart[(size_t)row * 32 + (u.pn - PN_V0) * 4 + wc] = ss; }
        }
    }
};
template <bool ADD> struct EpiGate {
    static constexpr bool PERM = true, AFTER_DRAIN = false;
    bf16_t* O; int ldc; const bf16_t* Mg; int ldm; const bf16_t* Prev;
    __device__ __forceinline__ void operator()(const f32x4 (&acc)[2][2][4][2], const Unit& u, int wr, int wc, int fr, int fq) const {
        const int row0 = u.pm * BM + wr * 64 + fr, col0 = u.pn * BM + wc * 32 + 8 * fq;
#pragma unroll
        for (int ai = 0; ai < 2; ++ai)
#pragma unroll
            for (int m = 0; m < 4; ++m) { const size_t row = (size_t)(row0 + ai * HALF + m * 16);
#pragma unroll
                for (int bj = 0; bj < 2; ++bj) { const f32x4 v0 = acc[ai][bj][m][0], v1 = acc[ai][bj][m][1];
                    const u32x4 mg = *(const u32x4*)(Mg + row * ldm + col0 + bj * HALF);
                    float r[8];
                    r[0] = v0[0] * fast_sigmoid(bf_lo(mg.x)); r[1] = v0[1] * fast_sigmoid(bf_hi(mg.x)); r[2] = v0[2] * fast_sigmoid(bf_lo(mg.y)); r[3] = v0[3] * fast_sigmoid(bf_hi(mg.y));
                    r[4] = v1[0] * fast_sigmoid(bf_lo(mg.z)); r[5] = v1[1] * fast_sigmoid(bf_hi(mg.z)); r[6] = v1[2] * fast_sigmoid(bf_lo(mg.w)); r[7] = v1[3] * fast_sigmoid(bf_hi(mg.w));
                    if (ADD) { const u32x4 pv = *(const u32x4*)(Prev + row * ldc + col0 + bj * HALF);
                        r[0] += bf_lo(pv.x); r[1] += bf_hi(pv.x); r[2] += bf_lo(pv.y); r[3] += bf_hi(pv.y); r[4] += bf_lo(pv.z); r[5] += bf_hi(pv.z); r[6] += bf_lo(pv.w); r[7] += bf_hi(pv.w); }
                    u32x4 w; w.x = cvt_pk_bf16(r[0], r[1]); w.y = cvt_pk_bf16(r[2], r[3]); w.z = cvt_pk_bf16(r[4], r[5]); w.w = cvt_pk_bf16(r[6], r[7]);
                    *(u32x4*)(O + row * ldc + col0 + bj * HALF) = w; } }
    }
};
struct EpiMerge {
    static constexpr bool PERM = true, AFTER_DRAIN = false;
    bf16_t* O; int ldc; const bf16_t* Gt;
    __device__ __forceinline__ void mid(f32x4 (&acc)[2][2][4][2], const Unit& u, int wr, int wc, int fr, int fq) const {
        const int tid_ = ((wr * 4 + wc) * 4 + fq) * 16 + fr;
        const char* gpa = (const char*)Gt + ((size_t)(u.pn * 32 + u.pm) * 16 * 512 + tid_) * 16; const char* gpb = gpa + (size_t)16 * 32 * 16 * 512 * 16;
        const int row0 = u.pm * BM + wr * 64 + fr, col0 = u.pn * BM + wc * 32 + 8 * fq;
#pragma unroll
        for (int ai = 0; ai < 2; ++ai) {
            u32x4 ga[8], gb[8];
#pragma unroll
            for (int m = 0; m < 4; ++m) { const size_t row = (size_t)(row0 + ai * HALF + m * 16);
#pragma unroll
                for (int bj = 0; bj < 2; ++bj) { ga[m * 2 + bj] = *(const u32x4*)(gpa + (size_t)((ai * 4 + m) * 2 + bj) * 8192); gb[m * 2 + bj] = *(const u32x4*)(gpb + (size_t)((ai * 4 + m) * 2 + bj) * 8192); } }
            __builtin_amdgcn_sched_barrier(0);
#pragma unroll
            for (int m = 0; m < 4; ++m)
#pragma unroll
                for (int bj = 0; bj < 2; ++bj) { const u32x4 a = ga[m * 2 + bj], b = gb[m * 2 + bj];
                    const unsigned aw[4] = {a.x, a.y, a.z, a.w}, bw[4] = {b.x, b.y, b.z, b.w};
#pragma unroll
                    for (int e = 0; e < 4; ++e) {
                        const float r0 = (1.0f + __builtin_amdgcn_exp2f(-1.4426950408889634f * bf_lo(bw[e]))) * __builtin_amdgcn_rcpf(1.0f + __builtin_amdgcn_exp2f(-1.4426950408889634f * bf_lo(aw[e])));
                        const float r1 = (1.0f + __builtin_amdgcn_exp2f(-1.4426950408889634f * bf_hi(bw[e]))) * __builtin_amdgcn_rcpf(1.0f + __builtin_amdgcn_exp2f(-1.4426950408889634f * bf_hi(aw[e])));
                        acc[ai][bj][m][e >> 1][(e & 1) * 2] *= r0; acc[ai][bj][m][e >> 1][(e & 1) * 2 + 1] *= r1; } }
            __builtin_amdgcn_sched_barrier(0);
        }
    }
    __device__ __forceinline__ void operator()(const f32x4 (&acc)[2][2][4][2], const Unit& u, int wr, int wc, int fr, int fq) const {
        const int row0 = u.pm * BM + wr * 64 + fr, col0 = u.pn * BM + wc * 32 + 8 * fq;
        const int tid_ = ((wr * 4 + wc) * 4 + fq) * 16 + fr;
        const char* gpb = (const char*)Gt + ((size_t)((16 + u.pn) * 32 + u.pm) * 16 * 512 + tid_) * 16;
        u32x4 mgs[16];
#pragma unroll
        for (int ai = 0; ai < 2; ++ai)
#pragma unroll
            for (int m = 0; m < 4; ++m) { const size_t row = (size_t)(row0 + ai * HALF + m * 16);
#pragma unroll
                for (int bj = 0; bj < 2; ++bj) mgs[(ai * 4 + m) * 2 + bj] = *(const u32x4*)(gpb + (size_t)((ai * 4 + m) * 2 + bj) * 8192); }
        __builtin_amdgcn_sched_barrier(0);
#pragma unroll
        for (int ai = 0; ai < 2; ++ai)
#pragma unroll
            for (int m = 0; m < 4; ++m) { const size_t row = (size_t)(row0 + ai * HALF + m * 16);
#pragma unroll
                for (int bj = 0; bj < 2; ++bj) { const f32x4 v0 = acc[ai][bj][m][0], v1 = acc[ai][bj][m][1];
                    const u32x4 mg = mgs[(ai * 4 + m) * 2 + bj];
                    u32x4 w; w.x = cvt_pk_bf16(v0[0] * fast_sigmoid(bf_lo(mg.x)), v0[1] * fast_sigmoid(bf_hi(mg.x))); w.y = cvt_pk_bf16(v0[2] * fast_sigmoid(bf_lo(mg.y)), v0[3] * fast_sigmoid(bf_hi(mg.y)));
                    w.z = cvt_pk_bf16(v1[0] * fast_sigmoid(bf_lo(mg.z)), v1[1] * fast_sigmoid(bf_hi(mg.z))); w.w = cvt_pk_bf16(v1[2] * fast_sigmoid(bf_lo(mg.w)), v1[3] * fast_sigmoid(bf_hi(mg.w)));
                    *(u32x4*)(O + row * ldc + col0 + bj * HALF) = w; } }
    }
};
struct EpiF32Plain {
    static constexpr bool PERM = false, AFTER_DRAIN = false;
    float* C; int ldc;
    __device__ __forceinline__ void operator()(const f32x4 (&acc)[2][2][4][2], const Unit& u, int wr, int wc, int fr, int fq) const {
        const int row0 = u.pm * BM + wr * 64 + fr, col0 = u.pn * BM + wc * 32 + 4 * fq;
#pragma unroll
        for (int ai = 0; ai < 2; ++ai)
#pragma unroll
            for (int m = 0; m < 4; ++m) { float* rowp = C + (size_t)(row0 + ai * HALF + m * 16) * ldc + col0;
#pragma unroll
                for (int bj = 0; bj < 2; ++bj)
#pragma unroll
                    for (int n = 0; n < 2; ++n) *(f32x4*)(rowp + bj * HALF + n * 16) = acc[ai][bj][m][n]; }
    }
};
struct ProjOrder : StaticOrder {
    int late, nearly, nlate;
    __host__ __device__ void init2(int M, int n_early, int n_late, int G_, int c_, int late_) { StaticOrder::init(M, n_early * BM, G_, c_); late = late_; nearly = n_early; nlate = n_late; }
    __host__ __device__ bool next(int i, Unit& u) const {
        if (!late) return StaticOrder::next(i, u);
        const long L = (long)i * G + c; if (L >= (long)nM * nlate) return false;
        u.pm = (int)(L % nM); u.pn = nearly + (int)(L / nM); u.sub = 0; return true;
    }
};
#ifndef PG8_SP2
#define PG8_SP2 true
#endif
#ifndef PG8_ALIGN
#define PG8_ALIGN true
#endif
template <class Epi, class Sched, bool STAMP = false, bool ALIGN_EPI = PG8_ALIGN, bool SP2 = PG8_SP2>
__device__ __forceinline__ void gemm_phase(PG8_LAS unsigned char* lds, const Gemm g, const Sched& S, const Epi& E, unsigned long long* stamps) {
    int tid_o = threadIdx.x; asm volatile("" : "+v"(tid_o));
    const int tid = tid_o, wid = __builtin_amdgcn_readfirstlane(tid >> 6), lane = tid & 63, wr = wid >> 2, wc = wid & 3, fr = lane & 15, fq = lane >> 4;
    const int K = g.K, nt = K / BK;
    int ts_lo = 0, ts_hi = 0, nts = 0; const unsigned long long rt_entry = STAMP ? (unsigned long long)wall_clock64() : 0ull;
#define PG8_STAMP() do { if (STAMP && wid == 0 && nts < 64) { const unsigned long long _c = (unsigned long long)clock64(); \
        ts_lo = (lane == nts) ? (int)(unsigned)_c : ts_lo; ts_hi = (lane == nts) ? (int)(unsigned)(_c >> 32) : ts_hi; ++nts; } } while (0)
    PG8_STAMP();
    unsigned voffA[2], voffB[2];
#pragma unroll
    for (int i = 0; i < 2; ++i) { int R, C; stage_rc(tid * 16 + i * 8192, R, C); const int Rb = Epi::PERM ? ((R & ~31) + perm32(R & 31)) : R;
        voffA[i] = (unsigned)(R * K + C) * 2u; voffB[i] = (unsigned)(Rb * K + C) * 2u; }
    const size_t kstep = (size_t)(BK * 2);
    const size_t hstep = (size_t)HALF * K * 2;
    const size_t tstep = 2 * hstep;
    const unsigned ldsw = (unsigned)wid * 1024u;
    const int aoff = lds_byte(wr * 64 + fr, fq * 8), boff = lds_byte(wc * 32 + fr, fq * 8);
#define PG8_SA(b, h) (((b) * 2 + (h)) * HTB)
#define PG8_SB(b, h) ((4 + (b) * 2 + (h)) * HTB)
#define PG8_STAGE(bufoff, gbase, voff) do { _Pragma("unroll") for (int _i = 0; _i < 2; ++_i) \
        __builtin_amdgcn_global_load_lds((const unsigned*)((const char*)(gbase) + (voff)[_i]), (PG8_LAS unsigned*)(lds + (bufoff) + ldsw + _i * 8192), 16, 0, 0); } while (0)
#define PG8_LDA(dst, b, h) do { _Pragma("unroll") for (int m = 0; m < 4; ++m) _Pragma("unroll") for (int k = 0; k < 2; ++k) dst[m][k] = *(const PG8_LAS bf16x8*)(lds + PG8_SA(b, h) + aoff + m * 2048 + k * 1024); } while (0)
#define PG8_LDB(dst, b, h) do { _Pragma("unroll") for (int n = 0; n < 2; ++n) _Pragma("unroll") for (int k = 0; k < 2; ++k) dst[n][k] = *(const PG8_LAS bf16x8*)(lds + PG8_SB(b, h) + boff + n * 2048 + k * 1024); } while (0)
#define PG8_MMA(ai, bj, At, Bt) do { __builtin_amdgcn_s_setprio(1); _Pragma("unroll") for (int m = 0; m < 4; ++m) _Pragma("unroll") for (int n = 0; n < 2; ++n) _Pragma("unroll") for (int k = 0; k < 2; ++k) \
        acc[ai][bj][m][n] = __builtin_amdgcn_mfma_f32_16x16x32_bf16(Bt[n][k], At[m][k], acc[ai][bj][m][n], 0, 0, 0); __builtin_amdgcn_s_setprio(0); } while (0)
#define PG8_WAIT_V(n) asm volatile("s_waitcnt vmcnt(" #n ")" ::: "memory")
#define PG8_WAIT_L(n) asm volatile("s_waitcnt lgkmcnt(" #n ")" ::: "memory")
#define PG8_BAR __builtin_amdgcn_s_barrier()
#define PG8_SCHED __builtin_amdgcn_sched_barrier(0)
    Unit cur, nxt; int ui = 0;
    if (!S.next(0, cur)) return;
    f32x4 acc[2][2][4][2];
#pragma unroll
    for (int a = 0; a < 2; ++a)
#pragma unroll
        for (int b = 0; b < 2; ++b)
#pragma unroll
            for (int m = 0; m < 4; ++m)
#pragma unroll
                for (int n = 0; n < 2; ++n) acc[a][b][m][n] = (f32x4){0.f, 0.f, 0.f, 0.f};
    bf16x8 At[4][2], B0[2][2], B1[2][2];
    const char* cA = (const char*)S.baseA(g, cur) + (size_t)cur.pm * tstep; const char* cB = (const char*)S.baseB(g, cur) + (size_t)cur.pn * tstep;
    S.a_ready(cur);
    if constexpr (SP2) {
        PG8_STAGE(PG8_SB(0, 0), cB, voffB); PG8_STAGE(PG8_SB(0, 1), cB + hstep, voffB); PG8_STAGE(PG8_SA(0, 0), cA, voffA); PG8_STAGE(PG8_SA(0, 1), cA + hstep, voffA);
        if (wr == 1) PG8_BAR;
        PG8_WAIT_V(2); PG8_BAR;
        PG8_STAGE(PG8_SB(1, 0), cB + kstep, voffB); PG8_STAGE(PG8_SA(1, 0), cA + kstep, voffA); PG8_STAGE(PG8_SB(1, 1), cB + hstep + kstep, voffB);
        PG8_WAIT_V(6); PG8_BAR;
    } else {
    PG8_STAGE(PG8_SB(0, 0), cB, voffB); PG8_STAGE(PG8_SA(0, 0), cA, voffA); PG8_STAGE(PG8_SB(0, 1), cB + hstep, voffB); PG8_STAGE(PG8_SA(0, 1), cA + hstep, voffA);
    if (wr == 1) PG8_BAR;
    PG8_WAIT_V(4); PG8_BAR;
    PG8_STAGE(PG8_SB(1, 0), cB + kstep, voffB); PG8_STAGE(PG8_SA(1, 0), cA + kstep, voffA); PG8_STAGE(PG8_SB(1, 1), cB + hstep + kstep, voffB);
    PG8_WAIT_V(6); PG8_BAR;
    }
    PG8_STAMP();
    for (;;) {
        const bool has_next = S.next(ui + 1, nxt);
        const char* nA = has_next ? (const char*)S.baseA(g, nxt) + (size_t)nxt.pm * tstep : cA; const char* nB = has_next ? (const char*)S.baseB(g, nxt) + (size_t)nxt.pn * tstep : cB;
        for (int t = 0; t < nt; t += 2) {
            const bool last = (t == nt - 2);
            const char* a1 = cA + (size_t)(t + 1) * kstep;
            const char* a2 = last ? nA : cA + (size_t)(t + 2) * kstep; const char* b2 = last ? nB : cB + (size_t)(t + 2) * kstep;
            const char* a3 = a2 + kstep; const char* b3 = b2 + kstep;
            if (last && has_next) S.a_ready(nxt);
            if constexpr (SP2) {
            PG8_LDB(B0, 0, 0); PG8_LDB(B1, 0, 1); PG8_SCHED; PG8_LDA(At, 0, 0); PG8_STAGE(PG8_SA(1, 1), a1 + hstep, voffA);
            PG8_WAIT_V(8); PG8_WAIT_L(0); PG8_BAR; PG8_MMA(0, 0, At, B0); PG8_MMA(0, 1, At, B1); PG8_BAR; PG8_SCHED;
            PG8_LDA(At, 0, 1); PG8_STAGE(PG8_SB(0, 0), b2, voffB); PG8_STAGE(PG8_SB(0, 1), b2 + hstep, voffB); PG8_STAGE(PG8_SA(0, 0), a2, voffA);
            PG8_WAIT_V(8); PG8_WAIT_L(0); PG8_BAR; PG8_MMA(1, 0, At, B0); PG8_MMA(1, 1, At, B1); PG8_BAR; PG8_SCHED;
            PG8_LDB(B0, 1, 0); PG8_LDB(B1, 1, 1); PG8_SCHED; PG8_LDA(At, 1, 0); PG8_STAGE(PG8_SA(0, 1), a2 + hstep, voffA);
            PG8_WAIT_V(8); PG8_WAIT_L(0); PG8_BAR; PG8_MMA(0, 0, At, B0); PG8_MMA(0, 1, At, B1); PG8_BAR; PG8_SCHED;
            PG8_LDA(At, 1, 1); PG8_STAGE(PG8_SB(1, 0), b3, voffB); PG8_STAGE(PG8_SB(1, 1), b3 + hstep, voffB); PG8_STAGE(PG8_SA(1, 0), a3, voffA);
            PG8_WAIT_V(8); PG8_WAIT_L(0); PG8_BAR; PG8_MMA(1, 0, At, B0); PG8_MMA(1, 1, At, B1); PG8_BAR; PG8_SCHED;
            } else {
            PG8_LDB(B0, 0, 0); PG8_SCHED; PG8_LDA(At, 0, 0); PG8_STAGE(PG8_SA(1, 1), a1 + hstep, voffA);
            PG8_WAIT_L(8); PG8_BAR; PG8_WAIT_L(0); PG8_MMA(0, 0, At, B0); PG8_BAR; PG8_SCHED;
            PG8_LDB(B1, 0, 1); PG8_STAGE(PG8_SB(0, 0), b2, voffB);
            PG8_BAR; PG8_WAIT_L(0); PG8_MMA(0, 1, At, B1); PG8_BAR;
            PG8_LDA(At, 0, 1); PG8_STAGE(PG8_SA(0, 0), a2, voffA);
            PG8_BAR; PG8_WAIT_L(0); PG8_MMA(1, 0, At, B0); PG8_BAR; PG8_SCHED;
            PG8_STAGE(PG8_SB(0, 1), b2 + hstep, voffB);
            PG8_WAIT_V(6); PG8_BAR; PG8_MMA(1, 1, At, B1); PG8_BAR;
            PG8_LDB(B0, 1, 0); PG8_SCHED; PG8_LDA(At, 1, 0); PG8_STAGE(PG8_SA(0, 1), a2 + hstep, voffA);
            PG8_WAIT_L(8); PG8_BAR; PG8_WAIT_L(0); PG8_MMA(0, 0, At, B0); PG8_BAR; PG8_SCHED;
            PG8_LDB(B1, 1, 1); PG8_STAGE(PG8_SB(1, 0), b3, voffB);
            PG8_BAR; PG8_WAIT_L(0); PG8_MMA(0, 1, At, B1); PG8_BAR;
            PG8_LDA(At, 1, 1); PG8_STAGE(PG8_SA(1, 0), a3, voffA);
            PG8_BAR; PG8_WAIT_L(0); PG8_MMA(1, 0, At, B0); PG8_BAR; PG8_SCHED;
            PG8_STAGE(PG8_SB(1, 1), b3 + hstep, voffB);
            PG8_WAIT_V(6); PG8_BAR; PG8_MMA(1, 1, At, B1); PG8_BAR;
                    }
        }
        PG8_STAMP();
        if constexpr (ALIGN_EPI) { if (wr == 0) PG8_BAR; }
        bool keep_acc = false;
        if constexpr (Sched::DUAL) { if (cur.sub == 0) { E.mid(acc, cur, wr, wc, fr, fq); keep_acc = true; } else E(acc, cur, wr, wc, fr, fq); }
        else if constexpr (!Epi::AFTER_DRAIN) { E(acc, cur, wr, wc, fr, fq); S.done(cur); }
        PG8_STAMP();
        if (!has_next) break;
        if (!keep_acc)
#pragma unroll
        for (int a = 0; a < 2; ++a)
#pragma unroll
            for (int b = 0; b < 2; ++b)
#pragma unroll
                for (int m = 0; m < 4; ++m)
#pragma unroll
                    for (int n = 0; n < 2; ++n) acc[a][b][m][n] = (f32x4){0.f, 0.f, 0.f, 0.f};
        cur = nxt; cA = nA; cB = nB; ++ui;
        if constexpr (ALIGN_EPI) { if (wr == 1) PG8_BAR; }
    }
    PG8_WAIT_V(0);
    if constexpr (!ALIGN_EPI) { if (wr == 0) PG8_BAR; }
    PG8_BAR;
    if constexpr (Epi::AFTER_DRAIN) { E.fused(acc, cur, wr, wc, fr, fq, lds, wid, lane); S.done(cur); }
    PG8_STAMP();
    if (STAMP && wid == 0) { stamps[lane] = lane < nts ? (((unsigned long long)(unsigned)ts_hi << 32) | (unsigned)ts_lo) : 0ull;
        if (lane == 62) stamps[62] = rt_entry; if (lane == 63) stamps[63] = (unsigned long long)wall_clock64(); }
#undef PG8_STAMP
#undef PG8_SA
#undef PG8_SB
#undef PG8_STAGE
#undef PG8_LDA
#undef PG8_LDB
#undef PG8_MMA
#undef PG8_WAIT_V
#undef PG8_WAIT_L
#undef PG8_BAR
#undef PG8_SCHED
}
}

#define XB_TMO      128
#define XB_XCNT(j)  (256  + 64 * (j))
#define XB_XSUB(j)  (1280 + 64 * (j))
#define XB_XGEN(j)  (2304 + 64 * (j))
#define XB_TOP      3328
#define XB_TOPGEN   3392
#define XCD_BAR_WORDS 3456
#define XB_SPIN_CAP (1u << 18)
#define LAS __attribute__((address_space(3)))

__device__ __forceinline__ unsigned xb_ld(unsigned* p)              { return __hip_atomic_load(p, __ATOMIC_RELAXED, __HIP_MEMORY_SCOPE_AGENT); }
__device__ __forceinline__ unsigned xb_add(unsigned* p, unsigned v) { return __hip_atomic_fetch_add(p, v, __ATOMIC_RELAXED, __HIP_MEMORY_SCOPE_AGENT); }
__device__ __forceinline__ unsigned xb_xcc_id() { return (unsigned)__builtin_amdgcn_s_getreg((3 << 11) | 20) & 0xFu; }
#define XB_SPIN(cond, bar) do { unsigned _sp = 0; while (cond) { __builtin_amdgcn_s_sleep(1); \
    if ((++_sp & 255u) == 0u) { if (xb_ld(&(bar)[XB_TMO])) break; if (_sp > XB_SPIN_CAP) { atomicAdd(&(bar)[XB_TMO], 1u); break; } } } } while (0)

struct XcdBarrier {
    unsigned* bar; unsigned x;
    volatile LAS unsigned* st;
};

__device__ __forceinline__ XcdBarrier xcd_barrier_post(unsigned* bar, volatile LAS unsigned* st) {
    XcdBarrier b; b.bar = bar; b.x = xb_xcc_id(); b.st = st;
    if (threadIdx.x == 0) (void)xb_add(&bar[XB_XCNT(b.x)], 1u);
    return b;
}
__device__ __forceinline__ void xcd_barrier_complete(unsigned* bar, unsigned x, unsigned& nloc, unsigned& nx) {
    const unsigned G = gridDim.x * gridDim.y * gridDim.z;
    unsigned sum, cnt, mine, sp = 0u;
    for (;;) {
        sum = 0u; cnt = 0u; mine = 0u;
#pragma unroll
        for (unsigned j = 0; j < 16; ++j) { const unsigned c = xb_ld(&bar[XB_XCNT(j)]); sum += c; cnt += (c > 0u) ? 1u : 0u; mine = (j == x) ? c : mine; }
        if (sum == G) break;
        __builtin_amdgcn_s_sleep(1);
        if ((++sp & 255u) == 0u) { if (xb_ld(&bar[XB_TMO])) break; if (sp > XB_SPIN_CAP) { atomicAdd(&bar[XB_TMO], 1u); break; } }
    }
    nloc = mine > 0u ? mine : 1u; nx = cnt > 0u ? cnt : 1u;
}

__device__ __forceinline__ void xcd_barrier(const XcdBarrier& b) {
    asm volatile("s_waitcnt vmcnt(0)" ::: "memory");
    __syncthreads();
    if (threadIdx.x == 0) {
        unsigned* bar = b.bar;
        __builtin_amdgcn_s_waitcnt(0);
        unsigned nloc = b.st[0], nx = b.st[1];
        if (nloc == 0u) { xcd_barrier_complete(bar, b.x, nloc, nx); b.st[0] = nloc; b.st[1] = nx; }
        const unsigned old = xb_add(&bar[XB_XSUB(b.x)], 1u);
        const unsigned gen = old / nloc;
        if (old + 1u == (gen + 1u) * nloc) {
            __builtin_amdgcn_fence(__ATOMIC_RELEASE, "agent");
            asm volatile("s_waitcnt vmcnt(0)" ::: "memory");
            const unsigned og = xb_add(&bar[XB_TOP], 1u);
            const unsigned tg = og / nx;
            if (og + 1u == (tg + 1u) * nx) xb_add(&bar[XB_TOPGEN], 1u);
            else XB_SPIN(xb_ld(&bar[XB_TOPGEN]) == tg, bar);
            __builtin_amdgcn_fence(__ATOMIC_ACQUIRE, "agent");
            xb_add(&bar[XB_XGEN(b.x)], 1u);
            asm volatile("s_waitcnt vmcnt(0)" ::: "memory");
        } else {
            XB_SPIN(xb_ld(&bar[XB_XGEN(b.x)]) == gen, bar);
            __builtin_amdgcn_fence(__ATOMIC_ACQUIRE, "agent");
            asm volatile("s_waitcnt vmcnt(0)" ::: "memory");
        }
    }
    __syncthreads();
}
typedef pg8::bf16_t bf16_t;
typedef short bf16x8 __attribute__((ext_vector_type(8)));
typedef short s16x4 __attribute__((ext_vector_type(4)));
typedef float f32x4 __attribute__((ext_vector_type(4)));
typedef float f32x16 __attribute__((ext_vector_type(16)));
typedef unsigned u32x4 __attribute__((ext_vector_type(4)));
typedef unsigned u32x2 __attribute__((ext_vector_type(2)));
constexpr int T = 8192, DM = 4096, NIN = 21552, NP = 21760, DEPTH = 2, NWAVES = 8, NTHREADS = 512;
constexpr int C_Q = 0, C_KV = 2048, C_ZA = 5120, C_UB = 7168, C_VB = 9216, C_ZB = 11264, C_MA = 13312, C_MB = 17408, C_GA = 21504;
constexpr int AW = 2048, BW = 2048, HD = 128, NCMP = 511, NCP = 512;
constexpr float NORM_EPS = 1e-6f;
constexpr size_t al256(size_t x) { return (x + 255) & ~(size_t)255; }
constexpr size_t WS_CTL = 0, CTL_BYTES = 1u << 20;
constexpr size_t SZ_WIN = (size_t)NP * DM * 2, SZ_WAB = (size_t)DM * AW * 2, SZ_WO = (size_t)DM * DM * 2, SZ_W1 = (size_t)HD * 4096 * 2, SZ_W2 = (size_t)HD * HD * 2;
constexpr size_t WS_WIN = WS_CTL + CTL_BYTES;
constexpr size_t WS_WA = WS_WIN + DEPTH * SZ_WIN;
constexpr size_t WS_WB = WS_WA + DEPTH * SZ_WAB;
constexpr size_t WS_WO = WS_WB + DEPTH * SZ_WAB;
constexpr size_t WS_W1 = WS_WO + DEPTH * SZ_WO;
constexpr size_t WS_W2 = WS_W1 + DEPTH * 2 * SZ_W1;
constexpr size_t WS_H = al256(WS_W2 + DEPTH * 2 * SZ_W2);
constexpr size_t WS_PROJ = WS_H + (size_t)T * DM * 2;
constexpr size_t WS_KC = WS_PROJ + (size_t)T * NP * 2;
constexpr size_t WS_VC = WS_KC + (size_t)NCP * 512 * 2;
constexpr size_t WS_OA = WS_VC + (size_t)NCP * 512 * 2;
constexpr size_t WS_OB = WS_OA + (size_t)T * AW * 2;
constexpr size_t WS_T1 = WS_OB + (size_t)T * BW * 2;
constexpr size_t WS_MG = WS_T1 + (size_t)T * DM * 2;
constexpr size_t WS_Y = WS_MG + (size_t)T * DM * 2;
constexpr size_t WS_X1 = WS_Y + (size_t)T * DM * 4;
constexpr size_t WS_SS = WS_X1 + (size_t)T * DM * 4;
constexpr size_t WS_PARK = WS_SS + (size_t)T * 32 * 4;
constexpr size_t WS_SGW = WS_PARK + (size_t)1024 * 32 * 512 * 16;
constexpr size_t WS_GATE = WS_SGW + (size_t)DEPTH * 16 * 128 * 128 * 4;
constexpr size_t WS_END = WS_GATE + (size_t)32 * 32 * 16 * 512 * 16;
constexpr int LDS_STAGE = 0;
constexpr int LDS_BIAS = 131072;
constexpr int LDS_MISC = LDS_BIAS + 16 * 256 * 4;
constexpr int LDS_RS = LDS_MISC + 64;
constexpr int LDS_ATT = LDS_RS + 512;
constexpr int LDS_BYTES = LDS_ATT + 8192;
static_assert(LDS_BYTES <= 160 * 1024, "LDS");
#define LAS3 __attribute__((address_space(3)))
#define LDS_WAIT() asm volatile("s_waitcnt lgkmcnt(0)" ::: "memory")
#define VM_WAIT() asm volatile("s_waitcnt vmcnt(0)" ::: "memory")

struct Params {
    const float *x, *rel_bias, *pre_norm, *w_in, *pe_k, *w1_k, *w2_k, *pe_v, *w1_v, *w2_v, *w_out_a, *sgu_norm, *sgu_w, *sgu_b, *w_out_b, *w_out, *post_norm;
    float* out; unsigned char* ws; int ph_lo, ph_hi;
};
__device__ __forceinline__ unsigned pk2(float lo, float hi) { return pg8::cvt_pk_bf16(lo, hi); }
__device__ __forceinline__ float wave_sum(float v) {
    v += dpp_f<0xB1>(v); v += dpp_f<0x4E>(v); v += dpp_f<0x141>(v); v += dpp_f<0x140>(v);
    v = xor16_sum(v); v = xor32_sum(v);
    return v;
}
__device__ const unsigned char BUCKET[128] = {0, 1, 2, 3, 4, 5, 6, 7, 8, 9, 10, 11, 12, 13, 14, 15, 16, 16, 16, 17, 17, 18, 18, 18, 19, 19, 19, 20, 20, 20, 20, 21, 21, 21, 21, 22, 22, 22, 22, 22, 23, 23, 23, 23, 23, 23, 24, 24, 24, 24, 24, 24, 25, 25, 25, 25, 25, 25, 25, 26, 26, 26, 26, 26, 26, 26, 26, 27, 27, 27, 27, 27, 27, 27, 27, 27, 27, 28, 28, 28, 28, 28, 28, 28, 28, 28, 28, 29, 29, 29, 29, 29, 29, 29, 29, 29, 29, 29, 29, 30, 30, 30, 30, 30, 30, 30, 30, 30, 30, 30, 30, 30, 30, 31, 31, 31, 31, 31, 31, 31, 31, 31, 31, 31, 31, 31, 31, 31};

constexpr int W_ITEMS_PER_LAYER = 64 * (NP / 64) + 2 * 32 * 64 + 64 * 64 + 2 * 64 * 2 + 2 * 2 * 2;
constexpr int W_ITEMS = DEPTH * W_ITEMS_PER_LAYER;
constexpr int W_TAIL_ITEMS = 0;
__device__ __forceinline__ int srcmap_in(int n) { return n < 5120 ? n : (n < 21504 ? n + 48 : (n < 21552 ? n - 21504 + 5120 : -1)); }
template <int MODE>
__device__ __forceinline__ void transpose_item(const float* __restrict__ W, int K, int N, bf16_t* __restrict__ WT, LAS3 float* scr, int item, int nblk, int lane) {
    int kb, nb;
    if ((nblk & 3) == 0) { const int g8 = item >> 3, sub = item & 7, q = nblk >> 2; const int gk = g8 / q, gn = g8 - gk * q; nb = gn * 4 + (sub & 3); kb = gk * 2 + (sub >> 2); }
    else { kb = item / nblk; nb = item - kb * nblk; }
    const int k0 = 64 * kb, n0 = 64 * nb;
    const int nn = n0 + 4 * (lane & 15); const int s = (MODE == 1) ? srcmap_in(nn) : nn;
    const float* src = W + (size_t)(k0 + (lane >> 4)) * N + (s >= 0 ? s : 0);
    f32x4 v[16];
#pragma unroll
    for (int i = 0; i < 16; ++i) v[i] = *(const f32x4*)(src + (size_t)(4 * i) * N);
    __builtin_amdgcn_sched_barrier(0);
#pragma unroll
    for (int i = 0; i < 16; ++i) { f32x4 x = v[i]; if (s < 0) x = (f32x4){0.f, 0.f, 0.f, 0.f};
        LAS3 float* d = scr + (4 * i + (lane >> 4)) * 65 + 4 * (lane & 15); d[0] = x[0]; d[1] = x[1]; d[2] = x[2]; d[3] = x[3]; }
    LDS_WAIT();
    const int c = lane & 7;
#pragma unroll
    for (int j = 0; j < 8; ++j) { const int n = (lane >> 3) + 8 * j; const LAS3 float* p = scr + (8 * c) * 65 + n;
        u32x4 o; o.x = pk2(p[0 * 65], p[1 * 65]); o.y = pk2(p[2 * 65], p[3 * 65]); o.z = pk2(p[4 * 65], p[5 * 65]); o.w = pk2(p[6 * 65], p[7 * 65]);
        if (MODE == 2) { const int k8 = (k0 >> 3) + c, na = n0 + n; *(u32x4*)(WT + (size_t)((((k8 >> 1) * (N >> 5) + (na >> 5)) * 64) + (k8 & 1) * 32 + (na & 31)) * 8) = o; }
        else *(u32x4*)(WT + (size_t)(n0 + n) * K + k0 + 8 * c) = o; }
    LDS_WAIT();
}
__device__ __forceinline__ void phase_weights(const Params& P, LAS3 unsigned char* lds, int gw, int NGW, int wave, int lane, int it_lo, int it_hi) {
    asm volatile("" : "+v"(lane));
    LAS3 float* scr = (LAS3 float*)(lds + LDS_STAGE + wave * 16640);
    constexpr int I_IN = 64 * (NP / 64), I_AB = 32 * 64, I_O = 64 * 64, I_W1 = 64 * 2, I_W2 = 2 * 2;
    constexpr int PER_LAYER = I_IN + 2 * I_AB + I_O + 2 * I_W1 + 2 * I_W2;
    static_assert(PER_LAYER == W_ITEMS_PER_LAYER, "item count");
    for (int it = it_lo + gw; it < it_hi; it += NGW) {
        const int L = it / PER_LAYER; int r = it - L * PER_LAYER;
        unsigned char* ws = P.ws;
        if (r < I_IN) { transpose_item<1>(P.w_in + (size_t)L * DM * NIN, DM, NIN, (bf16_t*)(ws + WS_WIN + L * SZ_WIN), scr, r, NP / 64, lane); continue; } r -= I_IN;
        if (r < I_AB) { transpose_item<0>(P.w_out_a + (size_t)L * AW * DM, AW, DM, (bf16_t*)(ws + WS_WA + L * SZ_WAB), scr, r, 64, lane); continue; } r -= I_AB;
        if (r < I_AB) { transpose_item<0>(P.w_out_b + (size_t)L * BW * DM, BW, DM, (bf16_t*)(ws + WS_WB + L * SZ_WAB), scr, r, 64, lane); continue; } r -= I_AB;
        if (r < I_O) { transpose_item<0>(P.w_out + (size_t)L * DM * DM, DM, DM, (bf16_t*)(ws + WS_WO + L * SZ_WO), scr, r, 64, lane); continue; } r -= I_O;
        if (r < I_W1) { transpose_item<2>(P.w1_k + (size_t)L * 4096 * HD, 4096, HD, (bf16_t*)(ws + WS_W1 + (L * 2 + 0) * SZ_W1), scr, r, 2, lane); continue; } r -= I_W1;
        if (r < I_W1) { transpose_item<2>(P.w1_v + (size_t)L * 4096 * HD, 4096, HD, (bf16_t*)(ws + WS_W1 + (L * 2 + 1) * SZ_W1), scr, r, 2, lane); continue; } r -= I_W1;
        if (r < I_W2) { transpose_item<0>(P.w2_k + (size_t)L * HD * HD, HD, HD, (bf16_t*)(ws + WS_W2 + (L * 2 + 0) * SZ_W2), scr, r, 2, lane); continue; } r -= I_W2;
        transpose_item<0>(P.w2_v + (size_t)L * HD * HD, HD, HD, (bf16_t*)(ws + WS_W2 + (L * 2 + 1) * SZ_W2), scr, r, 2, lane);
    }
}
__device__ __forceinline__ void phase_prenorm(const float* __restrict__ x, const float* __restrict__ g, bf16_t* __restrict__ h, int gw, int NGW, int lane) {
    asm volatile("" : "+v"(lane));
#pragma unroll 1
    for (int m = gw; m < T; m += 2 * NGW) {
        const bool two = (m + NGW) < T; const int m2 = two ? m + NGW : m;
        const f32x4* xa = (const f32x4*)(x + (size_t)m * DM) + lane; const f32x4* xb = (const f32x4*)(x + (size_t)m2 * DM) + lane;
        f32x4 va[16], vb[16];
#pragma unroll
        for (int j = 0; j < 16; ++j) va[j] = xa[64 * j];
#pragma unroll
        for (int j = 0; j < 16; ++j) vb[j] = xb[64 * j];
        __builtin_amdgcn_sched_barrier(0);
        float sa = 0.f, sb = 0.f;
#pragma unroll
        for (int j = 0; j < 16; ++j) { sa += (va[j][0] * va[j][0] + va[j][1] * va[j][1]) + (va[j][2] * va[j][2] + va[j][3] * va[j][3]); sb += (vb[j][0] * vb[j][0] + vb[j][1] * vb[j][1]) + (vb[j][2] * vb[j][2] + vb[j][3] * vb[j][3]); }
        const float ra = 1.0f / sqrtf(wave_sum(sa) * (1.0f / DM) + NORM_EPS), rb = 1.0f / sqrtf(wave_sum(sb) * (1.0f / DM) + NORM_EPS);
        const f32x4* gr = (const f32x4*)g + lane;
        u32x2* oa = (u32x2*)(h + (size_t)m * DM) + lane; u32x2* ob = (u32x2*)(h + (size_t)m2 * DM) + lane;
#pragma unroll
        for (int j = 0; j < 16; ++j) { const f32x4 gg = gr[64 * j]; u32x2 w; w.x = pk2(va[j][0] * ra * gg[0], va[j][1] * ra * gg[1]); w.y = pk2(va[j][2] * ra * gg[2], va[j][3] * ra * gg[3]); oa[64 * j] = w;
            if (two) { u32x2 w2; w2.x = pk2(vb[j][0] * rb * gg[0], vb[j][1] * rb * gg[1]); w2.y = pk2(vb[j][2] * rb * gg[2], vb[j][3] * rb * gg[3]); ob[64 * j] = w2; } }
    }
}
template <bool XOLD_BF16, bool XNEW_BF16>
__device__ __forceinline__ void phase_postnorm(const bf16_t* __restrict__ Y, const void* __restrict__ xold, const float* __restrict__ gpost, void* __restrict__ xnew,
                                               const float* __restrict__ gpre, bf16_t* __restrict__ h, bool next, int gw, int NGW, int lane_) {
#pragma unroll 1
    for (int m = gw; m < T; m += NGW) {
        int lane = lane_; asm volatile("" : "+v"(lane));
        const u32x2* yr = (const u32x2*)(Y + (size_t)m * DM) + lane;
        u32x2 yw[16]; f32x4 xx[16]; u32x2 xw[16]; f32x4 gp[16];
#pragma unroll
        for (int j = 0; j < 16; ++j) yw[j] = yr[64 * j];
        if (XOLD_BF16) {
#pragma unroll
            for (int j = 0; j < 16; ++j) xw[j] = ((const u32x2*)((const bf16_t*)xold + (size_t)m * DM) + lane)[64 * j];
        } else {
#pragma unroll
            for (int j = 0; j < 16; ++j) xx[j] = ((const f32x4*)((const float*)xold + (size_t)m * DM) + lane)[64 * j];
        }
#pragma unroll
        for (int j = 0; j < 16; ++j) gp[j] = ((const f32x4*)gpost + lane)[64 * j];
        __builtin_amdgcn_sched_barrier(0);
        f32x4 v[16]; float ss = 0.f;
#pragma unroll
        for (int j = 0; j < 16; ++j) { const u32x2 w = yw[j]; v[j] = (f32x4){pg8::bf_lo(w.x), pg8::bf_hi(w.x), pg8::bf_lo(w.y), pg8::bf_hi(w.y)}; ss += (v[j][0] * v[j][0] + v[j][1] * v[j][1]) + (v[j][2] * v[j][2] + v[j][3] * v[j][3]); }
        const float rs = 1.0f / sqrtf(wave_sum(ss) * (1.0f / DM) + NORM_EPS);
        float s2 = 0.f;
#pragma unroll
        for (int j = 0; j < 16; ++j) { f32x4 xo;
            if (XOLD_BF16) { const u32x2 w = xw[j]; xo = (f32x4){pg8::bf_lo(w.x), pg8::bf_hi(w.x), pg8::bf_lo(w.y), pg8::bf_hi(w.y)}; } else xo = xx[j];
            const f32x4 r = xo + v[j] * rs * gp[j]; v[j] = r;
            if (XNEW_BF16) { u32x2 w; w.x = pk2(r[0], r[1]); w.y = pk2(r[2], r[3]); ((u32x2*)((bf16_t*)xnew + (size_t)m * DM) + lane)[64 * j] = w; }
            else ((f32x4*)((float*)xnew + (size_t)m * DM) + lane)[64 * j] = r;
            s2 += (r[0] * r[0] + r[1] * r[1]) + (r[2] * r[2] + r[3] * r[3]); }
        if (next) {
            f32x4 g2[16];
#pragma unroll
            for (int j = 0; j < 16; ++j) g2[j] = ((const f32x4*)gpre + lane)[64 * j];
            __builtin_amdgcn_sched_barrier(0);
            const float rs2 = 1.0f / sqrtf(wave_sum(s2) * (1.0f / DM) + NORM_EPS);
            u32x2* o = (u32x2*)(h + (size_t)m * DM) + lane;
#pragma unroll
            for (int j = 0; j < 16; ++j) { const f32x4 gg = g2[j]; u32x2 w; w.x = pk2(v[j][0] * rs2 * gg[0], v[j][1] * rs2 * gg[1]); w.y = pk2(v[j][2] * rs2 * gg[2], v[j][3] * rs2 * gg[3]); o[64 * j] = w; }
        }
    }
}
namespace att {
constexpr float SCALE = 0.08838834764831845f, LOG2E = 1.4426950408889634f, C2 = SCALE * LOG2E;
constexpr int SHM = 16384;
constexpr int NSLOT = 3;
constexpr int L_V = 0, L_K = NSLOT * SHM, L_IMP = 2 * NSLOT * SHM, L_SEL = LDS_ATT, L_WS = L_SEL + 1024, L_SC = L_WS + 2048, L_END = L_SC + 4096;
static_assert(L_IMP + 32768 <= 131072 && L_END <= LDS_ATT + 8192, "attention LDS");
#define KSWZ(row, colB) ((row) * 256 + ((colB) ^ (((row) & 7) << 4)))
#define SBAR() __builtin_amdgcn_sched_barrier(0)
__device__ __forceinline__ int v_st(int k, int c) { const int kk = (k & ~0xC) | ((k & 4) << 1) | ((k & 8) >> 1); return ((kk >> 3) * 4 + (c >> 5)) * 512 + ((kk & 7) * 32 + (c & 31)) * 2; }
__device__ __forceinline__ int v_rd_base(int lane) { return ((lane & 3) << 3) | (((lane >> 2) & 3) << 6) | (((lane >> 4) & 1) << 5) | (((lane >> 5) & 1) << 8); }
constexpr int v_rd_off(int d0, int ks, int half) { return d0 * 512 + ks * 4096 + half * 2048; }
__device__ __forceinline__ int crow(int r, int hi) { return (r & 3) + 8 * (r >> 2) + 4 * hi; }
__device__ __forceinline__ unsigned cvtpk(float lo, float hi) { return pg8::cvt_pk_bf16(lo, hi); }
enum { MODE_STAT = 0, MODE_IMP = 1, MODE_ONLINE = 2, MODE_ACC = 3, MODE_IMPACC = 4 };
#ifndef PP_STAT
#define PP_STAT false
#endif
#ifndef PP_ACC
#define PP_ACC false
#endif

struct Ctx {
    bf16x8 qr[8]; f32x16 o[4];
    int tq, r32, hi, wid, lane, tid, t0;
    const LAS3 float* tb; float bfar;
    LAS3 char* lds;
};
__device__ __forceinline__ void qkt(f32x16& p0, f32x16& p1, const LAS3 char* Kt, int r32, int hi, const bf16x8* qr) {
    p0 = f32x16{}; p1 = f32x16{};
    const LAS3 char* kb[4];
#pragma unroll
    for (int dd = 0; dd < 4; ++dd) kb[dd] = Kt + KSWZ(r32, (dd * 16 + hi * 8) * 2);
#pragma unroll
    for (int d0 = 0; d0 < 8; ++d0) { const LAS3 char* a = kb[d0 & 3] + (d0 >> 2) * 128;
        const bf16x8 b0 = *reinterpret_cast<const LAS3 bf16x8*>(a);
        const bf16x8 b1 = *reinterpret_cast<const LAS3 bf16x8*>(a + 32 * 256);
        p0 = __builtin_amdgcn_mfma_f32_32x32x16_bf16(b0, qr[d0], p0, 0, 0, 0);
        p1 = __builtin_amdgcn_mfma_f32_32x32x16_bf16(b1, qr[d0], p1, 0, 0, 0);
        if ((d0 & 3) == 3) SBAR(); }
}
__device__ __forceinline__ void pv_tile(f32x16* o, int vb0, bf16x8 pa0, bf16x8 pa1, bf16x8 pa2, bf16x8 pa3) {
#define TRRD(dst, off) asm volatile("ds_read_b64_tr_b16 %0, %1 offset:%2" : "=&v"(dst) : "v"(vb0), "i"(off) : "memory")
#define PV_KS(ks, PA) do { s16x4 l0, l1, l2, l3, h0, h1, h2, h3; constexpr int b_ = v_rd_off(0, ks, 0); \
        TRRD(l0, b_); TRRD(h0, b_ + 2048); TRRD(l1, b_ + 512); TRRD(h1, b_ + 512 + 2048); TRRD(l2, b_ + 1024); TRRD(h2, b_ + 1024 + 2048); TRRD(l3, b_ + 1536); TRRD(h3, b_ + 1536 + 2048); \
        asm volatile("s_waitcnt lgkmcnt(0)" ::: "memory"); SBAR(); \
        o[0] = __builtin_amdgcn_mfma_f32_32x32x16_bf16(PA, (bf16x8){l0[0], l0[1], l0[2], l0[3], h0[0], h0[1], h0[2], h0[3]}, o[0], 0, 0, 0); \
        o[1] = __builtin_amdgcn_mfma_f32_32x32x16_bf16(PA, (bf16x8){l1[0], l1[1], l1[2], l1[3], h1[0], h1[1], h1[2], h1[3]}, o[1], 0, 0, 0); \
        o[2] = __builtin_amdgcn_mfma_f32_32x32x16_bf16(PA, (bf16x8){l2[0], l2[1], l2[2], l2[3], h2[0], h2[1], h2[2], h2[3]}, o[2], 0, 0, 0); \
        o[3] = __builtin_amdgcn_mfma_f32_32x32x16_bf16(PA, (bf16x8){l3[0], l3[1], l3[2], l3[3], h3[0], h3[1], h3[2], h3[3]}, o[3], 0, 0, 0); } while (0)
    PV_KS(0, pa0); PV_KS(1, pa1); PV_KS(2, pa2); PV_KS(3, pa3);
#undef PV_KS
#undef TRRD
}
__device__ __forceinline__ void pack_p(const f32x16& p0, const f32x16& p1, bf16x8& pa0, bf16x8& pa1, bf16x8& pa2, bf16x8& pa3) {
#define PK4(P, B_, OUT) do { u32x4 w = {cvtpk(P[B_+0], P[B_+1]), cvtpk(P[B_+2], P[B_+3]), cvtpk(P[B_+4], P[B_+5]), cvtpk(P[B_+6], P[B_+7])}; OUT = *reinterpret_cast<bf16x8*>(&w); } while (0)
    PK4(p0, 0, pa0); PK4(p0, 8, pa1); PK4(p1, 0, pa2); PK4(p1, 8, pa3);
#undef PK4
}
__device__ __forceinline__ float half_max(float v) { auto rr = __builtin_amdgcn_permlane32_swap(__float_as_uint(v), __float_as_uint(v), false, false); return fmaxf(__uint_as_float(rr[0]), __uint_as_float(rr[1])); }
__device__ __forceinline__ float half_sum(float v) { auto rr = __builtin_amdgcn_permlane32_swap(__float_as_uint(v), __float_as_uint(v), false, false); return __uint_as_float(rr[0]) + __uint_as_float(rr[1]); }

template <int MODE, int STEP, int OFF, bool ROWSEL, bool PP>
__device__ __forceinline__ void run_pass(Ctx& c, const bf16_t* __restrict__ Kg, const bf16_t* __restrict__ Vg, const int ldk, const int j_lo, const int j_hi, const unsigned W,
                                         float& m_reg, float& l_reg, const float pscale, unsigned sm0, unsigned sm1, unsigned sm2, unsigned sm3, const float gate = 1.f, const bool rev = false) {
    constexpr bool HASV = (MODE == MODE_ONLINE || MODE == MODE_ACC || MODE == MODE_IMPACC), RUNMAX = (MODE == MODE_ONLINE || MODE == MODE_STAT);
    int tid = c.tid, r32 = c.r32, hi = c.hi, lane = c.lane;
    asm volatile("" : "+v"(tid), "+v"(r32), "+v"(hi), "+v"(lane));
    const int n = j_hi - j_lo + 1;
    if (n <= 0) return;
    LAS3 char* V_lds = c.lds + L_V; LAS3 char* K_lds = c.lds + L_K;
    LAS3 float* al_l = (LAS3 float*)(c.lds + L_WS) + c.wid * 64 + 32;
    const int krow = tid >> 4;
    const unsigned ko0 = (unsigned)(krow * ldk + (((tid & 15) ^ (krow & 7)) * 8)) * 2u;
    const int vkk = ((tid >> 7) * 8) + ((tid & 31) >> 2), vkey = vkk, vcol = ((tid >> 5) & 3) * 32 + (tid & 3) * 8;
    const unsigned vo0 = (unsigned)(vkey * ldk + vcol) * 2u;
    const unsigned half_step = (unsigned)(32 * ldk) * 2u;
    const int vbase = (int)(uintptr_t)V_lds + v_rd_base(lane);
#define LOADT(j, bf) do { const char* kp_ = (const char*)(Kg + (size_t)((j) * 64) * ldk); LAS3 char* kd_ = K_lds + (bf) * SHM + c.wid * 1024; \
        __builtin_amdgcn_global_load_lds((const unsigned*)(kp_ + ko0), (LAS3 unsigned*)kd_, 16, 0, 0); \
        __builtin_amdgcn_global_load_lds((const unsigned*)((kp_ + half_step) + ko0), (LAS3 unsigned*)(kd_ + 8192), 16, 0, 0); \
        if (HASV) { const char* vp_ = (const char*)(Vg + (size_t)((j) * 64) * ldk); LAS3 char* vd_ = V_lds + (bf) * SHM + c.wid * 1024; \
            __builtin_amdgcn_global_load_lds((const unsigned*)(vp_ + vo0), (LAS3 unsigned*)vd_, 16, 0, 0); \
            __builtin_amdgcn_global_load_lds((const unsigned*)((vp_ + half_step) + vo0), (LAS3 unsigned*)(vd_ + 8192), 16, 0, 0); } } while (0)
#define WAIT_OLDER(younger) do { if (younger) { if (HASV) asm volatile("s_waitcnt vmcnt(4)" ::: "memory"); else asm volatile("s_waitcnt vmcnt(2)" ::: "memory"); } else VM_WAIT(); } while (0)
#define STEP_END(oddstep, ldt) do { if (oddstep) WAIT_OLDER(ldt); LDS_WAIT(); __builtin_amdgcn_s_barrier(); asm volatile("" ::: "memory"); } while (0)
#define TJ(t_) (rev ? j_hi - (t_) : j_lo + (t_))
    LOADT(TJ(0), 0); if (n > 1) LOADT(TJ(1), 1);
    WAIT_OLDER(n > 1);
    __builtin_amdgcn_s_barrier(); asm volatile("" ::: "memory");
    const int role = PP ? (c.wid >> 2) : 0, tqw = c.t0 + 8 * c.wid;
    const float NEG = -__builtin_inff();
    const float lp = RUNMAX ? 0.f : __builtin_amdgcn_logf(pscale);
    if (PP && role == 1) { __builtin_amdgcn_s_barrier(); asm volatile("" ::: "memory"); }
    int slot = 0;
#pragma unroll 1
    for (int t = 0; t < n; ++t) {
        const int j = TJ(t);
        const bool ldt = (t + 2 < n); const int lslot = slot == 0 ? 2 : slot - 1;
        if ((!PP || role == 1) && ldt) LOADT(TJ(t + 2), lslot);
        f32x16 p0, p1; float mul = C2, off = 0.f, alpha = 1.f; bool resc = false;
        const int kpos0 = STEP * (j * 64) + OFF;
        const int dmin = tqw - (kpos0 + STEP * 63), dmax = tqw + 7 - kpos0;
        bool rowsel = true;
        if (ROWSEL) { const unsigned wsel = (j < 32) ? sm0 : (j < 64) ? sm1 : (j < 96) ? sm2 : sm3; rowsel = (wsel >> (j & 31)) & 1u; }
        bool act = (dmax >= 0) && (dmin < (int)W);
        if (ROWSEL) act = act && __any(rowsel);
        if (act) {
            SBAR(); __builtin_amdgcn_s_setprio(2); qkt(p0, p1, K_lds + slot * SHM, r32, hi, c.qr); __builtin_amdgcn_s_setprio(0); SBAR();
            const bool needmask = (dmin < 0) || ((unsigned)dmax >= W);
            const int d0 = c.tq - kpos0 - STEP * 4 * hi;
            float add0 = c.bfar;
            if (dmin < 113) {
                if (STEP == 1) {
                    const LAS3 float* tbase = c.tb + (d0 + 5);
#pragma unroll
                    for (int r = 0; r < 16; ++r) { const int cc = (r & 3) + 8 * (r >> 2);
                        p0[r] = fmaf(p0[r], C2, tbase[59 - cc]); p1[r] = fmaf(p1[r], C2, tbase[59 - cc - 32]);
                        if ((r & 3) == 3) SBAR(); }
                } else {
#pragma unroll
                    for (int r = 0; r < 16; ++r) { const int cc = (r & 3) + 8 * (r >> 2); const int da = d0 - STEP * cc, db = d0 - STEP * (cc + 32);
                        const float ba = c.tb[64 + min(max(da, 0), 127)], bb = c.tb[64 + min(max(db, 0), 127)];
                        p0[r] = fmaf(p0[r], C2, ba); p1[r] = fmaf(p1[r], C2, bb);
                        if ((r & 3) == 3) SBAR(); }
                }
                mul = 1.f; add0 = 0.f;
            }
            if (needmask) {
#pragma unroll
                for (int r = 0; r < 16; ++r) { const int cc = (r & 3) + 8 * (r >> 2); const int da = d0 - STEP * cc, db = d0 - STEP * (cc + 32);
                    if ((unsigned)da >= W) p0[r] = NEG; if ((unsigned)db >= W) p1[r] = NEG; }
            }
            SBAR();
            if (RUNMAX) {
                float pm = fmaxf(p0[0], p1[0]);
#pragma unroll
                for (int r = 1; r < 16; ++r) pm = fmaxf(fmaxf(pm, p0[r]), p1[r]);
                pm = half_max(pm);
                float xmax = fmaf(pm, mul, add0); if (ROWSEL) xmax = rowsel ? xmax : NEG;
                float mn = m_reg;
                if (MODE != MODE_ONLINE || !__all(xmax - m_reg <= 8.0f)) { mn = fmaxf(m_reg, xmax); alpha = __builtin_amdgcn_exp2f(m_reg - mn); m_reg = mn; }
                off = add0 - mn; if (ROWSEL) off = rowsel ? off : NEG;
                if (MODE == MODE_ONLINE) { resc = __any(alpha < 1.f); if (resc && hi == 0) al_l[r32] = alpha; }
            } else off = (add0 - m_reg) + lp;
        }
        if (PP) STEP_END(role == 1, ldt);
        if (PP && role == 0 && ldt) LOADT(TJ(t + 2), lslot);
        if (act) {
#pragma unroll
            for (int r = 0; r < 16; ++r) { p0[r] = __builtin_amdgcn_exp2f(fmaf(p0[r], mul, off)); p1[r] = __builtin_amdgcn_exp2f(fmaf(p1[r], mul, off)); }
            if (RUNMAX) {
                float ps = 0.f;
#pragma unroll
                for (int r = 0; r < 16; ++r) ps += p0[r] + p1[r];
                ps = half_sum(ps);
                l_reg = l_reg * alpha + ps;
            }
            if (MODE == MODE_IMP || MODE == MODE_IMPACC) {
                LAS3 float* imp = (LAS3 float*)(c.lds + L_IMP) + (c.wid * 8 + (r32 >> 2)) * 128;
#pragma unroll
                for (int hf = 0; hf < 2; ++hf)
#pragma unroll
                    for (int m = 0; m < 4; ++m) { const f32x16& P = hf ? p1 : p0;
                        float a = 2.f * (P[4 * m] + P[4 * m + 1] + P[4 * m + 2]) + P[4 * m + 3], b = P[4 * m + 3];
                        a += xor1_f(a); b += xor1_f(b); a += xor2_f(a); b += xor2_f(b);
                        const int jj = 16 * j + 8 * hf + 2 * m + hi;
                        if ((r32 & 3) == 0) { __hip_atomic_fetch_add(imp + jj, a, __ATOMIC_RELAXED, __HIP_MEMORY_SCOPE_WORKGROUP);
                            if (jj + 1 < 128) __hip_atomic_fetch_add(imp + jj + 1, b, __ATOMIC_RELAXED, __HIP_MEMORY_SCOPE_WORKGROUP); } }
            }
            if (MODE == MODE_IMPACC) {
#pragma unroll
                for (int r = 0; r < 16; ++r) { p0[r] *= gate; p1[r] *= gate; }
            }
            if (HASV) {
                bf16x8 pa0, pa1, pa2, pa3;
                SBAR(); pack_p(p0, p1, pa0, pa1, pa2, pa3); SBAR();
                if (MODE == MODE_ONLINE && resc) {
#pragma unroll
                    for (int d_ = 0; d_ < 4; ++d_)
#pragma unroll
                        for (int r = 0; r < 16; ++r) c.o[d_][r] *= al_l[crow(r, hi)];
                    SBAR(); }
                pv_tile(c.o, vbase + slot * SHM, pa0, pa1, pa2, pa3);
            }
        }
        STEP_END(role == 0, ldt);
        slot = slot == 2 ? 0 : slot + 1;
    }
    if (PP && role == 0) { __builtin_amdgcn_s_barrier(); asm volatile("" ::: "memory"); }
#undef TJ
#undef STEP_END
#undef WAIT_OLDER
#undef LOADT
}
__device__ __forceinline__ void attn_unit(LAS3 char* lds, const bf16_t* __restrict__ proj, const bf16_t* __restrict__ kc, const bf16_t* __restrict__ vc, bf16_t* __restrict__ oa, float* park, int qt, int g, bool rev) {
    int tid_ = threadIdx.x; asm volatile("" : "+v"(tid_));
    Ctx c; c.lds = lds; c.tid = tid_; c.lane = c.tid & 63; c.wid = __builtin_amdgcn_readfirstlane(c.tid >> 6); c.r32 = c.lane & 31; c.hi = c.lane >> 5;
    c.t0 = qt * 64; c.tq = c.t0 + 8 * c.wid + (c.r32 >> 2);
    const int head = g * 4 + (c.r32 & 3);
    c.tb = (const LAS3 float*)(lds + LDS_BIAS) + head * 256; c.bfar = c.tb[64 + 127];
    { const bf16_t* qp = proj + (size_t)c.tq * NP + C_Q + head * HD + c.hi * 8;
#pragma unroll
      for (int d0 = 0; d0 < 8; ++d0) c.qr[d0] = *(const bf16x8*)(qp + d0 * 16); }
    float ga[3];
    { const bf16_t* gp = proj + (size_t)c.tq * NP + C_GA + head * 3;
#pragma unroll
      for (int b = 0; b < 3; ++b) ga[b] = pg8::fast_sigmoid(__uint_as_float(((unsigned)gp[b]) << 16)); }
    { LAS3 f32x4* z = (LAS3 f32x4*)(lds + L_IMP);
#pragma unroll
      for (int i = 0; i < 4; ++i) z[c.tid + 512 * i] = (f32x4){0.f, 0.f, 0.f, 0.f}; }
    __syncthreads();
    const bf16_t* Kc = kc + g * HD; const bf16_t* Vc = vc + g * HD;
    const bf16_t* Ks = proj + C_KV + 2 * 512 + g * HD; const bf16_t* Vs = proj + C_KV + 3 * 512 + g * HD;
    const bf16_t* Kw = proj + C_KV + 4 * 512 + g * HD; const bf16_t* Vw = proj + C_KV + 5 * 512 + g * HD;
    const int ntc = (4 * qt + 2) / 64;
    constexpr unsigned WINF = 0x7fffffffu;
    LAS3 float* wsf = (LAS3 float*)(lds + L_WS) + c.wid * 64;
#define PARK_PTR(sl_) int pt_ = c.tid; asm volatile("" : "+v"(pt_)); char* pp_ = (char*)park + ((size_t)blockIdx.x * 32 * 512 + (size_t)(sl_) * 16 * 512 + pt_) * 16
#define PARK_STORE(sl_) do { PARK_PTR(sl_); _Pragma("unroll") for (int d_ = 0; d_ < 4; ++d_) _Pragma("unroll") for (int q_ = 0; q_ < 4; ++q_) { \
        *(f32x4*)pp_ = (f32x4){c.o[d_][4 * q_], c.o[d_][4 * q_ + 1], c.o[d_][4 * q_ + 2], c.o[d_][4 * q_ + 3]}; pp_ += 8192; } } while (0)
#define PARK_ADD(sl_) do { PARK_PTR(sl_); _Pragma("unroll") for (int hh_ = 0; hh_ < 2; ++hh_) { f32x4 t_[8]; _Pragma("unroll") for (int e_ = 0; e_ < 8; ++e_) { t_[e_] = *(const f32x4*)pp_; pp_ += 8192; } SBAR(); \
        _Pragma("unroll") for (int e_ = 0; e_ < 8; ++e_) { const int d_ = hh_ * 2 + (e_ >> 2), q_ = e_ & 3; \
        c.o[d_][4 * q_] += t_[e_][0]; c.o[d_][4 * q_ + 1] += t_[e_][1]; c.o[d_][4 * q_ + 2] += t_[e_][2]; c.o[d_][4 * q_ + 3] += t_[e_][3]; } SBAR(); } } while (0)
#define ROW_SCALE(f_) do { if (c.hi == 0) wsf[c.r32] = (f_); LDS_WAIT(); _Pragma("unroll") for (int d_ = 0; d_ < 4; ++d_) _Pragma("unroll") for (int r = 0; r < 16; ++r) c.o[d_][r] *= wsf[crow(r, c.hi)]; } while (0)
#ifndef AREP
#define AREP 0
#endif
    {
        float m_c = -1e30f, l_c = 0.f;
        run_pass<MODE_STAT, 16, 31, false, false>(c, Kc, Vc, 512, 0, ntc, WINF, m_c, l_c, 0.f, 0u, 0u, 0u, 0u);
        const float rl_c = l_c > 0.f ? 1.0f / l_c : 0.f;
#pragma unroll
        for (int d_ = 0; d_ < 4; ++d_) c.o[d_] = f32x16{};
        run_pass<MODE_IMPACC, 16, 31, false, false>(c, Kc, Vc, 512, 0, ntc, WINF, m_c, l_c, rl_c, 0u, 0u, 0u, 0u, ga[0]);
        PARK_STORE(0);
    }
    {
        LAS3 unsigned* selw = (LAS3 unsigned*)(lds + L_SEL);
#pragma unroll 1
        for (int tk = 0; tk < 8; ++tk) {
            const int tok = c.wid * 8 + tk; const LAS3 float* imp = (const LAS3 float*)(lds + L_IMP) + tok * 128;
            const int ja = c.lane, jb = c.lane + 64;
            unsigned ka = __float_as_uint(imp[ja]) + 1u, kb = __float_as_uint(imp[jb]) + 1u;
            ka = (ja == 0 || ja == qt || ja == qt - 1) ? 0xffffffffu : (ja > qt ? 0u : ka);
            kb = (jb == qt || jb == qt - 1) ? 0xffffffffu : (jb > qt ? 0u : kb);
            unsigned T = 0u;
#pragma unroll 1
            for (int bit = 31; bit >= 0; --bit) { const unsigned cand = T | (1u << bit);
                const int cnt = __popcll(__ballot(ka >= cand)) + __popcll(__ballot(kb >= cand));
                T = cnt >= 16 ? cand : T; }
            const int cgt = __popcll(__ballot(ka > T)) + __popcll(__ballot(kb > T)); const int rr = 16 - cgt;
            const unsigned long long ea = __ballot(ka == T), eb = __ballot(kb == T);
            const int ra = __builtin_amdgcn_mbcnt_hi((unsigned)(ea >> 32), __builtin_amdgcn_mbcnt_lo((unsigned)ea, 0u));
            const int rb = __popcll(ea) + (int)__builtin_amdgcn_mbcnt_hi((unsigned)(eb >> 32), __builtin_amdgcn_mbcnt_lo((unsigned)eb, 0u));
            const unsigned long long ba = __ballot(ka > T || (ka == T && ra < rr)), bb = __ballot(kb > T || (kb == T && rb < rr));
            if (c.lane == 0) { selw[tok * 4 + 0] = (unsigned)ba; selw[tok * 4 + 1] = (unsigned)(ba >> 32); selw[tok * 4 + 2] = (unsigned)bb; selw[tok * 4 + 3] = (unsigned)(bb >> 32); }
        }
        LDS_WAIT();
    }
    {
        float m_w = -1e30f, l_w = 0.f; const int jlo = qt >= 8 ? qt - 8 : 0;
#pragma unroll
        for (int d_ = 0; d_ < 4; ++d_) c.o[d_] = f32x16{};
        run_pass<MODE_ONLINE, 1, 0, false, false>(c, Kw, Vw, NP, jlo, qt, 512u, m_w, l_w, 0.f, 0u, 0u, 0u, 0u);
        ROW_SCALE(ga[2] / l_w);
        PARK_STORE(1);
    }
    unsigned zr[64];
    {
        unsigned sm0, sm1, sm2, sm3;
        { const LAS3 unsigned* selw = (const LAS3 unsigned*)(lds + L_SEL) + (c.wid * 8 + (c.r32 >> 2)) * 4; sm0 = selw[0]; sm1 = selw[1]; sm2 = selw[2]; sm3 = selw[3]; }
        float m_s = -1e30f, l_s = 0.f;
#pragma unroll
        for (int d_ = 0; d_ < 4; ++d_) c.o[d_] = f32x16{};
        run_pass<MODE_ONLINE, 1, 0, true, true>(c, Ks, Vs, NP, 0, qt, WINF, m_s, l_s, 0.f, sm0, sm1, sm2, sm3, 1.f, rev);
        { int r32_ = c.r32; asm volatile("" : "+v"(r32_));
          const char* zbase = (const char*)(proj + C_ZA + g * 4 * HD);
#pragma unroll
          for (int r = 0; r < 16; ++r) { const int row = crow(r, c.hi); const int tok = c.t0 + 8 * c.wid + (row >> 2), hd = row & 3; const unsigned zo = (unsigned)(tok * NP + hd * HD + r32_) * 2u;
#pragma unroll
              for (int d0 = 0; d0 < 4; ++d0) zr[r * 4 + d0] = *(const unsigned short*)(zbase + zo + d0 * 64); } }
        SBAR();
        ROW_SCALE(ga[1] / l_s);
        PARK_ADD(0);
        PARK_ADD(1);
    }
#undef PARK_STORE
#undef PARK_ADD
#undef ROW_SCALE
#ifdef NO_EPI
    if (c.o[0][0] == 123.f && c.o[1][1] == 3.f && c.o[2][2] == 1.f && c.o[3][3] == 5.f) oa[0] = 1;
    if (false)
#endif
    {
        const int tw = c.t0 + 8 * c.wid; const bool odd = (c.r32 & 1) != 0;
        char* obase = (char*)(oa + g * 4 * HD);
#pragma unroll
        for (int r = 0; r < 16; ++r) { const int row = crow(r, c.hi); const int tok = tw + (row >> 2), hd = row & 3;
            const unsigned oo = (unsigned)(tok * AW + hd * HD + c.r32) * 2u;
#pragma unroll
            for (int p = 0; p < 2; ++p) { const float za = __uint_as_float(zr[r * 4 + 2 * p] << 16), zb = __uint_as_float(zr[r * 4 + 2 * p + 1] << 16);
                const float a = c.o[2 * p][r] * za * pg8::fast_sigmoid(za), b = c.o[2 * p + 1][r] * zb * pg8::fast_sigmoid(zb);
                const float recv = xor1_f(odd ? a : b);
                const unsigned w = cvtpk(odd ? recv : a, odd ? b : recv);
                *(unsigned*)(obase + (odd ? oo + (2 * p + 1) * 64 - 2u : oo + (2 * p) * 64)) = w; }
        }
    }
    __syncthreads();
}
__device__ __forceinline__ void phase_attn(LAS3 char* lds, const bf16_t* proj, const bf16_t* kc, const bf16_t* vc, bf16_t* oa, float* park, int vcu, int G) {
#pragma unroll 1
    for (int item = vcu; item < 256; item += G) {
        const int g = item >> 6, p = item & 63;
#pragma unroll 1
        for (int s = 0; s < 2; ++s) attn_unit(lds, proj, kc, vc, oa, park, s ? p : 127 - p, g, s != 0);
    }
}
}
__device__ __forceinline__ float gelu_tanh(float x) { const float y = 1.5957691216057308f * (x + 0.044715f * x * x * x); return x * pg8::fast_sigmoid(y); }
__device__ __forceinline__ float silu_f(float x) { return x * pg8::fast_sigmoid(x); }
__device__ __forceinline__ void compress_unit(LAS3 char* lds, const bf16_t* __restrict__ proj, const float* __restrict__ pe, const bf16_t* __restrict__ w1t, const bf16_t* __restrict__ w2t,
                                              bf16_t* __restrict__ outc, int u, int which) {
    int tid_o = threadIdx.x; asm volatile("" : "+v"(tid_o));
    const int tid = tid_o, lane = tid & 63, wid = __builtin_amdgcn_readfirstlane(tid >> 6), r32 = lane & 31, hi = lane >> 5;
    const int i = 8 * u + (r32 >> 2), g = r32 & 3;
    f32x16 acc[4];
#pragma unroll
    for (int nb = 0; nb < 4; ++nb) acc[nb] = f32x16{};
    const bf16_t* abase = proj + C_KV + which * 512 + g * HD + hi * 8;
    const bf16_t* bbase = w1t + (size_t)(wid * 32) * 2048 + lane * 8;
#pragma unroll 1
    for (int lt = 0; lt < 4; ++lt) {
        const int l = wid * 4 + lt; int tokn = 16 * i + l; tokn = tokn < T ? tokn : T - 1;
        const bf16_t* ap = abase + (size_t)tokn * NP; const float* pp = pe + l * HD + hi * 8;
#pragma unroll
        for (int hf = 0; hf < 2; ++hf) {
            u32x4 araw[4]; f32x4 e0[4], e1[4]; bf16x8 bfr[4][4];
#pragma unroll
            for (int k = 0; k < 4; ++k) { const int k8 = hf * 4 + k; araw[k] = *(const u32x4*)(ap + k8 * 16); e0[k] = *(const f32x4*)(pp + k8 * 16); e1[k] = *(const f32x4*)(pp + k8 * 16 + 4);
#pragma unroll
                for (int nb = 0; nb < 4; ++nb) bfr[k][nb] = *(const bf16x8*)(bbase + (size_t)((lt * 8 + k8) * 4 + nb) * 512); }
            __builtin_amdgcn_sched_barrier(0);
#pragma unroll
            for (int k = 0; k < 4; ++k) { const u32x4 raw = araw[k];
                u32x4 aw; aw.x = pk2(pg8::bf_lo(raw.x) + e0[k][0], pg8::bf_hi(raw.x) + e0[k][1]); aw.y = pk2(pg8::bf_lo(raw.y) + e0[k][2], pg8::bf_hi(raw.y) + e0[k][3]);
                aw.z = pk2(pg8::bf_lo(raw.z) + e1[k][0], pg8::bf_hi(raw.z) + e1[k][1]); aw.w = pk2(pg8::bf_lo(raw.w) + e1[k][2], pg8::bf_hi(raw.w) + e1[k][3]);
                const bf16x8 a = *reinterpret_cast<const bf16x8*>(&aw);
#pragma unroll
                for (int nb = 0; nb < 4; ++nb) acc[nb] = __builtin_amdgcn_mfma_f32_32x32x16_bf16(a, bfr[k][nb], acc[nb], 0, 0, 0); }
            __builtin_amdgcn_sched_barrier(0);
        }
    }
    bf16x8 b2[8];
#pragma unroll
    for (int ks = 0; ks < 8; ++ks) b2[ks] = *(const bf16x8*)(w2t + (size_t)((wid & 3) * 32 + r32) * HD + ks * 16 + hi * 8);
    LAS3 float* part = (LAS3 float*)lds + wid * 4096;
#pragma unroll
    for (int nb = 0; nb < 4; ++nb)
#pragma unroll
        for (int r = 0; r < 16; ++r) part[att::crow(r, hi) * 128 + nb * 32 + r32] = acc[nb][r];
    __syncthreads();
    f32x4 s0 = {0.f, 0.f, 0.f, 0.f}, s1 = {0.f, 0.f, 0.f, 0.f};
#pragma unroll
    for (int w = 0; w < 8; ++w) { const LAS3 f32x4* p = (const LAS3 f32x4*)((LAS3 float*)lds + w * 4096 + tid * 8); s0 += p[0]; s1 += p[1]; }
    __syncthreads();
    {
        u32x4 hw; hw.x = pk2(silu_f(s0[0]), silu_f(s0[1])); hw.y = pk2(silu_f(s0[2]), silu_f(s0[3])); hw.z = pk2(silu_f(s1[0]), silu_f(s1[1])); hw.w = pk2(silu_f(s1[2]), silu_f(s1[3]));
        const int row = tid >> 4, col = (tid & 15) * 8;
        *(LAS3 u32x4*)(lds + (row * 136 + col) * 2) = hw;
    }
    __syncthreads();
    if (wid < 4) {
        f32x16 o2 = f32x16{};
#pragma unroll
        for (int ks = 0; ks < 8; ++ks) { const bf16x8 a = *(const LAS3 bf16x8*)(lds + (r32 * 136 + ks * 16 + hi * 8) * 2);
            o2 = __builtin_amdgcn_mfma_f32_32x32x16_bf16(a, b2[ks], o2, 0, 0, 0); }
#pragma unroll
        for (int r = 0; r < 16; ++r) { const int row = att::crow(r, hi); const int ii = 8 * u + (row >> 2), gg = row & 3;
            const float v = ii < NCMP ? o2[r] : 0.f; const float vn = xor1_f(v);
            if ((r32 & 1) == 0) *(unsigned*)(outc + (size_t)(ii * 4 + gg) * HD + wid * 32 + r32) = pk2(v, vn); }
    }
    __syncthreads();
}
#define SWAP32(A_, B_) do { const unsigned a__ = (A_), b__ = (B_); auto r__ = __builtin_amdgcn_permlane32_swap(a__, b__, false, false); const unsigned r0__ = r__[0], r1__ = r__[1]; (A_) = r0__; (B_) = r1__; } while (0)
__device__ __forceinline__ void gmlp_unit(LAS3 char* lds, const bf16_t* __restrict__ proj, const float* __restrict__ sspart, const float* __restrict__ gain, const float* __restrict__ sw, const float* __restrict__ sb,
                                          bf16_t* __restrict__ ob, int ch, int qd) {
    int tid_o = threadIdx.x; asm volatile("" : "+v"(tid_o));
    const int tid = tid_o, lane = tid & 63, wid = __builtin_amdgcn_readfirstlane(tid >> 6), r32 = lane & 31, hi = lane >> 5;
    const int tc0 = ch * 128;
    LAS3 float* rsl = (LAS3 float*)(lds + LDS_RS);
    {   const int vkk = ((tid >> 7) * 8) + ((tid & 31) >> 2), vkey = (vkk & ~0xC) | ((vkk & 4) << 1) | ((vkk & 8) >> 1), vcol = ((tid >> 5) & 3) * 32 + (tid & 3) * 8;
        const unsigned vo0 = (unsigned)(vkey * NP + vcol) * 2u; const unsigned half_step = (unsigned)(32 * NP) * 2u;
#pragma unroll
        for (int gg = 0; gg < 4; ++gg)
#pragma unroll
            for (int kt = 0; kt < 2; ++kt) { const char* vp_ = (const char*)(proj + (size_t)(tc0 + kt * 64) * NP + C_VB + (qd * 4 + gg) * 128); LAS3 char* vd_ = lds + (gg * 2 + kt) * att::SHM + wid * 1024;
                __builtin_amdgcn_global_load_lds((const unsigned*)(vp_ + vo0), (LAS3 unsigned*)vd_, 16, 0, 0);
                __builtin_amdgcn_global_load_lds((const unsigned*)((vp_ + half_step) + vo0), (LAS3 unsigned*)(vd_ + 8192), 16, 0, 0); } }
    if (tid < 128) { const f32x4* sp = (const f32x4*)(sspart + (size_t)(tc0 + tid) * 32); f32x4 s = sp[0];
#pragma unroll
        for (int i = 1; i < 8; ++i) s += sp[i];
        rsl[tid] = 1.0f / sqrtf(((s[0] + s[1]) + (s[2] + s[3])) * (1.0f / BW) + NORM_EPS); }
    VM_WAIT();
    __syncthreads();
    const int gg = wid >> 1, wd = wid & 1, G = qd * 4 + gg, cb = G * 128;
    const int vb1 = (int)(uintptr_t)(lds) + gg * 2 * att::SHM + att::v_rd_base(lane) + wd * 1024;
    f32x4 gn[2][4];
#pragma unroll
    for (int dd = 0; dd < 2; ++dd)
#pragma unroll
        for (int m = 0; m < 4; ++m) gn[dd][m] = *(const f32x4*)(gain + cb + (wd * 2 + dd) * 32 + 8 * m + 4 * hi);
#pragma unroll 1
    for (int pb = 0; pb < 4; ++pb) {
        const int p = pb * 32 + r32; const size_t tok = (size_t)(tc0 + p); const int nks = 2 * pb + 2;
        f32x4 wr0[8], wr1[8];
        const float* wrow = sw + ((size_t)((G * 4 + pb) * 8) * 64 + lane) * 8;
#pragma unroll
        for (int ks = 0; ks < 8; ++ks) if (ks < nks) { wr0[ks] = *(const f32x4*)(wrow + ks * 512); wr1[ks] = *(const f32x4*)(wrow + ks * 512 + 4); }
        const char* ubase = (const char*)(proj + tok * NP + C_UB + cb); const char* zbase = (const char*)(proj + tok * NP + C_ZB + cb); char* obase = (char*)(ob + tok * BW + cb);
        u32x4 uq[4], zq[4];
#pragma unroll
        for (int m = 0; m < 4; ++m) { const int dq = wd * 64 + 8 * m + 32 * hi; uq[m] = *(const u32x4*)(ubase + dq * 2); zq[m] = *(const u32x4*)(zbase + dq * 2); }
        const float bs = sb[G * 128 + p];
        __builtin_amdgcn_sched_barrier(0);
        bf16x8 af[8];
#pragma unroll
        for (int ks = 0; ks < 8; ++ks) { if (ks < nks) { const f32x4 a0 = wr0[ks], a1 = wr1[ks]; const int q0 = ks * 16 + hi * 8;
                const f32x4 r0 = *(const LAS3 f32x4*)(rsl + q0), r1 = *(const LAS3 f32x4*)(rsl + q0 + 4);
                u32x4 w; w.x = pk2(q0 + 0 <= p ? a0[0] * r0[0] : 0.f, q0 + 1 <= p ? a0[1] * r0[1] : 0.f); w.y = pk2(q0 + 2 <= p ? a0[2] * r0[2] : 0.f, q0 + 3 <= p ? a0[3] * r0[3] : 0.f);
                w.z = pk2(q0 + 4 <= p ? a1[0] * r1[0] : 0.f, q0 + 5 <= p ? a1[1] * r1[1] : 0.f); w.w = pk2(q0 + 6 <= p ? a1[2] * r1[2] : 0.f, q0 + 7 <= p ? a1[3] * r1[3] : 0.f);
                af[ks] = *reinterpret_cast<const bf16x8*>(&w); } else af[ks] = bf16x8{}; }
        f32x16 acc[2] = {f32x16{}, f32x16{}};
#define TRRD(dst, off) asm volatile("ds_read_b64_tr_b16 %0, %1 offset:%2" : "=&v"(dst) : "v"(vb1), "i"(off) : "memory")
#define GM_STEP(ks) do { if ((ks) < nks) { s16x4 l0, h0, l1, h1; constexpr int o_ = ((ks) >> 2) * att::SHM + att::v_rd_off(0, (ks) & 3, 0); \
            TRRD(l0, o_); TRRD(h0, o_ + 2048); TRRD(l1, o_ + 512); TRRD(h1, o_ + 512 + 2048); \
            asm volatile("s_waitcnt lgkmcnt(0)" ::: "memory"); __builtin_amdgcn_sched_barrier(0); \
            acc[0] = __builtin_amdgcn_mfma_f32_32x32x16_bf16((bf16x8){l0[0], l0[1], l0[2], l0[3], h0[0], h0[1], h0[2], h0[3]}, af[ks], acc[0], 0, 0, 0); \
            acc[1] = __builtin_amdgcn_mfma_f32_32x32x16_bf16((bf16x8){l1[0], l1[1], l1[2], l1[3], h1[0], h1[1], h1[2], h1[3]}, af[ks], acc[1], 0, 0, 0); } } while (0)
        GM_STEP(0); GM_STEP(1); GM_STEP(2); GM_STEP(3); GM_STEP(4); GM_STEP(5); GM_STEP(6); GM_STEP(7);
#undef GM_STEP
#undef TRRD
#pragma unroll
        for (int m = 0; m < 4; ++m) { SWAP32(uq[m].x, uq[m].z); SWAP32(uq[m].y, uq[m].w); SWAP32(zq[m].x, zq[m].z); SWAP32(zq[m].y, zq[m].w); }
#pragma unroll
        for (int m = 0; m < 4; ++m) { u32x4 ow;
#pragma unroll
            for (int dd = 0; dd < 2; ++dd) { const unsigned ux = dd ? uq[m].z : uq[m].x, uy = dd ? uq[m].w : uq[m].y, zx = dd ? zq[m].z : zq[m].x, zy = dd ? zq[m].w : zq[m].y; const f32x4 g4 = gn[dd][m];
                const float o0 = gelu_tanh(pg8::bf_lo(ux)) * (acc[dd][4 * m + 0] * g4[0] + bs) * silu_f(pg8::bf_lo(zx));
                const float o1 = gelu_tanh(pg8::bf_hi(ux)) * (acc[dd][4 * m + 1] * g4[1] + bs) * silu_f(pg8::bf_hi(zx));
                const float o2 = gelu_tanh(pg8::bf_lo(uy)) * (acc[dd][4 * m + 2] * g4[2] + bs) * silu_f(pg8::bf_lo(zy));
                const float o3 = gelu_tanh(pg8::bf_hi(uy)) * (acc[dd][4 * m + 3] * g4[3] + bs) * silu_f(pg8::bf_hi(zy));
                if (dd == 0) { ow.x = pk2(o0, o1); ow.y = pk2(o2, o3); } else { ow.z = pk2(o0, o1); ow.w = pk2(o2, o3); } }
            SWAP32(ow.x, ow.z); SWAP32(ow.y, ow.w);
            *(u32x4*)(obase + (wd * 64 + 8 * m + 32 * hi) * 2) = ow; }
    }
    __syncthreads();
}
#ifndef N_LAUNCH_MODE
#define N_LAUNCH_MODE 1
#endif
constexpr int NPHASES = 1 + 6 * DEPTH;
#ifndef PHMASK
#define PHMASK 0x7f
#endif
#ifndef REPMASK
#define REPMASK 0
#endif
#define REPS(bit) ((REPMASK & (bit)) ? 2 : 1)
__global__ void __launch_bounds__(NTHREADS, 2) fwd_kernel(Params P) {
    extern __shared__ __attribute__((aligned(16))) unsigned char lds_raw[];
    LAS3 unsigned char* lds = (LAS3 unsigned char*)lds_raw;
    const int tid = threadIdx.x, wave = __builtin_amdgcn_readfirstlane(tid >> 6);
#define lane hw_lane_id()
    const int G = gridDim.x; const int bx = blockIdx.x; const int vcu = (G % 8 == 0) ? (bx % 8) * (G / 8) + bx / 8 : bx;
    const int gw = vcu * NWAVES + wave, NGW = G * NWAVES;
    unsigned char* ws = P.ws;
    if (tid < 16) ((LAS3 unsigned*)(lds + LDS_MISC))[tid] = 0u;
    __syncthreads();
    XcdBarrier bar; bar.bar = (unsigned*)(ws + WS_CTL); bar.x = 0; bar.st = nullptr;
    if (N_LAUNCH_MODE == 1) bar = xcd_barrier_post((unsigned*)(ws + WS_CTL), (volatile LAS unsigned*)(lds + LDS_MISC));
    const int lo = P.ph_lo, hi = P.ph_hi;
#define IN(k) (lo <= (k) && (k) < hi)
#define SEAM(k) do { if (IN(k) && IN((k) + 1)) xcd_barrier(bar); } while (0)
    bf16_t* hbuf = (bf16_t*)(ws + WS_H); bf16_t* proj = (bf16_t*)(ws + WS_PROJ); bf16_t* kc = (bf16_t*)(ws + WS_KC); bf16_t* vc = (bf16_t*)(ws + WS_VC);
    bf16_t* oa = (bf16_t*)(ws + WS_OA); bf16_t* ob = (bf16_t*)(ws + WS_OB); bf16_t* t1 = (bf16_t*)(ws + WS_T1); bf16_t* mg = (bf16_t*)(ws + WS_MG);
    bf16_t* Y = (bf16_t*)(ws + WS_Y); bf16_t* x1 = (bf16_t*)(ws + WS_X1);
    constexpr int NU_PROJ = (T / 256) * (NP / 256);
#pragma unroll 1
    for (int w = 0; w < 2; ++w) {
        const int rem = NU_PROJ % G; const bool tailcu = (rem != 0) && (bx >= rem);
        const bool doit = (w == 0) ? (IN(0) && (PHMASK & 1)) : (IN(1) && tailcu);
        const bool alltail = (rem == 0);
        if (doit) {
            const int lo_ = (w == 0) ? 0 : W_ITEMS - W_TAIL_ITEMS, hi_ = (w == 0) ? (alltail ? W_ITEMS : W_ITEMS - W_TAIL_ITEMS) : W_ITEMS;
            const int gw_ = (w == 0) ? gw : (bx - rem) * NWAVES + wave, ngw_ = (w == 0) ? NGW : (G - rem) * NWAVES;
            for (int rep = 0; rep < REPS(1); ++rep) phase_weights(P, lds, gw_, ngw_, wave, lane, lo_, hi_);
        }
        if (w == 0 && IN(0) && (PHMASK & 1)) {
            for (int i = bx * NTHREADS + tid; i < DEPTH * 16 * 4 * 8 * 64; i += G * NTHREADS) { const int ln = i & 63, ks = (i >> 6) & 7, pbk = (i >> 9) & 3, lg = i >> 11;
                const float* src = P.sgu_w + ((size_t)lg * 128 + 32 * pbk + (ln & 31)) * 128 + 16 * ks + 8 * (ln >> 5);
                float* dst = (float*)(ws + WS_SGW) + (size_t)i * 8;
                const f32x4 a = *(const f32x4*)src, b = *(const f32x4*)(src + 4); *(f32x4*)dst = a; *(f32x4*)(dst + 4) = b; } }
        if (w == 0 && IN(0) && (PHMASK & 1)) for (int rep = 0; rep < REPS(128); ++rep) phase_prenorm(P.x, P.pre_norm, hbuf, gw, NGW, lane);
        __syncthreads();
        {   unsigned bk[8]; float bv[8];
#pragma unroll
            for (int q = 0; q < 8; ++q) { const int i = tid + q * NTHREADS; int dd = (i & 255) - 64; dd = dd < 0 ? 0 : (dd > 127 ? 127 : dd); bk[q] = BUCKET[dd]; }
            __builtin_amdgcn_sched_barrier(0);
#pragma unroll
            for (int q = 0; q < 8; ++q) { const int i = tid + q * NTHREADS; bv[q] = P.rel_bias[bk[q] * 16 + (i >> 8)]; }
            __builtin_amdgcn_sched_barrier(0);
#pragma unroll
            for (int q = 0; q < 8; ++q) ((LAS3 float*)(lds + LDS_BIAS))[tid + q * NTHREADS] = bv[q] * att::LOG2E; }
        __syncthreads();
        if (w == 0) SEAM(0);
    }
#pragma unroll 1
    for (int L = 0; L < DEPTH; ++L) {
        const int pb = 1 + 6 * L;
        constexpr int PN_EARLY = 80, PN_LATE = NP / 256 - PN_EARLY, N_LATE_UNITS = (T / 256) * PN_LATE;
#pragma unroll 1
        for (int half = 0; half < 2; ++half) {
            if (IN(pb + half) && (PHMASK & 2)) for (int rep = 0; rep < REPS(2); ++rep) {
                pg8::Gemm g{hbuf, (const bf16_t*)(ws + WS_WIN + L * SZ_WIN), T, NP, DM, nullptr, nullptr}; pg8::ProjOrder S; S.init2(T, PN_EARLY, PN_LATE, G, bx, half);
                pg8::EpiProj E{proj, NP, (float*)(ws + WS_SS), (bf16_t*)(ws + WS_GATE)};
                pg8::gemm_phase<pg8::EpiProj, pg8::ProjOrder>(lds + LDS_STAGE, g, S, E, nullptr);
            }
            if (half == 0) SEAM(pb);
        }
        if (IN(pb + 1) && (PHMASK & 4)) for (int rep = 0; rep < REPS(4); ++rep) {
#pragma unroll 1
            for (int q = 0; ; ++q) {
                int item;
                if (G == 256) {
                    if (bx >= N_LATE_UNITS) { const int k = bx - N_LATE_UNITS;
                        if (k < 64) { if (q >= 4) break; item = q < 3 ? 3 * k + q : 256 + k; }
                        else { if (q >= 4) break; item = q < 2 ? 192 + 2 * (k - 64) + q : 256 + 64 + 2 * (k - 64) + (q - 2); } }
                    else break;
                }
                else { item = bx + q * G; if (item >= 384) break; }
                if (item < 256) gmlp_unit((LAS3 char*)lds, proj, (const float*)(ws + WS_SS), P.sgu_norm + L * BW, (const float*)(ws + WS_SGW) + (size_t)L * 16 * 128 * 128, P.sgu_b + L * 16 * 128, ob, item >> 2, item & 3);
                else { const int ci = item - 256, which = ci & 1, u = ci >> 1;
                    compress_unit((LAS3 char*)lds, proj, (which ? P.pe_v : P.pe_k) + L * 32 * HD, (const bf16_t*)(ws + WS_W1 + (L * 2 + which) * SZ_W1), (const bf16_t*)(ws + WS_W2 + (L * 2 + which) * SZ_W2), which ? vc : kc, u, which); }
            }
        }
        SEAM(pb + 1);
        if (IN(pb + 2) && (PHMASK & 8)) for (int rep = 0; rep < REPS(8); ++rep) att::phase_attn((LAS3 char*)lds, proj, kc, vc, oa, (float*)(ws + WS_PARK), vcu, G);
        SEAM(pb + 2);
        if (IN(pb + 3) && (PHMASK & 16)) for (int rep = 0; rep < REPS(16); ++rep) {
            pg8::DualOrder S; S.init(T, DM, G, bx);
            pg8::Gemm g{oa, (const bf16_t*)(ws + WS_WA + L * SZ_WAB), T, DM, AW, ob, (const bf16_t*)(ws + WS_WB + L * SZ_WAB)};
            pg8::EpiMerge E{mg, DM, (const bf16_t*)(ws + WS_GATE)};
            pg8::gemm_phase<pg8::EpiMerge, pg8::DualOrder>(lds + LDS_STAGE, g, S, E, nullptr);
        }
        SEAM(pb + 3);
        if (IN(pb + 4) && (PHMASK & 32)) for (int rep = 0; rep < REPS(32); ++rep) {
            pg8::Gemm g{mg, (const bf16_t*)(ws + WS_WO + L * SZ_WO), T, DM, DM, nullptr, nullptr}; pg8::StaticOrder S; S.init(T, DM, G, bx);
            pg8::EpiBf16Plain E{Y, DM};
            pg8::gemm_phase<pg8::EpiBf16Plain, pg8::StaticOrder>(lds + LDS_STAGE, g, S, E, nullptr);
        }
        SEAM(pb + 4);
        if (IN(pb + 5) && (PHMASK & 64)) for (int rep = 0; rep < REPS(64); ++rep) {
            if (L == 0) phase_postnorm<false, true>(Y, P.x, P.post_norm, x1, P.pre_norm + DM, hbuf, true, gw, NGW, lane);
            else phase_postnorm<true, false>(Y, x1, P.post_norm + L * DM, P.out, P.pre_norm, hbuf, false, gw, NGW, lane);
        }
        SEAM(pb + 5);
    }
#undef IN
#undef SEAM
#undef lane
}
extern "C" void kernel_launch(void* const* d_in, const int* in_sizes, int n_in, void* d_out, int out_size, void* d_ws, size_t ws_size, hipStream_t stream) {
    static int grid = 0;
    if (grid == 0) {
        if (n_in != 17 || in_sizes[0] != T * DM || out_size != T * DM || ws_size < WS_END) { fprintf(stderr, "kernel_launch: unexpected shapes (n_in %d, in0 %d, out %d, ws %zu < %zu)\n", n_in, n_in > 0 ? in_sizes[0] : -1, out_size, ws_size, (size_t)WS_END); grid = -1; return; }
        int dev = 0, cus = 0, per_cu = 0;
        if (hipGetDevice(&dev) != hipSuccess || hipDeviceGetAttribute(&cus, hipDeviceAttributeMultiprocessorCount, dev) != hipSuccess) { grid = -1; return; }
        if (hipFuncSetAttribute((const void*)fwd_kernel, hipFuncAttributeMaxDynamicSharedMemorySize, LDS_BYTES) != hipSuccess) { fprintf(stderr, "kernel_launch: hipFuncSetAttribute failed\n"); grid = -1; return; }
        if (hipOccupancyMaxActiveBlocksPerMultiprocessor(&per_cu, (const void*)fwd_kernel, NTHREADS, LDS_BYTES) != hipSuccess || per_cu < 1) { fprintf(stderr, "kernel_launch: occupancy query says %d blocks per CU\n", per_cu); (void)hipGetLastError(); grid = -1; return; }
        grid = cus;
    }
    if (grid < 0) return;
    (void)hipMemsetAsync((char*)d_ws + WS_CTL, 0, CTL_BYTES, stream);
    Params p{};
    p.x = (const float*)d_in[0]; p.rel_bias = (const float*)d_in[1]; p.pre_norm = (const float*)d_in[2]; p.w_in = (const float*)d_in[3];
    p.pe_k = (const float*)d_in[4]; p.w1_k = (const float*)d_in[5]; p.w2_k = (const float*)d_in[6]; p.pe_v = (const float*)d_in[7]; p.w1_v = (const float*)d_in[8]; p.w2_v = (const float*)d_in[9];
    p.w_out_a = (const float*)d_in[10]; p.sgu_norm = (const float*)d_in[11]; p.sgu_w = (const float*)d_in[12]; p.sgu_b = (const float*)d_in[13]; p.w_out_b = (const float*)d_in[14]; p.w_out = (const float*)d_in[15]; p.post_norm = (const float*)d_in[16];
    p.out = (float*)d_out; p.ws = (unsigned char*)d_ws;
#if N_LAUNCH_MODE == 1
    p.ph_lo = 0; p.ph_hi = NPHASES;
    hipLaunchKernelGGL(fwd_kernel, dim3(grid), dim3(NTHREADS), LDS_BYTES, stream, p);
#else
    for (int k = 0; k < NPHASES; ++k) { p.ph_lo = k; p.ph_hi = k + 1; hipLaunchKernelGGL(fwd_kernel, dim3(grid), dim3(NTHREADS), LDS_BYTES, stream, p); }
#endif
}
```
